# Optimizing an MI355X kernel written in HIP

```python
import math
import jax, jax.numpy as jnp
from jax import lax
import numpy as np

D_MODEL = 2048
BATCH = 16
SEQ = 256
DEPTH = 2
DEC_BATCH = 4
DEC_SEQ = 1024
PAST_LEN = 256

GRID_W = 64
HEAD_DIM = 128
EPS = 1e-6
GLA_H = 4
GLA_DK = 64
GLA_DV = 128
GLA_W = GLA_H * GLA_DV
GLA_LR = 16
GLA_GATE_NORM = 16.0
GLA_CHUNK = 64
ATT_HQ = 8
ATT_HKV = 2
ATT_W = ATT_HQ * HEAD_DIM
Q_BLOCK = 128
ROPE_THETA = 10000.0
DN_H = 4
DN_DK = 128
DN_DV = 128
DN_W = DN_H * DN_DV
DN_CONV = 3
DN_CHUNK = 64
MIX_W = GLA_W + ATT_W + DN_W
FF = 4 * D_MODEL
N_MOD = 6
SPLITS = (GLA_H * GLA_DK, GLA_H * GLA_DK, GLA_W, GLA_W, 2 * GLA_LR,
          ATT_HQ * HEAD_DIM, ATT_HKV * HEAD_DIM, ATT_HKV * HEAD_DIM,
          3 * DN_W, DN_W, 2 * DN_H, 2 * DN_H)
IN_COLS = sum(SPLITS)

kernel_name = 'hybrid_gla_gqa_deltanet_diffusion_step'


def _rms_norm(x, g):
    xf = x.astype(jnp.float32)
    y = xf * lax.rsqrt(jnp.mean(xf * xf, axis=-1, keepdims=True) + EPS)
    return (y * g.astype(jnp.float32)).astype(x.dtype)


def _l2norm(x):
    return x * lax.rsqrt(jnp.sum(x * x, axis=-1, keepdims=True) + EPS)


def _flip(t):
    return jnp.flip(t, axis=1)


def _split_cols(p):
    idx = np.cumsum(SPLITS)[:-1].tolist()
    return jnp.split(p, idx, axis=-1)


def _to_chunks(t, C):
    B, L, H = t.shape[:3]
    t = t.reshape((B, L // C, C, H) + t.shape[3:])
    return jnp.moveaxis(t, (1, 3), (0, 2))


def _from_chunks(o):
    o = jnp.moveaxis(o, (0, 2), (1, 3))
    B, n, C, H, d = o.shape
    return o.reshape(B, n * C, H, d)


def _modulation(cond, w_mod, b_mod):
    m = jax.nn.silu(cond) @ w_mod + b_mod
    return [t[:, None, :] for t in jnp.split(m, N_MOD, axis=-1)]


def _gla_scan(q, k, v, la, S0):
    C = GLA_CHUNK
    mask = jnp.tril(jnp.ones((C, C), bool))[:, :, None]

    def step(S, xs):
        qc, kc, vc, gc = xs
        b = jnp.cumsum(gc, axis=-2)
        diff = b[..., :, None, :] - b[..., None, :, :]
        dec = jnp.where(mask, jnp.exp(jnp.where(mask, diff, 0.0)), 0.0)
        A = jnp.einsum('bhid,bhijd,bhjd->bhij', qc, dec, kc)
        o = jnp.einsum('bhij,bhjv->bhiv', A, vc) + jnp.einsum('bhid,bhdv->bhiv', qc * jnp.exp(b), S)
        bl = b[..., -1, :]
        S = S * jnp.exp(bl)[..., None] + jnp.einsum('bhjd,bhjv->bhdv', kc * jnp.exp(bl[..., None, :] - b), vc)
        return S, o

    S, o = lax.scan(step, S0, (_to_chunks(q, C), _to_chunks(k, C), _to_chunks(v, C), _to_chunks(la, C)))
    return _from_chunks(o), S


def _delta_scan(q, k, v, g, beta, S0):
    C = DN_CHUNK
    incl = jnp.tril(jnp.ones((C, C), bool))
    strict = jnp.tril(jnp.ones((C, C), bool), -1)
    dv = v.shape[-1]

    def step(S, xs):
        qc, kc, vc, gc, bc = xs
        G = jnp.cumsum(gc, axis=-1)
        diff = G[..., :, None] - G[..., None, :]
        gam = jnp.where(incl, jnp.exp(jnp.where(incl, diff, 0.0)), 0.0)
        kb = kc * bc[..., None]
        A = jnp.where(strict, jnp.einsum('bhid,bhjd->bhij', kb, kc) * gam, 0.0)
        rhs = jnp.concatenate([vc * bc[..., None], kb * jnp.exp(G)[..., None]], axis=-1)
        sol = lax.linalg.triangular_solve(A, rhs, left_side=True, lower=True, unit_diagonal=True)
        u, w = sol[..., :dv], sol[..., dv:]
        v_new = u - jnp.einsum('bhcd,bhdv->bhcv', w, S)
        att = jnp.einsum('bhid,bhjd->bhij', qc, kc) * gam
        o = jnp.einsum('bhid,bhdv->bhiv', qc * jnp.exp(G)[..., None], S) + jnp.einsum('bhij,bhjv->bhiv', att, v_new)
        Gl = G[..., -1:]
        S = S * jnp.exp(Gl)[..., None] + jnp.einsum('bhjd,bhjv->bhdv', kc * jnp.exp(Gl - G)[..., None], v_new)
        return S, o

    S, o = lax.scan(step, S0, (_to_chunks(q, C), _to_chunks(k, C), _to_chunks(v, C),
                                _to_chunks(g, C), _to_chunks(beta, C)))
    return _from_chunks(o), S


def _gla_mixer(gq, gk, gv, gr, glr, w2, bias, norm_g, S0):
    B, L, _ = gq.shape
    f32 = jnp.float32
    q = gq.reshape(B, L, GLA_H, GLA_DK).astype(f32) * GLA_DK ** -0.5
    k = gk.reshape(B, L, GLA_H, GLA_DK).astype(f32)
    v = gv.reshape(B, L, GLA_H, GLA_DV).astype(f32)
    lr = glr.reshape(B, L, 2, GLA_LR).astype(f32)
    la = jax.nn.log_sigmoid(jnp.einsum('blzr,zrk->blzk', lr, w2.astype(f32)) + bias.astype(f32)) / GLA_GATE_NORM
    la = la.reshape(B, L, 2, GLA_H, GLA_DK)
    S0 = S0.astype(f32)
    of, Sf = _gla_scan(q, k, v, la[:, :, 0], S0[:, 0])
    ob, Sb = _gla_scan(_flip(q), _flip(k), _flip(v), _flip(la[:, :, 1]), S0[:, 1])
    o = of + _flip(ob)
    o = _rms_norm(o, norm_g) * jax.nn.silu(gr.reshape(B, L, GLA_H, GLA_DV).astype(f32))
    return o.reshape(B, L, GLA_W).astype(gq.dtype), jnp.stack([Sf, Sb], axis=1)


def _axial_rope(x):
    B, L, H, hd = x.shape
    f32 = jnp.float32
    n_rows = L // GRID_W
    row = jnp.repeat(jnp.arange(n_rows), GRID_W)
    col = jnp.tile(jnp.arange(GRID_W), n_rows)
    half = hd // 2
    inv = ROPE_THETA ** (-jnp.arange(0, half, 2, dtype=f32) / half)

    def rot(xa, pos):
        ang = pos.astype(f32)[:, None] * inv
        cos = jnp.cos(ang)[None, :, None, :]
        sin = jnp.sin(ang)[None, :, None, :]
        x1, x2 = jnp.split(xa.astype(f32), 2, axis=-1)
        return jnp.concatenate([x1 * cos - x2 * sin, x2 * cos + x1 * sin], axis=-1)

    return jnp.concatenate([rot(x[..., :half], row), rot(x[..., half:], col)], axis=-1).astype(x.dtype)


def _attention(q, k, v):
    B, L, HQ, hd = q.shape
    hkv = k.shape[2]
    G = HQ // hkv
    nb = L // Q_BLOCK
    qb = jnp.moveaxis(q.reshape(B, nb, Q_BLOCK, hkv, G, hd), 1, 0)
    scale = hd ** -0.5

    def block(qi):
        s = jnp.einsum('bqhgd,bkhd->bhgqk', qi, k).astype(jnp.float32) * scale
        p = jax.nn.softmax(s, axis=-1)
        return jnp.einsum('bhgqk,bkhd->bqhgd', p.astype(v.dtype), v)

    o = lax.map(block, qb)
    return jnp.moveaxis(o, 0, 1).reshape(B, L, HQ, hd)


def _gqa_mixer(aq, ak, av, q_g, k_g, kv_ctx):
    B, L, _ = aq.shape
    q = _rms_norm(aq.reshape(B, L, ATT_HQ, HEAD_DIM), q_g)
    k = _rms_norm(ak.reshape(B, L, ATT_HKV, HEAD_DIM), k_g)
    v = av.reshape(B, L, ATT_HKV, HEAD_DIM)
    if kv_ctx is None:
        o = _attention(q, k, v)
    else:
        k_ctx, v_ctx = kv_ctx
        k_all = jnp.concatenate([k_ctx.astype(k.dtype), _axial_rope(k)], axis=1)
        v_all = jnp.concatenate([v_ctx.astype(v.dtype), v], axis=1)
        o = _attention(_axial_rope(q), k_all, v_all)
    return o.reshape(B, L, ATT_W), k, v


def _short_conv(x, w):
    Ch = x.shape[-1]
    y = lax.conv_general_dilated(x, w[:, None, :], window_strides=(1,),
                                 padding=[(DN_CONV // 2, DN_CONV // 2)],
                                 dimension_numbers=('NWC', 'WIO', 'NWC'),
                                 feature_group_count=Ch)
    return jax.nn.silu(y)


def _deltanet_mixer(dqkv, dz, da, db, conv_w, a_log, dt_bias, norm_g, S0):
    B, L, _ = dqkv.shape
    f32 = jnp.float32
    qkv = _short_conv(dqkv.astype(f32), conv_w.astype(f32))
    q, k, v = jnp.split(qkv, 3, axis=-1)
    q = _l2norm(q.reshape(B, L, DN_H, DN_DK)) * DN_DK ** -0.5
    k = _l2norm(k.reshape(B, L, DN_H, DN_DK))
    v = v.reshape(B, L, DN_H, DN_DV)
    a = da.reshape(B, L, 2, DN_H).astype(f32)
    b = db.reshape(B, L, 2, DN_H).astype(f32)
    g = -jnp.exp(a_log.astype(f32)) * jax.nn.softplus(a + dt_bias.astype(f32))
    beta = jax.nn.sigmoid(b)
    S0 = S0.astype(f32)
    of, Sf = _delta_scan(q, k, v, g[:, :, 0], beta[:, :, 0], S0[:, 0])
    ob, Sb = _delta_scan(_flip(q), _flip(k), _flip(v), _flip(g[:, :, 1]), _flip(beta[:, :, 1]), S0[:, 1])
    o = of + _flip(ob)
    o = _rms_norm(o, norm_g) * jax.nn.silu(dz.reshape(B, L, DN_H, DN_DV).astype(f32))
    return o.reshape(B, L, DN_W).astype(dqkv.dtype), jnp.stack([Sf, Sb], axis=1)


def _layer(x, mods, lw, ctx):
    shift1, scale1, gate1, shift2, scale2, gate2 = mods
    B, L, _ = x.shape
    h = _rms_norm(x, lw['norm1_g']) * (1.0 + scale1) + shift1
    gq, gk, gv, gr, glr, aq, ak, av, dqkv, dz, da, db = _split_cols(h @ lw['w_in'])
    if ctx is None:
        kv_ctx = None
        s_gla0 = jnp.zeros((B, 2, GLA_H, GLA_DK, GLA_DV), jnp.float32)
        s_dn0 = jnp.zeros((B, 2, DN_H, DN_DK, DN_DV), jnp.float32)
    else:
        k_ctx, v_ctx, s_gla0, s_dn0 = ctx
        kv_ctx = (k_ctx, v_ctx)
    o_gla, s_gla = _gla_mixer(gq, gk, gv, gr, glr, lw['gla_w2'], lw['gla_b'], lw['gla_norm_g'], s_gla0)
    o_att, k, v = _gqa_mixer(aq, ak, av, lw['q_norm_g'], lw['k_norm_g'], kv_ctx)
    o_dn, s_dn = _deltanet_mixer(dqkv, dz, da, db, lw['dn_conv'], lw['dn_a_log'], lw['dn_dt_bias'],
                                 lw['dn_norm_g'], s_dn0)
    mix = jnp.concatenate([o_gla, o_att, o_dn], axis=-1) @ lw['w_out']
    x = x + gate1 * mix
    h = _rms_norm(x, lw['norm2_g']) * (1.0 + scale2) + shift2
    ff = jnp.square(jax.nn.relu(h @ lw['w_ff1'])) @ lw['w_ff2']
    x = x + gate2 * ff
    return x, (k, v, s_gla.astype(x.dtype), s_dn.astype(x.dtype))


def setup_inputs(seed: int = 0) -> dict:
    key = jax.random.key(seed)
    ks = jax.random.split(key, 32)
    f32 = jnp.float32

    def nrm(k, shape, s):
        return jax.random.normal(k, shape, f32) * s

    dt = jnp.exp(jax.random.uniform(ks[20], (DEPTH, 2, DN_H), f32, math.log(1e-3), math.log(1e-1)))
    return {
        'x_prompt': nrm(ks[0], (BATCH, SEQ, D_MODEL), 1.0),
        'x_sample': nrm(ks[1], (DEC_BATCH, DEC_SEQ, D_MODEL), 1.0),
        'cache_k': nrm(ks[2], (DEC_BATCH, DEPTH, PAST_LEN, ATT_HKV, HEAD_DIM), 1.0),
        'cache_v': nrm(ks[3], (DEC_BATCH, DEPTH, PAST_LEN, ATT_HKV, HEAD_DIM), 1.0),
        'state_gla': nrm(ks[4], (DEC_BATCH, DEPTH, 2, GLA_H, GLA_DK, GLA_DV), 1.0),
        'state_dn': nrm(ks[5], (DEC_BATCH, DEPTH, 2, DN_H, DN_DK, DN_DV), 0.3),
        'c': nrm(ks[6], (DEC_BATCH, D_MODEL), 1.0),
        'c_ctx': nrm(ks[7], (D_MODEL,), 1.0),
        'norm1_g': 1.0 + nrm(ks[8], (DEPTH, D_MODEL), 0.02),
        'norm2_g': 1.0 + nrm(ks[9], (DEPTH, D_MODEL), 0.02),
        'w_mod': nrm(ks[10], (DEPTH, D_MODEL, N_MOD * D_MODEL), 0.5 * D_MODEL ** -0.5),
        'b_mod': nrm(ks[11], (DEPTH, N_MOD * D_MODEL), 0.02),
        'w_in': nrm(ks[12], (DEPTH, D_MODEL, IN_COLS), D_MODEL ** -0.5),
        'gla_w2': nrm(ks[13], (DEPTH, 2, GLA_LR, GLA_H * GLA_DK), GLA_LR ** -0.5),
        'gla_b': nrm(ks[14], (DEPTH, 2, GLA_H * GLA_DK), 0.1),
        'gla_norm_g': 1.0 + nrm(ks[15], (DEPTH, GLA_DV), 0.02),
        'q_norm_g': 1.0 + nrm(ks[16], (DEPTH, HEAD_DIM), 0.02),
        'k_norm_g': 1.0 + nrm(ks[17], (DEPTH, HEAD_DIM), 0.02),
        'dn_conv': nrm(ks[18], (DEPTH, DN_CONV, 3 * DN_W), DN_CONV ** -0.5),
        'dn_a_log': jnp.log(jax.random.uniform(ks[19], (DEPTH, 2, DN_H), f32, 1.0, 16.0)),
        'dn_dt_bias': dt + jnp.log(-jnp.expm1(-dt)),
        'dn_norm_g': 1.0 + nrm(ks[21], (DEPTH, DN_DV), 0.02),
        'w_out': nrm(ks[22], (DEPTH, MIX_W, D_MODEL), MIX_W ** -0.5),
        'w_ff1': nrm(ks[23], (DEPTH, D_MODEL, FF), D_MODEL ** -0.5),
        'w_ff2': nrm(ks[24], (DEPTH, FF, D_MODEL), FF ** -0.5),
    }


def reference(x_prompt, x_sample, cache_k, cache_v, state_gla, state_dn, c, c_ctx,
              norm1_g, norm2_g, w_mod, b_mod, w_in, gla_w2, gla_b, gla_norm_g,
              q_norm_g, k_norm_g, dn_conv, dn_a_log, dn_dt_bias, dn_norm_g,
              w_out, w_ff1, w_ff2):
    stacked = dict(norm1_g=norm1_g, norm2_g=norm2_g, w_in=w_in, gla_w2=gla_w2, gla_b=gla_b,
                   gla_norm_g=gla_norm_g, q_norm_g=q_norm_g, k_norm_g=k_norm_g, dn_conv=dn_conv,
                   dn_a_log=dn_a_log, dn_dt_bias=dn_dt_bias, dn_norm_g=dn_norm_g,
                   w_out=w_out, w_ff1=w_ff1, w_ff2=w_ff2)

    x = x_prompt
    ks, vs, sgs, sds = [], [], [], []
    for l in range(DEPTH):
        lw = {n: a[l] for n, a in stacked.items()}
        mods = _modulation(c_ctx[None, :], w_mod[l], b_mod[l])
        x, (k, v, s_gla, s_dn) = _layer(x, mods, lw, None)
        ks.append(k)
        vs.append(v)
        sgs.append(s_gla)
        sds.append(s_dn)
    y_prompt = x
    new_cache_k = jnp.stack(ks, axis=1)
    new_cache_v = jnp.stack(vs, axis=1)
    new_state_gla = jnp.stack(sgs, axis=1)
    new_state_dn = jnp.stack(sds, axis=1)

    x = x_sample
    for l in range(DEPTH):
        lw = {n: a[l] for n, a in stacked.items()}
        mods = _modulation(c, w_mod[l], b_mod[l])
        ctx = (cache_k[:, l], cache_v[:, l], state_gla[:, l], state_dn[:, l])
        x, _ = _layer(x, mods, lw, ctx)
    y_sample = x
    return (y_prompt, y_sample, new_cache_k, new_cache_v, new_state_gla, new_state_dn)
```

```cpp
#include <hip/hip_runtime.h>
#include <hip/hip_cooperative_groups.h>
#include <cstdio>
#include <cstdint>
namespace cg = cooperative_groups;
namespace pg8 {
#define PG8_LAS __attribute__((address_space(3)))
typedef unsigned short bf16_t;
typedef short bf16x8 __attribute__((ext_vector_type(8)));
typedef float f32x4 __attribute__((ext_vector_type(4)));
typedef unsigned u32x4 __attribute__((ext_vector_type(4)));
constexpr int BM = 256, BK = 64, HALF = 128, HTB = HALF * BK * 2  , STAGE_BYTES = 8 * HTB, NXCD = 8, WGM = 8;

__host__ __device__ __forceinline__ int lds_byte(int r, int c) { const int st = (r >> 4) * 2 + (c >> 5), rr = r & 15, cc = c & 31, ob = rr * 64 + cc * 2; return st * 1024 + (ob ^ (((ob >> 9) & 1) << 5)); }
__host__ __device__ __forceinline__ void stage_rc(int b, int& R, int& C) { const int st = b / 1024, sb = b % 1024, swz = sb ^ (((sb >> 9) & 1) << 5); R = (st >> 1) * 16 + swz / 64; C = (st & 1) * 32 + (swz % 64) / 2; }
__host__ __device__ __forceinline__ int perm32(int rho) { const int n = rho >> 4, i = rho & 15; return 8 * (i >> 2) + 4 * n + (i & 3); }

struct Unit { int pm, pn; };
struct Gemm { const bf16_t* A; const bf16_t* Bt; int M, N, K; };

struct StaticOrder {
    int nM, nN, nwg, G, c;
    __host__ __device__ void init(int M, int N, int G_, int c_) { nM = M / BM; nN = N / BM; nwg = nM * nN; G = G_; c = c_; }
    __host__ __device__ bool next(int i, Unit& u) const {
        const long L = (long)i * G + c; if (L >= nwg) return false;
        int wgid = (int)L; { const int q = nwg / NXCD, r = nwg % NXCD, xcd = wgid % NXCD, off = wgid / NXCD; wgid = (xcd < r ? xcd * (q + 1) : r * (q + 1) + (xcd - r) * q) + off; }
        const int nig = WGM * nN, gid = wgid / nig, fm = gid * WGM, gsz = (nM - fm) < WGM ? (nM - fm) : WGM;
        u.pm = fm + ((wgid % nig) % gsz); u.pn = (wgid % nig) / gsz; return true;
    }
    __device__ __forceinline__ void a_ready(const Unit&) const {}
    __device__ __forceinline__ void done(const Unit&) const {}
};

__device__ __forceinline__ unsigned cvt_pk_bf16(float lo, float hi) { unsigned r; asm volatile("v_cvt_pk_bf16_f32 %0, %1, %2" : "=v"(r) : "v"(lo), "v"(hi)); return r; }
struct EpiP {
    static constexpr bool PERM = true, AFTER_DRAIN = false;
    bf16_t* P; float* G;
    __device__ __forceinline__ void operator()(const f32x4 (&acc)[2][2][4][2], const Unit& u, int wr, int wc, int fr, int fq) const {
        const int row0 = u.pm * BM + wr * 64 + fr;
        if (u.pn < 20) {
            const int col0 = u.pn * BM + wc * 32 + 8 * fq;
#pragma unroll
            for (int ai = 0; ai < 2; ++ai)
#pragma unroll
                for (int m = 0; m < 4; ++m) { bf16_t* rowp = P + (size_t)(row0 + ai * HALF + m * 16) * 5120 + col0;
#pragma unroll
                    for (int bj = 0; bj < 2; ++bj) { const f32x4 v0 = acc[ai][bj][m][0], v1 = acc[ai][bj][m][1];
                        u32x4 w; w.x = cvt_pk_bf16(v0[0], v0[1]); w.y = cvt_pk_bf16(v0[2], v0[3]); w.z = cvt_pk_bf16(v1[0], v1[1]); w.w = cvt_pk_bf16(v1[2], v1[3]);
                        *(u32x4*)(rowp + bj * HALF) = w; } }
        } else if (wc < 2) {
            const int col0 = wc * 32 + 8 * fq;
#pragma unroll
            for (int ai = 0; ai < 2; ++ai)
#pragma unroll
                for (int m = 0; m < 4; ++m) { float* rowp = G + (size_t)(row0 + ai * HALF + m * 16) * 64 + col0;
                    *(f32x4*)(rowp) = acc[ai][0][m][0]; *(f32x4*)(rowp + 4) = acc[ai][0][m][1]; }
        }
    }
};
struct EpiRes {
    static constexpr bool PERM = false, AFTER_DRAIN = false;
    const float* base0; const float* base1; float* out; const float* gate;
    __device__ __forceinline__ void operator()(const f32x4 (&acc)[2][2][4][2], const Unit& u, int wr, int wc, int fr, int fq) const {
        const int row0 = u.pm * BM + wr * 64 + fr; const int col0 = u.pn * BM + wc * 32 + 4 * fq;
        const int cond = (u.pm < 16) ? 0 : 1 + ((u.pm - 16) >> 2);
        const float* base = (u.pm < 16) ? base0 : base1;
        const float* gp = gate + (size_t)cond * 6 * 2048 + col0;
        f32x4 gv[2][2];
#pragma unroll
        for (int bj = 0; bj < 2; ++bj)
#pragma unroll
            for (int n = 0; n < 2; ++n) gv[bj][n] = *(const f32x4*)(gp + bj * HALF + n * 16);
#pragma unroll
        for (int ai = 0; ai < 2; ++ai)
#pragma unroll
            for (int m = 0; m < 4; ++m) { const size_t off = (size_t)(row0 + ai * HALF + m * 16) * 2048 + col0;
#pragma unroll
                for (int bj = 0; bj < 2; ++bj)
#pragma unroll
                    for (int n = 0; n < 2; ++n) { const f32x4 b = *(const f32x4*)(base + off + bj * HALF + n * 16);
                        *(f32x4*)(out + off + bj * HALF + n * 16) = b + gv[bj][n] * acc[ai][bj][m][n]; } }
    }
};
struct EpiSqRelu {
    static constexpr bool PERM = true, AFTER_DRAIN = false;
    bf16_t* O; int ldc;
    __device__ __forceinline__ void operator()(const f32x4 (&acc)[2][2][4][2], const Unit& u, int wr, int wc, int fr, int fq) const {
        const int row0 = u.pm * BM + wr * 64 + fr; const int col0 = u.pn * BM + wc * 32 + 8 * fq;
#pragma unroll
        for (int ai = 0; ai < 2; ++ai)
#pragma unroll
            for (int m = 0; m < 4; ++m) { bf16_t* rowp = O + (size_t)(row0 + ai * HALF + m * 16) * ldc + col0;
#pragma unroll
                for (int bj = 0; bj < 2; ++bj) { f32x4 v0 = acc[ai][bj][m][0], v1 = acc[ai][bj][m][1];
#pragma unroll
                    for (int e = 0; e < 4; ++e) { const float a = fmaxf(v0[e], 0.f), b = fmaxf(v1[e], 0.f); v0[e] = a * a; v1[e] = b * b; }
                    u32x4 w; w.x = cvt_pk_bf16(v0[0], v0[1]); w.y = cvt_pk_bf16(v0[2], v0[3]); w.z = cvt_pk_bf16(v1[0], v1[1]); w.w = cvt_pk_bf16(v1[2], v1[3]);
                    *(u32x4*)(rowp + bj * HALF) = w; } }
    }
};

template <class Epi, class Sched, bool ALIGN_EPI = false, bool SP2 = false>
__device__ __forceinline__ void gemm_phase(PG8_LAS unsigned char* lds, const Gemm g, const Sched& S, const Epi& E) {
    int tid = threadIdx.x; asm volatile("" : "+v"(tid)); const int wid = __builtin_amdgcn_readfirstlane(tid >> 6), lane = tid & 63, wr = wid >> 2, wc = wid & 3, fr = lane & 15, fq = lane >> 4;
    const int K = g.K, nt = K / BK;
    unsigned voffA[2], voffB[2];
#pragma unroll
    for (int i = 0; i < 2; ++i) { int R, C; stage_rc(tid * 16 + i * 8192, R, C); const int Rb = Epi::PERM ? ((R & ~31) + perm32(R & 31)) : R;
        voffA[i] = (unsigned)(R * K + C) * 2u; voffB[i] = (unsigned)(Rb * K + C) * 2u; }
    const size_t kstep = (size_t)(BK * 2);
    const size_t hstep = (size_t)HALF * K * 2;
    const size_t tstep = 2 * hstep;
    const unsigned ldsw = (unsigned)wid * 1024u;
    const int aoff = lds_byte(wr * 64 + fr, fq * 8), boff = lds_byte(wc * 32 + fr, fq * 8);
#define PG8_SA(b, h) (((b) * 2 + (h)) * HTB)
#define PG8_SB(b, h) ((4 + (b) * 2 + (h)) * HTB)
#define PG8_STAGE(bufoff, gbase, voff) do { _Pragma("unroll") for (int _i = 0; _i < 2; ++_i) \
        __builtin_amdgcn_global_load_lds((const unsigned*)((const char*)(gbase) + (voff)[_i]), (PG8_LAS unsigned*)(lds + (bufoff) + ldsw + _i * 8192), 16, 0, 0); } while (0)
#define PG8_LDA(dst, b, h) do { _Pragma("unroll") for (int m = 0; m < 4; ++m) _Pragma("unroll") for (int k = 0; k < 2; ++k) dst[m][k] = *(const PG8_LAS bf16x8*)(lds + PG8_SA(b, h) + aoff + m * 2048 + k * 1024); } while (0)
#define PG8_LDB(dst, b, h) do { _Pragma("unroll") for (int n = 0; n < 2; ++n) _Pragma("unroll") for (int k = 0; k < 2; ++k) dst[n][k] = *(const PG8_LAS bf16x8*)(lds + PG8_SB(b, h) + boff + n * 2048 + k * 1024); } while (0)
#define PG8_MMA(ai, bj, At, Bt) do { __builtin_amdgcn_s_setprio(1); _Pragma("unroll") for (int m = 0; m < 4; ++m) _Pragma("unroll") for (int n = 0; n < 2; ++n) _Pragma("unroll") for (int k = 0; k < 2; ++k) \
        acc[ai][bj][m][n] = __builtin_amdgcn_mfma_f32_16x16x32_bf16(Bt[n][k], At[m][k], acc[ai][bj][m][n], 0, 0, 0); __builtin_amdgcn_s_setprio(0); } while (0)
#define PG8_WAIT_V(n) asm volatile("s_waitcnt vmcnt(" #n ")" ::: "memory")
#define PG8_WAIT_L(n) asm volatile("s_waitcnt lgkmcnt(" #n ")" ::: "memory")
#define PG8_BAR __builtin_amdgcn_s_barrier()
#define PG8_SCHED __builtin_amdgcn_sched_barrier(0)
    Unit cur, nxt; int ui = 0;
    if (!S.next(0, cur)) return;
    f32x4 acc[2][2][4][2];
#pragma unroll
    for (int a = 0; a < 2; ++a)
#pragma unroll
        for (int b = 0; b < 2; ++b)
#pragma unroll
            for (int m = 0; m < 4; ++m)
#pragma unroll
                for (int n = 0; n < 2; ++n) acc[a][b][m][n] = (f32x4){0.f, 0.f, 0.f, 0.f};
    bf16x8 At[4][2], B0[2][2], B1[2][2];
    const char* cA = (const char*)g.A + (size_t)cur.pm * tstep; const char* cB = (const char*)g.Bt + (size_t)cur.pn * tstep;
    S.a_ready(cur);
    if constexpr (SP2) {
        PG8_STAGE(PG8_SB(0, 0), cB, voffB); PG8_STAGE(PG8_SB(0, 1), cB + hstep, voffB); PG8_STAGE(PG8_SA(0, 0), cA, voffA); PG8_STAGE(PG8_SA(0, 1), cA + hstep, voffA);
        if (wr == 1) PG8_BAR;
        PG8_WAIT_V(2); PG8_BAR;
        PG8_STAGE(PG8_SB(1, 0), cB + kstep, voffB); PG8_STAGE(PG8_SA(1, 0), cA + kstep, voffA); PG8_STAGE(PG8_SB(1, 1), cB + hstep + kstep, voffB);
        PG8_WAIT_V(6); PG8_BAR;
    } else {
        PG8_STAGE(PG8_SB(0, 0), cB, voffB); PG8_STAGE(PG8_SA(0, 0), cA, voffA); PG8_STAGE(PG8_SB(0, 1), cB + hstep, voffB); PG8_STAGE(PG8_SA(0, 1), cA + hstep, voffA);
        if (wr == 1) PG8_BAR;
        PG8_WAIT_V(4); PG8_BAR;
        PG8_STAGE(PG8_SB(1, 0), cB + kstep, voffB); PG8_STAGE(PG8_SA(1, 0), cA + kstep, voffA); PG8_STAGE(PG8_SB(1, 1), cB + hstep + kstep, voffB);
        PG8_WAIT_V(6); PG8_BAR;
    }
    for (;;) {
        const bool has_next = S.next(ui + 1, nxt);
        const char* nA = has_next ? (const char*)g.A + (size_t)nxt.pm * tstep : cA; const char* nB = has_next ? (const char*)g.Bt + (size_t)nxt.pn * tstep : cB;
        for (int t = 0; t < nt; t += 2) {
            const bool last = (t == nt - 2);
            const char* a1 = cA + (size_t)(t + 1) * kstep;
            const char* a2 = last ? nA : cA + (size_t)(t + 2) * kstep; const char* b2 = last ? nB : cB + (size_t)(t + 2) * kstep;
            const char* a3 = a2 + kstep; const char* b3 = b2 + kstep;
            if (last && has_next) S.a_ready(nxt);
            if constexpr (SP2) {
            PG8_LDB(B0, 0, 0); PG8_LDB(B1, 0, 1); PG8_SCHED; PG8_LDA(At, 0, 0); PG8_STAGE(PG8_SA(1, 1), a1 + hstep, voffA);
            PG8_WAIT_V(8); PG8_WAIT_L(0); PG8_BAR; PG8_MMA(0, 0, At, B0); PG8_MMA(0, 1, At, B1); PG8_BAR; PG8_SCHED;
            PG8_LDA(At, 0, 1); PG8_STAGE(PG8_SB(0, 0), b2, voffB); PG8_STAGE(PG8_SB(0, 1), b2 + hstep, voffB); PG8_STAGE(PG8_SA(0, 0), a2, voffA);
            PG8_WAIT_V(8); PG8_WAIT_L(0); PG8_BAR; PG8_MMA(1, 0, At, B0); PG8_MMA(1, 1, At, B1); PG8_BAR; PG8_SCHED;
            PG8_LDB(B0, 1, 0); PG8_LDB(B1, 1, 1); PG8_SCHED; PG8_LDA(At, 1, 0); PG8_STAGE(PG8_SA(0, 1), a2 + hstep, voffA);
            PG8_WAIT_V(8); PG8_WAIT_L(0); PG8_BAR; PG8_MMA(0, 0, At, B0); PG8_MMA(0, 1, At, B1); PG8_BAR; PG8_SCHED;
            PG8_LDA(At, 1, 1); PG8_STAGE(PG8_SB(1, 0), b3, voffB); PG8_STAGE(PG8_SB(1, 1), b3 + hstep, voffB); PG8_STAGE(PG8_SA(1, 0), a3, voffA);
            PG8_WAIT_V(8); PG8_WAIT_L(0); PG8_BAR; PG8_MMA(1, 0, At, B0); PG8_MMA(1, 1, At, B1); PG8_BAR; PG8_SCHED;
            } else {
            PG8_LDB(B0, 0, 0); PG8_SCHED; PG8_LDA(At, 0, 0); PG8_STAGE(PG8_SA(1, 1), a1 + hstep, voffA);
            PG8_WAIT_L(8); PG8_BAR; PG8_WAIT_L(0); PG8_MMA(0, 0, At, B0); PG8_BAR; PG8_SCHED;
            PG8_LDB(B1, 0, 1); PG8_STAGE(PG8_SB(0, 0), b2, voffB);
            PG8_BAR; PG8_WAIT_L(0); PG8_MMA(0, 1, At, B1); PG8_BAR;
            PG8_LDA(At, 0, 1); PG8_STAGE(PG8_SA(0, 0), a2, voffA);
            PG8_BAR; PG8_WAIT_L(0); PG8_MMA(1, 0, At, B0); PG8_BAR; PG8_SCHED;
            PG8_STAGE(PG8_SB(0, 1), b2 + hstep, voffB);
            PG8_WAIT_V(6); PG8_BAR; PG8_MMA(1, 1, At, B1); PG8_BAR;
            PG8_LDB(B0, 1, 0); PG8_SCHED; PG8_LDA(At, 1, 0); PG8_STAGE(PG8_SA(0, 1), a2 + hstep, voffA);
            PG8_WAIT_L(8); PG8_BAR; PG8_WAIT_L(0); PG8_MMA(0, 0, At, B0); PG8_BAR; PG8_SCHED;
            PG8_LDB(B1, 1, 1); PG8_STAGE(PG8_SB(1, 0), b3, voffB);
            PG8_BAR; PG8_WAIT_L(0); PG8_MMA(0, 1, At, B1); PG8_BAR;
            PG8_LDA(At, 1, 1); PG8_STAGE(PG8_SA(1, 0), a3, voffA);
            PG8_BAR; PG8_WAIT_L(0); PG8_MMA(1, 0, At, B0); PG8_BAR; PG8_SCHED;
            PG8_STAGE(PG8_SB(1, 1), b3 + hstep, voffB);
            PG8_WAIT_V(6); PG8_BAR; PG8_MMA(1, 1, At, B1); PG8_BAR;
            }
        }
        if constexpr (ALIGN_EPI) { if (wr == 0) PG8_BAR; }
        if constexpr (!Epi::AFTER_DRAIN) { E(acc, cur, wr, wc, fr, fq); S.done(cur); }
        if (!has_next) break;
#pragma unroll
        for (int a = 0; a < 2; ++a)
#pragma unroll
            for (int b = 0; b < 2; ++b)
#pragma unroll
                for (int m = 0; m < 4; ++m)
#pragma unroll
                    for (int n = 0; n < 2; ++n) acc[a][b][m][n] = (f32x4){0.f, 0.f, 0.f, 0.f};
        cur = nxt; cA = nA; cB = nB; ++ui;
        if constexpr (ALIGN_EPI) { if (wr == 1) PG8_BAR; }
    }
    PG8_WAIT_V(0);
    if constexpr (!ALIGN_EPI) { if (wr == 0) PG8_BAR; }
    PG8_BAR;
    if constexpr (Epi::AFTER_DRAIN) { E.fused(acc, cur, wr, wc, fr, fq, lds, wid, lane); S.done(cur); }
#undef PG8_SA
#undef PG8_SB
#undef PG8_STAGE
#undef PG8_LDA
#undef PG8_LDB
#undef PG8_MMA
#undef PG8_WAIT_V
#undef PG8_WAIT_L
#undef PG8_BAR
#undef PG8_SCHED
}
}
namespace att {
typedef unsigned short bf16;
constexpr int   D = 128, NW = 8, QBLK = 32, KVBLK = 64;
constexpr float SCALE = 0.088388347648318440f;
constexpr float THR = 8.f;
constexpr int SDEPTH = 2;
constexpr size_t SHM_V = KVBLK * D * 2, SHM_K = KVBLK * D * 2, SHM_ATTN = 2 * SHM_V + 2 * SHM_K + NW * 64 * 4;
__device__ __forceinline__ bf16 f2bf_s(float f) { unsigned u = __builtin_bit_cast(unsigned, f); return (bf16)((u + 0x7fffu + ((u >> 16) & 1u)) >> 16); }
using bf16x8 = __attribute__((ext_vector_type(8))) short;
using s16x4  = __attribute__((ext_vector_type(4))) short;
using f32x16 = __attribute__((ext_vector_type(16))) float;
using f32x8  = __attribute__((ext_vector_type(8))) float;
using u32x4  = __attribute__((ext_vector_type(4))) unsigned;
#define KSWZ(row, colB) ((row) * 256 + ((colB) ^ (((row) & 7) << 4)))
#define SBAR() __builtin_amdgcn_sched_barrier(0)
__device__ __forceinline__ int crow(int r, int hi) { return (r & 3) + 8 * (r >> 2) + 4 * hi; }
__device__ __forceinline__ unsigned cvtpk(float lo, float hi) {
  unsigned r; asm volatile("v_cvt_pk_bf16_f32 %0, %1, %2" : "=v"(r) : "v"(lo), "v"(hi)); return r;
}
__device__ __forceinline__ void partialSM(f32x16& p0, f32x16& p1, float& m_reg, float& mn, float& alpha) {
  constexpr float C = SCALE * 1.4426950408889634f;
  float pmax = p0[0]; for (int r = 1; r < 16; ++r) pmax = fmaxf(pmax, p0[r]); for (int r = 0; r < 16; ++r) pmax = fmaxf(pmax, p1[r]);
  { auto rr = __builtin_amdgcn_permlane32_swap(__float_as_uint(pmax), __float_as_uint(pmax), false, false);
    pmax = fmaxf(__uint_as_float(rr[0]), __uint_as_float(rr[1])); }
  if (__builtin_expect(__all(pmax - m_reg <= THR / SCALE), 1)) { mn = m_reg; alpha = 1.f; }
  else { mn = fmaxf(m_reg, pmax); alpha = __builtin_amdgcn_exp2f((m_reg - mn) * C); m_reg = mn; }
  float mnC = -mn * C;
  for (int r = 0; r < 16; ++r) p0[r] = fmaf(p0[r], C, mnC); for (int r = 0; r < 16; ++r) p1[r] = fmaf(p1[r], C, mnC);
  for (int r = 0; r < 16; ++r) p0[r] = __builtin_amdgcn_exp2f(p0[r]);
}
__device__ __forceinline__ void finishSM(f32x16& p0, f32x16& p1, float alpha, float& l_reg, bf16x8& pa0, bf16x8& pa1, bf16x8& pa2, bf16x8& pa3) {
  for (int r = 0; r < 16; ++r) p1[r] = __builtin_amdgcn_exp2f(p1[r]);
  float ps = 0; for (int r = 0; r < 16; ++r) ps += p0[r]; for (int r = 0; r < 16; ++r) ps += p1[r];
  { auto rr = __builtin_amdgcn_permlane32_swap(__float_as_uint(ps), __float_as_uint(ps), false, false);
    ps = __uint_as_float(rr[0]) + __uint_as_float(rr[1]); }
  l_reg = l_reg * alpha + ps;
#define PK4(P, BASE, OUT) do { unsigned a0 = cvtpk(P[BASE + 0], P[BASE + 1]), a1 = cvtpk(P[BASE + 2], P[BASE + 3]);   \
    unsigned b0 = cvtpk(P[BASE + 4], P[BASE + 5]), b1 = cvtpk(P[BASE + 6], P[BASE + 7]);                              \
    auto r0 = __builtin_amdgcn_permlane32_swap(a0, b0, false, false); auto r1 = __builtin_amdgcn_permlane32_swap(a1, b1, false, false); \
    u32x4 w = {r0[0], r1[0], r0[1], r1[1]}; OUT = *reinterpret_cast<bf16x8*>(&w); } while (0)
  PK4(p0, 0, pa0); PK4(p0, 8, pa1); PK4(p1, 0, pa2); PK4(p1, 8, pa3);
#undef PK4
}
__device__ __forceinline__ void qkt(f32x16& p0, f32x16& p1, const bf16* Ks, const bf16x8* qr, int r32, int hi) {
  p0 = f32x16{}; p1 = f32x16{};
  for (int d0 = 0; d0 < 8; ++d0) { int cb = (d0 * 16 + hi * 8) * 2;
    bf16x8 b0 = *reinterpret_cast<const bf16x8*>((const char*)Ks + KSWZ(r32, cb));
    bf16x8 b1 = *reinterpret_cast<const bf16x8*>((const char*)Ks + KSWZ(32 + r32, cb));
    p0 = __builtin_amdgcn_mfma_f32_32x32x16_bf16(b0, qr[d0], p0, 0, 0, 0);
    p1 = __builtin_amdgcn_mfma_f32_32x32x16_bf16(b1, qr[d0], p1, 0, 0, 0); }
}
__device__ __forceinline__ int v_st(int k, int c) { const int kk = (k & ~0xC) | ((k & 4) << 1) | ((k & 8) >> 1); return ((kk >> 3) * 4 + (c >> 5)) * 512 + ((kk & 7) * 32 + (c & 31)) * 2; }
__device__ __forceinline__ int v_rd_base(int lane) { return ((lane & 3) << 3) | (((lane >> 2) & 3) << 6) | (((lane >> 4) & 1) << 5) | (((lane >> 5) & 1) << 8); }
constexpr int v_rd_off(int d0, int ks, int half) { return d0 * 512 + ks * 4096 + half * 2048; }
template <int OFF> __device__ __forceinline__ s16x4 tr_read(int vb) {
  s16x4 r; asm volatile("ds_read_b64_tr_b16 %0, %1 offset:%2" : "=&v"(r) : "v"(vb), "i"(OFF) : "memory"); return r;
}
template <int D0> __device__ __forceinline__ void pv_one(f32x16& od, int vb, bf16x8 pa0, bf16x8 pa1, bf16x8 pa2, bf16x8 pa3) {
  const s16x4 l0 = tr_read<v_rd_off(D0, 0, 0)>(vb), h0 = tr_read<v_rd_off(D0, 0, 1)>(vb), l1 = tr_read<v_rd_off(D0, 1, 0)>(vb), h1 = tr_read<v_rd_off(D0, 1, 1)>(vb);
  const s16x4 l2 = tr_read<v_rd_off(D0, 2, 0)>(vb), h2 = tr_read<v_rd_off(D0, 2, 1)>(vb), l3 = tr_read<v_rd_off(D0, 3, 0)>(vb), h3 = tr_read<v_rd_off(D0, 3, 1)>(vb);
  asm volatile("s_waitcnt lgkmcnt(0)" ::: "memory"); SBAR();
#define PK(L, H) (bf16x8){L[0], L[1], L[2], L[3], H[0], H[1], H[2], H[3]}
  od = __builtin_amdgcn_mfma_f32_32x32x16_bf16(pa0, PK(l0, h0), od, 0, 0, 0);
  od = __builtin_amdgcn_mfma_f32_32x32x16_bf16(pa1, PK(l1, h1), od, 0, 0, 0);
  od = __builtin_amdgcn_mfma_f32_32x32x16_bf16(pa2, PK(l2, h2), od, 0, 0, 0);
  od = __builtin_amdgcn_mfma_f32_32x32x16_bf16(pa3, PK(l3, h3), od, 0, 0, 0);
#undef PK
}
__device__ __forceinline__ void pv_d0(f32x16* o, int vb, bf16x8 pa0, bf16x8 pa1, bf16x8 pa2, bf16x8 pa3) {
  pv_one<0>(o[0], vb, pa0, pa1, pa2, pa3); pv_one<1>(o[1], vb, pa0, pa1, pa2, pa3); pv_one<2>(o[2], vb, pa0, pa1, pa2, pa3); pv_one<3>(o[3], vb, pa0, pa1, pa2, pa3);
}

template <int LDQ, int LDK, int LDO>
__device__ __forceinline__ void attn_dense_body(const bf16* Qb, const bf16* Kh, const bf16* Vh,
                                                bf16* Ob, int seq, char* lds) {
  int tid = threadIdx.x; asm volatile("" : "+v"(tid)); const int wid = tid >> 6, lane = tid & 63, r32 = lane & 31, hi = lane >> 5;
  bf16* V_lds = (bf16*)lds; bf16* K_lds = (bf16*)(lds + 2 * SHM_V);
  float* ws = (float*)(lds + 2 * SHM_V + 2 * SHM_K) + wid * 64; float* li_l = ws; float* al_l = ws + 32;
  float m_reg = -1e30f, l_reg = 0; f32x16 o[4] = {}; bf16x8 qr[8];
  const bf16* Qw = Qb + (long)(wid * QBLK + r32) * LDQ + hi * 8;
#pragma unroll
  for (int d0 = 0; d0 < 8; ++d0) qr[d0] = *reinterpret_cast<const bf16x8*>(Qw + d0 * 16);
  const int sr = tid >> 4, sc = (tid & 15) * 8, vst0 = v_st(sr, sc), vst1 = v_st(32 + sr, sc);
  const int vb0 = (int)(uintptr_t)V_lds + v_rd_base(lane);
  struct { bf16x8 vs0, vs1, ks0, ks1; } sr_[SDEPTH];
#define SLOAD(i, k0) do { sr_[i].vs0 = (*reinterpret_cast<const bf16x8*>(&Vh[(long)((k0) + sr) * LDK + sc])); sr_[i].vs1 = (*reinterpret_cast<const bf16x8*>(&Vh[(long)((k0) + 32 + sr) * LDK + sc])); \
    sr_[i].ks0 = (*reinterpret_cast<const bf16x8*>(&Kh[(long)((k0) + sr) * LDK + sc])); sr_[i].ks1 = (*reinterpret_cast<const bf16x8*>(&Kh[(long)((k0) + 32 + sr) * LDK + sc])); } while (0)
#define SWRITE(b, i) do { *(bf16x8*)((char*)V_lds + (b) * SHM_V + vst0) = (sr_[i].vs0);          \
    *(bf16x8*)((char*)V_lds + (b) * SHM_V + vst1) = (sr_[i].vs1); int kc = sc * 2;               \
    *(bf16x8*)((char*)K_lds + (b) * SHM_K + KSWZ(sr, kc)) = (sr_[i].ks0);                       \
    *(bf16x8*)((char*)K_lds + (b) * SHM_K + KSWZ(32 + sr, kc)) = (sr_[i].ks1); } while (0)
#define SWAIT() do { if constexpr (SDEPTH == 2) asm volatile("s_waitcnt vmcnt(4)" ::: "memory"); else asm volatile("s_waitcnt vmcnt(0)" ::: "memory"); } while (0)
#define RESC(a) do { if (__any((a) < 1.f)) { if (hi == 0) al_l[r32] = (a); asm volatile("s_waitcnt lgkmcnt(0)" ::: "memory"); \
    for (int d = 0; d < 4; ++d) for (int r = 0; r < 16; ++r) o[d][r] *= al_l[crow(r, hi)]; } } while (0)
  f32x16 pA0, pA1, pB0, pB1; float mnA, mnB, alA, alB; bf16x8 pa0, pa1, pa2, pa3; const int NT = seq / KVBLK;
  constexpr int SE = 0, SO = SDEPTH - 1;
  SLOAD(SE, 0); asm volatile("s_waitcnt vmcnt(0)" ::: "memory"); SWRITE(0, SE); __syncthreads();
  qkt(pA0, pA1, K_lds, qr, r32, hi); partialSM(pA0, pA1, m_reg, mnA, alA);
  SLOAD(SO, KVBLK); if constexpr (SDEPTH == 2) { if (2 < NT) SLOAD(SE, 2 * KVBLK); }
  SWAIT(); SWRITE(1, SO); __syncthreads();
  for (int j = 1; j + 1 < NT; j += 2) {
    SBAR(); qkt(pB0, pB1, (bf16*)((char*)K_lds + SHM_K), qr, r32, hi);
    finishSM(pA0, pA1, alA, l_reg, pa0, pa1, pa2, pa3); SBAR();
    SLOAD(SO, (j + SDEPTH) * KVBLK); SBAR();
    pv_d0(o, vb0, pa0, pa1, pa2, pa3); partialSM(pB0, pB1, m_reg, mnB, alB);
    __syncthreads(); SWAIT(); SWRITE(0, SE);
    RESC(alB); __syncthreads();
    SBAR(); qkt(pA0, pA1, K_lds, qr, r32, hi);
    finishSM(pB0, pB1, alB, l_reg, pa0, pa1, pa2, pa3); SBAR();
    if (SDEPTH == 1 || j + 3 < NT) SLOAD(SE, (j + 1 + SDEPTH) * KVBLK); SBAR();
    pv_d0(o, vb0 + (int)SHM_V, pa0, pa1, pa2, pa3); partialSM(pA0, pA1, m_reg, mnA, alA);
    __syncthreads(); SWAIT(); SWRITE(1, SO);
    RESC(alA); __syncthreads();
  }
  SBAR(); qkt(pB0, pB1, (bf16*)((char*)K_lds + SHM_K), qr, r32, hi);
  finishSM(pA0, pA1, alA, l_reg, pa0, pa1, pa2, pa3); SBAR();
  pv_d0(o, vb0, pa0, pa1, pa2, pa3); partialSM(pB0, pB1, m_reg, mnB, alB);
  __syncthreads(); RESC(alB);
  finishSM(pB0, pB1, alB, l_reg, pa0, pa1, pa2, pa3); SBAR();
  pv_d0(o, vb0 + (int)SHM_V, pa0, pa1, pa2, pa3);
  if (hi == 0) li_l[r32] = l_reg; asm volatile("s_waitcnt lgkmcnt(0)" ::: "memory");
  float rli[16];
#pragma unroll
  for (int r = 0; r < 16; ++r) rli[r] = __builtin_amdgcn_rcpf(li_l[crow(r, hi)]);
  bf16* Ow = Ob + (long)(wid * QBLK) * LDO;
#pragma unroll
  for (int r = 0; r < 16; ++r) { int orow = crow(r, hi);
    for (int d0 = 0; d0 < 4; ++d0) Ow[(long)orow * LDO + d0 * 32 + r32] = f2bf_s(o[d0][r] * rli[r]); }
#undef SLOAD
#undef SWRITE
#undef SWAIT
#undef RESC
}
#undef KSWZ
#undef SBAR
}
typedef unsigned short bf16_t;
typedef float f32x4 __attribute__((ext_vector_type(4)));
typedef float f32x2 __attribute__((ext_vector_type(2)));
typedef unsigned u32x4 __attribute__((ext_vector_type(4)));
typedef unsigned u32x2 __attribute__((ext_vector_type(2)));
#define LAS __attribute__((address_space(3)))
constexpr int DM = 2048, NTOK = 8192, INC = 5168, PNW = 5376, PLD = 5120, FFD = 8192, NMOD = 12288;
constexpr size_t MiB = 1u << 20;
constexpr size_t WS_CTL = 0, WS_MODS = 1 * MiB, WS_WIN = 2 * MiB, WS_WOUT = 44 * MiB, WS_WFF1 = 60 * MiB, WS_WFF2 = 124 * MiB, WS_H = 188 * MiB, WS_XA = 220 * MiB, WS_XB = 284 * MiB,
    WS_P = 348 * MiB, WS_G = 428 * MiB, WS_QN = 430 * MiB, WS_KB = 446 * MiB, WS_VB = 451 * MiB, WS_LA = 456 * MiB, WS_DQKV = 472 * MiB, WS_GB = 496 * MiB, WS_OG = 497 * MiB, WS_OD = 529 * MiB,
    WS_MIX = 561 * MiB, WS_END = 593 * MiB;
constexpr size_t WS_H2 = 348 * MiB;
constexpr size_t ZERO_BYTES = 2 * MiB;
constexpr size_t OUT_Y = 0, OUT_CK = 16777216, OUT_CV = 18874368, OUT_SG = 20971520, OUT_SD = 23068672, OUT_TOTAL = 27262976;
constexpr int LDS_BYTES = 147456;
constexpr float EPS = 1e-6f;

struct Params { const float* in[25]; float* out; unsigned char* ws; };
constexpr int PTAB_OFF = 147456 - 512;
typedef __attribute__((address_space(3))) const unsigned* ptab_t;
__device__ __forceinline__ const void* ldp(ptab_t pt, int i) { unsigned a; asm volatile("v_mov_b32 %0, %1" : "=v"(a) : "s"((unsigned)(unsigned long long)pt + 8u * (unsigned)i));
    const ptab_t q = (ptab_t)(unsigned long long)a; const unsigned lo = __builtin_amdgcn_readfirstlane(q[0]), hi = __builtin_amdgcn_readfirstlane(q[1]); return (const void*)(((unsigned long long)hi << 32) | lo); }
#define PIN(i) ((const float*)ldp(pt, (i)))
#define POUT ((float*)ldp(pt, 25))
#define PWS ((unsigned char*)ldp(pt, 26))

__device__ __forceinline__ float bf2f(unsigned short v) { return __uint_as_float(((unsigned)v) << 16); }
__device__ __forceinline__ float bflo(unsigned w) { return __uint_as_float(w << 16); }
__device__ __forceinline__ float bfhi(unsigned w) { return __uint_as_float(w & 0xffff0000u); }
__device__ __forceinline__ unsigned short f2bf(float f) { unsigned u = __float_as_uint(f); return (unsigned short)((u + 0x7fffu + ((u >> 16) & 1u)) >> 16); }
__device__ __forceinline__ unsigned pk2(float lo, float hi) { return (unsigned)f2bf(lo) | ((unsigned)f2bf(hi) << 16); }
__device__ __forceinline__ float wave_sum(float v) {
#pragma unroll
    for (int o = 1; o < 64; o <<= 1) v += __shfl_xor(v, o);
    return v;
}
__device__ __forceinline__ float silu_f(float x) { return x / (1.f + __expf(-x)); }
__device__ __forceinline__ float softplus_f(float x) { return fmaxf(x, 0.f) + log1pf(__expf(-fabsf(x))); }
__device__ __forceinline__ float logsigmoid_f(float x) { return fminf(x, 0.f) - log1pf(__expf(-fabsf(x))); }
#define LDS_WAIT() asm volatile("s_waitcnt lgkmcnt(0)" ::: "memory")
__device__ __forceinline__ int tid_opaque() { int t = threadIdx.x; asm volatile("" : "+v"(t)); return t; }

template <bool GUARD>
__device__ __forceinline__ void transpose_item(const float* W, int ldw, int o0, int nvalid, int K, bf16_t* WT, int n0, int k0, LAS float* scr, int lane) {
#pragma unroll 8
    for (int i = 0; i < 32; ++i) { const int kk = 2 * i + (lane >> 5), c = lane & 31; float v;
        if (GUARD) { v = 0.f; if (c < nvalid) v = W[(size_t)(k0 + kk) * ldw + o0 + c]; } else v = W[(size_t)(k0 + kk) * ldw + o0 + c];
        scr[kk * 33 + c] = v; }
    LDS_WAIT(); asm volatile("" ::: "memory");
    const int c8 = lane & 7;
#pragma unroll
    for (int j = 0; j < 4; ++j) { const int n = (lane >> 3) + 8 * j; const LAS float* s = scr + (8 * c8) * 33 + n;
        u32x4 o; o.x = pk2(s[0 * 33], s[1 * 33]); o.y = pk2(s[2 * 33], s[3 * 33]); o.z = pk2(s[4 * 33], s[5 * 33]); o.w = pk2(s[6 * 33], s[7 * 33]);
        *(u32x4*)(WT + (size_t)(n0 + n) * K + k0 + 8 * c8) = o; }
    LDS_WAIT(); asm volatile("" ::: "memory");
}
__device__ __forceinline__ void p0_prologue(ptab_t pt, LAS unsigned char* lds, int bid, int nb) {
    const int tid = tid_opaque(), lane = tid & 63, wave = __builtin_amdgcn_readfirstlane(tid >> 6);
    unsigned char* ws = PWS;
    {
        LAS float* scr = (LAS float*)(lds + wave * 8448);
        constexpr int I_IN = 32 * 168, I_OUT = 32 * 64, I_F1 = 32 * 256, I_F2 = 128 * 64, I_L = I_IN + I_OUT + I_F1 + I_F2;
        const int gw = bid * 8 + wave, NGW = nb * 8;
        for (int it = gw; it < 2 * I_L; it += NGW) {
            const int l = it / I_L; int r = it - l * I_L;
            const float* W; bf16_t* WT; int ldw, K, kb, nbk, o0, nvalid = 32;
            if (r < I_IN) { kb = r / 168; nbk = r % 168; const int n0 = 32 * nbk; W = PIN(12) + (size_t)l * 2048 * INC; WT = (bf16_t*)(ws + WS_WIN) + (size_t)l * PNW * 2048; ldw = INC; K = 2048;
                o0 = n0 < 1536 ? n0 : (n0 < 5120 ? n0 + 32 : (n0 < 5152 ? n0 - 5120 + 1536 : (n0 < INC ? n0 : 0))); nvalid = n0 < 5152 ? 32 : (n0 == 5152 ? 16 : 0); }
            else if ((r -= I_IN) < I_OUT) { kb = r / 64; nbk = r % 64; W = PIN(22) + (size_t)l * 2048 * 2048; WT = (bf16_t*)(ws + WS_WOUT) + (size_t)l * 2048 * 2048; ldw = 2048; K = 2048; o0 = 32 * nbk; }
            else if ((r -= I_OUT) < I_F1) { kb = r / 256; nbk = r % 256; W = PIN(23) + (size_t)l * 2048 * 8192; WT = (bf16_t*)(ws + WS_WFF1) + (size_t)l * 8192 * 2048; ldw = 8192; K = 2048; o0 = 32 * nbk; }
            else { r -= I_F1; kb = r / 64; nbk = r % 64; W = PIN(24) + (size_t)l * 8192 * 2048; WT = (bf16_t*)(ws + WS_WFF2) + (size_t)l * 2048 * 8192; ldw = 2048; K = 8192; o0 = 32 * nbk; }
            if (nvalid == 32) transpose_item<false>(W, ldw, o0, 32, K, WT, 32 * nbk, 64 * kb, scr, lane);
            else transpose_item<true>(W, ldw, o0, nvalid, K, WT, 32 * nbk, 64 * kb, scr, lane);
        }
    }
    __syncthreads();
    {
        LAS float* sc = (LAS float*)lds;
        LAS float* red = (LAS float*)(lds + 10240);
        float* mods = (float*)(ws + WS_MODS);
        for (int it = bid; it < 384; it += nb) {
            const int l = it / 192, rem = it % 192, nc = rem >> 2, kq = rem & 3;
            for (int idx = tid; idx < 5 * 512; idx += 512) { const int j = idx >> 9, kk = idx & 511, k = kq * 512 + kk;
                const float cv = (j == 0) ? PIN(7)[k] : PIN(6)[(j - 1) * 2048 + k]; sc[idx] = silu_f(cv); }
            __syncthreads();
            const float* Wp = PIN(10) + ((size_t)l * 2048 + kq * 512 + wave * 64) * NMOD + nc * 256 + lane * 4;
            f32x4 acc[5];
#pragma unroll
            for (int j = 0; j < 5; ++j) acc[j] = (f32x4){0.f, 0.f, 0.f, 0.f};
#pragma unroll 8
            for (int kk = 0; kk < 64; ++kk) { const f32x4 w = *(const f32x4*)(Wp + (size_t)kk * NMOD);
#pragma unroll
                for (int j = 0; j < 5; ++j) acc[j] += sc[j * 512 + wave * 64 + kk] * w; }
#pragma unroll
            for (int j = 0; j < 5; ++j) *(LAS f32x4*)(red + (wave * 5 + j) * 256 + lane * 4) = acc[j];
            __syncthreads();
            for (int idx = tid; idx < 1280; idx += 512) { const int j = idx >> 8, col = idx & 255; float s = 0.f;
#pragma unroll
                for (int w = 0; w < 8; ++w) s += red[(w * 5 + j) * 256 + col];
                if (kq == 0) s += PIN(11)[(size_t)l * NMOD + nc * 256 + col];
                atomicAdd(mods + ((size_t)l * 5 + j) * NMOD + nc * 256 + col, s); }
            __syncthreads();
        }
    }
}

__device__ __forceinline__ void norm_phase(const float* x0, const float* x1, const float* g, const float* mods_l, int shift_i, int scale_i, bf16_t* H, int bid, int nb) {
    const int tid = tid_opaque(), lane = tid & 63, wave = tid >> 6;
    for (int r = bid * 8 + wave; r < NTOK; r += nb * 8) {
        const float* xr = (r < 4096 ? x0 : x1) + (size_t)r * DM;
        f32x4 v[8]; float ss = 0.f;
#pragma unroll
        for (int j = 0; j < 8; ++j) { v[j] = *(const f32x4*)(xr + 4 * (lane + 64 * j)); ss += (v[j].x * v[j].x + v[j].y * v[j].y) + (v[j].z * v[j].z + v[j].w * v[j].w); }
        const float rstd = rsqrtf(wave_sum(ss) * (1.f / DM) + EPS);
        const int cond = r < 4096 ? 0 : 1 + ((r - 4096) >> 10);
        const float* sh = mods_l + ((size_t)cond * 6 + shift_i) * DM; const float* sc = mods_l + ((size_t)cond * 6 + scale_i) * DM;
#pragma unroll
        for (int j = 0; j < 8; ++j) { const int col = 4 * (lane + 64 * j); const f32x4 gg = *(const f32x4*)(g + col), s = *(const f32x4*)(sc + col), h = *(const f32x4*)(sh + col);
            const f32x4 o = v[j] * rstd * gg * (s + 1.f) + h; u32x2 w; w.x = pk2(o.x, o.y); w.y = pk2(o.z, o.w); *(u32x2*)(H + (size_t)r * DM + col) = w; }
    }
}

__device__ __forceinline__ void prep_phase(ptab_t pt, int l, LAS unsigned char* lds, int bid, int nb) {
    const int tid = tid_opaque(), lane = tid & 63, wave = tid >> 6;
    unsigned char* ws = PWS;
    const bf16_t* P = (const bf16_t*)(ws + WS_P); const float* G = (const float*)(ws + WS_G);
    bf16_t* QN = (bf16_t*)(ws + WS_QN); bf16_t* KB = (bf16_t*)(ws + WS_KB); bf16_t* VB = (bf16_t*)(ws + WS_VB);
    float* LA = (float*)(ws + WS_LA); bf16_t* DQKV = (bf16_t*)(ws + WS_DQKV); float* GB = (float*)(ws + WS_GB);
    float* out_ck = POUT + OUT_CK; float* out_cv = POUT + OUT_CV;
    LAS float* w2s = (LAS float*)lds;
    for (int i = tid; i < 8192; i += 512) w2s[i] = PIN(13)[(size_t)l * 8192 + i];
    for (int i = tid; i < 512; i += 512) w2s[8192 + i] = PIN(14)[(size_t)l * 512 + i];
    __syncthreads();
    const float qg0 = PIN(16)[l * 128 + lane], qg1 = PIN(16)[l * 128 + 64 + lane], kg0 = PIN(17)[l * 128 + lane], kg1 = PIN(17)[l * 128 + 64 + lane];
    const float inv = exp2f(-(float)(lane & 31) * (13.287712379549449f / 32.f));
    const float sgn = lane < 32 ? -1.f : 1.f;
    for (int r = bid * 8 + wave; r < NTOK; r += nb * 8) {
        const bool lat = r >= 4096; const int rr = lat ? r - 4096 : r; const int b = lat ? rr >> 10 : rr >> 8; const int t = lat ? rr & 1023 : rr & 255; const int L = lat ? 1024 : 256;
        const bf16_t* Pr = P + (size_t)r * PLD;
        float cR = 1.f, sR = 0.f, cC = 1.f, sC = 0.f;
        if (lat) { const float aR = (float)(t >> 6) * inv, aC = (float)(t & 63) * inv; sR = __sinf(aR); cR = __cosf(aR); sC = __sinf(aC); cC = __cosf(aC); }
#pragma unroll
        for (int h = 0; h < 8; ++h) {
            const float x0 = bf2f(Pr[1536 + h * 128 + lane]), x1 = bf2f(Pr[1536 + h * 128 + 64 + lane]);
            const float rstd = rsqrtf(wave_sum(x0 * x0 + x1 * x1) * (1.f / 128.f) + EPS);
            float y0 = x0 * rstd * qg0, y1 = x1 * rstd * qg1;
            if (lat) { const float p0 = __shfl_xor(y0, 32), p1 = __shfl_xor(y1, 32); const float n0 = y0 * cR + sgn * p0 * sR, n1 = y1 * cC + sgn * p1 * sC; y0 = n0; y1 = n1; }
            QN[(size_t)r * 1024 + h * 128 + lane] = f2bf(y0); QN[(size_t)r * 1024 + h * 128 + 64 + lane] = f2bf(y1);
        }
#pragma unroll
        for (int hk = 0; hk < 2; ++hk) {
            const float x0 = bf2f(Pr[2560 + hk * 128 + lane]), x1 = bf2f(Pr[2560 + hk * 128 + 64 + lane]);
            const unsigned short v0 = Pr[2816 + hk * 128 + lane], v1 = Pr[2816 + hk * 128 + 64 + lane];
            const float rstd = rsqrtf(wave_sum(x0 * x0 + x1 * x1) * (1.f / 128.f) + EPS);
            float y0 = x0 * rstd * kg0, y1 = x1 * rstd * kg1;
            if (!lat) { const size_t o = ((((size_t)b * 2 + l) * 256 + t) * 2 + hk) * 128;
                out_ck[o + lane] = y0; out_ck[o + 64 + lane] = y1; out_cv[o + lane] = bf2f(v0); out_cv[o + 64 + lane] = bf2f(v1);
                const size_t kr = (size_t)r * 256 + hk * 128; KB[kr + lane] = f2bf(y0); KB[kr + 64 + lane] = f2bf(y1); VB[kr + lane] = v0; VB[kr + 64 + lane] = v1; }
            else { const float p0 = __shfl_xor(y0, 32), p1 = __shfl_xor(y1, 32); const float n0 = y0 * cR + sgn * p0 * sR, n1 = y1 * cC + sgn * p1 * sC;
                const size_t kr = ((size_t)4096 + (size_t)b * 1280 + 256 + t) * 256 + hk * 128; KB[kr + lane] = f2bf(n0); KB[kr + 64 + lane] = f2bf(n1); VB[kr + lane] = v0; VB[kr + 64 + lane] = v1; }
        }
        {
            float lr[32];
#pragma unroll
            for (int j = 0; j < 8; ++j) { const f32x4 t4 = *(const f32x4*)(G + (size_t)r * 64 + 4 * j); lr[4 * j] = t4.x; lr[4 * j + 1] = t4.y; lr[4 * j + 2] = t4.z; lr[4 * j + 3] = t4.w; }
#pragma unroll
            for (int d = 0; d < 2; ++d)
#pragma unroll
                for (int jj = 0; jj < 4; ++jj) { const int n = lane + 64 * jj; float a = w2s[8192 + d * 256 + n];
#pragma unroll
                    for (int q = 0; q < 16; ++q) a += lr[d * 16 + q] * w2s[(d * 16 + q) * 256 + n];
                    LA[(size_t)r * 512 + d * 256 + n] = logsigmoid_f(a) * (1.f / 16.f); }
        }
        {
            const bool hasm = t > 0, hasp = t < L - 1;
            const float* cw = PIN(18) + (size_t)l * 3 * 1536;
#pragma unroll
            for (int blk = 0; blk < 12; ++blk) { const int c = blk * 128 + 2 * lane;
                const unsigned xm = hasm ? *(const unsigned*)(Pr - PLD + 3072 + c) : 0u, xc = *(const unsigned*)(Pr + 3072 + c), xp = hasp ? *(const unsigned*)(Pr + PLD + 3072 + c) : 0u;
                const f32x2 w0 = *(const f32x2*)(cw + c), w1 = *(const f32x2*)(cw + 1536 + c), w2 = *(const f32x2*)(cw + 3072 + c);
                float y0 = silu_f(w0.x * bflo(xm) + w1.x * bflo(xc) + w2.x * bflo(xp)), y1 = silu_f(w0.y * bfhi(xm) + w1.y * bfhi(xc) + w2.y * bfhi(xp));
                if (blk < 8) { const float sc = rsqrtf(wave_sum(y0 * y0 + y1 * y1) + EPS) * (blk < 4 ? 0.08838834764831845f : 1.f); y0 *= sc; y1 *= sc; }
                *(unsigned*)(DQKV + (size_t)r * 1536 + c) = pk2(y0, y1); }
        }
        if (lane < 8) { const float a = G[(size_t)r * 64 + 32 + lane], bb = G[(size_t)r * 64 + 40 + lane];
            GB[(size_t)r * 16 + lane] = -__expf(PIN(19)[l * 8 + lane]) * softplus_f(a + PIN(20)[l * 8 + lane]); GB[(size_t)r * 16 + 8 + lane] = 1.f / (1.f + __expf(-bb)); }
    }
    for (int i = bid * 512 + tid; i < 65536; i += nb * 512) { const int b = i >> 14, rem = i & 16383, pp = rem >> 6, c4 = rem & 63;
        const size_t src = (((size_t)b * 2 + l) * 256 + pp) * 256 + c4 * 4, dst = ((size_t)4096 + (size_t)b * 1280 + pp) * 256 + c4 * 4;
        const f32x4 k4 = *(const f32x4*)(PIN(2) + src), v4 = *(const f32x4*)(PIN(3) + src);
        u32x2 kw, vw; kw.x = pk2(k4.x, k4.y); kw.y = pk2(k4.z, k4.w); vw.x = pk2(v4.x, v4.y); vw.y = pk2(v4.z, v4.w);
        *(u32x2*)(KB + dst) = kw; *(u32x2*)(VB + dst) = vw; }
}

__device__ __forceinline__ void gla_naive_item(ptab_t pt, int l, bool lat, int b, int h, int d, LAS float* red) {
    const int tid = tid_opaque(), vq = tid & 127, kg = tid >> 7;
    unsigned char* ws = PWS;
    const bf16_t* P = (const bf16_t*)(ws + WS_P); const float* LA = (const float*)(ws + WS_LA); float* OG = (float*)(ws + WS_OG);
    const int L = lat ? 1024 : 256, rowbase = lat ? 4096 + b * 1024 : b * 256;
    float S[16];
    const size_t sidx = ((((size_t)b * 2 + l) * 2 + d) * 4 + h) * 8192 + (size_t)(kg * 16) * 128 + vq;
#pragma unroll
    for (int j = 0; j < 16; ++j) S[j] = lat ? PIN(4)[sidx + j * 128] : 0.f;
    f32x4 la[4], nla[4]; u32x4 kq[4], nkq[4]; unsigned short vv, nvv;
#define GLA_LOAD(LAv, KQv, Vv, step) do { const int t_ = d ? L - 1 - (step) : (step); const size_t r_ = (size_t)(rowbase + t_); \
        const float* lp_ = LA + r_ * 512 + d * 256 + h * 64 + kg * 16; const bf16_t* pr_ = P + r_ * PLD; \
        _Pragma("unroll") for (int j_ = 0; j_ < 4; ++j_) LAv[j_] = *(const f32x4*)(lp_ + 4 * j_); \
        KQv[0] = *(const u32x4*)(pr_ + 256 + h * 64 + kg * 16); KQv[1] = *(const u32x4*)(pr_ + 256 + h * 64 + kg * 16 + 8); \
        KQv[2] = *(const u32x4*)(pr_ + h * 64 + kg * 16); KQv[3] = *(const u32x4*)(pr_ + h * 64 + kg * 16 + 8); Vv = pr_[512 + h * 128 + vq]; } while (0)
    GLA_LOAD(la, kq, vv, 0);
    for (int step = 0; step < L; ++step) {
        const int sn = step + 1 < L ? step + 1 : step;
        GLA_LOAD(nla, nkq, nvv, sn);
        const float v = bf2f(vv); float part = 0.f;
#pragma unroll
        for (int j = 0; j < 16; ++j) { const unsigned kw = kq[j >> 3][(j >> 1) & 3], qw = kq[2 + (j >> 3)][(j >> 1) & 3];
            const float kk = (j & 1) ? bfhi(kw) : bflo(kw), qq = (j & 1) ? bfhi(qw) : bflo(qw);
            S[j] = __expf(la[j >> 2][j & 3]) * S[j] + kk * v; part += S[j] * qq; }
        red[((step & 1) * 4 + kg) * 128 + vq] = part * 0.125f;
        __syncthreads();
        if (kg == 0) { const LAS float* rp = red + (step & 1) * 512 + vq; const int t = d ? L - 1 - step : step;
            OG[((size_t)d * NTOK + rowbase + t) * 512 + h * 128 + vq] = (rp[0] + rp[128]) + (rp[256] + rp[384]); }
#pragma unroll
        for (int j = 0; j < 4; ++j) { la[j] = nla[j]; kq[j] = nkq[j]; } vv = nvv;
    }
#undef GLA_LOAD
    if (!lat) {
#pragma unroll
        for (int j = 0; j < 16; ++j) POUT[OUT_SG + sidx + j * 128] = S[j]; }
    __syncthreads();
}
__device__ __forceinline__ void dn_naive_item(ptab_t pt, int l, bool lat, int b, int h, int d, LAS float* red) {
    const int tid = tid_opaque(), vq = tid & 127, kg = tid >> 7;
    unsigned char* ws = PWS;
    const bf16_t* DQKV = (const bf16_t*)(ws + WS_DQKV); const float* GB = (const float*)(ws + WS_GB); float* OD = (float*)(ws + WS_OD);
    const int L = lat ? 1024 : 256, rowbase = lat ? 4096 + b * 1024 : b * 256;
    LAS float* redR = red; LAS float* redO = red + 1024;
    float S[32];
    const size_t sidx = ((((size_t)b * 2 + l) * 2 + d) * 4 + h) * 16384 + (size_t)(kg * 32) * 128 + vq;
#pragma unroll
    for (int j = 0; j < 32; ++j) S[j] = lat ? PIN(5)[sidx + j * 128] : 0.f;
    u32x4 kq[8], nkq[8]; unsigned short vv, nvv; float gg, ngg, be, nbe;
#define DN_LOAD(KQv, Vv, Gv, Bv, step) do { const int t_ = d ? L - 1 - (step) : (step); const size_t r_ = (size_t)(rowbase + t_); const bf16_t* pr_ = DQKV + r_ * 1536; \
        _Pragma("unroll") for (int j_ = 0; j_ < 4; ++j_) { KQv[j_] = *(const u32x4*)(pr_ + 512 + h * 128 + kg * 32 + 8 * j_); KQv[4 + j_] = *(const u32x4*)(pr_ + h * 128 + kg * 32 + 8 * j_); } \
        Vv = pr_[1024 + h * 128 + vq]; Gv = GB[r_ * 16 + d * 4 + h]; Bv = GB[r_ * 16 + 8 + d * 4 + h]; } while (0)
    DN_LOAD(kq, vv, gg, be, 0);
    for (int step = 0; step < L; ++step) {
        const int sn = step + 1 < L ? step + 1 : step;
        DN_LOAD(nkq, nvv, ngg, nbe, sn);
        float kf[32], rp = 0.f;
#pragma unroll
        for (int j = 0; j < 32; ++j) { const unsigned kw = kq[j >> 3][(j >> 1) & 3]; kf[j] = (j & 1) ? bfhi(kw) : bflo(kw); rp += kf[j] * S[j]; }
        redR[((step & 1) * 4 + kg) * 128 + vq] = rp;
        __syncthreads();
        if (step > 0 && kg == 0) { const LAS float* op = redO + ((step - 1) & 1) * 512 + vq; const int t = d ? L - step : step - 1;
            OD[((size_t)d * NTOK + rowbase + t) * 512 + h * 128 + vq] = (op[0] + op[128]) + (op[256] + op[384]); }
        const LAS float* rr = redR + (step & 1) * 512 + vq;
        const float rs = (rr[0] + rr[128]) + (rr[256] + rr[384]);
        const float eg = __expf(gg), w = be * (bf2f(vv) - eg * rs);
        float op = 0.f;
#pragma unroll
        for (int j = 0; j < 32; ++j) { const unsigned qw = kq[4 + (j >> 3)][(j >> 1) & 3]; const float qq = (j & 1) ? bfhi(qw) : bflo(qw);
            S[j] = eg * S[j] + kf[j] * w; op += qq * S[j]; }
        redO[((step & 1) * 4 + kg) * 128 + vq] = op;
#pragma unroll
        for (int j = 0; j < 8; ++j) kq[j] = nkq[j];
        vv = nvv; gg = ngg; be = nbe;
    }
#undef DN_LOAD
    __syncthreads();
    if (kg == 0) { const LAS float* op = redO + ((L - 1) & 1) * 512 + vq; const int t = d ? 0 : L - 1;
        OD[((size_t)d * NTOK + rowbase + t) * 512 + h * 128 + vq] = (op[0] + op[128]) + (op[256] + op[384]); }
    if (!lat) {
#pragma unroll
        for (int j = 0; j < 32; ++j) POUT[OUT_SD + sidx + j * 128] = S[j]; }
    __syncthreads();
}

__device__ __forceinline__ void mixer_phase(ptab_t pt, int l, unsigned char* lds_generic, int bid, int nb) {
    LAS float* red = (LAS float*)lds_generic;
    for (int it = bid; it < 576; it += nb) {
        if (it < 320) {
            const bool lat = it < 64; const bool dn = lat ? it < 32 : it < 192;
            const int i = lat ? (it & 31) : (dn ? it - 64 : it - 192);
            if (dn) dn_naive_item(pt, l, lat, i >> 3, (i >> 1) & 3, i & 1, red);
            else gla_naive_item(pt, l, lat, i >> 3, (i >> 1) & 3, i & 1, red);
        } else {
            unsigned char* ws = PWS;
            const bf16_t* QN = (const bf16_t*)(ws + WS_QN); const bf16_t* KB = (const bf16_t*)(ws + WS_KB); const bf16_t* VB = (const bf16_t*)(ws + WS_VB); bf16_t* MIX = (bf16_t*)(ws + WS_MIX);
            const bool lat = it < 448; const int i = lat ? it - 320 : it - 448;
            const int b = lat ? i >> 5 : i >> 3, h = lat ? (i >> 2) & 7 : i & 7, qb = lat ? i & 3 : 0;
            const size_t row0 = lat ? 4096 + (size_t)b * 1024 + qb * 256 : (size_t)b * 256;
            const size_t krow0 = lat ? (size_t)4096 + (size_t)b * 1280 : (size_t)b * 256;
            att::attn_dense_body<1024, 256, 2048>(QN + row0 * 1024 + h * 128, KB + krow0 * 256 + (h >> 2) * 128, VB + krow0 * 256 + (h >> 2) * 128, MIX + row0 * 2048 + 512 + h * 128, lat ? 1280 : 256, (char*)lds_generic);
            __syncthreads();
        }
    }
}

__device__ __forceinline__ void postmix_phase(ptab_t pt, int l, int bid, int nb) {
    const int tid = tid_opaque(), lane = tid & 63, wave = tid >> 6;
    unsigned char* ws = PWS;
    const bf16_t* P = (const bf16_t*)(ws + WS_P); const float* OG = (const float*)(ws + WS_OG); const float* OD = (const float*)(ws + WS_OD); bf16_t* MIX = (bf16_t*)(ws + WS_MIX);
    const float gg0 = PIN(15)[l * 128 + lane], gg1 = PIN(15)[l * 128 + 64 + lane], dg0 = PIN(21)[l * 128 + lane], dg1 = PIN(21)[l * 128 + 64 + lane];
    for (int r = bid * 8 + wave; r < NTOK; r += nb * 8) {
        const bf16_t* Pr = P + (size_t)r * PLD;
#pragma unroll
        for (int blk = 0; blk < 8; ++blk) { const bool dn = blk >= 4; const int hb = blk & 3;
            const float* o0 = (dn ? OD : OG) + (size_t)r * 512 + hb * 128; const float* o1 = o0 + (size_t)NTOK * 512;
            const float a0 = o0[lane] + o1[lane], a1 = o0[64 + lane] + o1[64 + lane];
            const float rstd = rsqrtf(wave_sum(a0 * a0 + a1 * a1) * (1.f / 128.f) + EPS);
            const int gc = (dn ? 4608 : 1024) + hb * 128;
            const float z0 = bf2f(Pr[gc + lane]), z1 = bf2f(Pr[gc + 64 + lane]);
            const int mc = (dn ? 1536 : 0) + hb * 128;
            MIX[(size_t)r * 2048 + mc + lane] = f2bf(a0 * rstd * (dn ? dg0 : gg0) * silu_f(z0));
            MIX[(size_t)r * 2048 + mc + 64 + lane] = f2bf(a1 * rstd * (dn ? dg1 : gg1) * silu_f(z1)); }
    }
}

__global__ void __launch_bounds__(512, 2) mega(Params p) {
    extern __shared__ __attribute__((aligned(16))) unsigned char lds[];
    cg::grid_group grid = cg::this_grid();
    const int bid = blockIdx.x, nb = gridDim.x;
    LAS unsigned char* l3 = (LAS unsigned char*)lds;
    ptab_t pt = (ptab_t)(l3 + PTAB_OFF);
    if (threadIdx.x < 27) { const int i = threadIdx.x; const void* v = i < 25 ? (const void*)p.in[i] : (i == 25 ? (const void*)p.out : (const void*)p.ws);
        ((LAS unsigned long long*)(l3 + PTAB_OFF))[i] = (unsigned long long)v; }
    __syncthreads();
#define GSYNC() do { grid.sync(); } while (0)
    p0_prologue(pt, l3, bid, nb);
    GSYNC();
#pragma unroll 1
    for (int l = 0; l < 2; ++l) {
        { unsigned char* ws = PWS; const float* mods_l = (const float*)(ws + WS_MODS) + (size_t)l * 5 * NMOD;
          const float* xin0 = l == 0 ? PIN(0) : (const float*)(ws + WS_XB); const float* xin1 = l == 0 ? PIN(1) - (size_t)4096 * DM : (const float*)(ws + WS_XB);
          norm_phase(xin0, xin1, PIN(8) + l * DM, mods_l, 0, 1, (bf16_t*)(ws + WS_H), bid, nb); }
        GSYNC();
        { unsigned char* ws = PWS; pg8::Gemm g{(const bf16_t*)(ws + WS_H), (const bf16_t*)(ws + WS_WIN) + (size_t)l * PNW * 2048, NTOK, PNW, 2048}; pg8::StaticOrder S; S.init(NTOK, PNW, nb, bid);
          pg8::EpiP E{(bf16_t*)(ws + WS_P), (float*)(ws + WS_G)};
          pg8::gemm_phase<pg8::EpiP, pg8::StaticOrder, true, true>(l3, g, S, E); }
        GSYNC();
        prep_phase(pt, l, l3, bid, nb);
        GSYNC();
        mixer_phase(pt, l, lds, bid, nb);
        GSYNC();
        postmix_phase(pt, l, bid, nb);
        GSYNC();
        { unsigned char* ws = PWS; const float* mods_l = (const float*)(ws + WS_MODS) + (size_t)l * 5 * NMOD;
          const float* xin0 = l == 0 ? PIN(0) : (const float*)(ws + WS_XB); const float* xin1 = l == 0 ? PIN(1) - (size_t)4096 * DM : (const float*)(ws + WS_XB);
          pg8::Gemm g{(const bf16_t*)(ws + WS_MIX), (const bf16_t*)(ws + WS_WOUT) + (size_t)l * 2048 * 2048, NTOK, 2048, 2048}; pg8::StaticOrder S; S.init(NTOK, 2048, nb, bid);
          pg8::EpiRes E{xin0, xin1, (float*)(ws + WS_XA), mods_l + 2 * DM};
          pg8::gemm_phase<pg8::EpiRes, pg8::StaticOrder, true, true>(l3, g, S, E); }
        GSYNC();
        { unsigned char* ws = PWS; const float* mods_l = (const float*)(ws + WS_MODS) + (size_t)l * 5 * NMOD; const float* XA = (const float*)(ws + WS_XA);
          norm_phase(XA, XA, PIN(9) + l * DM, mods_l, 3, 4, (bf16_t*)(ws + WS_H), bid, nb); }
        GSYNC();
        { unsigned char* ws = PWS; pg8::Gemm g{(const bf16_t*)(ws + WS_H), (const bf16_t*)(ws + WS_WFF1) + (size_t)l * 8192 * 2048, NTOK, FFD, 2048}; pg8::StaticOrder S; S.init(NTOK, FFD, nb, bid);
          pg8::EpiSqRelu E{(bf16_t*)(ws + WS_H2), FFD};
          pg8::gemm_phase<pg8::EpiSqRelu, pg8::StaticOrder, true, true>(l3, g, S, E); }
        GSYNC();
        { unsigned char* ws = PWS; const float* mods_l = (const float*)(ws + WS_MODS) + (size_t)l * 5 * NMOD; const float* XA = (const float*)(ws + WS_XA);
          pg8::Gemm g{(const bf16_t*)(ws + WS_H2), (const bf16_t*)(ws + WS_WFF2) + (size_t)l * 2048 * 8192, NTOK, 2048, FFD}; pg8::StaticOrder S; S.init(NTOK, 2048, nb, bid);
          pg8::EpiRes E{XA, XA, l == 0 ? (float*)(ws + WS_XB) : POUT + OUT_Y, mods_l + 5 * DM};
          pg8::gemm_phase<pg8::EpiRes, pg8::StaticOrder, true, true>(l3, g, S, E); }
        if (l == 0) GSYNC();
    }
}

extern "C" void kernel_launch(void* const* d_in, const int* in_sizes, int n_in, void* d_out, int out_size, void* d_ws, size_t ws_size, hipStream_t stream) {
    static int grid_blocks = 0;
    if (grid_blocks == 0) {
        if (n_in != 25 || out_size != (int)OUT_TOTAL || ws_size < WS_END) { fprintf(stderr, "kernel_launch: unexpected shapes: n_in %d out %d ws %zu (need %zu)\n", n_in, out_size, ws_size, (size_t)WS_END); grid_blocks = -1; return; }
        int dev = 0, cus = 0, per_cu = 0;
        if (hipGetDevice(&dev) != hipSuccess || hipDeviceGetAttribute(&cus, hipDeviceAttributeMultiprocessorCount, dev) != hipSuccess) { grid_blocks = -1; return; }
        if (hipFuncSetAttribute((const void*)mega, hipFuncAttributeMaxDynamicSharedMemorySize, LDS_BYTES) != hipSuccess) { fprintf(stderr, "kernel_launch: hipFuncSetAttribute failed\n"); grid_blocks = -1; return; }
        if (hipOccupancyMaxActiveBlocksPerMultiprocessor(&per_cu, (const void*)mega, 512, LDS_BYTES) != hipSuccess || per_cu < 1) { fprintf(stderr, "kernel_launch: occupancy query says %d blocks per CU\n", per_cu); (void)hipGetLastError(); grid_blocks = -1; return; }
        grid_blocks = cus;
    }
    if (grid_blocks < 0) return;
    if (hipMemsetAsync((char*)d_ws + WS_CTL, 0, ZERO_BYTES, stream) != hipSuccess) { fprintf(stderr, "kernel_launch: memset failed\n"); return; }
    Params p{};
    for (int i = 0; i < 25; ++i) p.in[i] = (const float*)d_in[i];
    p.out = (float*)d_out; p.ws = (unsigned char*)d_ws;
    void* args[] = {&p};
    const hipError_t e = hipLaunchCooperativeKernel((void*)mega, dim3(grid_blocks), dim3(512), args, LDS_BYTES, stream);
    if (e != hipSuccess) fprintf(stderr, "kernel_launch: cooperative launch failed: %s (grid %d)\n", hipGetErrorString(e), grid_blocks);
}
```

```cpp
#include <hip/hip_runtime.h>
#include <hip/hip_cooperative_groups.h>
#include <cstdio>
#include <cstdint>
namespace cg = cooperative_groups;
#ifndef PROBE_DUP
#define PROBE_DUP 0
#endif
namespace pg8 {
#define PG8_LAS __attribute__((address_space(3)))
typedef unsigned short bf16_t;
typedef short bf16x8 __attribute__((ext_vector_type(8)));
typedef float f32x4 __attribute__((ext_vector_type(4)));
typedef unsigned u32x4 __attribute__((ext_vector_type(4)));
constexpr int BM = 256, BK = 64, HALF = 128, HTB = HALF * BK * 2  , STAGE_BYTES = 8 * HTB, NXCD = 8, WGM = 8;

__host__ __device__ __forceinline__ int lds_byte(int r, int c) { const int st = (r >> 4) * 2 + (c >> 5), rr = r & 15, cc = c & 31, ob = rr * 64 + cc * 2; return st * 1024 + (ob ^ (((ob >> 9) & 1) << 5)); }
__host__ __device__ __forceinline__ void stage_rc(int b, int& R, int& C) { const int st = b / 1024, sb = b % 1024, swz = sb ^ (((sb >> 9) & 1) << 5); R = (st >> 1) * 16 + swz / 64; C = (st & 1) * 32 + (swz % 64) / 2; }
__host__ __device__ __forceinline__ int perm32(int rho) { const int n = rho >> 4, i = rho & 15; return 8 * (i >> 2) + 4 * n + (i & 3); }

struct Unit { int pm, pn; };
struct Gemm { const bf16_t* A; const bf16_t* Bt; int M, N, K; };

struct StaticOrder {
    int nM, nN, nwg, G, c;
    __host__ __device__ void init(int M, int N, int G_, int c_) { nM = M / BM; nN = N / BM; nwg = nM * nN; G = G_; c = c_; }
    __host__ __device__ bool next(int i, Unit& u) const {
        const long L = (long)i * G + c; if (L >= nwg) return false;
        int wgid = (int)L; { const int q = nwg / NXCD, r = nwg % NXCD, xcd = wgid % NXCD, off = wgid / NXCD; wgid = (xcd < r ? xcd * (q + 1) : r * (q + 1) + (xcd - r) * q) + off; }
        const int nig = WGM * nN, gid = wgid / nig, fm = gid * WGM, gsz = (nM - fm) < WGM ? (nM - fm) : WGM;
        u.pm = fm + ((wgid % nig) % gsz); u.pn = (wgid % nig) / gsz; return true;
    }
    __device__ __forceinline__ void a_ready(const Unit&) const {}
    __device__ __forceinline__ void done(const Unit&) const {}
};

__device__ __forceinline__ unsigned cvt_pk_bf16(float lo, float hi) { unsigned r; asm volatile("v_cvt_pk_bf16_f32 %0, %1, %2" : "=v"(r) : "v"(lo), "v"(hi)); return r; }
struct EpiP {
    static constexpr bool PERM = true, AFTER_DRAIN = false;
    bf16_t* P; float* G;
    __device__ __forceinline__ void operator()(const f32x4 (&acc)[2][2][4][2], const Unit& u, int wr, int wc, int fr, int fq) const {
        const int row0 = u.pm * BM + wr * 64 + fr;
        if (u.pn < 20) {
            const int col0 = u.pn * BM + wc * 32 + 8 * fq;
#pragma unroll
            for (int ai = 0; ai < 2; ++ai)
#pragma unroll
                for (int m = 0; m < 4; ++m) { bf16_t* rowp = P + (size_t)(row0 + ai * HALF + m * 16) * 5120 + col0;
#pragma unroll
                    for (int bj = 0; bj < 2; ++bj) { const f32x4 v0 = acc[ai][bj][m][0], v1 = acc[ai][bj][m][1];
                        u32x4 w; w.x = cvt_pk_bf16(v0[0], v0[1]); w.y = cvt_pk_bf16(v0[2], v0[3]); w.z = cvt_pk_bf16(v1[0], v1[1]); w.w = cvt_pk_bf16(v1[2], v1[3]);
                        *(u32x4*)(rowp + bj * HALF) = w; } }
        } else if (wc < 2) {
            const int col0 = wc * 32 + 8 * fq;
#pragma unroll
            for (int ai = 0; ai < 2; ++ai)
#pragma unroll
                for (int m = 0; m < 4; ++m) { float* rowp = G + (size_t)(row0 + ai * HALF + m * 16) * 64 + col0;
                    *(f32x4*)(rowp) = acc[ai][0][m][0]; *(f32x4*)(rowp + 4) = acc[ai][0][m][1]; }
        }
    }
};
struct EpiRes {
    static constexpr bool PERM = false, AFTER_DRAIN = false;
    const float* base0; const float* base1; float* out; const float* gate;
    __device__ __forceinline__ void operator()(const f32x4 (&acc)[2][2][4][2], const Unit& u, int wr, int wc, int fr, int fq) const {
        const int row0 = u.pm * BM + wr * 64 + fr; const int col0 = u.pn * BM + wc * 32 + 4 * fq;
        const int cond = (u.pm < 16) ? 0 : 1 + ((u.pm - 16) >> 2);
        const float* base = (u.pm < 16) ? base0 : base1;
        const float* gp = gate + (size_t)cond * 6 * 2048 + col0;
        f32x4 gv[2][2];
#pragma unroll
        for (int bj = 0; bj < 2; ++bj)
#pragma unroll
            for (int n = 0; n < 2; ++n) gv[bj][n] = *(const f32x4*)(gp + bj * HALF + n * 16);
#pragma unroll
        for (int ai = 0; ai < 2; ++ai)
#pragma unroll
            for (int m = 0; m < 4; ++m) { const size_t off = (size_t)(row0 + ai * HALF + m * 16) * 2048 + col0;
#pragma unroll
                for (int bj = 0; bj < 2; ++bj)
#pragma unroll
                    for (int n = 0; n < 2; ++n) { const f32x4 b = *(const f32x4*)(base + off + bj * HALF + n * 16);
                        *(f32x4*)(out + off + bj * HALF + n * 16) = b + gv[bj][n] * acc[ai][bj][m][n]; } }
    }
};
struct EpiSqRelu {
    static constexpr bool PERM = true, AFTER_DRAIN = false;
    bf16_t* O; int ldc;
    __device__ __forceinline__ void operator()(const f32x4 (&acc)[2][2][4][2], const Unit& u, int wr, int wc, int fr, int fq) const {
        const int row0 = u.pm * BM + wr * 64 + fr; const int col0 = u.pn * BM + wc * 32 + 8 * fq;
#pragma unroll
        for (int ai = 0; ai < 2; ++ai)
#pragma unroll
            for (int m = 0; m < 4; ++m) { bf16_t* rowp = O + (size_t)(row0 + ai * HALF + m * 16) * ldc + col0;
#pragma unroll
                for (int bj = 0; bj < 2; ++bj) { f32x4 v0 = acc[ai][bj][m][0], v1 = acc[ai][bj][m][1];
#pragma unroll
                    for (int e = 0; e < 4; ++e) { const float a = fmaxf(v0[e], 0.f), b = fmaxf(v1[e], 0.f); v0[e] = a * a; v1[e] = b * b; }
                    u32x4 w; w.x = cvt_pk_bf16(v0[0], v0[1]); w.y = cvt_pk_bf16(v0[2], v0[3]); w.z = cvt_pk_bf16(v1[0], v1[1]); w.w = cvt_pk_bf16(v1[2], v1[3]);
                    *(u32x4*)(rowp + bj * HALF) = w; } }
    }
};

template <class Epi, class Sched, bool ALIGN_EPI = false, bool SP2 = false>
__device__ __forceinline__ void gemm_phase(PG8_LAS unsigned char* lds, const Gemm g, const Sched& S, const Epi& E) {
    int tid = threadIdx.x; asm volatile("" : "+v"(tid)); const int wid = __builtin_amdgcn_readfirstlane(tid >> 6), lane = tid & 63, wr = wid >> 2, wc = wid & 3, fr = lane & 15, fq = lane >> 4;
    const int K = g.K, nt = K / BK;
    unsigned voffA[2], voffB[2];
#pragma unroll
    for (int i = 0; i < 2; ++i) { int R, C; stage_rc(tid * 16 + i * 8192, R, C); const int Rb = Epi::PERM ? ((R & ~31) + perm32(R & 31)) : R;
        voffA[i] = (unsigned)(R * K + C) * 2u; voffB[i] = (unsigned)(Rb * K + C) * 2u; }
    const size_t kstep = (size_t)(BK * 2);
    const size_t hstep = (size_t)HALF * K * 2;
    const size_t tstep = 2 * hstep;
    const unsigned ldsw = (unsigned)wid * 1024u;
    const int aoff = lds_byte(wr * 64 + fr, fq * 8), boff = lds_byte(wc * 32 + fr, fq * 8);
#define PG8_SA(b, h) (((b) * 2 + (h)) * HTB)
#define PG8_SB(b, h) ((4 + (b) * 2 + (h)) * HTB)
#define PG8_STAGE(bufoff, gbase, voff) do { _Pragma("unroll") for (int _i = 0; _i < 2; ++_i) \
        __builtin_amdgcn_global_load_lds((const unsigned*)((const char*)(gbase) + (voff)[_i]), (PG8_LAS unsigned*)(lds + (bufoff) + ldsw + _i * 8192), 16, 0, 0); } while (0)
#define PG8_LDA(dst, b, h) do { _Pragma("unroll") for (int m = 0; m < 4; ++m) _Pragma("unroll") for (int k = 0; k < 2; ++k) dst[m][k] = *(const PG8_LAS bf16x8*)(lds + PG8_SA(b, h) + aoff + m * 2048 + k * 1024); } while (0)
#define PG8_LDB(dst, b, h) do { _Pragma("unroll") for (int n = 0; n < 2; ++n) _Pragma("unroll") for (int k = 0; k < 2; ++k) dst[n][k] = *(const PG8_LAS bf16x8*)(lds + PG8_SB(b, h) + boff + n * 2048 + k * 1024); } while (0)
#define PG8_MMA(ai, bj, At, Bt) do { __builtin_amdgcn_s_setprio(1); _Pragma("unroll") for (int m = 0; m < 4; ++m) _Pragma("unroll") for (int n = 0; n < 2; ++n) _Pragma("unroll") for (int k = 0; k < 2; ++k) \
        acc[ai][bj][m][n] = __builtin_amdgcn_mfma_f32_16x16x32_bf16(Bt[n][k], At[m][k], acc[ai][bj][m][n], 0, 0, 0); __builtin_amdgcn_s_setprio(0); } while (0)
#define PG8_WAIT_V(n) asm volatile("s_waitcnt vmcnt(" #n ")" ::: "memory")
#define PG8_WAIT_L(n) asm volatile("s_waitcnt lgkmcnt(" #n ")" ::: "memory")
#define PG8_BAR __builtin_amdgcn_s_barrier()
#define PG8_SCHED __builtin_amdgcn_sched_barrier(0)
    Unit cur, nxt; int ui = 0;
    if (!S.next(0, cur)) return;
    f32x4 acc[2][2][4][2];
#pragma unroll
    for (int a = 0; a < 2; ++a)
#pragma unroll
        for (int b = 0; b < 2; ++b)
#pragma unroll
            for (int m = 0; m < 4; ++m)
#pragma unroll
                for (int n = 0; n < 2; ++n) acc[a][b][m][n] = (f32x4){0.f, 0.f, 0.f, 0.f};
    bf16x8 At[4][2], B0[2][2], B1[2][2];
    const char* cA = (const char*)g.A + (size_t)cur.pm * tstep; const char* cB = (const char*)g.Bt + (size_t)cur.pn * tstep;
    S.a_ready(cur);
    if constexpr (SP2) {
        PG8_STAGE(PG8_SB(0, 0), cB, voffB); PG8_STAGE(PG8_SB(0, 1), cB + hstep, voffB); PG8_STAGE(PG8_SA(0, 0), cA, voffA); PG8_STAGE(PG8_SA(0, 1), cA + hstep, voffA);
        if (wr == 1) PG8_BAR;
        PG8_WAIT_V(2); PG8_BAR;
        PG8_STAGE(PG8_SB(1, 0), cB + kstep, voffB); PG8_STAGE(PG8_SA(1, 0), cA + kstep, voffA); PG8_STAGE(PG8_SB(1, 1), cB + hstep + kstep, voffB);
        PG8_WAIT_V(6); PG8_BAR;
    } else {
        PG8_STAGE(PG8_SB(0, 0), cB, voffB); PG8_STAGE(PG8_SA(0, 0), cA, voffA); PG8_STAGE(PG8_SB(0, 1), cB + hstep, voffB); PG8_STAGE(PG8_SA(0, 1), cA + hstep, voffA);
        if (wr == 1) PG8_BAR;
        PG8_WAIT_V(4); PG8_BAR;
        PG8_STAGE(PG8_SB(1, 0), cB + kstep, voffB); PG8_STAGE(PG8_SA(1, 0), cA + kstep, voffA); PG8_STAGE(PG8_SB(1, 1), cB + hstep + kstep, voffB);
        PG8_WAIT_V(6); PG8_BAR;
    }
    for (;;) {
        const bool has_next = S.next(ui + 1, nxt);
        const char* nA = has_next ? (const char*)g.A + (size_t)nxt.pm * tstep : cA; const char* nB = has_next ? (const char*)g.Bt + (size_t)nxt.pn * tstep : cB;
        for (int t = 0; t < nt; t += 2) {
            const bool last = (t == nt - 2);
            const char* a1 = cA + (size_t)(t + 1) * kstep;
            const char* a2 = last ? nA : cA + (size_t)(t + 2) * kstep; const char* b2 = last ? nB : cB + (size_t)(t + 2) * kstep;
            const char* a3 = a2 + kstep; const char* b3 = b2 + kstep;
            if (last && has_next) S.a_ready(nxt);
            if constexpr (SP2) {
            PG8_LDB(B0, 0, 0); PG8_LDB(B1, 0, 1); PG8_SCHED; PG8_LDA(At, 0, 0); PG8_STAGE(PG8_SA(1, 1), a1 + hstep, voffA);
            PG8_WAIT_V(8); PG8_WAIT_L(0); PG8_BAR; PG8_MMA(0, 0, At, B0); PG8_MMA(0, 1, At, B1); PG8_BAR; PG8_SCHED;
            PG8_LDA(At, 0, 1); PG8_STAGE(PG8_SB(0, 0), b2, voffB); PG8_STAGE(PG8_SB(0, 1), b2 + hstep, voffB); PG8_STAGE(PG8_SA(0, 0), a2, voffA);
            PG8_WAIT_V(8); PG8_WAIT_L(0); PG8_BAR; PG8_MMA(1, 0, At, B0); PG8_MMA(1, 1, At, B1); PG8_BAR; PG8_SCHED;
            PG8_LDB(B0, 1, 0); PG8_LDB(B1, 1, 1); PG8_SCHED; PG8_LDA(At, 1, 0); PG8_STAGE(PG8_SA(0, 1), a2 + hstep, voffA);
            PG8_WAIT_V(8); PG8_WAIT_L(0); PG8_BAR; PG8_MMA(0, 0, At, B0); PG8_MMA(0, 1, At, B1); PG8_BAR; PG8_SCHED;
            PG8_LDA(At, 1, 1); PG8_STAGE(PG8_SB(1, 0), b3, voffB); PG8_STAGE(PG8_SB(1, 1), b3 + hstep, voffB); PG8_STAGE(PG8_SA(1, 0), a3, voffA);
            PG8_WAIT_V(8); PG8_WAIT_L(0); PG8_BAR; PG8_MMA(1, 0, At, B0); PG8_MMA(1, 1, At, B1); PG8_BAR; PG8_SCHED;
            } else {
            PG8_LDB(B0, 0, 0); PG8_SCHED; PG8_LDA(At, 0, 0); PG8_STAGE(PG8_SA(1, 1), a1 + hstep, voffA);
            PG8_WAIT_L(8); PG8_BAR; PG8_WAIT_L(0); PG8_MMA(0, 0, At, B0); PG8_BAR; PG8_SCHED;
            PG8_LDB(B1, 0, 1); PG8_STAGE(PG8_SB(0, 0), b2, voffB);
            PG8_BAR; PG8_WAIT_L(0); PG8_MMA(0, 1, At, B1); PG8_BAR;
            PG8_LDA(At, 0, 1); PG8_STAGE(PG8_SA(0, 0), a2, voffA);
            PG8_BAR; PG8_WAIT_L(0); PG8_MMA(1, 0, At, B0); PG8_BAR; PG8_SCHED;
            PG8_STAGE(PG8_SB(0, 1), b2 + hstep, voffB);
            PG8_WAIT_V(6); PG8_BAR; PG8_MMA(1, 1, At, B1); PG8_BAR;
            PG8_LDB(B0, 1, 0); PG8_SCHED; PG8_LDA(At, 1, 0); PG8_STAGE(PG8_SA(0, 1), a2 + hstep, voffA);
            PG8_WAIT_L(8); PG8_BAR; PG8_WAIT_L(0); PG8_MMA(0, 0, At, B0); PG8_BAR; PG8_SCHED;
            PG8_LDB(B1, 1, 1); PG8_STAGE(PG8_SB(1, 0), b3, voffB);
            PG8_BAR; PG8_WAIT_L(0); PG8_MMA(0, 1, At, B1); PG8_BAR;
            PG8_LDA(At, 1, 1); PG8_STAGE(PG8_SA(1, 0), a3, voffA);
            PG8_BAR; PG8_WAIT_L(0); PG8_MMA(1, 0, At, B0); PG8_BAR; PG8_SCHED;
            PG8_STAGE(PG8_SB(1, 1), b3 + hstep, voffB);
            PG8_WAIT_V(6); PG8_BAR; PG8_MMA(1, 1, At, B1); PG8_BAR;
            }
        }
        if constexpr (ALIGN_EPI) { if (wr == 0) PG8_BAR; }
        if constexpr (!Epi::AFTER_DRAIN) { E(acc, cur, wr, wc, fr, fq); S.done(cur); }
        if (!has_next) break;
#pragma unroll
        for (int a = 0; a < 2; ++a)
#pragma unroll
            for (int b = 0; b < 2; ++b)
#pragma unroll
                for (int m = 0; m < 4; ++m)
#pragma unroll
                    for (int n = 0; n < 2; ++n) acc[a][b][m][n] = (f32x4){0.f, 0.f, 0.f, 0.f};
        cur = nxt; cA = nA; cB = nB; ++ui;
        if constexpr (ALIGN_EPI) { if (wr == 1) PG8_BAR; }
    }
    PG8_WAIT_V(0);
    if constexpr (!ALIGN_EPI) { if (wr == 0) PG8_BAR; }
    PG8_BAR;
    if constexpr (Epi::AFTER_DRAIN) { E.fused(acc, cur, wr, wc, fr, fq, lds, wid, lane); S.done(cur); }
#undef PG8_SA
#undef PG8_SB
#undef PG8_STAGE
#undef PG8_LDA
#undef PG8_LDB
#undef PG8_MMA
#undef PG8_WAIT_V
#undef PG8_WAIT_L
#undef PG8_BAR
#undef PG8_SCHED
}
}
namespace att {
typedef unsigned short bf16;
constexpr int   D = 128, NW = 8, QBLK = 32, KVBLK = 64;
constexpr float SCALE = 0.088388347648318440f;
constexpr float THR = 8.f;
constexpr int SDEPTH = 2;
constexpr size_t SHM_V = KVBLK * D * 2, SHM_K = KVBLK * D * 2, SHM_ATTN = 2 * SHM_V + 2 * SHM_K + NW * 64 * 4;
__device__ __forceinline__ bf16 f2bf_s(float f) { unsigned u = __builtin_bit_cast(unsigned, f); return (bf16)((u + 0x7fffu + ((u >> 16) & 1u)) >> 16); }
using bf16x8 = __attribute__((ext_vector_type(8))) short;
using s16x4  = __attribute__((ext_vector_type(4))) short;
using f32x16 = __attribute__((ext_vector_type(16))) float;
using f32x8  = __attribute__((ext_vector_type(8))) float;
using u32x4  = __attribute__((ext_vector_type(4))) unsigned;
#define KSWZ(row, colB) ((row) * 256 + ((colB) ^ (((row) & 7) << 4)))
#define SBAR() __builtin_amdgcn_sched_barrier(0)
__device__ __forceinline__ int crow(int r, int hi) { return (r & 3) + 8 * (r >> 2) + 4 * hi; }
__device__ __forceinline__ unsigned cvtpk(float lo, float hi) {
  unsigned r; asm volatile("v_cvt_pk_bf16_f32 %0, %1, %2" : "=v"(r) : "v"(lo), "v"(hi)); return r;
}
__device__ __forceinline__ void partialSM(f32x16& p0, f32x16& p1, float& m_reg, float& mn, float& alpha) {
  constexpr float C = SCALE * 1.4426950408889634f;
  float pmax = p0[0]; for (int r = 1; r < 16; ++r) pmax = fmaxf(pmax, p0[r]); for (int r = 0; r < 16; ++r) pmax = fmaxf(pmax, p1[r]);
  { auto rr = __builtin_amdgcn_permlane32_swap(__float_as_uint(pmax), __float_as_uint(pmax), false, false);
    pmax = fmaxf(__uint_as_float(rr[0]), __uint_as_float(rr[1])); }
  if (__builtin_expect(__all(pmax - m_reg <= THR / SCALE), 1)) { mn = m_reg; alpha = 1.f; }
  else { mn = fmaxf(m_reg, pmax); alpha = __builtin_amdgcn_exp2f((m_reg - mn) * C); m_reg = mn; }
  float mnC = -mn * C;
  for (int r = 0; r < 16; ++r) p0[r] = fmaf(p0[r], C, mnC); for (int r = 0; r < 16; ++r) p1[r] = fmaf(p1[r], C, mnC);
  for (int r = 0; r < 16; ++r) p0[r] = __builtin_amdgcn_exp2f(p0[r]);
}
__device__ __forceinline__ void finishSM(f32x16& p0, f32x16& p1, float alpha, float& l_reg, bf16x8& pa0, bf16x8& pa1, bf16x8& pa2, bf16x8& pa3) {
  for (int r = 0; r < 16; ++r) p1[r] = __builtin_amdgcn_exp2f(p1[r]);
  float ps = 0; for (int r = 0; r < 16; ++r) ps += p0[r]; for (int r = 0; r < 16; ++r) ps += p1[r];
  { auto rr = __builtin_amdgcn_permlane32_swap(__float_as_uint(ps), __float_as_uint(ps), false, false);
    ps = __uint_as_float(rr[0]) + __uint_as_float(rr[1]); }
  l_reg = l_reg * alpha + ps;
#define PK4(P, BASE, OUT) do { unsigned a0 = cvtpk(P[BASE + 0], P[BASE + 1]), a1 = cvtpk(P[BASE + 2], P[BASE + 3]);   \
    unsigned b0 = cvtpk(P[BASE + 4], P[BASE + 5]), b1 = cvtpk(P[BASE + 6], P[BASE + 7]);                              \
    auto r0 = __builtin_amdgcn_permlane32_swap(a0, b0, false, false); auto r1 = __builtin_amdgcn_permlane32_swap(a1, b1, false, false); \
    u32x4 w = {r0[0], r1[0], r0[1], r1[1]}; OUT = *reinterpret_cast<bf16x8*>(&w); } while (0)
  PK4(p0, 0, pa0); PK4(p0, 8, pa1); PK4(p1, 0, pa2); PK4(p1, 8, pa3);
#undef PK4
}
__device__ __forceinline__ void qkt(f32x16& p0, f32x16& p1, const bf16* Ks, const bf16x8* qr, int r32, int hi) {
  p0 = f32x16{}; p1 = f32x16{};
  for (int d0 = 0; d0 < 8; ++d0) { int cb = (d0 * 16 + hi * 8) * 2;
    bf16x8 b0 = *reinterpret_cast<const bf16x8*>((const char*)Ks + KSWZ(r32, cb));
    bf16x8 b1 = *reinterpret_cast<const bf16x8*>((const char*)Ks + KSWZ(32 + r32, cb));
    p0 = __builtin_amdgcn_mfma_f32_32x32x16_bf16(b0, qr[d0], p0, 0, 0, 0);
    p1 = __builtin_amdgcn_mfma_f32_32x32x16_bf16(b1, qr[d0], p1, 0, 0, 0); }
}
__device__ __forceinline__ int v_st(int k, int c) { const int kk = (k & ~0xC) | ((k & 4) << 1) | ((k & 8) >> 1); return ((kk >> 3) * 4 + (c >> 5)) * 512 + ((kk & 7) * 32 + (c & 31)) * 2; }
__device__ __forceinline__ int v_rd_base(int lane) { return ((lane & 3) << 3) | (((lane >> 2) & 3) << 6) | (((lane >> 4) & 1) << 5) | (((lane >> 5) & 1) << 8); }
constexpr int v_rd_off(int d0, int ks, int half) { return d0 * 512 + ks * 4096 + half * 2048; }
template <int OFF> __device__ __forceinline__ s16x4 tr_read(int vb) {
  s16x4 r; asm volatile("ds_read_b64_tr_b16 %0, %1 offset:%2" : "=&v"(r) : "v"(vb), "i"(OFF) : "memory"); return r;
}
template <int D0> __device__ __forceinline__ void pv_one(f32x16& od, int vb, bf16x8 pa0, bf16x8 pa1, bf16x8 pa2, bf16x8 pa3) {
  const s16x4 l0 = tr_read<v_rd_off(D0, 0, 0)>(vb), h0 = tr_read<v_rd_off(D0, 0, 1)>(vb), l1 = tr_read<v_rd_off(D0, 1, 0)>(vb), h1 = tr_read<v_rd_off(D0, 1, 1)>(vb);
  const s16x4 l2 = tr_read<v_rd_off(D0, 2, 0)>(vb), h2 = tr_read<v_rd_off(D0, 2, 1)>(vb), l3 = tr_read<v_rd_off(D0, 3, 0)>(vb), h3 = tr_read<v_rd_off(D0, 3, 1)>(vb);
  asm volatile("s_waitcnt lgkmcnt(0)" ::: "memory"); SBAR();
#define PK(L, H) (bf16x8){L[0], L[1], L[2], L[3], H[0], H[1], H[2], H[3]}
  od = __builtin_amdgcn_mfma_f32_32x32x16_bf16(pa0, PK(l0, h0), od, 0, 0, 0);
  od = __builtin_amdgcn_mfma_f32_32x32x16_bf16(pa1, PK(l1, h1), od, 0, 0, 0);
  od = __builtin_amdgcn_mfma_f32_32x32x16_bf16(pa2, PK(l2, h2), od, 0, 0, 0);
  od = __builtin_amdgcn_mfma_f32_32x32x16_bf16(pa3, PK(l3, h3), od, 0, 0, 0);
#undef PK
}
__device__ __forceinline__ void pv_d0(f32x16* o, int vb, bf16x8 pa0, bf16x8 pa1, bf16x8 pa2, bf16x8 pa3) {
  pv_one<0>(o[0], vb, pa0, pa1, pa2, pa3); pv_one<1>(o[1], vb, pa0, pa1, pa2, pa3); pv_one<2>(o[2], vb, pa0, pa1, pa2, pa3); pv_one<3>(o[3], vb, pa0, pa1, pa2, pa3);
}

template <int LDQ, int LDK, int LDO>
__device__ __forceinline__ void attn_dense_body(const bf16* Qb, const bf16* Kh, const bf16* Vh,
                                                bf16* Ob, int seq, char* lds) {
  int tid = threadIdx.x; asm volatile("" : "+v"(tid)); const int wid = tid >> 6, lane = tid & 63, r32 = lane & 31, hi = lane >> 5;
  bf16* V_lds = (bf16*)lds; bf16* K_lds = (bf16*)(lds + 2 * SHM_V);
  float* ws = (float*)(lds + 2 * SHM_V + 2 * SHM_K) + wid * 64; float* li_l = ws; float* al_l = ws + 32;
  float m_reg = -1e30f, l_reg = 0; f32x16 o[4] = {}; bf16x8 qr[8];
  const bf16* Qw = Qb + (long)(wid * QBLK + r32) * LDQ + hi * 8;
#pragma unroll
  for (int d0 = 0; d0 < 8; ++d0) qr[d0] = *reinterpret_cast<const bf16x8*>(Qw + d0 * 16);
  const int sr = tid >> 4, sc = (tid & 15) * 8, vst0 = v_st(sr, sc), vst1 = v_st(32 + sr, sc);
  const int vb0 = (int)(uintptr_t)V_lds + v_rd_base(lane);
  struct { bf16x8 vs0, vs1, ks0, ks1; } sr_[SDEPTH];
#define SLOAD(i, k0) do { sr_[i].vs0 = (*reinterpret_cast<const bf16x8*>(&Vh[(long)((k0) + sr) * LDK + sc])); sr_[i].vs1 = (*reinterpret_cast<const bf16x8*>(&Vh[(long)((k0) + 32 + sr) * LDK + sc])); \
    sr_[i].ks0 = (*reinterpret_cast<const bf16x8*>(&Kh[(long)((k0) + sr) * LDK + sc])); sr_[i].ks1 = (*reinterpret_cast<const bf16x8*>(&Kh[(long)((k0) + 32 + sr) * LDK + sc])); } while (0)
#define SWRITE(b, i) do { *(bf16x8*)((char*)V_lds + (b) * SHM_V + vst0) = (sr_[i].vs0);          \
    *(bf16x8*)((char*)V_lds + (b) * SHM_V + vst1) = (sr_[i].vs1); int kc = sc * 2;               \
    *(bf16x8*)((char*)K_lds + (b) * SHM_K + KSWZ(sr, kc)) = (sr_[i].ks0);                       \
    *(bf16x8*)((char*)K_lds + (b) * SHM_K + KSWZ(32 + sr, kc)) = (sr_[i].ks1); } while (0)
#define SWAIT() do { if constexpr (SDEPTH == 2) asm volatile("s_waitcnt vmcnt(4)" ::: "memory"); else asm volatile("s_waitcnt vmcnt(0)" ::: "memory"); } while (0)
#define RESC(a) do { if (__any((a) < 1.f)) { if (hi == 0) al_l[r32] = (a); asm volatile("s_waitcnt lgkmcnt(0)" ::: "memory"); \
    for (int d = 0; d < 4; ++d) for (int r = 0; r < 16; ++r) o[d][r] *= al_l[crow(r, hi)]; } } while (0)
  f32x16 pA0, pA1, pB0, pB1; float mnA, mnB, alA, alB; bf16x8 pa0, pa1, pa2, pa3; const int NT = seq / KVBLK;
  constexpr int SE = 0, SO = SDEPTH - 1;
  SLOAD(SE, 0); asm volatile("s_waitcnt vmcnt(0)" ::: "memory"); SWRITE(0, SE); __syncthreads();
  qkt(pA0, pA1, K_lds, qr, r32, hi); partialSM(pA0, pA1, m_reg, mnA, alA);
  SLOAD(SO, KVBLK); if constexpr (SDEPTH == 2) { if (2 < NT) SLOAD(SE, 2 * KVBLK); }
  SWAIT(); SWRITE(1, SO); __syncthreads();
  for (int j = 1; j + 1 < NT; j += 2) {
    SBAR(); qkt(pB0, pB1, (bf16*)((char*)K_lds + SHM_K), qr, r32, hi);
    finishSM(pA0, pA1, alA, l_reg, pa0, pa1, pa2, pa3); SBAR();
    SLOAD(SO, (j + SDEPTH) * KVBLK); SBAR();
    pv_d0(o, vb0, pa0, pa1, pa2, pa3); partialSM(pB0, pB1, m_reg, mnB, alB);
    __syncthreads(); SWAIT(); SWRITE(0, SE);
    RESC(alB); __syncthreads();
    SBAR(); qkt(pA0, pA1, K_lds, qr, r32, hi);
    finishSM(pB0, pB1, alB, l_reg, pa0, pa1, pa2, pa3); SBAR();
    if (SDEPTH == 1 || j + 3 < NT) SLOAD(SE, (j + 1 + SDEPTH) * KVBLK); SBAR();
    pv_d0(o, vb0 + (int)SHM_V, pa0, pa1, pa2, pa3); partialSM(pA0, pA1, m_reg, mnA, alA);
    __syncthreads(); SWAIT(); SWRITE(1, SO);
    RESC(alA); __syncthreads();
  }
  SBAR(); qkt(pB0, pB1, (bf16*)((char*)K_lds + SHM_K), qr, r32, hi);
  finishSM(pA0, pA1, alA, l_reg, pa0, pa1, pa2, pa3); SBAR();
  pv_d0(o, vb0, pa0, pa1, pa2, pa3); partialSM(pB0, pB1, m_reg, mnB, alB);
  __syncthreads(); RESC(alB);
  finishSM(pB0, pB1, alB, l_reg, pa0, pa1, pa2, pa3); SBAR();
  pv_d0(o, vb0 + (int)SHM_V, pa0, pa1, pa2, pa3);
  if (hi == 0) li_l[r32] = l_reg; asm volatile("s_waitcnt lgkmcnt(0)" ::: "memory");
  float rli[16];
#pragma unroll
  for (int r = 0; r < 16; ++r) rli[r] = __builtin_amdgcn_rcpf(li_l[crow(r, hi)]);
  bf16* Ow = Ob + (long)(wid * QBLK) * LDO;
#pragma unroll
  for (int r = 0; r < 16; ++r) { int orow = crow(r, hi);
    for (int d0 = 0; d0 < 4; ++d0) Ow[(long)orow * LDO + d0 * 32 + r32] = f2bf_s(o[d0][r] * rli[r]); }
#undef SLOAD
#undef SWRITE
#undef SWAIT
#undef RESC
}
#undef KSWZ
#undef SBAR
}
typedef unsigned short bf16_t;
typedef float f32x4 __attribute__((ext_vector_type(4)));
typedef float f32x2 __attribute__((ext_vector_type(2)));
typedef unsigned u32x4 __attribute__((ext_vector_type(4)));
typedef unsigned u32x2 __attribute__((ext_vector_type(2)));
#define LAS __attribute__((address_space(3)))
constexpr int DM = 2048, NTOK = 8192, INC = 5168, PNW = 5376, PLD = 5120, FFD = 8192, NMOD = 12288;
constexpr size_t MiB = 1u << 20;
constexpr size_t WS_CTL = 0, WS_MODS = 1 * MiB, WS_WIN = 2 * MiB, WS_WOUT = 44 * MiB, WS_WFF1 = 60 * MiB, WS_WFF2 = 124 * MiB, WS_H = 188 * MiB, WS_XA = 220 * MiB, WS_XB = 284 * MiB,
    WS_P = 348 * MiB, WS_G = 428 * MiB, WS_QN = 430 * MiB, WS_KB = 446 * MiB, WS_VB = 451 * MiB, WS_LA = 456 * MiB, WS_DQKV = 472 * MiB, WS_GB = 496 * MiB, WS_OG = 497 * MiB, WS_OD = 529 * MiB,
    WS_MIX = 561 * MiB, WS_GQ = 593 * MiB, WS_GO = 601 * MiB, WS_GU = 617 * MiB, WS_GD = 633 * MiB, WS_END = 634 * MiB;
constexpr size_t WS_MC = 188 * MiB, WS_NC = 220 * MiB, WS_QE = 252 * MiB, WS_OL = 268 * MiB;
constexpr size_t WS_QUEUE = 32768;
constexpr size_t WS_H2 = 348 * MiB;
constexpr size_t ZERO_BYTES = 2 * MiB;
constexpr size_t OUT_Y = 0, OUT_CK = 16777216, OUT_CV = 18874368, OUT_SG = 20971520, OUT_SD = 23068672, OUT_TOTAL = 27262976;
constexpr int LDS_BYTES = 147456;
constexpr float EPS = 1e-6f;

struct Params { const float* in[25]; float* out; unsigned char* ws; };
constexpr int PTAB_OFF = 147456 - 512;
typedef __attribute__((address_space(3))) const unsigned* ptab_t;
__device__ __forceinline__ const void* ldp(ptab_t pt, int i) { unsigned a; asm volatile("v_mov_b32 %0, %1" : "=v"(a) : "s"((unsigned)(unsigned long long)pt + 8u * (unsigned)i));
    const ptab_t q = (ptab_t)(unsigned long long)a; const unsigned lo = __builtin_amdgcn_readfirstlane(q[0]), hi = __builtin_amdgcn_readfirstlane(q[1]); return (const void*)(((unsigned long long)hi << 32) | lo); }
#define PIN(i) ((const float*)ldp(pt, (i)))
#define POUT ((float*)ldp(pt, 25))
#define PWS ((unsigned char*)ldp(pt, 26))

__device__ __forceinline__ float bf2f(unsigned short v) { return __uint_as_float(((unsigned)v) << 16); }
__device__ __forceinline__ float bflo(unsigned w) { return __uint_as_float(w << 16); }
__device__ __forceinline__ float bfhi(unsigned w) { return __uint_as_float(w & 0xffff0000u); }
__device__ __forceinline__ unsigned short f2bf(float f) { unsigned u = __float_as_uint(f); return (unsigned short)((u + 0x7fffu + ((u >> 16) & 1u)) >> 16); }
__device__ __forceinline__ unsigned pk2(float lo, float hi) { return (unsigned)f2bf(lo) | ((unsigned)f2bf(hi) << 16); }
__device__ __forceinline__ float wave_sum(float v) {
#pragma unroll
    for (int o = 1; o < 64; o <<= 1) v += __shfl_xor(v, o);
    return v;
}
__device__ __forceinline__ float silu_f(float x) { return x / (1.f + __expf(-x)); }
__device__ __forceinline__ float softplus_f(float x) { return fmaxf(x, 0.f) + log1pf(__expf(-fabsf(x))); }
__device__ __forceinline__ float logsigmoid_f(float x) { return fminf(x, 0.f) - log1pf(__expf(-fabsf(x))); }
#define LDS_WAIT() asm volatile("s_waitcnt lgkmcnt(0)" ::: "memory")
__device__ __forceinline__ int tid_opaque() { int t = threadIdx.x; asm volatile("" : "+v"(t)); return t; }

template <bool GUARD>
__device__ __forceinline__ void transpose_item(const float* W, int ldw, int o0, int nvalid, int K, bf16_t* WT, int n0, int k0, LAS float* scr, int lane) {
#pragma unroll 8
    for (int i = 0; i < 32; ++i) { const int kk = 2 * i + (lane >> 5), c = lane & 31; float v;
        if (GUARD) { v = 0.f; if (c < nvalid) v = W[(size_t)(k0 + kk) * ldw + o0 + c]; } else v = W[(size_t)(k0 + kk) * ldw + o0 + c];
        scr[kk * 33 + c] = v; }
    LDS_WAIT(); asm volatile("" ::: "memory");
    const int c8 = lane & 7;
#pragma unroll
    for (int j = 0; j < 4; ++j) { const int n = (lane >> 3) + 8 * j; const LAS float* s = scr + (8 * c8) * 33 + n;
        u32x4 o; o.x = pk2(s[0 * 33], s[1 * 33]); o.y = pk2(s[2 * 33], s[3 * 33]); o.z = pk2(s[4 * 33], s[5 * 33]); o.w = pk2(s[6 * 33], s[7 * 33]);
        *(u32x4*)(WT + (size_t)(n0 + n) * K + k0 + 8 * c8) = o; }
    LDS_WAIT(); asm volatile("" ::: "memory");
}
__device__ __forceinline__ void p0_prologue(ptab_t pt, LAS unsigned char* lds, int bid, int nb, bool do_mods) {
    const int tid = tid_opaque(), lane = tid & 63, wave = __builtin_amdgcn_readfirstlane(tid >> 6);
    unsigned char* ws = PWS;
    {
        LAS float* scr = (LAS float*)(lds + wave * 8448);
        constexpr int I_IN = 32 * 168, I_OUT = 32 * 64, I_F1 = 32 * 256, I_F2 = 128 * 64, I_L = I_IN + I_OUT + I_F1 + I_F2;
        const int gw = bid * 8 + wave, NGW = nb * 8;
        for (int it = gw; it < 2 * I_L; it += NGW) {
            const int l = it / I_L; int r = it - l * I_L;
            const float* W; bf16_t* WT; int ldw, K, kb, nbk, o0, nvalid = 32;
            if (r < I_IN) { kb = r / 168; nbk = r % 168; const int n0 = 32 * nbk; W = PIN(12) + (size_t)l * 2048 * INC; WT = (bf16_t*)(ws + WS_WIN) + (size_t)l * PNW * 2048; ldw = INC; K = 2048;
                o0 = n0 < 1536 ? n0 : (n0 < 5120 ? n0 + 32 : (n0 < 5152 ? n0 - 5120 + 1536 : (n0 < INC ? n0 : 0))); nvalid = n0 < 5152 ? 32 : (n0 == 5152 ? 16 : 0); }
            else if ((r -= I_IN) < I_OUT) { kb = r / 64; nbk = r % 64; W = PIN(22) + (size_t)l * 2048 * 2048; WT = (bf16_t*)(ws + WS_WOUT) + (size_t)l * 2048 * 2048; ldw = 2048; K = 2048; o0 = 32 * nbk; }
            else if ((r -= I_OUT) < I_F1) { kb = r / 256; nbk = r % 256; W = PIN(23) + (size_t)l * 2048 * 8192; WT = (bf16_t*)(ws + WS_WFF1) + (size_t)l * 8192 * 2048; ldw = 8192; K = 2048; o0 = 32 * nbk; }
            else { r -= I_F1; kb = r / 64; nbk = r % 64; W = PIN(24) + (size_t)l * 8192 * 2048; WT = (bf16_t*)(ws + WS_WFF2) + (size_t)l * 2048 * 8192; ldw = 2048; K = 8192; o0 = 32 * nbk; }
            if (nvalid == 32) transpose_item<false>(W, ldw, o0, 32, K, WT, 32 * nbk, 64 * kb, scr, lane);
            else transpose_item<true>(W, ldw, o0, nvalid, K, WT, 32 * nbk, 64 * kb, scr, lane);
        }
    }
    __syncthreads();
    if (do_mods) {
        LAS float* sc = (LAS float*)lds;
        LAS float* red = (LAS float*)(lds + 10240);
        float* mods = (float*)(ws + WS_MODS);
        for (int it = bid; it < 384; it += nb) {
            const int l = it / 192, rem = it % 192, nc = rem >> 2, kq = rem & 3;
            for (int idx = tid; idx < 5 * 512; idx += 512) { const int j = idx >> 9, kk = idx & 511, k = kq * 512 + kk;
                const float cv = (j == 0) ? PIN(7)[k] : PIN(6)[(j - 1) * 2048 + k]; sc[idx] = silu_f(cv); }
            __syncthreads();
            const float* Wp = PIN(10) + ((size_t)l * 2048 + kq * 512 + wave * 64) * NMOD + nc * 256 + lane * 4;
            f32x4 acc[5];
#pragma unroll
            for (int j = 0; j < 5; ++j) acc[j] = (f32x4){0.f, 0.f, 0.f, 0.f};
#pragma unroll 8
            for (int kk = 0; kk < 64; ++kk) { const f32x4 w = *(const f32x4*)(Wp + (size_t)kk * NMOD);
#pragma unroll
                for (int j = 0; j < 5; ++j) acc[j] += sc[j * 512 + wave * 64 + kk] * w; }
#pragma unroll
            for (int j = 0; j < 5; ++j) *(LAS f32x4*)(red + (wave * 5 + j) * 256 + lane * 4) = acc[j];
            __syncthreads();
            for (int idx = tid; idx < 1280; idx += 512) { const int j = idx >> 8, col = idx & 255; float s = 0.f;
#pragma unroll
                for (int w = 0; w < 8; ++w) s += red[(w * 5 + j) * 256 + col];
                if (kq == 0) s += PIN(11)[(size_t)l * NMOD + nc * 256 + col];
                atomicAdd(mods + ((size_t)l * 5 + j) * NMOD + nc * 256 + col, s); }
            __syncthreads();
        }
    }
}

__device__ __forceinline__ void norm_phase(const float* x0, const float* x1, const float* g, const float* mods_l, int shift_i, int scale_i, bf16_t* H, int bid, int nb) {
    const int tid = tid_opaque(), lane = tid & 63, wave = tid >> 6;
    for (int r = bid * 8 + wave; r < NTOK; r += nb * 8) {
        const float* xr = (r < 4096 ? x0 : x1) + (size_t)r * DM;
        f32x4 v[8]; float ss = 0.f;
#pragma unroll
        for (int j = 0; j < 8; ++j) { v[j] = *(const f32x4*)(xr + 4 * (lane + 64 * j)); ss += (v[j].x * v[j].x + v[j].y * v[j].y) + (v[j].z * v[j].z + v[j].w * v[j].w); }
        const float rstd = rsqrtf(wave_sum(ss) * (1.f / DM) + EPS);
        const int cond = r < 4096 ? 0 : 1 + ((r - 4096) >> 10);
        const float* sh = mods_l + ((size_t)cond * 6 + shift_i) * DM; const float* sc = mods_l + ((size_t)cond * 6 + scale_i) * DM;
#pragma unroll
        for (int j = 0; j < 8; ++j) { const int col = 4 * (lane + 64 * j); const f32x4 gg = *(const f32x4*)(g + col), s = *(const f32x4*)(sc + col), h = *(const f32x4*)(sh + col);
            const f32x4 o = v[j] * rstd * gg * (s + 1.f) + h; u32x2 w; w.x = pk2(o.x, o.y); w.y = pk2(o.z, o.w); *(u32x2*)(H + (size_t)r * DM + col) = w; }
    }
}

__device__ __forceinline__ void prep_phase(ptab_t pt, int l, LAS unsigned char* lds, int bid, int nb) {
    const int tid = tid_opaque(), lane = tid & 63, wave = tid >> 6;
    unsigned char* ws = PWS;
    const bf16_t* P = (const bf16_t*)(ws + WS_P); const float* G = (const float*)(ws + WS_G);
    bf16_t* QN = (bf16_t*)(ws + WS_QN); bf16_t* KB = (bf16_t*)(ws + WS_KB); bf16_t* VB = (bf16_t*)(ws + WS_VB);
    float* LA = (float*)(ws + WS_LA); bf16_t* DQKV = (bf16_t*)(ws + WS_DQKV); float* GB = (float*)(ws + WS_GB);
    float* out_ck = POUT + OUT_CK; float* out_cv = POUT + OUT_CV;
    LAS float* w2s = (LAS float*)lds;
    for (int i = tid; i < 8192; i += 512) w2s[i] = PIN(13)[(size_t)l * 8192 + i];
    for (int i = tid; i < 512; i += 512) w2s[8192 + i] = PIN(14)[(size_t)l * 512 + i];
    __syncthreads();
    const float qg0 = PIN(16)[l * 128 + lane], qg1 = PIN(16)[l * 128 + 64 + lane], kg0 = PIN(17)[l * 128 + lane], kg1 = PIN(17)[l * 128 + 64 + lane];
    const float inv = exp2f(-(float)(lane & 31) * (13.287712379549449f / 32.f));
    const float sgn = lane < 32 ? -1.f : 1.f;
    for (int r = bid * 8 + wave; r < NTOK; r += nb * 8) {
        const bool lat = r >= 4096; const int rr = lat ? r - 4096 : r; const int b = lat ? rr >> 10 : rr >> 8; const int t = lat ? rr & 1023 : rr & 255; const int L = lat ? 1024 : 256;
        const bf16_t* Pr = P + (size_t)r * PLD;
        float cR = 1.f, sR = 0.f, cC = 1.f, sC = 0.f;
        if (lat) { const float aR = (float)(t >> 6) * inv, aC = (float)(t & 63) * inv; sR = __sinf(aR); cR = __cosf(aR); sC = __sinf(aC); cC = __cosf(aC); }
#pragma unroll
        for (int h = 0; h < 8; ++h) {
            const float x0 = bf2f(Pr[1536 + h * 128 + lane]), x1 = bf2f(Pr[1536 + h * 128 + 64 + lane]);
            const float rstd = rsqrtf(wave_sum(x0 * x0 + x1 * x1) * (1.f / 128.f) + EPS);
            float y0 = x0 * rstd * qg0, y1 = x1 * rstd * qg1;
            if (lat) { const float p0 = __shfl_xor(y0, 32), p1 = __shfl_xor(y1, 32); const float n0 = y0 * cR + sgn * p0 * sR, n1 = y1 * cC + sgn * p1 * sC; y0 = n0; y1 = n1; }
            QN[(size_t)r * 1024 + h * 128 + lane] = f2bf(y0); QN[(size_t)r * 1024 + h * 128 + 64 + lane] = f2bf(y1);
        }
#pragma unroll
        for (int hk = 0; hk < 2; ++hk) {
            const float x0 = bf2f(Pr[2560 + hk * 128 + lane]), x1 = bf2f(Pr[2560 + hk * 128 + 64 + lane]);
            const unsigned short v0 = Pr[2816 + hk * 128 + lane], v1 = Pr[2816 + hk * 128 + 64 + lane];
            const float rstd = rsqrtf(wave_sum(x0 * x0 + x1 * x1) * (1.f / 128.f) + EPS);
            float y0 = x0 * rstd * kg0, y1 = x1 * rstd * kg1;
            if (!lat) { const size_t o = ((((size_t)b * 2 + l) * 256 + t) * 2 + hk) * 128;
                out_ck[o + lane] = y0; out_ck[o + 64 + lane] = y1; out_cv[o + lane] = bf2f(v0); out_cv[o + 64 + lane] = bf2f(v1);
                const size_t kr = (size_t)r * 256 + hk * 128; KB[kr + lane] = f2bf(y0); KB[kr + 64 + lane] = f2bf(y1); VB[kr + lane] = v0; VB[kr + 64 + lane] = v1; }
            else { const float p0 = __shfl_xor(y0, 32), p1 = __shfl_xor(y1, 32); const float n0 = y0 * cR + sgn * p0 * sR, n1 = y1 * cC + sgn * p1 * sC;
                const size_t kr = ((size_t)4096 + (size_t)b * 1280 + 256 + t) * 256 + hk * 128; KB[kr + lane] = f2bf(n0); KB[kr + 64 + lane] = f2bf(n1); VB[kr + lane] = v0; VB[kr + 64 + lane] = v1; }
        }
        {
            float lr[32];
#pragma unroll
            for (int j = 0; j < 8; ++j) { const f32x4 t4 = *(const f32x4*)(G + (size_t)r * 64 + 4 * j); lr[4 * j] = t4.x; lr[4 * j + 1] = t4.y; lr[4 * j + 2] = t4.z; lr[4 * j + 3] = t4.w; }
#pragma unroll
            for (int d = 0; d < 2; ++d)
#pragma unroll
                for (int jj = 0; jj < 4; ++jj) { const int n = lane + 64 * jj; float a = w2s[8192 + d * 256 + n];
#pragma unroll
                    for (int q = 0; q < 16; ++q) a += lr[d * 16 + q] * w2s[(d * 16 + q) * 256 + n];
                    LA[(size_t)r * 512 + d * 256 + n] = logsigmoid_f(a) * (1.f / 16.f); }
        }
        {
            const bool hasm = t > 0, hasp = t < L - 1;
            const float* cw = PIN(18) + (size_t)l * 3 * 1536;
#pragma unroll
            for (int blk = 0; blk < 12; ++blk) { const int c = blk * 128 + 2 * lane;
                const unsigned xm = hasm ? *(const unsigned*)(Pr - PLD + 3072 + c) : 0u, xc = *(const unsigned*)(Pr + 3072 + c), xp = hasp ? *(const unsigned*)(Pr + PLD + 3072 + c) : 0u;
                const f32x2 w0 = *(const f32x2*)(cw + c), w1 = *(const f32x2*)(cw + 1536 + c), w2 = *(const f32x2*)(cw + 3072 + c);
                float y0 = silu_f(w0.x * bflo(xm) + w1.x * bflo(xc) + w2.x * bflo(xp)), y1 = silu_f(w0.y * bfhi(xm) + w1.y * bfhi(xc) + w2.y * bfhi(xp));
                if (blk < 8) { const float sc = rsqrtf(wave_sum(y0 * y0 + y1 * y1) + EPS) * (blk < 4 ? 0.08838834764831845f : 1.f); y0 *= sc; y1 *= sc; }
                *(unsigned*)(DQKV + (size_t)r * 1536 + c) = pk2(y0, y1); }
        }
        if (lane < 8) { const float a = G[(size_t)r * 64 + 32 + lane], bb = G[(size_t)r * 64 + 40 + lane];
            GB[(size_t)r * 16 + lane] = -__expf(PIN(19)[l * 8 + lane]) * softplus_f(a + PIN(20)[l * 8 + lane]); GB[(size_t)r * 16 + 8 + lane] = 1.f / (1.f + __expf(-bb)); }
    }
    for (int i = bid * 512 + tid; i < 65536; i += nb * 512) { const int b = i >> 14, rem = i & 16383, pp = rem >> 6, c4 = rem & 63;
        const size_t src = (((size_t)b * 2 + l) * 256 + pp) * 256 + c4 * 4, dst = ((size_t)4096 + (size_t)b * 1280 + pp) * 256 + c4 * 4;
        const f32x4 k4 = *(const f32x4*)(PIN(2) + src), v4 = *(const f32x4*)(PIN(3) + src);
        u32x2 kw, vw; kw.x = pk2(k4.x, k4.y); kw.y = pk2(k4.z, k4.w); vw.x = pk2(v4.x, v4.y); vw.y = pk2(v4.z, v4.w);
        *(u32x2*)(KB + dst) = kw; *(u32x2*)(VB + dst) = vw; }
}

__device__ __forceinline__ void gla_naive_item(ptab_t pt, int l, bool lat, int b, int h, int d, LAS float* red) {
    const int tid = tid_opaque(), vq = tid & 127, kg = tid >> 7;
    unsigned char* ws = PWS;
    const bf16_t* P = (const bf16_t*)(ws + WS_P); const float* LA = (const float*)(ws + WS_LA); float* OG = (float*)(ws + WS_OG);
    const int L = lat ? 1024 : 256, rowbase = lat ? 4096 + b * 1024 : b * 256;
    float S[16];
    const size_t sidx = ((((size_t)b * 2 + l) * 2 + d) * 4 + h) * 8192 + (size_t)(kg * 16) * 128 + vq;
#pragma unroll
    for (int j = 0; j < 16; ++j) S[j] = lat ? PIN(4)[sidx + j * 128] : 0.f;
    f32x4 la[4], nla[4]; u32x4 kq[4], nkq[4]; unsigned short vv, nvv;
#define GLA_LOAD(LAv, KQv, Vv, step) do { const int t_ = d ? L - 1 - (step) : (step); const size_t r_ = (size_t)(rowbase + t_); \
        const float* lp_ = LA + r_ * 512 + d * 256 + h * 64 + kg * 16; const bf16_t* pr_ = P + r_ * PLD; \
        _Pragma("unroll") for (int j_ = 0; j_ < 4; ++j_) LAv[j_] = *(const f32x4*)(lp_ + 4 * j_); \
        KQv[0] = *(const u32x4*)(pr_ + 256 + h * 64 + kg * 16); KQv[1] = *(const u32x4*)(pr_ + 256 + h * 64 + kg * 16 + 8); \
        KQv[2] = *(const u32x4*)(pr_ + h * 64 + kg * 16); KQv[3] = *(const u32x4*)(pr_ + h * 64 + kg * 16 + 8); Vv = pr_[512 + h * 128 + vq]; } while (0)
    GLA_LOAD(la, kq, vv, 0);
    for (int step = 0; step < L; ++step) {
        const int sn = step + 1 < L ? step + 1 : step;
        GLA_LOAD(nla, nkq, nvv, sn);
        const float v = bf2f(vv); float part = 0.f;
#pragma unroll
        for (int j = 0; j < 16; ++j) { const unsigned kw = kq[j >> 3][(j >> 1) & 3], qw = kq[2 + (j >> 3)][(j >> 1) & 3];
            const float kk = (j & 1) ? bfhi(kw) : bflo(kw), qq = (j & 1) ? bfhi(qw) : bflo(qw);
            S[j] = __expf(la[j >> 2][j & 3]) * S[j] + kk * v; part += S[j] * qq; }
        red[((step & 1) * 4 + kg) * 128 + vq] = part * 0.125f;
        __syncthreads();
        if (kg == 0) { const LAS float* rp = red + (step & 1) * 512 + vq; const int t = d ? L - 1 - step : step;
            OG[((size_t)d * NTOK + rowbase + t) * 512 + h * 128 + vq] = (rp[0] + rp[128]) + (rp[256] + rp[384]); }
#pragma unroll
        for (int j = 0; j < 4; ++j) { la[j] = nla[j]; kq[j] = nkq[j]; } vv = nvv;
    }
#undef GLA_LOAD
    if (!lat) {
#pragma unroll
        for (int j = 0; j < 16; ++j) POUT[OUT_SG + sidx + j * 128] = S[j]; }
    __syncthreads();
}
__device__ __forceinline__ void dn_naive_item(ptab_t pt, int l, bool lat, int b, int h, int d, LAS float* red) {
    const int tid = tid_opaque(), vq = tid & 127, kg = tid >> 7;
    unsigned char* ws = PWS;
    const bf16_t* DQKV = (const bf16_t*)(ws + WS_DQKV); const float* GB = (const float*)(ws + WS_GB); float* OD = (float*)(ws + WS_OD);
    const int L = lat ? 1024 : 256, rowbase = lat ? 4096 + b * 1024 : b * 256;
    LAS float* redR = red; LAS float* redO = red + 1024;
    float S[32];
    const size_t sidx = ((((size_t)b * 2 + l) * 2 + d) * 4 + h) * 16384 + (size_t)(kg * 32) * 128 + vq;
#pragma unroll
    for (int j = 0; j < 32; ++j) S[j] = lat ? PIN(5)[sidx + j * 128] : 0.f;
    u32x4 kq[8], nkq[8]; unsigned short vv, nvv; float gg, ngg, be, nbe;
#define DN_LOAD(KQv, Vv, Gv, Bv, step) do { const int t_ = d ? L - 1 - (step) : (step); const size_t r_ = (size_t)(rowbase + t_); const bf16_t* pr_ = DQKV + r_ * 1536; \
        _Pragma("unroll") for (int j_ = 0; j_ < 4; ++j_) { KQv[j_] = *(const u32x4*)(pr_ + 512 + h * 128 + kg * 32 + 8 * j_); KQv[4 + j_] = *(const u32x4*)(pr_ + h * 128 + kg * 32 + 8 * j_); } \
        Vv = pr_[1024 + h * 128 + vq]; Gv = GB[r_ * 16 + d * 4 + h]; Bv = GB[r_ * 16 + 8 + d * 4 + h]; } while (0)
    DN_LOAD(kq, vv, gg, be, 0);
    for (int step = 0; step < L; ++step) {
        const int sn = step + 1 < L ? step + 1 : step;
        DN_LOAD(nkq, nvv, ngg, nbe, sn);
        float kf[32], rp = 0.f;
#pragma unroll
        for (int j = 0; j < 32; ++j) { const unsigned kw = kq[j >> 3][(j >> 1) & 3]; kf[j] = (j & 1) ? bfhi(kw) : bflo(kw); rp += kf[j] * S[j]; }
        redR[((step & 1) * 4 + kg) * 128 + vq] = rp;
        __syncthreads();
        if (step > 0 && kg == 0) { const LAS float* op = redO + ((step - 1) & 1) * 512 + vq; const int t = d ? L - step : step - 1;
            OD[((size_t)d * NTOK + rowbase + t) * 512 + h * 128 + vq] = (op[0] + op[128]) + (op[256] + op[384]); }
        const LAS float* rr = redR + (step & 1) * 512 + vq;
        const float rs = (rr[0] + rr[128]) + (rr[256] + rr[384]);
        const float eg = __expf(gg), w = be * (bf2f(vv) - eg * rs);
        float op = 0.f;
#pragma unroll
        for (int j = 0; j < 32; ++j) { const unsigned qw = kq[4 + (j >> 3)][(j >> 1) & 3]; const float qq = (j & 1) ? bfhi(qw) : bflo(qw);
            S[j] = eg * S[j] + kf[j] * w; op += qq * S[j]; }
        redO[((step & 1) * 4 + kg) * 128 + vq] = op;
#pragma unroll
        for (int j = 0; j < 8; ++j) kq[j] = nkq[j];
        vv = nvv; gg = ngg; be = nbe;
    }
#undef DN_LOAD
    __syncthreads();
    if (kg == 0) { const LAS float* op = redO + ((L - 1) & 1) * 512 + vq; const int t = d ? 0 : L - 1;
        OD[((size_t)d * NTOK + rowbase + t) * 512 + h * 128 + vq] = (op[0] + op[128]) + (op[256] + op[384]); }
    if (!lat) {
#pragma unroll
        for (int j = 0; j < 32; ++j) POUT[OUT_SD + sidx + j * 128] = S[j]; }
    __syncthreads();
}

typedef short bf16x8 __attribute__((ext_vector_type(8)));
typedef float f32x16 __attribute__((ext_vector_type(16)));
__device__ __forceinline__ int crow(int r, int hi) { return (r & 3) + 8 * (r >> 2) + 4 * hi; }
template <int K>
__device__ __forceinline__ f32x16 mm_tile(const LAS bf16_t* A, int lda, const LAS bf16_t* Bt, int ldb, int tm, int tn, int lane, f32x16 acc) {
    const int r32 = lane & 31, hi = lane >> 5;
    const LAS bf16_t* ap = A + (tm * 32 + r32) * lda + hi * 8; const LAS bf16_t* bp = Bt + (tn * 32 + r32) * ldb + hi * 8;
#pragma unroll
    for (int k0 = 0; k0 < K; k0 += 16) { const bf16x8 a = *(const LAS bf16x8*)(ap + k0), b = *(const LAS bf16x8*)(bp + k0); acc = __builtin_amdgcn_mfma_f32_32x32x16_bf16(a, b, acc, 0, 0, 0); }
    return acc;
}
template <int K>
__device__ __forceinline__ f32x16 mm_tile_ga(const bf16_t* A, int lda, const LAS bf16_t* Bt, int ldb, int tm, int tn, int lane, f32x16 acc) {
    const int r32 = lane & 31, hi = lane >> 5;
    const bf16_t* ap = A + (size_t)(tm * 32 + r32) * lda + hi * 8; const LAS bf16_t* bp = Bt + (tn * 32 + r32) * ldb + hi * 8;
    bf16x8 a[K / 16];
#pragma unroll
    for (int k = 0; k < K / 16; ++k) a[k] = *(const bf16x8*)(ap + 16 * k);
#pragma unroll
    for (int k = 0; k < K / 16; ++k) { const bf16x8 b = *(const LAS bf16x8*)(bp + 16 * k); acc = __builtin_amdgcn_mfma_f32_32x32x16_bf16(a[k], b, acc, 0, 0, 0); }
    return acc;
}
__device__ __forceinline__ void acc_store_pk(unsigned* dst, const f32x16& acc, int lane) {
#pragma unroll
    for (int r2 = 0; r2 < 8; ++r2) dst[r2 * 64 + lane] = pk2(acc[2 * r2], acc[2 * r2 + 1]);
}
__device__ __forceinline__ void acc_load_pk(const unsigned* src, unsigned (&w)[8], int lane) {
#pragma unroll
    for (int r2 = 0; r2 < 8; ++r2) w[r2] = src[r2 * 64 + lane];
}
__device__ __forceinline__ void acc_to_ST(LAS bf16_t* ST, int ld, int row0, int col0, const f32x16& s, int lane) {
    const int r32 = lane & 31, hi = lane >> 5;
#pragma unroll
    for (int g = 0; g < 4; ++g) { u32x2 w; w.x = pk2(s[4 * g], s[4 * g + 1]); w.y = pk2(s[4 * g + 2], s[4 * g + 3]);
        *(LAS u32x2*)(ST + (col0 + r32) * ld + row0 + 8 * g + 4 * hi) = w; }
}
constexpr int N_CH_UNITS = 1024;
__device__ __forceinline__ void gla_chunk_unit(ptab_t pt, int unit, LAS unsigned char* lds) {
    const int tid = tid_opaque(), lane = tid & 63, wave = tid >> 6;
    unsigned char* ws = PWS;
    const bf16_t* P = (const bf16_t*)(ws + WS_P); const float* LA = (const float*)(ws + WS_LA);
    bf16_t* GQ = (bf16_t*)(ws + WS_GQ) + (size_t)unit * 4096; unsigned* GO = (unsigned*)(ws + WS_GO) + (size_t)unit * 4096; unsigned* GU = (unsigned*)(ws + WS_GU) + (size_t)unit * 4096; float* GD = (float*)(ws + WS_GD) + (size_t)unit * 64;
    const int d = unit & 1, h = (unit >> 1) & 3, slot = unit >> 3;
    const bool lat = slot >= 64; const int b = lat ? (slot - 64) >> 4 : slot >> 2, c = lat ? (slot - 64) & 15 : slot & 3;
    const int L = lat ? 1024 : 256, rowbase = lat ? 4096 + b * 1024 : b * 256;
    LAS float* Bs = (LAS float*)lds;
    LAS bf16_t* Qt = (LAS bf16_t*)(lds + 16640);
    LAS bf16_t* Kt = Qt + 64 * 72;
    LAS bf16_t* KhT = Kt + 64 * 72;
    LAS bf16_t* VT = KhT + 64 * 72;
    LAS bf16_t* Am = VT + 128 * 72;
    for (int idx = tid; idx < 1024; idx += 512) { const int i = idx >> 4, c4 = idx & 15; const int s = c * 64 + i, t = d ? L - 1 - s : s;
        const f32x4 v = *(const f32x4*)(LA + (size_t)(rowbase + t) * 512 + d * 256 + h * 64 + c4 * 4);
        Bs[i * 65 + c4 * 4] = v.x; Bs[i * 65 + c4 * 4 + 1] = v.y; Bs[i * 65 + c4 * 4 + 2] = v.z; Bs[i * 65 + c4 * 4 + 3] = v.w; }
    __syncthreads();
    if (tid < 64) { float a = 0.f;
#pragma unroll 8
        for (int i = 0; i < 64; ++i) { a += Bs[i * 65 + tid]; Bs[i * 65 + tid] = a; } }
    __syncthreads();
    { const int i = tid >> 3, k0 = (tid & 7) * 8; const int s = c * 64 + i, t = d ? L - 1 - s : s; const bf16_t* Pr = P + (size_t)(rowbase + t) * PLD;
      const u32x4 qw = *(const u32x4*)(Pr + h * 64 + k0), kw = *(const u32x4*)(Pr + 256 + h * 64 + k0);
#pragma unroll
      for (int e = 0; e < 8; ++e) { const float bb = Bs[i * 65 + k0 + e], bl = Bs[63 * 65 + k0 + e];
          const float qv = (e & 1) ? bfhi(qw[e >> 1]) : bflo(qw[e >> 1]), kv = (e & 1) ? bfhi(kw[e >> 1]) : bflo(kw[e >> 1]);
          Qt[i * 72 + k0 + e] = f2bf(qv * 0.125f * __expf(bb)); Kt[i * 72 + k0 + e] = f2bf(kv * __expf(-bb)); KhT[(k0 + e) * 72 + i] = f2bf(kv * __expf(bl - bb)); }
      const int v0 = (tid & 7) * 16;
      const u32x4 va = *(const u32x4*)(Pr + 512 + h * 128 + v0), vb = *(const u32x4*)(Pr + 512 + h * 128 + v0 + 8);
#pragma unroll
      for (int e = 0; e < 8; ++e) { VT[(v0 + e) * 72 + i] = (bf16_t)((e & 1) ? (va[e >> 1] >> 16) : (va[e >> 1] & 0xffffu)); VT[(v0 + 8 + e) * 72 + i] = (bf16_t)((e & 1) ? (vb[e >> 1] >> 16) : (vb[e >> 1] & 0xffffu)); }
      if (tid < 64) GD[tid] = __expf(Bs[63 * 65 + tid]); }
    __syncthreads();
    { f32x16 acc = {}; acc = mm_tile<64>(KhT, 72, VT, 72, wave >> 2, wave & 3, lane, acc); acc_store_pk(GU + wave * 512, acc, lane); }
    if (wave < 4) { f32x16 acc = {}; const int tm = wave >> 1, tn = wave & 1; acc = mm_tile<64>(Qt, 72, Kt, 72, tm, tn, lane, acc);
        const int r32 = lane & 31, hi = lane >> 5;
#pragma unroll
        for (int r = 0; r < 16; ++r) { const int i = tm * 32 + crow(r, hi), j = tn * 32 + r32; Am[i * 72 + j] = f2bf(j <= i ? acc[r] : 0.f); } }
    { const int i = tid >> 3, k0 = (tid & 7) * 8; *(u32x4*)(GQ + i * 64 + k0) = *(const LAS u32x4*)(Qt + i * 72 + k0); }
    __syncthreads();
    { f32x16 acc = {}; acc = mm_tile<64>(Am, 72, VT, 72, wave >> 2, wave & 3, lane, acc); acc_store_pk(GO + wave * 512, acc, lane); }
    __syncthreads();
}
__device__ __forceinline__ void gla_scan_item(ptab_t pt, int l, bool lat, int b, int h, int d, LAS unsigned char* lds) {
    const int tid = tid_opaque(), lane = tid & 63, wave = tid >> 6, r32 = lane & 31, hi = lane >> 5;
    unsigned char* ws = PWS;
    float* OG = (float*)(ws + WS_OG);
    const int L = lat ? 1024 : 256, rowbase = lat ? 4096 + b * 1024 : b * 256, nch = L >> 6, slot0 = lat ? 64 + b * 16 : b * 4;
    const int tm = wave >> 2, tn = wave & 3;
    LAS bf16_t* ST = (LAS bf16_t*)lds;
    f32x16 S;
    const size_t sbase = ((((size_t)b * 2 + l) * 2 + d) * 4 + h) * 8192;
#pragma unroll
    for (int r = 0; r < 16; ++r) S[r] = lat ? PIN(4)[sbase + (size_t)(tm * 32 + crow(r, hi)) * 128 + tn * 32 + r32] : 0.f;
    for (int c = 0; c < nch; ++c) {
        const int unit = ((slot0 + c) * 4 + h) * 2 + d;
        const bf16_t* GQ = (const bf16_t*)(ws + WS_GQ) + (size_t)unit * 4096; const unsigned* GO = (const unsigned*)(ws + WS_GO) + (size_t)unit * 4096 + wave * 512;
        const unsigned* GU = (const unsigned*)(ws + WS_GU) + (size_t)unit * 4096 + wave * 512; const float* GD = (const float*)(ws + WS_GD) + (size_t)unit * 64;
        unsigned ow[8], uw[8]; acc_load_pk(GO, ow, lane); acc_load_pk(GU, uw, lane);
        float dec[16];
#pragma unroll
        for (int r = 0; r < 16; ++r) dec[r] = GD[tm * 32 + crow(r, hi)];
        acc_to_ST(ST, 72, tm * 32, tn * 32, S, lane);
        __syncthreads();
        f32x16 o;
#pragma unroll
        for (int r2 = 0; r2 < 8; ++r2) { o[2 * r2] = bflo(ow[r2]); o[2 * r2 + 1] = bfhi(ow[r2]); }
        o = mm_tile_ga<64>(GQ, 64, ST, 72, tm, tn, lane, o);
#pragma unroll
        for (int r = 0; r < 16; ++r) { const int i = tm * 32 + crow(r, hi), s = c * 64 + i, t = d ? L - 1 - s : s;
            OG[((size_t)d * NTOK + rowbase + t) * 512 + h * 128 + tn * 32 + r32] = o[r]; }
#pragma unroll
        for (int r2 = 0; r2 < 8; ++r2) { S[2 * r2] = dec[2 * r2] * S[2 * r2] + bflo(uw[r2]); S[2 * r2 + 1] = dec[2 * r2 + 1] * S[2 * r2 + 1] + bfhi(uw[r2]); }
        __syncthreads();
    }
    if (!lat) {
#pragma unroll
        for (int r = 0; r < 16; ++r) POUT[OUT_SG + sbase + (size_t)(tm * 32 + crow(r, hi)) * 128 + tn * 32 + r32] = S[r]; }
}
template <int BLK>
__device__ __forceinline__ void solve_block(float (&x)[64], const LAS float* Af) {
#pragma unroll
    for (int ii = 0; ii < 16; ++ii) { const int i = 16 * BLK + ii; float s0 = 0.f, s1 = 0.f, s2 = 0.f, s3 = 0.f;
#pragma unroll
        for (int j4 = 0; j4 < 4 * BLK + 4; ++j4) { const f32x4 a = *(const LAS f32x4*)(Af + i * 68 + 4 * j4);
            s0 += a.x * x[4 * j4]; s1 += a.y * x[4 * j4 + 1]; s2 += a.z * x[4 * j4 + 2]; s3 += a.w * x[4 * j4 + 3]; }
        x[i] -= (s0 + s1) + (s2 + s3); asm volatile("" : "+v"(x[i])); }
}
__device__ __forceinline__ void dn_chunk_unit(ptab_t pt, int unit, LAS unsigned char* lds) {
    const int tid = tid_opaque(), lane = tid & 63, wave = tid >> 6, r32 = lane & 31, hi = lane >> 5;
    unsigned char* ws = PWS;
    const bf16_t* DQKV = (const bf16_t*)(ws + WS_DQKV); const float* GB = (const float*)(ws + WS_GB);
    bf16_t* MC = (bf16_t*)(ws + WS_MC) + (size_t)unit * 16384; unsigned* NC = (unsigned*)(ws + WS_NC) + (size_t)unit * 8192;
    bf16_t* QE = (bf16_t*)(ws + WS_QE) + (size_t)unit * 8192; unsigned* OL = (unsigned*)(ws + WS_OL) + (size_t)unit * 4096;
    const int d = unit & 1, h = (unit >> 1) & 3, slot = unit >> 3;
    const bool lat = slot >= 64; const int b = lat ? (slot - 64) >> 4 : slot >> 2, c = lat ? (slot - 64) & 15 : slot & 3;
    const int L = lat ? 1024 : 256, rowbase = lat ? 4096 + b * 1024 : b * 256;
    LAS bf16_t* Qs = (LAS bf16_t*)lds;
    LAS bf16_t* Ks = Qs + 64 * 136;
    LAS bf16_t* Vs = Ks + 64 * 136;
    LAS float* Af = (LAS float*)(lds + 52224);
    LAS bf16_t* Att = (LAS bf16_t*)(lds + 69632);
    LAS bf16_t* KhT = (LAS bf16_t*)(lds + 78848);
    LAS bf16_t* WT = (LAS bf16_t*)(lds + 97280);
    LAS bf16_t* UT = (LAS bf16_t*)(lds + 115712);
    LAS float* Gs = (LAS float*)(lds + 134144);
    LAS float* Bt = Gs + 64;
    { const int i = tid >> 3, c16 = (tid & 7) * 16; const int s = c * 64 + i, t = d ? L - 1 - s : s; const bf16_t* pr = DQKV + (size_t)(rowbase + t) * 1536 + h * 128 + c16;
      const u32x4 q0 = *(const u32x4*)(pr), q1 = *(const u32x4*)(pr + 8), k0 = *(const u32x4*)(pr + 512), k1 = *(const u32x4*)(pr + 520), v0 = *(const u32x4*)(pr + 1024), v1 = *(const u32x4*)(pr + 1032);
      *(LAS u32x4*)(Qs + i * 136 + c16) = q0; *(LAS u32x4*)(Qs + i * 136 + c16 + 8) = q1; *(LAS u32x4*)(Ks + i * 136 + c16) = k0; *(LAS u32x4*)(Ks + i * 136 + c16 + 8) = k1;
      *(LAS u32x4*)(Vs + i * 136 + c16) = v0; *(LAS u32x4*)(Vs + i * 136 + c16 + 8) = v1; }
    if (tid < 64) { const int s = c * 64 + tid, t = d ? L - 1 - s : s; const float* gp = GB + (size_t)(rowbase + t) * 16 + d * 4 + h; float x = gp[0]; const float be = gp[8];
#pragma unroll
        for (int o = 1; o < 64; o <<= 1) { const float n = __shfl_up(x, o); if (lane >= o) x += n; }
        Gs[tid] = x; Bt[tid] = be; }
    __syncthreads();
    { const int w4 = wave & 3, tm = w4 >> 1, tn = w4 & 1; f32x16 acc = {};
      acc = mm_tile<128>(wave < 4 ? Ks : Qs, 136, Ks, 136, tm, tn, lane, acc);
      const int j = tn * 32 + r32; const float Gj = Gs[j];
#pragma unroll
      for (int r = 0; r < 16; ++r) { const int i = tm * 32 + crow(r, hi); const float e = __expf(Gs[i] - Gj);
          if (wave < 4) Af[i * 68 + j] = (j < i) ? Bt[i] * acc[r] * e : 0.f; else Att[i * 72 + j] = f2bf((j <= i) ? acc[r] * e : 0.f); } }
    __syncthreads();
    if (tid < 256) {
        float x[64];
        if (tid < 128) {
#pragma unroll
            for (int j = 0; j < 64; ++j) x[j] = bf2f(Vs[j * 136 + tid]) * Bt[j];
        } else {
#pragma unroll
            for (int j = 0; j < 64; ++j) x[j] = bf2f(Ks[j * 136 + tid - 128]) * Bt[j] * __expf(Gs[j]);
        }
#pragma unroll
        for (int j = 0; j < 64; ++j) asm volatile("" : "+v"(x[j]));
        solve_block<0>(x, Af); solve_block<1>(x, Af); solve_block<2>(x, Af); solve_block<3>(x, Af);
        LAS bf16_t* dst = tid < 128 ? UT + tid * 72 : WT + (tid - 128) * 72;
#pragma unroll
        for (int j8 = 0; j8 < 8; ++j8) { u32x4 w; w.x = pk2(x[8 * j8], x[8 * j8 + 1]); w.y = pk2(x[8 * j8 + 2], x[8 * j8 + 3]); w.z = pk2(x[8 * j8 + 4], x[8 * j8 + 5]); w.w = pk2(x[8 * j8 + 6], x[8 * j8 + 7]);
            *(LAS u32x4*)(dst + 8 * j8) = w; }
    } else {
        const int t2 = tid - 256, i = t2 >> 2, a0 = (t2 & 3) * 32; const float f = __expf(Gs[63] - Gs[i]);
#pragma unroll 8
        for (int e = 0; e < 32; ++e) KhT[(a0 + e) * 72 + i] = f2bf(bf2f(Ks[i * 136 + a0 + e]) * f);
    }
    __syncthreads();
    { const int tn = wave & 3, tmo = wave >> 2; const float eGl = __expf(Gs[63]);
      { f32x16 acc = {}; acc = mm_tile<64>(Att, 72, UT, 72, tmo, tn, lane, acc); acc_store_pk(OL + wave * 512, acc, lane); }
      { f32x16 acc = {}; acc = mm_tile<64>(Att, 72, WT, 72, tmo, tn, lane, acc);
#pragma unroll
        for (int r = 0; r < 16; ++r) { const int i = tmo * 32 + crow(r, hi), a = tn * 32 + r32; QE[i * 128 + a] = f2bf(bf2f(Qs[i * 136 + a]) * __expf(Gs[i]) - acc[r]); } }
#pragma unroll
      for (int q = 0; q < 2; ++q) { const int tm = tmo + 2 * q;
        { f32x16 acc = {}; acc = mm_tile<64>(KhT, 72, UT, 72, tm, tn, lane, acc); acc_store_pk(NC + (tm * 4 + tn) * 512, acc, lane); }
        { f32x16 acc = {}; acc = mm_tile<64>(KhT, 72, WT, 72, tm, tn, lane, acc);
#pragma unroll
          for (int r = 0; r < 16; ++r) { const int a = tm * 32 + crow(r, hi), a2 = tn * 32 + r32; MC[a * 128 + a2] = f2bf((a == a2 ? eGl : 0.f) - acc[r]); } } } }
    __syncthreads();
}
__device__ __forceinline__ void dn_scan_item(ptab_t pt, int l, bool lat, int b, int h, int d, LAS unsigned char* lds) {
    const int tid = tid_opaque(), lane = tid & 63, wave = tid >> 6, r32 = lane & 31, hi = lane >> 5;
    unsigned char* ws = PWS;
    float* OD = (float*)(ws + WS_OD);
    const int L = lat ? 1024 : 256, rowbase = lat ? 4096 + b * 1024 : b * 256, nch = L >> 6, slot0 = lat ? 64 + b * 16 : b * 4;
    const int tn = wave & 3, tmo = wave >> 2;
    LAS bf16_t* ST = (LAS bf16_t*)lds;
    f32x16 S0, S1;
    const size_t sbase = ((((size_t)b * 2 + l) * 2 + d) * 4 + h) * 16384;
#pragma unroll
    for (int r = 0; r < 16; ++r) { S0[r] = lat ? PIN(5)[sbase + (size_t)(tmo * 32 + crow(r, hi)) * 128 + tn * 32 + r32] : 0.f; S1[r] = lat ? PIN(5)[sbase + (size_t)((tmo + 2) * 32 + crow(r, hi)) * 128 + tn * 32 + r32] : 0.f; }
    for (int c = 0; c < nch; ++c) {
        const int unit = ((slot0 + c) * 4 + h) * 2 + d;
        const bf16_t* MC = (const bf16_t*)(ws + WS_MC) + (size_t)unit * 16384; const unsigned* NC = (const unsigned*)(ws + WS_NC) + (size_t)unit * 8192;
        const bf16_t* QE = (const bf16_t*)(ws + WS_QE) + (size_t)unit * 8192; const unsigned* OL = (const unsigned*)(ws + WS_OL) + (size_t)unit * 4096;
        unsigned ow[8], n0[8], n1[8]; acc_load_pk(OL + wave * 512, ow, lane); acc_load_pk(NC + (tmo * 4 + tn) * 512, n0, lane); acc_load_pk(NC + ((tmo + 2) * 4 + tn) * 512, n1, lane);
        acc_to_ST(ST, 136, tmo * 32, tn * 32, S0, lane); acc_to_ST(ST, 136, (tmo + 2) * 32, tn * 32, S1, lane);
        __syncthreads();
        f32x16 o;
#pragma unroll
        for (int r2 = 0; r2 < 8; ++r2) { o[2 * r2] = bflo(ow[r2]); o[2 * r2 + 1] = bfhi(ow[r2]); S0[2 * r2] = bflo(n0[r2]); S0[2 * r2 + 1] = bfhi(n0[r2]); S1[2 * r2] = bflo(n1[r2]); S1[2 * r2 + 1] = bfhi(n1[r2]); }
        o = mm_tile_ga<128>(QE, 128, ST, 136, tmo, tn, lane, o);
#pragma unroll
        for (int r = 0; r < 16; ++r) { const int i = tmo * 32 + crow(r, hi), s = c * 64 + i, t = d ? L - 1 - s : s;
            OD[((size_t)d * NTOK + rowbase + t) * 512 + h * 128 + tn * 32 + r32] = o[r]; }
        S0 = mm_tile_ga<128>(MC, 128, ST, 136, tmo, tn, lane, S0);
        S1 = mm_tile_ga<128>(MC, 128, ST, 136, tmo + 2, tn, lane, S1);
        __syncthreads();
    }
    if (!lat) {
#pragma unroll
        for (int r = 0; r < 16; ++r) { POUT[OUT_SD + sbase + (size_t)(tmo * 32 + crow(r, hi)) * 128 + tn * 32 + r32] = S0[r]; POUT[OUT_SD + sbase + (size_t)((tmo + 2) * 32 + crow(r, hi)) * 128 + tn * 32 + r32] = S1[r]; } }
}
__device__ __forceinline__ void mixer1_phase(ptab_t pt, int l, unsigned char* lds_generic, int bid, int nb) {
    LAS unsigned char* l3 = (LAS unsigned char*)lds_generic;
    LAS int* qslot = (LAS int*)(l3 + PTAB_OFF + 272);
    unsigned* qctr = (unsigned*)(PWS + WS_QUEUE) + (l * 2 + 0) * 64;
    constexpr int N_ITEMS = 2304;
    int it = bid;
    while (it < N_ITEMS) {
        int nxt = 0;
        if (threadIdx.x == 0) nxt = nb + (int)atomicAdd(qctr, 1u);
        if (it < 128 || (it >= 1152 && it < 1280)) {
            unsigned char* ws = PWS;
            const bf16_t* QN = (const bf16_t*)(ws + WS_QN); const bf16_t* KB = (const bf16_t*)(ws + WS_KB); const bf16_t* VB = (const bf16_t*)(ws + WS_VB); bf16_t* MIX = (bf16_t*)(ws + WS_MIX);
            const bool lat = it < 128; const int i = lat ? it : it - 1152;
            const int b = lat ? i >> 5 : i >> 3, h = lat ? (i >> 2) & 7 : i & 7, qb = lat ? i & 3 : 0;
            const size_t row0 = lat ? 4096 + (size_t)b * 1024 + qb * 256 : (size_t)b * 256;
            const size_t krow0 = lat ? (size_t)4096 + (size_t)b * 1280 : (size_t)b * 256;
            att::attn_dense_body<1024, 256, 2048>(QN + row0 * 1024 + h * 128, KB + krow0 * 256 + (h >> 2) * 128, VB + krow0 * 256 + (h >> 2) * 128, MIX + row0 * 2048 + 512 + h * 128, lat ? 1280 : 256, (char*)lds_generic);
        } else if (it < 1152) {
            dn_chunk_unit(pt, it - 128, l3);
        } else {
            gla_chunk_unit(pt, it - 1280, l3);
        }
        __syncthreads();
        if (threadIdx.x == 0) *qslot = nxt;
        __syncthreads();
        it = *qslot;
    }
}
__device__ __forceinline__ void mixer2_phase(ptab_t pt, int l, unsigned char* lds_generic, int bid, int nb) {
    LAS unsigned char* l3 = (LAS unsigned char*)lds_generic;
    for (int it = bid; it < 320; it += nb) { const bool lat = it < 64; const bool dn = lat ? it < 32 : it < 192; const int j = lat ? (it & 31) : (dn ? it - 64 : it - 192);
        if (dn) dn_scan_item(pt, l, lat, j >> 3, (j >> 1) & 3, j & 1, l3); else gla_scan_item(pt, l, lat, j >> 3, (j >> 1) & 3, j & 1, l3);
        __syncthreads(); }
}

__device__ __forceinline__ void postmix_phase(ptab_t pt, int l, int bid, int nb) {
    const int tid = tid_opaque(), lane = tid & 63, wave = tid >> 6;
    unsigned char* ws = PWS;
    const bf16_t* P = (const bf16_t*)(ws + WS_P); const float* OG = (const float*)(ws + WS_OG); const float* OD = (const float*)(ws + WS_OD); bf16_t* MIX = (bf16_t*)(ws + WS_MIX);
    const float gg0 = PIN(15)[l * 128 + lane], gg1 = PIN(15)[l * 128 + 64 + lane], dg0 = PIN(21)[l * 128 + lane], dg1 = PIN(21)[l * 128 + 64 + lane];
    for (int r = bid * 8 + wave; r < NTOK; r += nb * 8) {
        const bf16_t* Pr = P + (size_t)r * PLD;
#pragma unroll
        for (int blk = 0; blk < 8; ++blk) { const bool dn = blk >= 4; const int hb = blk & 3;
            const float* o0 = (dn ? OD : OG) + (size_t)r * 512 + hb * 128; const float* o1 = o0 + (size_t)NTOK * 512;
            const float a0 = o0[lane] + o1[lane], a1 = o0[64 + lane] + o1[64 + lane];
            const float rstd = rsqrtf(wave_sum(a0 * a0 + a1 * a1) * (1.f / 128.f) + EPS);
            const int gc = (dn ? 4608 : 1024) + hb * 128;
            const float z0 = bf2f(Pr[gc + lane]), z1 = bf2f(Pr[gc + 64 + lane]);
            const int mc = (dn ? 1536 : 0) + hb * 128;
            MIX[(size_t)r * 2048 + mc + lane] = f2bf(a0 * rstd * (dn ? dg0 : gg0) * silu_f(z0));
            MIX[(size_t)r * 2048 + mc + 64 + lane] = f2bf(a1 * rstd * (dn ? dg1 : gg1) * silu_f(z1)); }
    }
}

#define RLX_AGENT __ATOMIC_RELAXED, __HIP_MEMORY_SCOPE_AGENT
#define XB_TMO      128
#define XB_XCNT(j)  (256  + 64 * (j))
#define XB_XSUB(j)  (1280 + 64 * (j))
#define XB_XGEN(j)  (2304 + 64 * (j))
#define XB_TOP      3328
#define XB_TOPGEN   3392
#define XCD_BAR_WORDS 3456
#define XB_SPIN_CAP (1u << 18)

__device__ __forceinline__ unsigned xb_ld(unsigned* p)              { return __hip_atomic_load(p, __ATOMIC_RELAXED, __HIP_MEMORY_SCOPE_AGENT); }
__device__ __forceinline__ unsigned xb_add(unsigned* p, unsigned v) { return __hip_atomic_fetch_add(p, v, __ATOMIC_RELAXED, __HIP_MEMORY_SCOPE_AGENT); }
__device__ __forceinline__ unsigned xb_xcc_id() { return (unsigned)__builtin_amdgcn_s_getreg((3 << 11) | 20) & 0xFu; }
#define XB_SPIN(cond, bar) do { unsigned _sp = 0; while (cond) { __builtin_amdgcn_s_sleep(1); \
    if ((++_sp & 255u) == 0u) { if (xb_ld(&(bar)[XB_TMO])) break; if (_sp > XB_SPIN_CAP) { atomicAdd(&(bar)[XB_TMO], 1u); break; } } } } while (0)

struct XcdBarrier {
    unsigned* bar; unsigned x;
    volatile LAS unsigned* st;
};

__device__ __forceinline__ XcdBarrier xcd_barrier_post(unsigned* bar, volatile LAS unsigned* st) {
    XcdBarrier b; b.bar = bar; b.x = xb_xcc_id(); b.st = st;
    if (threadIdx.x == 0) (void)xb_add(&bar[XB_XCNT(b.x)], 1u);
    return b;
}
__device__ __forceinline__ void xcd_barrier_complete(unsigned* bar, unsigned x, unsigned& nloc, unsigned& nx) {
    const unsigned G = gridDim.x * gridDim.y * gridDim.z;
    unsigned sum, cnt, mine, sp = 0u;
    for (;;) {
        sum = 0u; cnt = 0u; mine = 0u;
#pragma unroll
        for (unsigned j = 0; j < 16; ++j) { const unsigned c = xb_ld(&bar[XB_XCNT(j)]); sum += c; cnt += (c > 0u) ? 1u : 0u; mine = (j == x) ? c : mine; }
        if (sum == G) break;
        __builtin_amdgcn_s_sleep(1);
        if ((++sp & 255u) == 0u) { if (xb_ld(&bar[XB_TMO])) break; if (sp > XB_SPIN_CAP) { atomicAdd(&bar[XB_TMO], 1u); break; } }
    }
    nloc = mine > 0u ? mine : 1u; nx = cnt > 0u ? cnt : 1u;
}

__device__ __forceinline__ void xcd_barrier(const XcdBarrier& b) {
    asm volatile("s_waitcnt vmcnt(0)" ::: "memory");
    __syncthreads();
    if (threadIdx.x == 0) {
        unsigned* bar = b.bar;
        __builtin_amdgcn_s_waitcnt(0);
        unsigned nloc = b.st[0], nx = b.st[1];
        if (nloc == 0u) { xcd_barrier_complete(bar, b.x, nloc, nx); b.st[0] = nloc; b.st[1] = nx; }
        const unsigned old = xb_add(&bar[XB_XSUB(b.x)], 1u);
        const unsigned gen = old / nloc;
        if (old + 1u == (gen + 1u) * nloc) {
            __builtin_amdgcn_fence(__ATOMIC_RELEASE, "agent");
            asm volatile("s_waitcnt vmcnt(0)" ::: "memory");
            const unsigned og = xb_add(&bar[XB_TOP], 1u);
            const unsigned tg = og / nx;
            if (og + 1u == (tg + 1u) * nx) xb_add(&bar[XB_TOPGEN], 1u);
            else XB_SPIN(xb_ld(&bar[XB_TOPGEN]) == tg, bar);
            __builtin_amdgcn_fence(__ATOMIC_ACQUIRE, "agent");
            xb_add(&bar[XB_XGEN(b.x)], 1u);
            asm volatile("s_waitcnt vmcnt(0)" ::: "memory");
        } else {
            XB_SPIN(xb_ld(&bar[XB_XGEN(b.x)]) == gen, bar);
            __builtin_amdgcn_fence(__ATOMIC_ACQUIRE, "agent");
            asm volatile("s_waitcnt vmcnt(0)" ::: "memory");
        }
    }
    __syncthreads();
}

__global__ void __launch_bounds__(512, 2) mega(Params p) {
    extern __shared__ __attribute__((aligned(16))) unsigned char lds[];
    cg::grid_group grid = cg::this_grid();
    const int bid = blockIdx.x, nb = gridDim.x;
    LAS unsigned char* l3 = (LAS unsigned char*)lds;
    ptab_t pt = (ptab_t)(l3 + PTAB_OFF);
    if (threadIdx.x < 27) { const int i = threadIdx.x; const void* v = i < 25 ? (const void*)p.in[i] : (i == 25 ? (const void*)p.out : (const void*)p.ws);
        ((LAS unsigned long long*)(l3 + PTAB_OFF))[i] = (unsigned long long)v; }
    if (threadIdx.x < 2) ((LAS unsigned*)(l3 + PTAB_OFF + 256))[threadIdx.x] = 0u;
    __syncthreads();
    XcdBarrier xbar = xcd_barrier_post((unsigned*)PWS + 1024, (volatile LAS unsigned*)(l3 + PTAB_OFF + 256));
#define GSYNC() do { xcd_barrier(xbar); } while (0)
    p0_prologue(pt, l3, bid, nb, true);
    grid.sync();
    if (PROBE_DUP == 3) { p0_prologue(pt, l3, bid, nb, false); }
    if (PROBE_DUP == 5) { for (int i = 0; i < 20; ++i) GSYNC(); }
#define REP(code) for (int rep_ = 0; rep_ < ((PROBE_DUP == (code)) ? 2 : 1); ++rep_)
#pragma unroll 1
    for (int l = 0; l < 2; ++l) {
        REP(4) { unsigned char* ws = PWS; const float* mods_l = (const float*)(ws + WS_MODS) + (size_t)l * 5 * NMOD;
          const float* xin0 = l == 0 ? PIN(0) : (const float*)(ws + WS_XB); const float* xin1 = l == 0 ? PIN(1) - (size_t)4096 * DM : (const float*)(ws + WS_XB);
          norm_phase(xin0, xin1, PIN(8) + l * DM, mods_l, 0, 1, (bf16_t*)(ws + WS_H), bid, nb);
          GSYNC(); }
        REP(2) { unsigned char* ws = PWS; pg8::Gemm g{(const bf16_t*)(ws + WS_H), (const bf16_t*)(ws + WS_WIN) + (size_t)l * PNW * 2048, NTOK, PNW, 2048}; pg8::StaticOrder S; S.init(NTOK, PNW, nb, bid);
          pg8::EpiP E{(bf16_t*)(ws + WS_P), (float*)(ws + WS_G)};
          pg8::gemm_phase<pg8::EpiP, pg8::StaticOrder, true, true>(l3, g, S, E);
          GSYNC(); }
        REP(4) { prep_phase(pt, l, l3, bid, nb);
          GSYNC(); }
        REP(1) { mixer1_phase(pt, l, lds, bid, nb);
          GSYNC();
          mixer2_phase(pt, l, lds, bid, nb);
          GSYNC(); }
        REP(4) { postmix_phase(pt, l, bid, nb);
          GSYNC(); }
        REP(2) { unsigned char* ws = PWS; const float* mods_l = (const float*)(ws + WS_MODS) + (size_t)l * 5 * NMOD;
          const float* xin0 = l == 0 ? PIN(0) : (const float*)(ws + WS_XB); const float* xin1 = l == 0 ? PIN(1) - (size_t)4096 * DM : (const float*)(ws + WS_XB);
          pg8::Gemm g{(const bf16_t*)(ws + WS_MIX), (const bf16_t*)(ws + WS_WOUT) + (size_t)l * 2048 * 2048, NTOK, 2048, 2048}; pg8::StaticOrder S; S.init(NTOK, 2048, nb, bid);
          pg8::EpiRes E{xin0, xin1, (float*)(ws + WS_XA), mods_l + 2 * DM};
          pg8::gemm_phase<pg8::EpiRes, pg8::StaticOrder, true, true>(l3, g, S, E);
          GSYNC(); }
        REP(4) { unsigned char* ws = PWS; const float* mods_l = (const float*)(ws + WS_MODS) + (size_t)l * 5 * NMOD; const float* XA = (const float*)(ws + WS_XA);
          norm_phase(XA, XA, PIN(9) + l * DM, mods_l, 3, 4, (bf16_t*)(ws + WS_H), bid, nb);
          GSYNC(); }
        REP(2) { unsigned char* ws = PWS; pg8::Gemm g{(const bf16_t*)(ws + WS_H), (const bf16_t*)(ws + WS_WFF1) + (size_t)l * 8192 * 2048, NTOK, FFD, 2048}; pg8::StaticOrder S; S.init(NTOK, FFD, nb, bid);
          pg8::EpiSqRelu E{(bf16_t*)(ws + WS_H2), FFD};
          pg8::gemm_phase<pg8::EpiSqRelu, pg8::StaticOrder, true, true>(l3, g, S, E);
          GSYNC(); }
        REP(2) { unsigned char* ws = PWS; const float* mods_l = (const float*)(ws + WS_MODS) + (size_t)l * 5 * NMOD; const float* XA = (const float*)(ws + WS_XA);
          pg8::Gemm g{(const bf16_t*)(ws + WS_H2), (const bf16_t*)(ws + WS_WFF2) + (size_t)l * 2048 * 8192, NTOK, 2048, FFD}; pg8::StaticOrder S; S.init(NTOK, 2048, nb, bid);
          pg8::EpiRes E{XA, XA, l == 0 ? (float*)(ws + WS_XB) : POUT + OUT_Y, mods_l + 5 * DM};
          pg8::gemm_phase<pg8::EpiRes, pg8::StaticOrder, true, true>(l3, g, S, E);
          if (l == 0 || rep_ + 1 < ((PROBE_DUP == 2) ? 2 : 1)) GSYNC(); }
    }
}

extern "C" void kernel_launch(void* const* d_in, const int* in_sizes, int n_in, void* d_out, int out_size, void* d_ws, size_t ws_size, hipStream_t stream) {
    static int grid_blocks = 0;
    if (grid_blocks == 0) {
        if (n_in != 25 || out_size != (int)OUT_TOTAL || ws_size < WS_END) { fprintf(stderr, "kernel_launch: unexpected shapes: n_in %d out %d ws %zu (need %zu)\n", n_in, out_size, ws_size, (size_t)WS_END); grid_blocks = -1; return; }
        int dev = 0, cus = 0, per_cu = 0;
        if (hipGetDevice(&dev) != hipSuccess || hipDeviceGetAttribute(&cus, hipDeviceAttributeMultiprocessorCount, dev) != hipSuccess) { grid_blocks = -1; return; }
        if (hipFuncSetAttribute((const void*)mega, hipFuncAttributeMaxDynamicSharedMemorySize, LDS_BYTES) != hipSuccess) { fprintf(stderr, "kernel_launch: hipFuncSetAttribute failed\n"); grid_blocks = -1; return; }
        if (hipOccupancyMaxActiveBlocksPerMultiprocessor(&per_cu, (const void*)mega, 512, LDS_BYTES) != hipSuccess || per_cu < 1) { fprintf(stderr, "kernel_launch: occupancy query says %d blocks per CU\n", per_cu); (void)hipGetLastError(); grid_blocks = -1; return; }
        grid_blocks = cus;
    }
    if (grid_blocks < 0) return;
    if (hipMemsetAsync((char*)d_ws + WS_CTL, 0, ZERO_BYTES, stream) != hipSuccess) { fprintf(stderr, "kernel_launch: memset failed\n"); return; }
    Params p{};
    for (int i = 0; i < 25; ++i) p.in[i] = (const float*)d_in[i];
    p.out = (float*)d_out; p.ws = (unsigned char*)d_ws;
    void* args[] = {&p};
    const hipError_t e = hipLaunchCooperativeKernel((void*)mega, dim3(grid_blocks), dim3(512), args, LDS_BYTES, stream);
    if (e != hipSuccess) fprintf(stderr, "kernel_launch: cooperative launch failed: %s (grid %d)\n", hipGetErrorString(e), grid_blocks);
}
```

```cpp
#include <hip/hip_runtime.h>
#include <hip/hip_cooperative_groups.h>
#include <cstdio>
#include <cstdint>
namespace cg = cooperative_groups;
#ifndef WGM_IN
#define WGM_IN 8
#endif
#ifndef WGM_OUT
#define WGM_OUT 4
#endif
#ifndef WGM_F1
#define WGM_F1 4
#endif
#ifndef WGM_F2
#define WGM_F2 4
#endif
#ifndef PROBE_DUP
#define PROBE_DUP 0
#endif
#ifndef PROBE_SUB
#define PROBE_SUB 0
#endif
#ifndef PROBE_MASK
#define PROBE_MASK 0u
#endif
namespace pg8 {
#define PG8_LAS __attribute__((address_space(3)))
typedef unsigned short bf16_t;
typedef short bf16x8 __attribute__((ext_vector_type(8)));
typedef float f32x4 __attribute__((ext_vector_type(4)));
typedef unsigned u32x4 __attribute__((ext_vector_type(4)));
typedef unsigned u32x2 __attribute__((ext_vector_type(2)));
constexpr int BM = 256, BK = 64, HALF = 128, HTB = HALF * BK * 2  , STAGE_BYTES = 8 * HTB, NXCD = 8, WGM = 1;

__host__ __device__ __forceinline__ int lds_byte(int r, int c) { const int st = (r >> 4) * 2 + (c >> 5), rr = r & 15, cc = c & 31, ob = rr * 64 + cc * 2; return st * 1024 + (ob ^ (((ob >> 9) & 1) << 5)); }
__host__ __device__ __forceinline__ void stage_rc(int b, int& R, int& C) { const int st = b / 1024, sb = b % 1024, swz = sb ^ (((sb >> 9) & 1) << 5); R = (st >> 1) * 16 + swz / 64; C = (st & 1) * 32 + (swz % 64) / 2; }
__host__ __device__ __forceinline__ int perm32(int rho) { const int n = rho >> 4, i = rho & 15; return 8 * (i >> 2) + 4 * n + (i & 3); }

struct Unit { int pm, pn; };
struct Gemm { const bf16_t* A; const bf16_t* Bt; int M, N, K; };

struct StaticOrder {
    int nM, nN, nwg, G, c, wgm;
    __host__ __device__ void init(int M, int N, int G_, int c_, int wgm_ = WGM) { nM = M / BM; nN = N / BM; nwg = nM * nN; G = G_; c = c_; wgm = wgm_; }
    __host__ __device__ bool next(int i, Unit& u) const {
        const long L = (long)i * G + c; if (L >= nwg) return false;
        int wgid = (int)L; { const int q = nwg / NXCD, r = nwg % NXCD, xcd = wgid % NXCD, off = wgid / NXCD; wgid = (xcd < r ? xcd * (q + 1) : r * (q + 1) + (xcd - r) * q) + off; }
        const int nig = wgm * nN, gid = wgid / nig, fm = gid * wgm, gsz = (nM - fm) < wgm ? (nM - fm) : wgm;
        u.pm = fm + ((wgid % nig) % gsz); u.pn = (wgid % nig) / gsz; return true;
    }
    __device__ __forceinline__ void a_ready(const Unit&) const {}
    __device__ __forceinline__ void done(const Unit&) const {}
};

__device__ __forceinline__ unsigned cvt_pk_bf16(float lo, float hi) { unsigned r; asm volatile("v_cvt_pk_bf16_f32 %0, %1, %2" : "=v"(r) : "v"(lo), "v"(hi)); return r; }
struct EpiP {
    static constexpr bool PERM = true, AFTER_DRAIN = false;
    bf16_t* P; float* G; const float* RS; const float* bias;
    __device__ __forceinline__ void operator()(const f32x4 (&acc)[2][2][4][2], const Unit& u, int wr, int wc, int fr, int fq) const {
        const int row0 = u.pm * BM + wr * 64 + fr; const int cond = (u.pm < 16) ? 0 : 1 + ((u.pm - 16) >> 2);
        const int col0 = u.pn * BM + wc * 32 + 8 * fq;
        const float* bp = bias + (size_t)cond * 5376 + col0;
        if (u.pn < 20) {
#pragma unroll
            for (int ai = 0; ai < 2; ++ai)
#pragma unroll
                for (int m = 0; m < 4; ++m) { const int row = row0 + ai * HALF + m * 16; bf16_t* rowp = P + (size_t)row * 5120 + col0;
                    const float rs = RS ? rsqrtf(RS[row] * (1.f / 2048.f) + 1e-6f) : 1.f;
#pragma unroll
                    for (int bj = 0; bj < 2; ++bj) { f32x4 v0 = acc[ai][bj][m][0] * rs, v1 = acc[ai][bj][m][1] * rs;
                        if (RS) { v0 += *(const f32x4*)(bp + bj * HALF); v1 += *(const f32x4*)(bp + bj * HALF + 4); }
                        u32x4 w; w.x = cvt_pk_bf16(v0[0], v0[1]); w.y = cvt_pk_bf16(v0[2], v0[3]); w.z = cvt_pk_bf16(v1[0], v1[1]); w.w = cvt_pk_bf16(v1[2], v1[3]);
                        *(u32x4*)(rowp + bj * HALF) = w; } }
        } else if (wc < 2) {
            const int gc0 = wc * 32 + 8 * fq;
#pragma unroll
            for (int ai = 0; ai < 2; ++ai)
#pragma unroll
                for (int m = 0; m < 4; ++m) { const int row = row0 + ai * HALF + m * 16; float* rowp = G + (size_t)row * 64 + gc0;
                    const float rs = RS ? rsqrtf(RS[row] * (1.f / 2048.f) + 1e-6f) : 1.f;
                    f32x4 v0 = acc[ai][0][m][0] * rs, v1 = acc[ai][0][m][1] * rs;
                    if (RS) { v0 += *(const f32x4*)(bp); v1 += *(const f32x4*)(bp + 4); }
                    *(f32x4*)(rowp) = v0; *(f32x4*)(rowp + 4) = v1; }
        }
    }
};
struct EpiRes {
    static constexpr bool PERM = true, AFTER_DRAIN = false;
    const void* base0; const void* base1; void* out; const float* gate;
    bf16_t* Hn; const float* gnorm; const float* scale; float* RS;
    int base_bf16, out_bf16;
    __device__ __forceinline__ void operator()(const f32x4 (&acc)[2][2][4][2], const Unit& u, int wr, int wc, int fr, int fq) const {
        const int row0 = u.pm * BM + wr * 64 + fr; const int col0 = u.pn * BM + wc * 32 + 8 * fq;
        const int cond = (u.pm < 16) ? 0 : 1 + ((u.pm - 16) >> 2);
        const void* base = (u.pm < 16) ? base0 : base1;
        const float* gp = gate + (size_t)cond * 6 * 2048 + col0;
        f32x4 gv[2][2], gs[2][2];
#pragma unroll
        for (int bj = 0; bj < 2; ++bj)
#pragma unroll
            for (int n = 0; n < 2; ++n) { gv[bj][n] = *(const f32x4*)(gp + bj * HALF + n * 4);
                if (Hn) gs[bj][n] = *(const f32x4*)(gnorm + col0 + bj * HALF + n * 4) * (*(const f32x4*)(scale + (size_t)cond * 6 * 2048 + col0 + bj * HALF + n * 4) + 1.f); }
#pragma unroll
        for (int ai = 0; ai < 2; ++ai)
#pragma unroll
            for (int m = 0; m < 4; ++m) { const int row = row0 + ai * HALF + m * 16; const size_t off = (size_t)row * 2048 + col0; float ss = 0.f;
#pragma unroll
                for (int bj = 0; bj < 2; ++bj) { f32x4 b0, b1;
                    if (base_bf16) { const u32x4 w = *(const u32x4*)((const bf16_t*)base + off + bj * HALF);
                        b0 = (f32x4){__uint_as_float(w.x << 16), __uint_as_float(w.x & 0xffff0000u), __uint_as_float(w.y << 16), __uint_as_float(w.y & 0xffff0000u)};
                        b1 = (f32x4){__uint_as_float(w.z << 16), __uint_as_float(w.z & 0xffff0000u), __uint_as_float(w.w << 16), __uint_as_float(w.w & 0xffff0000u)}; }
                    else { b0 = *(const f32x4*)((const float*)base + off + bj * HALF); b1 = *(const f32x4*)((const float*)base + off + bj * HALF + 4); }
                    const f32x4 x0 = b0 + gv[bj][0] * acc[ai][bj][m][0], x1 = b1 + gv[bj][1] * acc[ai][bj][m][1];
                    if (out_bf16) { u32x4 w; w.x = cvt_pk_bf16(x0[0], x0[1]); w.y = cvt_pk_bf16(x0[2], x0[3]); w.z = cvt_pk_bf16(x1[0], x1[1]); w.w = cvt_pk_bf16(x1[2], x1[3]); *(u32x4*)((bf16_t*)out + off + bj * HALF) = w; }
                    else { *(f32x4*)((float*)out + off + bj * HALF) = x0; *(f32x4*)((float*)out + off + bj * HALF + 4) = x1; }
                    if (Hn) { ss += ((x0[0] * x0[0] + x0[1] * x0[1]) + (x0[2] * x0[2] + x0[3] * x0[3])) + ((x1[0] * x1[0] + x1[1] * x1[1]) + (x1[2] * x1[2] + x1[3] * x1[3]));
                        const f32x4 y0 = x0 * gs[bj][0], y1 = x1 * gs[bj][1];
                        u32x4 w; w.x = cvt_pk_bf16(y0[0], y0[1]); w.y = cvt_pk_bf16(y0[2], y0[3]); w.z = cvt_pk_bf16(y1[0], y1[1]); w.w = cvt_pk_bf16(y1[2], y1[3]);
                        *(u32x4*)(Hn + off + bj * HALF) = w; } }
                if (Hn) { ss += __shfl_xor(ss, 16); ss += __shfl_xor(ss, 32); if (fq == 0) atomicAdd(RS + row, ss); } }
    }
};
struct EpiSqRelu {
    static constexpr bool PERM = true, AFTER_DRAIN = false;
    bf16_t* O; int ldc; const float* RS; const float* bias;
    __device__ __forceinline__ void operator()(const f32x4 (&acc)[2][2][4][2], const Unit& u, int wr, int wc, int fr, int fq) const {
        const int row0 = u.pm * BM + wr * 64 + fr; const int col0 = u.pn * BM + wc * 32 + 8 * fq;
        const int cond = (u.pm < 16) ? 0 : 1 + ((u.pm - 16) >> 2);
        const float* bp = bias + (size_t)cond * ldc + col0;
        f32x4 bv[2][2];
#pragma unroll
        for (int bj = 0; bj < 2; ++bj)
#pragma unroll
            for (int n = 0; n < 2; ++n) bv[bj][n] = *(const f32x4*)(bp + bj * HALF + 4 * n);
#pragma unroll
        for (int ai = 0; ai < 2; ++ai)
#pragma unroll
            for (int m = 0; m < 4; ++m) { const int row = row0 + ai * HALF + m * 16; bf16_t* rowp = O + (size_t)row * ldc + col0;
                const float rs = rsqrtf(RS[row] * (1.f / 2048.f) + 1e-6f);
#pragma unroll
                for (int bj = 0; bj < 2; ++bj) { f32x4 v0 = acc[ai][bj][m][0] * rs + bv[bj][0], v1 = acc[ai][bj][m][1] * rs + bv[bj][1];
#pragma unroll
                    for (int e = 0; e < 4; ++e) { const float a = fmaxf(v0[e], 0.f), b = fmaxf(v1[e], 0.f); v0[e] = a * a; v1[e] = b * b; }
                    u32x4 w; w.x = cvt_pk_bf16(v0[0], v0[1]); w.y = cvt_pk_bf16(v0[2], v0[3]); w.z = cvt_pk_bf16(v1[0], v1[1]); w.w = cvt_pk_bf16(v1[2], v1[3]);
                    *(u32x4*)(rowp + bj * HALF) = w; } }
    }
};

template <class Epi, class Sched, bool ALIGN_EPI = false, bool SP2 = false>
__device__ __forceinline__ void gemm_phase(PG8_LAS unsigned char* lds, const Gemm g, const Sched& S, const Epi& E) {
    int tid = threadIdx.x; asm volatile("" : "+v"(tid)); const int wid = __builtin_amdgcn_readfirstlane(tid >> 6), lane = tid & 63, wr = wid >> 2, wc = wid & 3, fr = lane & 15, fq = lane >> 4;
    const int K = g.K, nt = K / BK;
    unsigned voffA[2], voffB[2];
#pragma unroll
    for (int i = 0; i < 2; ++i) { int R, C; stage_rc(tid * 16 + i * 8192, R, C); const int Rb = Epi::PERM ? ((R & ~31) + perm32(R & 31)) : R;
        voffA[i] = (unsigned)(R * K + C) * 2u; voffB[i] = (unsigned)(Rb * K + C) * 2u; }
    const size_t kstep = (size_t)(BK * 2);
    const size_t hstep = (size_t)HALF * K * 2;
    const size_t tstep = 2 * hstep;
    const unsigned ldsw = (unsigned)wid * 1024u;
    const int aoff = lds_byte(wr * 64 + fr, fq * 8), boff = lds_byte(wc * 32 + fr, fq * 8);
#define PG8_SA(b, h) (((b) * 2 + (h)) * HTB)
#define PG8_SB(b, h) ((4 + (b) * 2 + (h)) * HTB)
#define PG8_STAGE(bufoff, gbase, voff) do { _Pragma("unroll") for (int _i = 0; _i < 2; ++_i) \
        __builtin_amdgcn_global_load_lds((const unsigned*)((const char*)(gbase) + (voff)[_i]), (PG8_LAS unsigned*)(lds + (bufoff) + ldsw + _i * 8192), 16, 0, 0); } while (0)
#define PG8_LDA(dst, b, h) do { _Pragma("unroll") for (int m = 0; m < 4; ++m) _Pragma("unroll") for (int k = 0; k < 2; ++k) dst[m][k] = *(const PG8_LAS bf16x8*)(lds + PG8_SA(b, h) + aoff + m * 2048 + k * 1024); } while (0)
#define PG8_LDB(dst, b, h) do { _Pragma("unroll") for (int n = 0; n < 2; ++n) _Pragma("unroll") for (int k = 0; k < 2; ++k) dst[n][k] = *(const PG8_LAS bf16x8*)(lds + PG8_SB(b, h) + boff + n * 2048 + k * 1024); } while (0)
#define PG8_MMA(ai, bj, At, Bt) do { __builtin_amdgcn_s_setprio(1); _Pragma("unroll") for (int m = 0; m < 4; ++m) _Pragma("unroll") for (int n = 0; n < 2; ++n) _Pragma("unroll") for (int k = 0; k < 2; ++k) \
        acc[ai][bj][m][n] = __builtin_amdgcn_mfma_f32_16x16x32_bf16(Bt[n][k], At[m][k], acc[ai][bj][m][n], 0, 0, 0); __builtin_amdgcn_s_setprio(0); } while (0)
#define PG8_WAIT_V(n) asm volatile("s_waitcnt vmcnt(" #n ")" ::: "memory")
#define PG8_WAIT_L(n) asm volatile("s_waitcnt lgkmcnt(" #n ")" ::: "memory")
#define PG8_BAR __builtin_amdgcn_s_barrier()
#define PG8_SCHED __builtin_amdgcn_sched_barrier(0)
    Unit cur, nxt; int ui = 0;
    if (!S.next(0, cur)) return;
    f32x4 acc[2][2][4][2];
#pragma unroll
    for (int a = 0; a < 2; ++a)
#pragma unroll
        for (int b = 0; b < 2; ++b)
#pragma unroll
            for (int m = 0; m < 4; ++m)
#pragma unroll
                for (int n = 0; n < 2; ++n) acc[a][b][m][n] = (f32x4){0.f, 0.f, 0.f, 0.f};
    bf16x8 At[4][2], B0[2][2], B1[2][2];
    const char* cA = (const char*)g.A + (size_t)cur.pm * tstep; const char* cB = (const char*)g.Bt + (size_t)cur.pn * tstep;
    S.a_ready(cur);
    if constexpr (SP2) {
        PG8_STAGE(PG8_SB(0, 0), cB, voffB); PG8_STAGE(PG8_SB(0, 1), cB + hstep, voffB); PG8_STAGE(PG8_SA(0, 0), cA, voffA); PG8_STAGE(PG8_SA(0, 1), cA + hstep, voffA);
        if (wr == 1) PG8_BAR;
        PG8_WAIT_V(2); PG8_BAR;
        PG8_STAGE(PG8_SB(1, 0), cB + kstep, voffB); PG8_STAGE(PG8_SA(1, 0), cA + kstep, voffA); PG8_STAGE(PG8_SB(1, 1), cB + hstep + kstep, voffB);
        PG8_WAIT_V(6); PG8_BAR;
    } else {
        PG8_STAGE(PG8_SB(0, 0), cB, voffB); PG8_STAGE(PG8_SA(0, 0), cA, voffA); PG8_STAGE(PG8_SB(0, 1), cB + hstep, voffB); PG8_STAGE(PG8_SA(0, 1), cA + hstep, voffA);
        if (wr == 1) PG8_BAR;
        PG8_WAIT_V(4); PG8_BAR;
        PG8_STAGE(PG8_SB(1, 0), cB + kstep, voffB); PG8_STAGE(PG8_SA(1, 0), cA + kstep, voffA); PG8_STAGE(PG8_SB(1, 1), cB + hstep + kstep, voffB);
        PG8_WAIT_V(6); PG8_BAR;
    }
    for (;;) {
        const bool has_next = S.next(ui + 1, nxt);
        const char* nA = has_next ? (const char*)g.A + (size_t)nxt.pm * tstep : cA; const char* nB = has_next ? (const char*)g.Bt + (size_t)nxt.pn * tstep : cB;
        for (int t = 0; t < nt; t += 2) {
            const bool last = (t == nt - 2);
            const char* a1 = cA + (size_t)(t + 1) * kstep;
            const char* a2 = last ? nA : cA + (size_t)(t + 2) * kstep; const char* b2 = last ? nB : cB + (size_t)(t + 2) * kstep;
            const char* a3 = a2 + kstep; const char* b3 = b2 + kstep;
            if (last && has_next) S.a_ready(nxt);
            if constexpr (SP2) {
            PG8_LDB(B0, 0, 0); PG8_LDB(B1, 0, 1); PG8_SCHED; PG8_LDA(At, 0, 0); PG8_STAGE(PG8_SA(1, 1), a1 + hstep, voffA);
            PG8_WAIT_V(8); PG8_WAIT_L(0); PG8_BAR; PG8_MMA(0, 0, At, B0); PG8_MMA(0, 1, At, B1); PG8_BAR; PG8_SCHED;
            PG8_LDA(At, 0, 1); PG8_STAGE(PG8_SB(0, 0), b2, voffB); PG8_STAGE(PG8_SB(0, 1), b2 + hstep, voffB); PG8_STAGE(PG8_SA(0, 0), a2, voffA);
            PG8_WAIT_V(8); PG8_WAIT_L(0); PG8_BAR; PG8_MMA(1, 0, At, B0); PG8_MMA(1, 1, At, B1); PG8_BAR; PG8_SCHED;
            PG8_LDB(B0, 1, 0); PG8_LDB(B1, 1, 1); PG8_SCHED; PG8_LDA(At, 1, 0); PG8_STAGE(PG8_SA(0, 1), a2 + hstep, voffA);
            PG8_WAIT_V(8); PG8_WAIT_L(0); PG8_BAR; PG8_MMA(0, 0, At, B0); PG8_MMA(0, 1, At, B1); PG8_BAR; PG8_SCHED;
            PG8_LDA(At, 1, 1); PG8_STAGE(PG8_SB(1, 0), b3, voffB); PG8_STAGE(PG8_SB(1, 1), b3 + hstep, voffB); PG8_STAGE(PG8_SA(1, 0), a3, voffA);
            PG8_WAIT_V(8); PG8_WAIT_L(0); PG8_BAR; PG8_MMA(1, 0, At, B0); PG8_MMA(1, 1, At, B1); PG8_BAR; PG8_SCHED;
            } else {
            PG8_LDB(B0, 0, 0); PG8_SCHED; PG8_LDA(At, 0, 0); PG8_STAGE(PG8_SA(1, 1), a1 + hstep, voffA);
            PG8_WAIT_L(8); PG8_BAR; PG8_WAIT_L(0); PG8_MMA(0, 0, At, B0); PG8_BAR; PG8_SCHED;
            PG8_LDB(B1, 0, 1); PG8_STAGE(PG8_SB(0, 0), b2, voffB);
            PG8_BAR; PG8_WAIT_L(0); PG8_MMA(0, 1, At, B1); PG8_BAR;
            PG8_LDA(At, 0, 1); PG8_STAGE(PG8_SA(0, 0), a2, voffA);
            PG8_BAR; PG8_WAIT_L(0); PG8_MMA(1, 0, At, B0); PG8_BAR; PG8_SCHED;
            PG8_STAGE(PG8_SB(0, 1), b2 + hstep, voffB);
            PG8_WAIT_V(6); PG8_BAR; PG8_MMA(1, 1, At, B1); PG8_BAR;
            PG8_LDB(B0, 1, 0); PG8_SCHED; PG8_LDA(At, 1, 0); PG8_STAGE(PG8_SA(0, 1), a2 + hstep, voffA);
            PG8_WAIT_L(8); PG8_BAR; PG8_WAIT_L(0); PG8_MMA(0, 0, At, B0); PG8_BAR; PG8_SCHED;
            PG8_LDB(B1, 1, 1); PG8_STAGE(PG8_SB(1, 0), b3, voffB);
            PG8_BAR; PG8_WAIT_L(0); PG8_MMA(0, 1, At, B1); PG8_BAR;
            PG8_LDA(At, 1, 1); PG8_STAGE(PG8_SA(1, 0), a3, voffA);
            PG8_BAR; PG8_WAIT_L(0); PG8_MMA(1, 0, At, B0); PG8_BAR; PG8_SCHED;
            PG8_STAGE(PG8_SB(1, 1), b3 + hstep, voffB);
            PG8_WAIT_V(6); PG8_BAR; PG8_MMA(1, 1, At, B1); PG8_BAR;
            }
        }
        if constexpr (ALIGN_EPI) { if (wr == 0) PG8_BAR; }
        if constexpr (!Epi::AFTER_DRAIN) { E(acc, cur, wr, wc, fr, fq); S.done(cur); }
        if (!has_next) break;
#pragma unroll
        for (int a = 0; a < 2; ++a)
#pragma unroll
            for (int b = 0; b < 2; ++b)
#pragma unroll
                for (int m = 0; m < 4; ++m)
#pragma unroll
                    for (int n = 0; n < 2; ++n) acc[a][b][m][n] = (f32x4){0.f, 0.f, 0.f, 0.f};
        cur = nxt; cA = nA; cB = nB; ++ui;
        if constexpr (ALIGN_EPI) { if (wr == 1) PG8_BAR; }
    }
    PG8_WAIT_V(0);
    if constexpr (!ALIGN_EPI) { if (wr == 0) PG8_BAR; }
    PG8_BAR;
    if constexpr (Epi::AFTER_DRAIN) { E.fused(acc, cur, wr, wc, fr, fq, lds, wid, lane); S.done(cur); }
#undef PG8_SA
#undef PG8_SB
#undef PG8_STAGE
#undef PG8_LDA
#undef PG8_LDB
#undef PG8_MMA
#undef PG8_WAIT_V
#undef PG8_WAIT_L
#undef PG8_BAR
#undef PG8_SCHED
}
}
namespace att {
typedef unsigned short bf16;
constexpr int   D = 128, NW = 8, QBLK = 32, KVBLK = 64;
constexpr float SCALE = 0.088388347648318440f;
constexpr float THR = 8.f;
constexpr int SDEPTH = 2;
constexpr size_t SHM_V = KVBLK * D * 2, SHM_K = KVBLK * D * 2, SHM_ATTN = 2 * SHM_V + 2 * SHM_K + NW * 64 * 4;
__device__ __forceinline__ bf16 f2bf_s(float f) { unsigned u = __builtin_bit_cast(unsigned, f); return (bf16)((u + 0x7fffu + ((u >> 16) & 1u)) >> 16); }
using bf16x8 = __attribute__((ext_vector_type(8))) short;
using s16x4  = __attribute__((ext_vector_type(4))) short;
using f32x16 = __attribute__((ext_vector_type(16))) float;
using f32x8  = __attribute__((ext_vector_type(8))) float;
using u32x4  = __attribute__((ext_vector_type(4))) unsigned;
#define KSWZ(row, colB) ((row) * 256 + ((colB) ^ (((row) & 7) << 4)))
#define SBAR() __builtin_amdgcn_sched_barrier(0)
__device__ __forceinline__ int crow(int r, int hi) { return (r & 3) + 8 * (r >> 2) + 4 * hi; }
__device__ __forceinline__ unsigned cvtpk(float lo, float hi) {
  unsigned r; asm volatile("v_cvt_pk_bf16_f32 %0, %1, %2" : "=v"(r) : "v"(lo), "v"(hi)); return r;
}
__device__ __forceinline__ void partialSM(f32x16& p0, f32x16& p1, float& m_reg, float& mn, float& alpha) {
  constexpr float C = SCALE * 1.4426950408889634f;
  float pmax = p0[0]; for (int r = 1; r < 16; ++r) pmax = fmaxf(pmax, p0[r]); for (int r = 0; r < 16; ++r) pmax = fmaxf(pmax, p1[r]);
  { auto rr = __builtin_amdgcn_permlane32_swap(__float_as_uint(pmax), __float_as_uint(pmax), false, false);
    pmax = fmaxf(__uint_as_float(rr[0]), __uint_as_float(rr[1])); }
  if (__builtin_expect(__all(pmax - m_reg <= THR / SCALE), 1)) { mn = m_reg; alpha = 1.f; }
  else { mn = fmaxf(m_reg, pmax); alpha = __builtin_amdgcn_exp2f((m_reg - mn) * C); m_reg = mn; }
  float mnC = -mn * C;
  for (int r = 0; r < 16; ++r) p0[r] = fmaf(p0[r], C, mnC); for (int r = 0; r < 16; ++r) p1[r] = fmaf(p1[r], C, mnC);
  for (int r = 0; r < 16; ++r) p0[r] = __builtin_amdgcn_exp2f(p0[r]);
}
__device__ __forceinline__ void finishSM(f32x16& p0, f32x16& p1, float alpha, float& l_reg, bf16x8& pa0, bf16x8& pa1, bf16x8& pa2, bf16x8& pa3) {
  for (int r = 0; r < 16; ++r) p1[r] = __builtin_amdgcn_exp2f(p1[r]);
  float ps = 0; for (int r = 0; r < 16; ++r) ps += p0[r]; for (int r = 0; r < 16; ++r) ps += p1[r];
  { auto rr = __builtin_amdgcn_permlane32_swap(__float_as_uint(ps), __float_as_uint(ps), false, false);
    ps = __uint_as_float(rr[0]) + __uint_as_float(rr[1]); }
  l_reg = l_reg * alpha + ps;
#define PK4(P, BASE, OUT) do { unsigned a0 = cvtpk(P[BASE + 0], P[BASE + 1]), a1 = cvtpk(P[BASE + 2], P[BASE + 3]);   \
    unsigned b0 = cvtpk(P[BASE + 4], P[BASE + 5]), b1 = cvtpk(P[BASE + 6], P[BASE + 7]);                              \
    auto r0 = __builtin_amdgcn_permlane32_swap(a0, b0, false, false); auto r1 = __builtin_amdgcn_permlane32_swap(a1, b1, false, false); \
    u32x4 w = {r0[0], r1[0], r0[1], r1[1]}; OUT = *reinterpret_cast<bf16x8*>(&w); } while (0)
  PK4(p0, 0, pa0); PK4(p0, 8, pa1); PK4(p1, 0, pa2); PK4(p1, 8, pa3);
#undef PK4
}
__device__ __forceinline__ void qkt(f32x16& p0, f32x16& p1, const bf16* Ks, const bf16x8* qr, int r32, int hi) {
  p0 = f32x16{}; p1 = f32x16{};
  for (int d0 = 0; d0 < 8; ++d0) { int cb = (d0 * 16 + hi * 8) * 2;
    bf16x8 b0 = *reinterpret_cast<const bf16x8*>((const char*)Ks + KSWZ(r32, cb));
    bf16x8 b1 = *reinterpret_cast<const bf16x8*>((const char*)Ks + KSWZ(32 + r32, cb));
    p0 = __builtin_amdgcn_mfma_f32_32x32x16_bf16(b0, qr[d0], p0, 0, 0, 0);
    p1 = __builtin_amdgcn_mfma_f32_32x32x16_bf16(b1, qr[d0], p1, 0, 0, 0); }
}
__device__ __forceinline__ int v_st(int k, int c) { const int kk = (k & ~0xC) | ((k & 4) << 1) | ((k & 8) >> 1); return ((kk >> 3) * 4 + (c >> 5)) * 512 + ((kk & 7) * 32 + (c & 31)) * 2; }
__device__ __forceinline__ int v_rd_base(int lane) { return ((lane & 3) << 3) | (((lane >> 2) & 3) << 6) | (((lane >> 4) & 1) << 5) | (((lane >> 5) & 1) << 8); }
constexpr int v_rd_off(int d0, int ks, int half) { return d0 * 512 + ks * 4096 + half * 2048; }
template <int OFF> __device__ __forceinline__ s16x4 tr_read(int vb) {
  s16x4 r; asm volatile("ds_read_b64_tr_b16 %0, %1 offset:%2" : "=&v"(r) : "v"(vb), "i"(OFF) : "memory"); return r;
}
template <int D0> __device__ __forceinline__ void pv_one(f32x16& od, int vb, bf16x8 pa0, bf16x8 pa1, bf16x8 pa2, bf16x8 pa3) {
  const s16x4 l0 = tr_read<v_rd_off(D0, 0, 0)>(vb), h0 = tr_read<v_rd_off(D0, 0, 1)>(vb), l1 = tr_read<v_rd_off(D0, 1, 0)>(vb), h1 = tr_read<v_rd_off(D0, 1, 1)>(vb);
  const s16x4 l2 = tr_read<v_rd_off(D0, 2, 0)>(vb), h2 = tr_read<v_rd_off(D0, 2, 1)>(vb), l3 = tr_read<v_rd_off(D0, 3, 0)>(vb), h3 = tr_read<v_rd_off(D0, 3, 1)>(vb);
  asm volatile("s_waitcnt lgkmcnt(0)" ::: "memory"); SBAR();
#define PK(L, H) (bf16x8){L[0], L[1], L[2], L[3], H[0], H[1], H[2], H[3]}
  od = __builtin_amdgcn_mfma_f32_32x32x16_bf16(pa0, PK(l0, h0), od, 0, 0, 0);
  od = __builtin_amdgcn_mfma_f32_32x32x16_bf16(pa1, PK(l1, h1), od, 0, 0, 0);
  od = __builtin_amdgcn_mfma_f32_32x32x16_bf16(pa2, PK(l2, h2), od, 0, 0, 0);
  od = __builtin_amdgcn_mfma_f32_32x32x16_bf16(pa3, PK(l3, h3), od, 0, 0, 0);
#undef PK
}
__device__ __forceinline__ void pv_d0(f32x16* o, int vb, bf16x8 pa0, bf16x8 pa1, bf16x8 pa2, bf16x8 pa3) {
  pv_one<0>(o[0], vb, pa0, pa1, pa2, pa3); pv_one<1>(o[1], vb, pa0, pa1, pa2, pa3); pv_one<2>(o[2], vb, pa0, pa1, pa2, pa3); pv_one<3>(o[3], vb, pa0, pa1, pa2, pa3);
}

template <int LDQ, int LDK, int LDO>
__device__ __forceinline__ void attn_dense_body(const bf16* Qb, const bf16* Kh, const bf16* Vh,
                                                bf16* Ob, int seq, char* lds) {
  int tid = threadIdx.x; asm volatile("" : "+v"(tid)); const int wid = tid >> 6, lane = tid & 63, r32 = lane & 31, hi = lane >> 5;
  bf16* V_lds = (bf16*)lds; bf16* K_lds = (bf16*)(lds + 2 * SHM_V);
  float* ws = (float*)(lds + 2 * SHM_V + 2 * SHM_K) + wid * 64; float* li_l = ws; float* al_l = ws + 32;
  float m_reg = -1e30f, l_reg = 0; f32x16 o[4] = {}; bf16x8 qr[8];
  const bf16* Qw = Qb + (long)(wid * QBLK + r32) * LDQ + hi * 8;
#pragma unroll
  for (int d0 = 0; d0 < 8; ++d0) qr[d0] = *reinterpret_cast<const bf16x8*>(Qw + d0 * 16);
  const int sr = tid >> 4, sc = (tid & 15) * 8, vst0 = v_st(sr, sc), vst1 = v_st(32 + sr, sc);
  const int vb0 = (int)(uintptr_t)V_lds + v_rd_base(lane);
  struct { bf16x8 vs0, vs1, ks0, ks1; } sr_[SDEPTH];
#define SLOAD(i, k0) do { sr_[i].vs0 = (*reinterpret_cast<const bf16x8*>(&Vh[(long)((k0) + sr) * LDK + sc])); sr_[i].vs1 = (*reinterpret_cast<const bf16x8*>(&Vh[(long)((k0) + 32 + sr) * LDK + sc])); \
    sr_[i].ks0 = (*reinterpret_cast<const bf16x8*>(&Kh[(long)((k0) + sr) * LDK + sc])); sr_[i].ks1 = (*reinterpret_cast<const bf16x8*>(&Kh[(long)((k0) + 32 + sr) * LDK + sc])); } while (0)
#define SWRITE(b, i) do { *(bf16x8*)((char*)V_lds + (b) * SHM_V + vst0) = (sr_[i].vs0);          \
    *(bf16x8*)((char*)V_lds + (b) * SHM_V + vst1) = (sr_[i].vs1); int kc = sc * 2;               \
    *(bf16x8*)((char*)K_lds + (b) * SHM_K + KSWZ(sr, kc)) = (sr_[i].ks0);                       \
    *(bf16x8*)((char*)K_lds + (b) * SHM_K + KSWZ(32 + sr, kc)) = (sr_[i].ks1); } while (0)
#define SWAIT() do { if constexpr (SDEPTH == 2) asm volatile("s_waitcnt vmcnt(4)" ::: "memory"); else asm volatile("s_waitcnt vmcnt(0)" ::: "memory"); } while (0)
#define RESC(a) do { if (__any((a) < 1.f)) { if (hi == 0) al_l[r32] = (a); asm volatile("s_waitcnt lgkmcnt(0)" ::: "memory"); \
    for (int d = 0; d < 4; ++d) for (int r = 0; r < 16; ++r) o[d][r] *= al_l[crow(r, hi)]; } } while (0)
  f32x16 pA0, pA1, pB0, pB1; float mnA, mnB, alA, alB; bf16x8 pa0, pa1, pa2, pa3; const int NT = seq / KVBLK;
  constexpr int SE = 0, SO = SDEPTH - 1;
  SLOAD(SE, 0); asm volatile("s_waitcnt vmcnt(0)" ::: "memory"); SWRITE(0, SE); __syncthreads();
  qkt(pA0, pA1, K_lds, qr, r32, hi); partialSM(pA0, pA1, m_reg, mnA, alA);
  SLOAD(SO, KVBLK); if constexpr (SDEPTH == 2) { if (2 < NT) SLOAD(SE, 2 * KVBLK); }
  SWAIT(); SWRITE(1, SO); __syncthreads();
  for (int j = 1; j + 1 < NT; j += 2) {
    SBAR(); qkt(pB0, pB1, (bf16*)((char*)K_lds + SHM_K), qr, r32, hi);
    finishSM(pA0, pA1, alA, l_reg, pa0, pa1, pa2, pa3); SBAR();
    SLOAD(SO, (j + SDEPTH) * KVBLK); SBAR();
    pv_d0(o, vb0, pa0, pa1, pa2, pa3); partialSM(pB0, pB1, m_reg, mnB, alB);
    __syncthreads(); SWAIT(); SWRITE(0, SE);
    RESC(alB); __syncthreads();
    SBAR(); qkt(pA0, pA1, K_lds, qr, r32, hi);
    finishSM(pB0, pB1, alB, l_reg, pa0, pa1, pa2, pa3); SBAR();
    if (SDEPTH == 1 || j + 3 < NT) SLOAD(SE, (j + 1 + SDEPTH) * KVBLK); SBAR();
    pv_d0(o, vb0 + (int)SHM_V, pa0, pa1, pa2, pa3); partialSM(pA0, pA1, m_reg, mnA, alA);
    __syncthreads(); SWAIT(); SWRITE(1, SO);
    RESC(alA); __syncthreads();
  }
  SBAR(); qkt(pB0, pB1, (bf16*)((char*)K_lds + SHM_K), qr, r32, hi);
  finishSM(pA0, pA1, alA, l_reg, pa0, pa1, pa2, pa3); SBAR();
  pv_d0(o, vb0, pa0, pa1, pa2, pa3); partialSM(pB0, pB1, m_reg, mnB, alB);
  __syncthreads(); RESC(alB);
  finishSM(pB0, pB1, alB, l_reg, pa0, pa1, pa2, pa3); SBAR();
  pv_d0(o, vb0 + (int)SHM_V, pa0, pa1, pa2, pa3);
  if (hi == 0) li_l[r32] = l_reg; asm volatile("s_waitcnt lgkmcnt(0)" ::: "memory");
  float rli[16];
#pragma unroll
  for (int r = 0; r < 16; ++r) rli[r] = __builtin_amdgcn_rcpf(li_l[crow(r, hi)]);
  bf16* Ow = Ob + (long)(wid * QBLK) * LDO;
#pragma unroll
  for (int r = 0; r < 16; ++r) { int orow = crow(r, hi);
    for (int d0 = 0; d0 < 4; ++d0) Ow[(long)orow * LDO + d0 * 32 + r32] = f2bf_s(o[d0][r] * rli[r]); }
#undef SLOAD
#undef SWRITE
#undef SWAIT
#undef RESC
}
#undef KSWZ
#undef SBAR
}
typedef unsigned short bf16_t;
typedef float f32x4 __attribute__((ext_vector_type(4)));
typedef float f32x2 __attribute__((ext_vector_type(2)));
typedef unsigned u32x4 __attribute__((ext_vector_type(4)));
typedef unsigned u32x2 __attribute__((ext_vector_type(2)));
#define LAS __attribute__((address_space(3)))
constexpr int DM = 2048, NTOK = 8192, INC = 5168, PNW = 5376, PLD = 5120, FFD = 8192, NMOD = 12288;
constexpr size_t MiB = 1u << 20;
constexpr size_t WS_CTL = 0, WS_MODS = 1 * MiB, WS_WIN = 2 * MiB, WS_WOUT = 44 * MiB, WS_WFF1 = 60 * MiB, WS_WFF2 = 124 * MiB, WS_H = 188 * MiB, WS_XA = 220 * MiB, WS_XB = 284 * MiB,
    WS_P = 348 * MiB, WS_G = 428 * MiB, WS_QN = 430 * MiB, WS_KB = 446 * MiB, WS_VB = 451 * MiB, WS_LA = 456 * MiB, WS_DQKV = 472 * MiB, WS_GB = 496 * MiB, WS_OG = 497 * MiB, WS_OD = 529 * MiB,
    WS_MIX = 561 * MiB, WS_GQ = 593 * MiB, WS_GO = 601 * MiB, WS_GU = 617 * MiB, WS_GD = 633 * MiB, WS_END = 634 * MiB;
constexpr size_t WS_MC = 188 * MiB, WS_NC = 220 * MiB, WS_QE = 252 * MiB, WS_OL = 268 * MiB;
constexpr size_t WS_QUEUE = 32768;
constexpr size_t WS_RS = 65536;
constexpr size_t WS_BIAS = 1 * MiB + 524288;
constexpr size_t WS_H2 = 348 * MiB;
constexpr size_t ZERO_BYTES = 2 * MiB;
constexpr size_t OUT_Y = 0, OUT_CK = 16777216, OUT_CV = 18874368, OUT_SG = 20971520, OUT_SD = 23068672, OUT_TOTAL = 27262976;
constexpr int LDS_BYTES = 147456;
constexpr float EPS = 1e-6f;

struct Params { const float* in[25]; float* out; unsigned char* ws; };
constexpr int PTAB_OFF = 147456 - 512;
typedef __attribute__((address_space(3))) const unsigned* ptab_t;
__device__ __forceinline__ const void* ldp(ptab_t pt, int i) { unsigned a; asm volatile("v_mov_b32 %0, %1" : "=v"(a) : "s"((unsigned)(unsigned long long)pt + 8u * (unsigned)i));
    const ptab_t q = (ptab_t)(unsigned long long)a; const unsigned lo = __builtin_amdgcn_readfirstlane(q[0]), hi = __builtin_amdgcn_readfirstlane(q[1]); return (const void*)(__attribute__((address_space(1))) const unsigned char*)(((unsigned long long)hi << 32) | lo); }
#define PIN(i) ((const float*)ldp(pt, (i)))
#define POUT ((float*)ldp(pt, 25))
#define PWS ((unsigned char*)ldp(pt, 26))

__device__ __forceinline__ float bf2f(unsigned short v) { return __uint_as_float(((unsigned)v) << 16); }
__device__ __forceinline__ float bflo(unsigned w) { return __uint_as_float(w << 16); }
__device__ __forceinline__ float bfhi(unsigned w) { return __uint_as_float(w & 0xffff0000u); }
__device__ __forceinline__ unsigned short f2bf(float f) { unsigned u = __float_as_uint(f); return (unsigned short)((u + 0x7fffu + ((u >> 16) & 1u)) >> 16); }
typedef __bf16 bf16x2_hw __attribute__((ext_vector_type(2)));
__device__ __forceinline__ unsigned pk2(float lo, float hi) { const f32x2 v = {lo, hi}; return __builtin_bit_cast(unsigned, __builtin_convertvector(v, bf16x2_hw)); }
__device__ __forceinline__ float wave_sum(float v) {
#pragma unroll
    for (int o = 1; o < 64; o <<= 1) v += __shfl_xor(v, o);
    return v;
}
template <int N> __device__ __forceinline__ void wave_sum_n(float (&v)[N]) {
#pragma unroll
    for (int o = 1; o < 64; o <<= 1) {
        float t[N];
#pragma unroll
        for (int i = 0; i < N; ++i) t[i] = __shfl_xor(v[i], o);
#pragma unroll
        for (int i = 0; i < N; ++i) v[i] += t[i];
    }
}
__device__ __forceinline__ float silu_f(float x) { return x * __builtin_amdgcn_rcpf(1.f + __expf(-x)); }
__device__ __forceinline__ float softplus_f(float x) { return fmaxf(x, 0.f) + __logf(1.f + __expf(-fabsf(x))); }
__device__ __forceinline__ float logsigmoid_f(float x) { return fminf(x, 0.f) - __logf(1.f + __expf(-fabsf(x))); }
#define LDS_WAIT() asm volatile("s_waitcnt lgkmcnt(0)" ::: "memory")
#define LDS_BARRIER() do { asm volatile("s_waitcnt lgkmcnt(0)" ::: "memory"); __builtin_amdgcn_s_barrier(); asm volatile("" ::: "memory"); } while (0)
__device__ __forceinline__ int tid_opaque() { int t = threadIdx.x; asm volatile("" : "+v"(t)); return t; }

template <int MODE  >
__device__ __forceinline__ void transpose_item(const float* W, int ldw, int o0, int K, bf16_t* WT, int n0, int k0, LAS float* scr, int lane) {
    const int krow = lane >> 4, n4 = (lane & 15) * 4;
    if (MODE == 0) {
        f32x4 v[16];
#pragma unroll
        for (int i = 0; i < 16; ++i) v[i] = *(const f32x4*)(W + (size_t)(k0 + 4 * i + krow) * ldw + o0 + n4);
#pragma unroll
        for (int i = 0; i < 16; ++i) { LAS float* s = scr + (4 * i + krow) * 65 + n4; s[0] = v[i].x; s[1] = v[i].y; s[2] = v[i].z; s[3] = v[i].w; }
    } else {
#pragma unroll 4
        for (int i = 0; i < 16; ++i) { LAS float* s = scr + (4 * i + krow) * 65 + n4;
#pragma unroll
            for (int e = 0; e < 4; ++e) { const int c = n4 + e; float x = 0.f;
                if (MODE == 1 && c < 48) x = W[(size_t)(k0 + 4 * i + krow) * ldw + (c < 32 ? 1536 + c : 5152 + (c - 32))];
                s[e] = x; } }
    }
    LDS_WAIT(); asm volatile("" ::: "memory");
    const int c8 = lane & 7;
#pragma unroll
    for (int j = 0; j < 8; ++j) { const int n = (lane >> 3) + 8 * j; const LAS float* s = scr + (8 * c8) * 65 + n;
        u32x4 o; o.x = pk2(s[0 * 65], s[1 * 65]); o.y = pk2(s[2 * 65], s[3 * 65]); o.z = pk2(s[4 * 65], s[5 * 65]); o.w = pk2(s[6 * 65], s[7 * 65]);
        *(u32x4*)(WT + (size_t)(n0 + n) * K + k0 + 8 * c8) = o; }
    LDS_WAIT(); asm volatile("" ::: "memory");
}
constexpr int TI_IN = 32 * 84, TI_OUT = 32 * 32, TI_F1 = 32 * 128, TI_F2 = 128 * 32, TI_L = TI_IN + TI_OUT + TI_F1 + TI_F2;
__device__ __forceinline__ void do_transposes(ptab_t pt, LAS unsigned char* lds, int first, int count, int worker, int n_workers) {
    const int tid = tid_opaque(), lane = tid & 63, wave = __builtin_amdgcn_readfirstlane(tid >> 6);
    unsigned char* ws = PWS;
    LAS float* scr = (LAS float*)(lds + wave * 16640);
    for (int it = first + worker; it < first + count; it += n_workers) {
        const int l = it / TI_L; int r = it - l * TI_L;
        const float* W; bf16_t* WT; int ldw, K, kb, nbk, o0, mode = 0;
        if (r < TI_IN) { kb = r / 84; nbk = r % 84; const int n0 = 64 * nbk; W = PIN(12) + (size_t)l * 2048 * INC; WT = (bf16_t*)(ws + WS_WIN) + (size_t)l * PNW * 2048; ldw = INC; K = 2048;
            o0 = n0 < 1536 ? n0 : n0 + 32; mode = n0 < 5120 ? 0 : (n0 == 5120 ? 1 : 2); }
        else if ((r -= TI_IN) < TI_OUT) { kb = r / 32; nbk = r % 32; W = PIN(22) + (size_t)l * 2048 * 2048; WT = (bf16_t*)(ws + WS_WOUT) + (size_t)l * 2048 * 2048; ldw = 2048; K = 2048; o0 = 64 * nbk; }
        else if ((r -= TI_OUT) < TI_F1) { kb = r / 128; nbk = r % 128; W = PIN(23) + (size_t)l * 2048 * 8192; WT = (bf16_t*)(ws + WS_WFF1) + (size_t)l * 8192 * 2048; ldw = 8192; K = 2048; o0 = 64 * nbk; }
        else { r -= TI_F1; kb = r / 32; nbk = r % 32; W = PIN(24) + (size_t)l * 8192 * 2048; WT = (bf16_t*)(ws + WS_WFF2) + (size_t)l * 2048 * 8192; ldw = 2048; K = 8192; o0 = 64 * nbk; }
        if (mode == 0) transpose_item<0>(W, ldw, o0, K, WT, 64 * nbk, 64 * kb, scr, lane);
        else if (mode == 1) transpose_item<1>(W, ldw, o0, K, WT, 64 * nbk, 64 * kb, scr, lane);
        else transpose_item<2>(W, ldw, o0, K, WT, 64 * nbk, 64 * kb, scr, lane);
    }
}
__device__ __forceinline__ void p0_prologue(ptab_t pt, LAS unsigned char* lds, int bid, int nb, bool do_mods) {
    const int tid = tid_opaque(), lane = tid & 63, wave = __builtin_amdgcn_readfirstlane(tid >> 6);
    unsigned char* ws = PWS;
    do_transposes(pt, lds, 0, TI_L, bid * 8 + wave, nb * 8);
    do_transposes(pt, lds, TI_L + TI_IN + TI_OUT + TI_F1, TI_F2 / 3, bid * 8 + wave, nb * 8);
    __syncthreads();
    if (do_mods) {
        LAS float* sc = (LAS float*)lds;
        LAS float* red = (LAS float*)(lds + 40960);
        float* mods = (float*)(ws + WS_MODS);
        for (int idx = tid; idx < 5 * 2048; idx += 512) { const int j = idx >> 11, k = idx & 2047; const float cv = (j == 0) ? PIN(7)[k] : PIN(6)[(j - 1) * 2048 + k]; sc[idx] = silu_f(cv); }
        __syncthreads();
        const bool act = lane < 48; const int half = act ? lane / 24 : 0, c4 = act ? (lane % 24) * 4 : 0;
        for (int it = bid; it < 256; it += nb) {
            const int l = it >> 7, nc = it & 127;
            const float* Wp = PIN(10) + ((size_t)l * 2048 + wave * 256 + half) * NMOD + nc * 96 + c4;
            f32x4 acc[5];
#pragma unroll
            for (int j = 0; j < 5; ++j) acc[j] = (f32x4){0.f, 0.f, 0.f, 0.f};
#pragma unroll 8
            for (int i = 0; i < 128; ++i) { const f32x4 w = *(const f32x4*)(Wp + (size_t)(2 * i) * NMOD); const int row = wave * 256 + 2 * i + half;
#pragma unroll
                for (int j = 0; j < 5; ++j) acc[j] += sc[j * 2048 + row] * w; }
            if (act) {
#pragma unroll
                for (int j = 0; j < 5; ++j) *(LAS f32x4*)(red + ((wave * 2 + half) * 5 + j) * 96 + c4) = acc[j]; }
            __syncthreads();
            if (tid < 480) { const int j = tid / 96, col = tid % 96; float s = PIN(11)[(size_t)l * NMOD + nc * 96 + col];
#pragma unroll
                for (int g = 0; g < 16; ++g) s += red[(g * 5 + j) * 96 + col];
                mods[((size_t)l * 5 + j) * NMOD + nc * 96 + col] = s; }
            __syncthreads();
        }
    }
}

__device__ __forceinline__ void norm_phase(const float* x0, const float* x1, const float* g, const float* mods_l, int shift_i, int scale_i, bf16_t* H, int bid, int nb) {
    const int tid = tid_opaque(), lane = tid & 63, wave = tid >> 6;
    const int half_rows = NTOK / 2;
    for (int r0 = bid * 8 + wave; r0 < half_rows; r0 += nb * 8) {
        f32x4 v[2][8]; float ss[2] = {0.f, 0.f};
#pragma unroll
        for (int u = 0; u < 2; ++u) { const int r = r0 + u * half_rows; const float* xr = (r < 4096 ? x0 : x1) + (size_t)r * DM;
#pragma unroll
            for (int j = 0; j < 8; ++j) v[u][j] = *(const f32x4*)(xr + 4 * (lane + 64 * j)); }
#pragma unroll
        for (int u = 0; u < 2; ++u)
#pragma unroll
            for (int j = 0; j < 8; ++j) ss[u] += (v[u][j].x * v[u][j].x + v[u][j].y * v[u][j].y) + (v[u][j].z * v[u][j].z + v[u][j].w * v[u][j].w);
        wave_sum_n<2>(ss);
#pragma unroll
        for (int u = 0; u < 2; ++u) { const int r = r0 + u * half_rows; const float rstd = rsqrtf(ss[u] * (1.f / DM) + EPS);
            const int cond = r < 4096 ? 0 : 1 + ((r - 4096) >> 10);
            const float* sh = mods_l + ((size_t)cond * 6 + shift_i) * DM; const float* sc = mods_l + ((size_t)cond * 6 + scale_i) * DM;
#pragma unroll
            for (int j = 0; j < 8; ++j) { const int col = 4 * (lane + 64 * j); const f32x4 gg = *(const f32x4*)(g + col), s = *(const f32x4*)(sc + col), h = *(const f32x4*)(sh + col);
                const f32x4 o = v[u][j] * rstd * gg * (s + 1.f) + h; u32x2 w; w.x = pk2(o.x, o.y); w.y = pk2(o.z, o.w); *(u32x2*)(H + (size_t)r * DM + col) = w; } }
    }
}

__device__ __forceinline__ void bias_phase(const float* shift  , const bf16_t* WT, int N, float* out  , LAS unsigned char* lds, int bid, int nb) {
    const int tid = tid_opaque(), lane = tid & 63, wave = tid >> 6;
    LAS float* sh = (LAS float*)(lds + 65536);
    for (int idx = tid; idx < 5 * 2048; idx += 512) sh[idx] = shift[(size_t)(idx >> 11) * 6 * 2048 + (idx & 2047)];
    __syncthreads();
    const int NGW = nb * 8;
    for (int n0 = bid * 8 + wave; n0 < N; n0 += 2 * NGW) {
        u32x4 w[2][4]; float a[2][5];
#pragma unroll
        for (int u = 0; u < 2; ++u) { const int n = n0 + u * NGW < N ? n0 + u * NGW : n0; const bf16_t* row = WT + (size_t)n * 2048;
#pragma unroll
            for (int j = 0; j < 4; ++j) w[u][j] = *(const u32x4*)(row + (j * 64 + lane) * 8);
#pragma unroll
            for (int c = 0; c < 5; ++c) a[u][c] = 0.f; }
#pragma unroll
        for (int j = 0; j < 4; ++j) { const int k0 = (j * 64 + lane) * 8;
#pragma unroll
            for (int c = 0; c < 5; ++c) { const f32x4 s0 = *(const LAS f32x4*)(sh + c * 2048 + k0), s1 = *(const LAS f32x4*)(sh + c * 2048 + k0 + 4);
#pragma unroll
                for (int u = 0; u < 2; ++u) { const u32x4 ww = w[u][j];
                    a[u][c] += (bflo(ww.x) * s0.x + bfhi(ww.x) * s0.y) + (bflo(ww.y) * s0.z + bfhi(ww.y) * s0.w) + (bflo(ww.z) * s1.x + bfhi(ww.z) * s1.y) + (bflo(ww.w) * s1.z + bfhi(ww.w) * s1.w); } } }
        float f[10];
#pragma unroll
        for (int u = 0; u < 2; ++u)
#pragma unroll
            for (int c = 0; c < 5; ++c) f[u * 5 + c] = a[u][c];
        wave_sum_n<10>(f);
#pragma unroll
        for (int u = 0; u < 2; ++u) { const int n = n0 + u * NGW;
            if (n < N && lane < 5) out[(size_t)lane * N + n] = lane == 0 ? f[u * 5] : (lane == 1 ? f[u * 5 + 1] : (lane == 2 ? f[u * 5 + 2] : (lane == 3 ? f[u * 5 + 3] : f[u * 5 + 4]))); }
    }
    __syncthreads();
}

struct PrepPtrs { const bf16_t* P; const float* G; bf16_t* QN; bf16_t* KB; bf16_t* VB; float* LA; bf16_t* DQKV; float* GB; float* out_ck; float* out_cv; const float* cw; const float* alog; const float* dtb; };
template <bool LAT, int NT>
__device__ __forceinline__ void prep_tok(const int (&r)[NT], int l, int lane, const PrepPtrs& pp, const LAS float* w2s, f32x2 qg, f32x2 kg, float inv0, float inv1) {
    int bq[NT], tq[NT]; const bf16_t* Pr[NT];
#pragma unroll
    for (int u = 0; u < NT; ++u) { const int rr = LAT ? r[u] - 4096 : r[u]; bq[u] = LAT ? rr >> 10 : rr >> 8; tq[u] = LAT ? rr & 1023 : rr & 255; Pr[u] = pp.P + (size_t)r[u] * PLD; }
    const int L = LAT ? 1024 : 256;
    float c0[NT], s0[NT], c1[NT], s1[NT];
    const float sgn = (lane & 16) ? 1.f : -1.f;
#pragma unroll
    for (int u = 0; u < NT; ++u) { const float pos = (float)(lane < 32 ? tq[u] >> 6 : tq[u] & 63); const float a0 = pos * inv0, a1 = pos * inv1;
        c0[u] = LAT ? __cosf(a0) : 1.f; s0[u] = LAT ? __sinf(a0) : 0.f; c1[u] = LAT ? __cosf(a1) : 1.f; s1[u] = LAT ? __sinf(a1) : 0.f; }
    {
        unsigned xw[NT][10], vw[NT][2];
#pragma unroll
        for (int u = 0; u < NT; ++u) {
#pragma unroll
            for (int h = 0; h < 10; ++h) xw[u][h] = *(const unsigned*)(Pr[u] + 1536 + h * 128 + 2 * lane);
#pragma unroll
            for (int h = 0; h < 2; ++h) vw[u][h] = *(const unsigned*)(Pr[u] + 2816 + h * 128 + 2 * lane); }
        float ss[NT * 10];
#pragma unroll
        for (int u = 0; u < NT; ++u)
#pragma unroll
            for (int h = 0; h < 10; ++h) { const float x0 = bflo(xw[u][h]), x1 = bfhi(xw[u][h]); ss[u * 10 + h] = x0 * x0 + x1 * x1; }
        wave_sum_n<NT * 10>(ss);
        float y0[NT * 10], y1[NT * 10];
#pragma unroll
        for (int u = 0; u < NT; ++u)
#pragma unroll
            for (int h = 0; h < 10; ++h) { const float rstd = rsqrtf(ss[u * 10 + h] * (1.f / 128.f) + EPS); const f32x2 g = h < 8 ? qg : kg;
                y0[u * 10 + h] = bflo(xw[u][h]) * rstd * g.x; y1[u * 10 + h] = bfhi(xw[u][h]) * rstd * g.y; }
        if (!LAT) {
#pragma unroll
            for (int u = 0; u < NT; ++u)
#pragma unroll
                for (int hk = 0; hk < 2; ++hk) { const size_t o = ((((size_t)bq[u] * 2 + l) * 256 + tq[u]) * 2 + hk) * 128 + 2 * lane;
                    *(f32x2*)(pp.out_ck + o) = (f32x2){y0[u * 10 + 8 + hk], y1[u * 10 + 8 + hk]}; *(f32x2*)(pp.out_cv + o) = (f32x2){bflo(vw[u][hk]), bfhi(vw[u][hk])}; }
        } else {
            float p0[NT * 10], p1[NT * 10];
#pragma unroll
            for (int i = 0; i < NT * 10; ++i) { p0[i] = __shfl_xor(y0[i], 16); p1[i] = __shfl_xor(y1[i], 16); }
#pragma unroll
            for (int u = 0; u < NT; ++u)
#pragma unroll
                for (int h = 0; h < 10; ++h) { const int i = u * 10 + h; const float n0 = y0[i] * c0[u] + sgn * p0[i] * s0[u], n1 = y1[i] * c1[u] + sgn * p1[i] * s1[u]; y0[i] = n0; y1[i] = n1; }
        }
#pragma unroll
        for (int u = 0; u < NT; ++u) {
#pragma unroll
            for (int h = 0; h < 8; ++h) *(unsigned*)(pp.QN + (size_t)r[u] * 1024 + h * 128 + 2 * lane) = pk2(y0[u * 10 + h], y1[u * 10 + h]);
            const size_t krow = LAT ? ((size_t)4096 + (size_t)bq[u] * 1280 + 256 + tq[u]) : (size_t)r[u];
#pragma unroll
            for (int hk = 0; hk < 2; ++hk) { *(unsigned*)(pp.KB + krow * 256 + hk * 128 + 2 * lane) = pk2(y0[u * 10 + 8 + hk], y1[u * 10 + 8 + hk]); *(unsigned*)(pp.VB + krow * 256 + hk * 128 + 2 * lane) = vw[u][hk]; } }
    }
#pragma unroll
    for (int d = 0; d < 2; ++d) {
        float lr[NT][16];
#pragma unroll
        for (int u = 0; u < NT; ++u)
#pragma unroll
            for (int j = 0; j < 4; ++j) { const f32x4 t4 = *(const f32x4*)(pp.G + (size_t)r[u] * 64 + d * 16 + 4 * j); lr[u][4 * j] = t4.x; lr[u][4 * j + 1] = t4.y; lr[u][4 * j + 2] = t4.z; lr[u][4 * j + 3] = t4.w; }
#pragma unroll
        for (int jj = 0; jj < 4; ++jj) { const int n = lane + 64 * jj; float a[NT]; const float b0 = w2s[8192 + d * 256 + n];
#pragma unroll
            for (int u = 0; u < NT; ++u) a[u] = b0;
#pragma unroll
            for (int q = 0; q < 16; ++q) { const float w = w2s[(d * 16 + q) * 256 + n];
#pragma unroll
                for (int u = 0; u < NT; ++u) a[u] += lr[u][q] * w; }
#pragma unroll
            for (int u = 0; u < NT; ++u) pp.LA[(size_t)r[u] * 512 + d * 256 + n] = logsigmoid_f(a[u]) * (1.f / 16.f); }
    }
    {
        float ym[NT], yp[NT];
        const bf16_t* Pm[NT]; const bf16_t* Pp[NT];
#pragma unroll
        for (int u = 0; u < NT; ++u) { ym[u] = tq[u] > 0 ? 1.f : 0.f; yp[u] = tq[u] < L - 1 ? 1.f : 0.f; Pm[u] = tq[u] > 0 ? Pr[u] - PLD : Pr[u]; Pp[u] = tq[u] < L - 1 ? Pr[u] + PLD : Pr[u]; }
#pragma unroll
        for (int g4 = 0; g4 < 3; ++g4) {
            float y0[NT * 4], y1[NT * 4], ss[NT * 4];
#pragma unroll
            for (int bb = 0; bb < 4; ++bb) { const int c = (g4 * 4 + bb) * 128 + 2 * lane;
                const f32x2 w0 = *(const f32x2*)(pp.cw + c), w1 = *(const f32x2*)(pp.cw + 1536 + c), w2 = *(const f32x2*)(pp.cw + 3072 + c);
#pragma unroll
                for (int u = 0; u < NT; ++u) { const unsigned xm = *(const unsigned*)(Pm[u] + 3072 + c), xc = *(const unsigned*)(Pr[u] + 3072 + c), xp = *(const unsigned*)(Pp[u] + 3072 + c);
                    const float a0 = silu_f(w0.x * bflo(xm) * ym[u] + w1.x * bflo(xc) + w2.x * bflo(xp) * yp[u]), a1 = silu_f(w0.y * bfhi(xm) * ym[u] + w1.y * bfhi(xc) + w2.y * bfhi(xp) * yp[u]);
                    y0[u * 4 + bb] = a0; y1[u * 4 + bb] = a1; ss[u * 4 + bb] = a0 * a0 + a1 * a1; } }
            if (g4 < 2) { wave_sum_n<NT * 4>(ss);
#pragma unroll
                for (int i = 0; i < NT * 4; ++i) { const float sc = rsqrtf(ss[i] + EPS) * (g4 == 0 ? 0.08838834764831845f : 1.f); y0[i] *= sc; y1[i] *= sc; } }
#pragma unroll
            for (int u = 0; u < NT; ++u)
#pragma unroll
                for (int bb = 0; bb < 4; ++bb) *(unsigned*)(pp.DQKV + (size_t)r[u] * 1536 + (g4 * 4 + bb) * 128 + 2 * lane) = pk2(y0[u * 4 + bb], y1[u * 4 + bb]);
        }
    }
    if (lane < 8) {
#pragma unroll
        for (int u = 0; u < NT; ++u) { const float a = pp.G[(size_t)r[u] * 64 + 32 + lane], bb = pp.G[(size_t)r[u] * 64 + 40 + lane];
            pp.GB[(size_t)r[u] * 16 + lane] = -__expf(pp.alog[l * 8 + lane]) * softplus_f(a + pp.dtb[l * 8 + lane]); pp.GB[(size_t)r[u] * 16 + 8 + lane] = 1.f / (1.f + __expf(-bb)); } }
}
__device__ __forceinline__ void prep_phase(ptab_t pt, int l, LAS unsigned char* lds, int bid, int nb) {
    const int tid = tid_opaque(), lane = tid & 63, wave = tid >> 6;
    unsigned char* ws = PWS;
    PrepPtrs pp; pp.P = (const bf16_t*)(ws + WS_P); pp.G = (const float*)(ws + WS_G); pp.QN = (bf16_t*)(ws + WS_QN); pp.KB = (bf16_t*)(ws + WS_KB); pp.VB = (bf16_t*)(ws + WS_VB);
    pp.LA = (float*)(ws + WS_LA); pp.DQKV = (bf16_t*)(ws + WS_DQKV); pp.GB = (float*)(ws + WS_GB); pp.out_ck = POUT + OUT_CK; pp.out_cv = POUT + OUT_CV;
    pp.cw = PIN(18) + (size_t)l * 3 * 1536; pp.alog = PIN(19); pp.dtb = PIN(20);
    LAS float* w2s = (LAS float*)lds;
    for (int i = tid; i < 8192; i += 512) w2s[i] = PIN(13)[(size_t)l * 8192 + i];
    for (int i = tid; i < 512; i += 512) w2s[8192 + i] = PIN(14)[(size_t)l * 512 + i];
    __syncthreads();
    const f32x2 qg = *(const f32x2*)(PIN(16) + l * 128 + 2 * lane), kg = *(const f32x2*)(PIN(17) + l * 128 + 2 * lane);
    const float inv0 = exp2f(-(float)((2 * lane) & 31) * (13.287712379549449f / 32.f)), inv1 = exp2f(-(float)((2 * lane + 1) & 31) * (13.287712379549449f / 32.f));
    const int gw = bid * 8 + wave, NGW = nb * 8;
    for (int r = gw; r < 2048; r += NGW) { const int rc[2] = {r, r + 2048}; prep_tok<false, 2>(rc, l, lane, pp, w2s, qg, kg, inv0, inv1);
        const int rl[2] = {4096 + r, 4096 + r + 2048}; prep_tok<true, 2>(rl, l, lane, pp, w2s, qg, kg, inv0, inv1); }
    for (int i = bid * 512 + tid; i < 65536; i += nb * 512) { const int b = i >> 14, rem = i & 16383, pq = rem >> 6, c4 = rem & 63;
        const size_t srcx = (((size_t)b * 2 + l) * 256 + pq) * 256 + c4 * 4, dst = ((size_t)4096 + (size_t)b * 1280 + pq) * 256 + c4 * 4;
        const f32x4 k4 = *(const f32x4*)(PIN(2) + srcx), v4 = *(const f32x4*)(PIN(3) + srcx);
        u32x2 kw, vw; kw.x = pk2(k4.x, k4.y); kw.y = pk2(k4.z, k4.w); vw.x = pk2(v4.x, v4.y); vw.y = pk2(v4.z, v4.w);
        *(u32x2*)(pp.KB + dst) = kw; *(u32x2*)(pp.VB + dst) = vw; }
}

__device__ __forceinline__ void gla_naive_item(ptab_t pt, int l, bool lat, int b, int h, int d, LAS float* red) {
    const int tid = tid_opaque(), vq = tid & 127, kg = tid >> 7;
    unsigned char* ws = PWS;
    const bf16_t* P = (const bf16_t*)(ws + WS_P); const float* LA = (const float*)(ws + WS_LA); float* OG = (float*)(ws + WS_OG);
    const int L = lat ? 1024 : 256, rowbase = lat ? 4096 + b * 1024 : b * 256;
    float S[16];
    const size_t sidx = ((((size_t)b * 2 + l) * 2 + d) * 4 + h) * 8192 + (size_t)(kg * 16) * 128 + vq;
#pragma unroll
    for (int j = 0; j < 16; ++j) S[j] = lat ? PIN(4)[sidx + j * 128] : 0.f;
    f32x4 la[4], nla[4]; u32x4 kq[4], nkq[4]; unsigned short vv, nvv;
#define GLA_LOAD(LAv, KQv, Vv, step) do { const int t_ = d ? L - 1 - (step) : (step); const size_t r_ = (size_t)(rowbase + t_); \
        const float* lp_ = LA + r_ * 512 + d * 256 + h * 64 + kg * 16; const bf16_t* pr_ = P + r_ * PLD; \
        _Pragma("unroll") for (int j_ = 0; j_ < 4; ++j_) LAv[j_] = *(const f32x4*)(lp_ + 4 * j_); \
        KQv[0] = *(const u32x4*)(pr_ + 256 + h * 64 + kg * 16); KQv[1] = *(const u32x4*)(pr_ + 256 + h * 64 + kg * 16 + 8); \
        KQv[2] = *(const u32x4*)(pr_ + h * 64 + kg * 16); KQv[3] = *(const u32x4*)(pr_ + h * 64 + kg * 16 + 8); Vv = pr_[512 + h * 128 + vq]; } while (0)
    GLA_LOAD(la, kq, vv, 0);
    for (int step = 0; step < L; ++step) {
        const int sn = step + 1 < L ? step + 1 : step;
        GLA_LOAD(nla, nkq, nvv, sn);
        const float v = bf2f(vv); float part = 0.f;
#pragma unroll
        for (int j = 0; j < 16; ++j) { const unsigned kw = kq[j >> 3][(j >> 1) & 3], qw = kq[2 + (j >> 3)][(j >> 1) & 3];
            const float kk = (j & 1) ? bfhi(kw) : bflo(kw), qq = (j & 1) ? bfhi(qw) : bflo(qw);
            S[j] = __expf(la[j >> 2][j & 3]) * S[j] + kk * v; part += S[j] * qq; }
        red[((step & 1) * 4 + kg) * 128 + vq] = part * 0.125f;
        __syncthreads();
        if (kg == 0) { const LAS float* rp = red + (step & 1) * 512 + vq; const int t = d ? L - 1 - step : step;
            OG[((size_t)d * NTOK + rowbase + t) * 512 + h * 128 + vq] = (rp[0] + rp[128]) + (rp[256] + rp[384]); }
#pragma unroll
        for (int j = 0; j < 4; ++j) { la[j] = nla[j]; kq[j] = nkq[j]; } vv = nvv;
    }
#undef GLA_LOAD
    if (!lat) {
#pragma unroll
        for (int j = 0; j < 16; ++j) POUT[OUT_SG + sidx + j * 128] = S[j]; }
    __syncthreads();
}
__device__ __forceinline__ void dn_naive_item(ptab_t pt, int l, bool lat, int b, int h, int d, LAS float* red) {
    const int tid = tid_opaque(), vq = tid & 127, kg = tid >> 7;
    unsigned char* ws = PWS;
    const bf16_t* DQKV = (const bf16_t*)(ws + WS_DQKV); const float* GB = (const float*)(ws + WS_GB); float* OD = (float*)(ws + WS_OD);
    const int L = lat ? 1024 : 256, rowbase = lat ? 4096 + b * 1024 : b * 256;
    LAS float* redR = red; LAS float* redO = red + 1024;
    float S[32];
    const size_t sidx = ((((size_t)b * 2 + l) * 2 + d) * 4 + h) * 16384 + (size_t)(kg * 32) * 128 + vq;
#pragma unroll
    for (int j = 0; j < 32; ++j) S[j] = lat ? PIN(5)[sidx + j * 128] : 0.f;
    u32x4 kq[8], nkq[8]; unsigned short vv, nvv; float gg, ngg, be, nbe;
#define DN_LOAD(KQv, Vv, Gv, Bv, step) do { const int t_ = d ? L - 1 - (step) : (step); const size_t r_ = (size_t)(rowbase + t_); const bf16_t* pr_ = DQKV + r_ * 1536; \
        _Pragma("unroll") for (int j_ = 0; j_ < 4; ++j_) { KQv[j_] = *(const u32x4*)(pr_ + 512 + h * 128 + kg * 32 + 8 * j_); KQv[4 + j_] = *(const u32x4*)(pr_ + h * 128 + kg * 32 + 8 * j_); } \
        Vv = pr_[1024 + h * 128 + vq]; Gv = GB[r_ * 16 + d * 4 + h]; Bv = GB[r_ * 16 + 8 + d * 4 + h]; } while (0)
    DN_LOAD(kq, vv, gg, be, 0);
    for (int step = 0; step < L; ++step) {
        const int sn = step + 1 < L ? step + 1 : step;
        DN_LOAD(nkq, nvv, ngg, nbe, sn);
        float kf[32], rp = 0.f;
#pragma unroll
        for (int j = 0; j < 32; ++j) { const unsigned kw = kq[j >> 3][(j >> 1) & 3]; kf[j] = (j & 1) ? bfhi(kw) : bflo(kw); rp += kf[j] * S[j]; }
        redR[((step & 1) * 4 + kg) * 128 + vq] = rp;
        __syncthreads();
        if (step > 0 && kg == 0) { const LAS float* op = redO + ((step - 1) & 1) * 512 + vq; const int t = d ? L - step : step - 1;
            OD[((size_t)d * NTOK + rowbase + t) * 512 + h * 128 + vq] = (op[0] + op[128]) + (op[256] + op[384]); }
        const LAS float* rr = redR + (step & 1) * 512 + vq;
        const float rs = (rr[0] + rr[128]) + (rr[256] + rr[384]);
        const float eg = __expf(gg), w = be * (bf2f(vv) - eg * rs);
        float op = 0.f;
#pragma unroll
        for (int j = 0; j < 32; ++j) { const unsigned qw = kq[4 + (j >> 3)][(j >> 1) & 3]; const float qq = (j & 1) ? bfhi(qw) : bflo(qw);
            S[j] = eg * S[j] + kf[j] * w; op += qq * S[j]; }
        redO[((step & 1) * 4 + kg) * 128 + vq] = op;
#pragma unroll
        for (int j = 0; j < 8; ++j) kq[j] = nkq[j];
        vv = nvv; gg = ngg; be = nbe;
    }
#undef DN_LOAD
    __syncthreads();
    if (kg == 0) { const LAS float* op = redO + ((L - 1) & 1) * 512 + vq; const int t = d ? 0 : L - 1;
        OD[((size_t)d * NTOK + rowbase + t) * 512 + h * 128 + vq] = (op[0] + op[128]) + (op[256] + op[384]); }
    if (!lat) {
#pragma unroll
        for (int j = 0; j < 32; ++j) POUT[OUT_SD + sidx + j * 128] = S[j]; }
    __syncthreads();
}

typedef short bf16x8 __attribute__((ext_vector_type(8)));
typedef float f32x16 __attribute__((ext_vector_type(16)));
__device__ __forceinline__ int crow(int r, int hi) { return (r & 3) + 8 * (r >> 2) + 4 * hi; }
template <int K>
__device__ __forceinline__ f32x16 mm_tile(const LAS bf16_t* A, int lda, const LAS bf16_t* Bt, int ldb, int tm, int tn, int lane, f32x16 acc) {
    const int r32 = lane & 31, hi = lane >> 5;
    const LAS bf16_t* ap = A + (tm * 32 + r32) * lda + hi * 8; const LAS bf16_t* bp = Bt + (tn * 32 + r32) * ldb + hi * 8;
#pragma unroll
    for (int k0 = 0; k0 < K; k0 += 16) { const bf16x8 a = *(const LAS bf16x8*)(ap + k0), b = *(const LAS bf16x8*)(bp + k0); acc = __builtin_amdgcn_mfma_f32_32x32x16_bf16(a, b, acc, 0, 0, 0); }
    return acc;
}
template <int K>
__device__ __forceinline__ f32x16 mm_tile_ga(const bf16_t* A, int lda, const LAS bf16_t* Bt, int ldb, int tm, int tn, int lane, f32x16 acc) {
    const int r32 = lane & 31, hi = lane >> 5;
    const bf16_t* ap = A + (size_t)(tm * 32 + r32) * lda + hi * 8; const LAS bf16_t* bp = Bt + (tn * 32 + r32) * ldb + hi * 8;
    bf16x8 a[K / 16];
#pragma unroll
    for (int k = 0; k < K / 16; ++k) a[k] = *(const bf16x8*)(ap + 16 * k);
#pragma unroll
    for (int k = 0; k < K / 16; ++k) { const bf16x8 b = *(const LAS bf16x8*)(bp + 16 * k); acc = __builtin_amdgcn_mfma_f32_32x32x16_bf16(a[k], b, acc, 0, 0, 0); }
    return acc;
}
__device__ __forceinline__ void acc_store_pk(unsigned* dst, const f32x16& acc, int lane) {
#pragma unroll
    for (int r2 = 0; r2 < 8; ++r2) dst[r2 * 64 + lane] = pk2(acc[2 * r2], acc[2 * r2 + 1]);
}
__device__ __forceinline__ void acc_load_pk(const unsigned* src, unsigned (&w)[8], int lane) {
#pragma unroll
    for (int r2 = 0; r2 < 8; ++r2) w[r2] = src[r2 * 64 + lane];
}
__device__ __forceinline__ void acc_to_ST(LAS bf16_t* ST, int ld, int row0, int col0, const f32x16& s, int lane) {
    const int r32 = lane & 31, hi = lane >> 5;
#pragma unroll
    for (int g = 0; g < 4; ++g) { u32x2 w; w.x = pk2(s[4 * g], s[4 * g + 1]); w.y = pk2(s[4 * g + 2], s[4 * g + 3]);
        *(LAS u32x2*)(ST + (col0 + r32) * ld + row0 + 8 * g + 4 * hi) = w; }
}
__device__ __forceinline__ void store_o_tile_pk(unsigned* dst, const f32x16& o, long long row0, int st, int col0  , int lane) {
    const int odd = lane & 1; long long wb = row0 * 256 + ((col0 + (lane & 31)) >> 1);
    asm volatile("" : "+v"(wb));
#pragma unroll
    for (int r2 = 0; r2 < 8; ++r2) { const float send = odd ? o[2 * r2] : o[2 * r2 + 1]; const float recv = __shfl_xor(send, 1);
        const unsigned w = odd ? pk2(recv, o[2 * r2 + 1]) : pk2(o[2 * r2], recv);
        const int r = 2 * r2 + odd; dst[wb + (long long)st * 256 * ((r & 3) + 8 * (r >> 2))] = w; }
}
constexpr int N_CH_UNITS = 1024;
struct UnitPre { u32x4 r[6]; float f[2]; };
__device__ __forceinline__ void unit_geom(int unit, int& d, int& h, bool& lat, int& c, int& L, int& rowbase) {
    d = unit & 1; h = (unit >> 1) & 3; const int slot = unit >> 3; lat = slot >= 64; const int b = lat ? (slot - 64) >> 4 : slot >> 2; c = lat ? (slot - 64) & 15 : slot & 3;
    L = lat ? 1024 : 256; rowbase = lat ? 4096 + b * 1024 : b * 256;
}
__device__ __forceinline__ void gla_unit_load(ptab_t pt, int unit, UnitPre& p) {
    const int tid = tid_opaque(); unsigned char* ws = PWS; const bf16_t* P = (const bf16_t*)(ws + WS_P); const float* LA = (const float*)(ws + WS_LA);
    int d, h, c, L, rowbase; bool lat; unit_geom(unit, d, h, lat, c, L, rowbase);
#pragma unroll
    for (int q = 0; q < 2; ++q) { const int idx = tid + 512 * q, i = idx >> 4, c4 = idx & 15; const int s = c * 64 + i, t = d ? L - 1 - s : s;
        p.r[q] = *(const u32x4*)(LA + (size_t)(rowbase + t) * 512 + d * 256 + h * 64 + c4 * 4); }
    { const int i = tid >> 3, k0 = (tid & 7) * 8, v0 = (tid & 7) * 16; const int s = c * 64 + i, t = d ? L - 1 - s : s; const bf16_t* Pr = P + (size_t)(rowbase + t) * PLD;
      p.r[2] = *(const u32x4*)(Pr + h * 64 + k0); p.r[3] = *(const u32x4*)(Pr + 256 + h * 64 + k0); p.r[4] = *(const u32x4*)(Pr + 512 + h * 128 + v0); p.r[5] = *(const u32x4*)(Pr + 512 + h * 128 + v0 + 8); }
    p.f[0] = 0.f; p.f[1] = 0.f;
}
__device__ __forceinline__ void dn_unit_load(ptab_t pt, int unit, UnitPre& p) {
    const int tid = tid_opaque(); unsigned char* ws = PWS; const bf16_t* DQKV = (const bf16_t*)(ws + WS_DQKV); const float* GB = (const float*)(ws + WS_GB);
    int d, h, c, L, rowbase; bool lat; unit_geom(unit, d, h, lat, c, L, rowbase);
    { const int i = tid >> 3, c16 = (tid & 7) * 16; const int s = c * 64 + i, t = d ? L - 1 - s : s; const bf16_t* pr = DQKV + (size_t)(rowbase + t) * 1536 + h * 128 + c16;
      p.r[0] = *(const u32x4*)(pr); p.r[1] = *(const u32x4*)(pr + 8); p.r[2] = *(const u32x4*)(pr + 512); p.r[3] = *(const u32x4*)(pr + 520); p.r[4] = *(const u32x4*)(pr + 1024); p.r[5] = *(const u32x4*)(pr + 1032); }
    { const int i = tid & 63; const int s = c * 64 + i, t = d ? L - 1 - s : s; const float* gp = GB + (size_t)(rowbase + t) * 16 + d * 4 + h; p.f[0] = gp[0]; p.f[1] = gp[8]; }
}
__device__ __forceinline__ void gla_chunk_unit(ptab_t pt, int unit, LAS unsigned char* lds, const UnitPre& pre) {
    const int tid = tid_opaque(), lane = tid & 63, wave = tid >> 6;
    unsigned char* ws = PWS;
    const bf16_t* P = (const bf16_t*)(ws + WS_P); const float* LA = (const float*)(ws + WS_LA);
    bf16_t* GQ = (bf16_t*)(ws + WS_GQ) + (size_t)unit * 4096; unsigned* GO = (unsigned*)(ws + WS_GO) + (size_t)unit * 4096; unsigned* GU = (unsigned*)(ws + WS_GU) + (size_t)unit * 4096; float* GD = (float*)(ws + WS_GD) + (size_t)unit * 64;
    const int d = unit & 1, h = (unit >> 1) & 3, slot = unit >> 3;
    const bool lat = slot >= 64; const int b = lat ? (slot - 64) >> 4 : slot >> 2, c = lat ? (slot - 64) & 15 : slot & 3;
    const int L = lat ? 1024 : 256, rowbase = lat ? 4096 + b * 1024 : b * 256;
    LAS float* Bs = (LAS float*)lds;
    LAS bf16_t* Qt = (LAS bf16_t*)(lds + 16640);
    LAS bf16_t* Kt = Qt + 64 * 72;
    LAS bf16_t* KhT = Kt + 64 * 72;
    LAS bf16_t* VT = KhT + 64 * 72;
    LAS bf16_t* Am = VT + 128 * 72;
#pragma unroll
    for (int q = 0; q < 2; ++q) { const int idx = tid + 512 * q, i = idx >> 4, c4 = idx & 15; const u32x4 v = pre.r[q];
        Bs[i * 65 + c4 * 4] = __uint_as_float(v.x); Bs[i * 65 + c4 * 4 + 1] = __uint_as_float(v.y); Bs[i * 65 + c4 * 4 + 2] = __uint_as_float(v.z); Bs[i * 65 + c4 * 4 + 3] = __uint_as_float(v.w); }
    LDS_BARRIER();
    {
        const int k = tid & 63, s = tid >> 6; LAS float* tot = (LAS float*)(lds + 16640);
        float v[8]; float a = 0.f;
#pragma unroll
        for (int i = 0; i < 8; ++i) { a += Bs[(s * 8 + i) * 65 + k]; v[i] = a; }
        tot[s * 64 + k] = a;
        LDS_BARRIER();
        float off = 0.f;
#pragma unroll
        for (int q = 0; q < 7; ++q) off += (q < s) ? tot[q * 64 + k] : 0.f;
#pragma unroll
        for (int i = 0; i < 8; ++i) Bs[(s * 8 + i) * 65 + k] = v[i] + off;
    }
    LDS_BARRIER();
    { const int i = tid >> 3, k0 = (tid & 7) * 8;
      const u32x4 qw = pre.r[2], kw = pre.r[3];
#pragma unroll
      for (int e = 0; e < 8; ++e) { const float bb = Bs[i * 65 + k0 + e], bl = Bs[63 * 65 + k0 + e];
          const float qv = (e & 1) ? bfhi(qw[e >> 1]) : bflo(qw[e >> 1]), kv = (e & 1) ? bfhi(kw[e >> 1]) : bflo(kw[e >> 1]);
          Qt[i * 72 + k0 + e] = f2bf(qv * 0.125f * __expf(bb)); Kt[i * 72 + k0 + e] = f2bf(kv * __expf(-bb)); KhT[(k0 + e) * 72 + i] = f2bf(kv * __expf(bl - bb)); }
      const int v0 = (tid & 7) * 16;
      const u32x4 va = pre.r[4], vb = pre.r[5];
#pragma unroll
      for (int e = 0; e < 8; ++e) { VT[(v0 + e) * 72 + i] = (bf16_t)((e & 1) ? (va[e >> 1] >> 16) : (va[e >> 1] & 0xffffu)); VT[(v0 + 8 + e) * 72 + i] = (bf16_t)((e & 1) ? (vb[e >> 1] >> 16) : (vb[e >> 1] & 0xffffu)); }
      if (tid < 64) GD[tid] = __expf(Bs[63 * 65 + tid]); }
    LDS_BARRIER();
    { f32x16 acc = {}; acc = mm_tile<64>(KhT, 72, VT, 72, wave >> 2, wave & 3, lane, acc); acc_store_pk(GU + wave * 512, acc, lane); }
    if (wave < 4) { f32x16 acc = {}; const int tm = wave >> 1, tn = wave & 1; acc = mm_tile<64>(Qt, 72, Kt, 72, tm, tn, lane, acc);
        const int r32 = lane & 31, hi = lane >> 5;
#pragma unroll
        for (int r = 0; r < 16; ++r) { const int i = tm * 32 + crow(r, hi), j = tn * 32 + r32; Am[i * 72 + j] = f2bf(j <= i ? acc[r] : 0.f); } }
    { const int i = tid >> 3, k0 = (tid & 7) * 8; *(u32x4*)(GQ + i * 64 + k0) = *(const LAS u32x4*)(Qt + i * 72 + k0); }
    LDS_BARRIER();
    { f32x16 acc = {}; acc = mm_tile<64>(Am, 72, VT, 72, wave >> 2, wave & 3, lane, acc); acc_store_pk(GO + wave * 512, acc, lane); }
    LDS_BARRIER();
}
__device__ __forceinline__ void gla_scan_item(ptab_t pt, int l, bool lat, int b, int h, int d, LAS unsigned char* lds) {
    const int tid = tid_opaque(), lane = tid & 63, wave = tid >> 6, r32 = lane & 31, hi = lane >> 5;
    unsigned char* ws = PWS;
    float* OG = (float*)(ws + WS_OG);
    const int L = lat ? 1024 : 256, rowbase = lat ? 4096 + b * 1024 : b * 256, nch = L >> 6, slot0 = lat ? 64 + b * 16 : b * 4;
    const int tm = wave >> 2, tn = wave & 3;
    LAS bf16_t* ST = (LAS bf16_t*)lds;
    f32x16 S;
    const size_t sbase = ((((size_t)b * 2 + l) * 2 + d) * 4 + h) * 8192;
#pragma unroll
    for (int r = 0; r < 16; ++r) S[r] = lat ? PIN(4)[sbase + (size_t)(tm * 32 + crow(r, hi)) * 128 + tn * 32 + r32] : 0.f;
    unsigned ow[8], uw[8], now[8], nuw[8]; float dec[16], ndec[16]; bf16x8 qa[4], nqa[4];
#define GLA_SLOAD(OW, UW, DEC, QA, cc) do { const int unit_ = ((slot0 + (cc)) * 4 + h) * 2 + d; \
        acc_load_pk((const unsigned*)(ws + WS_GO) + (size_t)unit_ * 4096 + wave * 512, OW, lane); acc_load_pk((const unsigned*)(ws + WS_GU) + (size_t)unit_ * 4096 + wave * 512, UW, lane); \
        const float* gd_ = (const float*)(ws + WS_GD) + (size_t)unit_ * 64; _Pragma("unroll") for (int r_ = 0; r_ < 16; ++r_) DEC[r_] = gd_[tm * 32 + crow(r_, hi)]; \
        const bf16_t* gq_ = (const bf16_t*)(ws + WS_GQ) + (size_t)unit_ * 4096 + (size_t)(tm * 32 + r32) * 64 + hi * 8; _Pragma("unroll") for (int k_ = 0; k_ < 4; ++k_) QA[k_] = *(const bf16x8*)(gq_ + 16 * k_); } while (0)
    GLA_SLOAD(ow, uw, dec, qa, 0);
    GLA_SLOAD(now, nuw, ndec, nqa, 1);
#define GLA_STEP(c, OW, UW, DEC, QA) do { \
        acc_to_ST(ST, 72, tm * 32, tn * 32, S, lane); \
        LDS_BARRIER(); \
        f32x16 o; \
        _Pragma("unroll") for (int r2 = 0; r2 < 8; ++r2) { o[2 * r2] = bflo(OW[r2]); o[2 * r2 + 1] = bfhi(OW[r2]); } \
        { const LAS bf16_t* bp = ST + (tn * 32 + r32) * 72 + hi * 8; \
          _Pragma("unroll") for (int k = 0; k < 4; ++k) { const bf16x8 bb = *(const LAS bf16x8*)(bp + 16 * k); o = __builtin_amdgcn_mfma_f32_32x32x16_bf16(QA[k], bb, o, 0, 0, 0); } } \
        { const int s0_ = (c) * 64 + tm * 32 + 4 * hi; store_o_tile_pk((unsigned*)OG, o, (long long)((size_t)d * NTOK + rowbase + (d ? L - 1 - s0_ : s0_)), d ? -1 : 1, h * 128 + tn * 32, lane); } \
        _Pragma("unroll") for (int r2 = 0; r2 < 8; ++r2) { S[2 * r2] = DEC[2 * r2] * S[2 * r2] + bflo(UW[r2]); S[2 * r2 + 1] = DEC[2 * r2 + 1] * S[2 * r2 + 1] + bfhi(UW[r2]); } \
        { const int cn_ = (c) + 2 < nch ? (c) + 2 : nch - 1; GLA_SLOAD(OW, UW, DEC, QA, cn_); } \
        LDS_BARRIER(); } while (0)
    for (int c = 0; c < nch; c += 2) {
        GLA_STEP(c, ow, uw, dec, qa);
        GLA_STEP(c + 1, now, nuw, ndec, nqa);
    }
#undef GLA_STEP
#undef GLA_SLOAD
    if (!lat) {
#pragma unroll
        for (int r = 0; r < 16; ++r) POUT[OUT_SG + sbase + (size_t)(tm * 32 + crow(r, hi)) * 128 + tn * 32 + r32] = S[r]; }
}
template <int BLK>
__device__ __forceinline__ void solve_diag(float (&x)[64], const LAS float* Af) {
    f32x4 an[4];
    an[0] = *(const LAS f32x4*)(Af + (16 * BLK + 1) * 68 + 16 * BLK);
#pragma unroll
    for (int ii = 1; ii < 16; ++ii) { const int i = 16 * BLK + ii; f32x4 ac[4];
#pragma unroll
        for (int j4 = 0; j4 < (ii + 3) / 4; ++j4) ac[j4] = an[j4];
        if (ii + 1 < 16) {
#pragma unroll
            for (int j4 = 0; j4 < (ii + 4) / 4; ++j4) an[j4] = *(const LAS f32x4*)(Af + (i + 1) * 68 + 16 * BLK + 4 * j4); }
        float s0 = 0.f, s1 = 0.f, s2 = 0.f, s3 = 0.f;
#pragma unroll
        for (int j4 = 0; j4 < (ii + 3) / 4; ++j4) { s0 += ac[j4].x * x[16 * BLK + 4 * j4]; s1 += ac[j4].y * x[16 * BLK + 4 * j4 + 1]; s2 += ac[j4].z * x[16 * BLK + 4 * j4 + 2]; s3 += ac[j4].w * x[16 * BLK + 4 * j4 + 3]; }
        x[i] -= (s0 + s1) + (s2 + s3); asm("" : "+v"(x[i])); }
}
template <int BLK>
__device__ __forceinline__ void solve_offdiag(const LAS bf16_t* Ab, const LAS bf16_t* UT, const LAS bf16_t* WT, LAS float* Rb, int wave, int lane) {
    f32x16 acc = {};
    acc = mm_tile<16 * BLK>(Ab, 72, wave < 4 ? UT : WT, 72, BLK >> 1, wave & 3, lane, acc);
    const int r32 = lane & 31, hi = lane >> 5;
#pragma unroll
    for (int r = 0; r < 16; ++r) { const int rr = crow(r, hi) - (BLK & 1) * 16; if (rr >= 0 && rr < 16) Rb[rr * 260 + wave * 32 + r32] = acc[r]; }
}
template <int BLK>
__device__ __forceinline__ void solve_step(float (&x)[64], const LAS float* Af, const LAS bf16_t* Ab, LAS bf16_t* UT, LAS bf16_t* WT, LAS float* Rb, int tid, int wave, int lane) {
    if (BLK > 0) { solve_offdiag<(BLK > 0 ? BLK : 1)>(Ab, UT, WT, Rb, wave, lane); LDS_BARRIER(); }
    if (tid < 256) {
        if (BLK > 0) {
#pragma unroll
            for (int ii = 0; ii < 16; ++ii) { x[16 * BLK + ii] -= Rb[ii * 260 + tid]; asm("" : "+v"(x[16 * BLK + ii])); } }
        solve_diag<BLK>(x, Af);
        LAS bf16_t* dst = (tid < 128 ? UT + tid * 72 : WT + (tid - 128) * 72) + 16 * BLK;
        u32x4 w0, w1; w0.x = pk2(x[16 * BLK], x[16 * BLK + 1]); w0.y = pk2(x[16 * BLK + 2], x[16 * BLK + 3]); w0.z = pk2(x[16 * BLK + 4], x[16 * BLK + 5]); w0.w = pk2(x[16 * BLK + 6], x[16 * BLK + 7]);
        w1.x = pk2(x[16 * BLK + 8], x[16 * BLK + 9]); w1.y = pk2(x[16 * BLK + 10], x[16 * BLK + 11]); w1.z = pk2(x[16 * BLK + 12], x[16 * BLK + 13]); w1.w = pk2(x[16 * BLK + 14], x[16 * BLK + 15]);
        *(LAS u32x4*)(dst) = w0; *(LAS u32x4*)(dst + 8) = w1; }
    if (BLK < 3) LDS_BARRIER();
}
#define SUBA_BEGIN() unsigned long long tsa_ = 0; if (PROBE_SUB >= 10 && PROBE_SUB <= 14 && blockIdx.x == 0) { LDS_BARRIER(); tsa_ = __builtin_amdgcn_s_memrealtime(); }
#define SUBA_END(k) do { if (PROBE_SUB == (k) && blockIdx.x == 0) { LDS_BARRIER(); if (threadIdx.x == 0) *(volatile LAS unsigned long long*)(lds + PTAB_OFF + 320) += __builtin_amdgcn_s_memrealtime() - tsa_; } } while (0)
#define SUBA_MARK() do { if (PROBE_SUB >= 10 && PROBE_SUB <= 14 && blockIdx.x == 0) { LDS_BARRIER(); tsa_ = __builtin_amdgcn_s_memrealtime(); } } while (0)
__device__ __forceinline__ void dn_chunk_unit(ptab_t pt, int unit, LAS unsigned char* lds, const UnitPre& pre) {
    SUBA_BEGIN(); unsigned long long tsa0_ = tsa_;
    const int tid = tid_opaque(), lane = tid & 63, wave = tid >> 6, r32 = lane & 31, hi = lane >> 5;
    unsigned char* ws = PWS;
    const bf16_t* DQKV = (const bf16_t*)(ws + WS_DQKV); const float* GB = (const float*)(ws + WS_GB);
    bf16_t* MC = (bf16_t*)(ws + WS_MC) + (size_t)unit * 16384; unsigned* NC = (unsigned*)(ws + WS_NC) + (size_t)unit * 8192;
    bf16_t* QE = (bf16_t*)(ws + WS_QE) + (size_t)unit * 8192; unsigned* OL = (unsigned*)(ws + WS_OL) + (size_t)unit * 4096;
    const int d = unit & 1, h = (unit >> 1) & 3, slot = unit >> 3;
    const bool lat = slot >= 64; const int b = lat ? (slot - 64) >> 4 : slot >> 2, c = lat ? (slot - 64) & 15 : slot & 3;
    const int L = lat ? 1024 : 256, rowbase = lat ? 4096 + b * 1024 : b * 256;
    LAS bf16_t* Qs = (LAS bf16_t*)lds;
    LAS bf16_t* Ks = Qs + 64 * 136;
    LAS bf16_t* Vs = Ks + 64 * 136;
    LAS float* Af = (LAS float*)(lds + 52224);
    LAS bf16_t* Att = (LAS bf16_t*)(lds + 69632);
    LAS bf16_t* KhT = (LAS bf16_t*)(lds + 78848);
    LAS bf16_t* WT = (LAS bf16_t*)(lds + 97280);
    LAS bf16_t* UT = (LAS bf16_t*)(lds + 115712);
    LAS float* Gs = (LAS float*)(lds + 134144);
    LAS float* Bt = Gs + 64;
    LAS bf16_t* Ab = (LAS bf16_t*)(lds + 134656);
    LAS float* Rb = (LAS float*)(lds + 34816);
    { const int i = tid >> 3, c16 = (tid & 7) * 16;
      const u32x4 q0 = pre.r[0], q1 = pre.r[1], k0 = pre.r[2], k1 = pre.r[3], v0 = pre.r[4], v1 = pre.r[5];
      *(LAS u32x4*)(Qs + i * 136 + c16) = q0; *(LAS u32x4*)(Qs + i * 136 + c16 + 8) = q1; *(LAS u32x4*)(Ks + i * 136 + c16) = k0; *(LAS u32x4*)(Ks + i * 136 + c16 + 8) = k1;
      *(LAS u32x4*)(Vs + i * 136 + c16) = v0; *(LAS u32x4*)(Vs + i * 136 + c16 + 8) = v1; }
    if (tid < 64) { float x = pre.f[0]; const float be = pre.f[1];
#pragma unroll
        for (int o = 1; o < 64; o <<= 1) { const float n = __shfl_up(x, o); if (lane >= o) x += n; }
        Gs[tid] = x; Bt[tid] = be; }
    LDS_BARRIER();
    { const int w4 = wave & 3, tm = w4 >> 1, tn = w4 & 1; f32x16 acc = {};
      acc = mm_tile<128>(wave < 4 ? Ks : Qs, 136, Ks, 136, tm, tn, lane, acc);
      const int j = tn * 32 + r32; const float Gj = Gs[j];
#pragma unroll
      for (int r = 0; r < 16; ++r) { const int i = tm * 32 + crow(r, hi); const float e = __expf(Gs[i] - Gj);
          if (wave < 4) { const float av = (j < i) ? Bt[i] * acc[r] * e : 0.f; Af[i * 68 + j] = av; Ab[i * 72 + j] = f2bf(av); } else Att[i * 72 + j] = f2bf((j <= i) ? acc[r] * e : 0.f); } }
    LDS_BARRIER();
    SUBA_END(11); SUBA_MARK();
    {
        float x[64];
        if (tid < 128) {
#pragma unroll
            for (int j = 0; j < 64; ++j) x[j] = bf2f(Vs[j * 136 + tid]) * Bt[j];
        } else if (tid < 256) {
#pragma unroll
            for (int j = 0; j < 64; ++j) x[j] = bf2f(Ks[j * 136 + tid - 128]) * Bt[j] * __expf(Gs[j]);
        } else {
#pragma unroll
            for (int j = 0; j < 64; ++j) x[j] = 0.f;
            const int t2 = tid - 256, i = t2 >> 2, a0 = (t2 & 3) * 32; const float f = __expf(Gs[63] - Gs[i]);
#pragma unroll 8
            for (int e = 0; e < 32; ++e) KhT[(a0 + e) * 72 + i] = f2bf(bf2f(Ks[i * 136 + a0 + e]) * f);
        }
#pragma unroll
        for (int j = 0; j < 64; ++j) asm("" : "+v"(x[j]));
        LDS_BARRIER();
        solve_step<0>(x, Af, Ab, UT, WT, Rb, tid, wave, lane);
        solve_step<1>(x, Af, Ab, UT, WT, Rb, tid, wave, lane);
        solve_step<2>(x, Af, Ab, UT, WT, Rb, tid, wave, lane);
        solve_step<3>(x, Af, Ab, UT, WT, Rb, tid, wave, lane);
    }
    LDS_BARRIER();
    SUBA_END(12); SUBA_MARK();
    { const int tn = wave & 3, tmo = wave >> 2; const float eGl = __expf(Gs[63]);
      { f32x16 acc = {}; acc = mm_tile<64>(Att, 72, UT, 72, tmo, tn, lane, acc); acc_store_pk(OL + wave * 512, acc, lane); }
      { f32x16 acc = {}; acc = mm_tile<64>(Att, 72, WT, 72, tmo, tn, lane, acc);
#pragma unroll
        for (int r = 0; r < 16; ++r) { const int i = tmo * 32 + crow(r, hi), a = tn * 32 + r32; QE[i * 128 + a] = f2bf(bf2f(Qs[i * 136 + a]) * __expf(Gs[i]) - acc[r]); } }
#pragma unroll
      for (int q = 0; q < 2; ++q) { const int tm = tmo + 2 * q;
        { f32x16 acc = {}; acc = mm_tile<64>(KhT, 72, UT, 72, tm, tn, lane, acc); acc_store_pk(NC + (tm * 4 + tn) * 512, acc, lane); }
        { f32x16 acc = {}; acc = mm_tile<64>(KhT, 72, WT, 72, tm, tn, lane, acc);
#pragma unroll
          for (int r = 0; r < 16; ++r) { const int a = tm * 32 + crow(r, hi), a2 = tn * 32 + r32; MC[a * 128 + a2] = f2bf((a == a2 ? eGl : 0.f) - acc[r]); } } } }
    LDS_BARRIER();
    SUBA_END(13); tsa_ = tsa0_; SUBA_END(10);
    if (PROBE_SUB == 14 && blockIdx.x == 0 && threadIdx.x == 0) *(volatile LAS unsigned long long*)(lds + PTAB_OFF + 320) += 1000;
}
__device__ __forceinline__ void dn_scan_item(ptab_t pt, int l, bool lat, int b, int h, int d, int vh, LAS unsigned char* lds) {
    const int tid = tid_opaque(), lane = tid & 63, wave = tid >> 6, r32 = lane & 31, hi = lane >> 5;
    unsigned char* ws = PWS;
    float* OD = (float*)(ws + WS_OD);
    const int L = lat ? 1024 : 256, rowbase = lat ? 4096 + b * 1024 : b * 256, nch = L >> 6, slot0 = lat ? 64 + b * 16 : b * 4;
    const int tm = wave & 3, tnl = wave >> 2, tn = vh * 2 + tnl;
    const bool ow_ = wave < 4; const int tmo = wave & 1, tnlo = (wave >> 1) & 1, tno = vh * 2 + tnlo;
    LAS bf16_t* ST = (LAS bf16_t*)lds;
    LAS bf16_t* AMb = (LAS bf16_t*)(lds + 34816);
    f32x16 S;
    const size_t sbase = ((((size_t)b * 2 + l) * 2 + d) * 4 + h) * 16384;
#pragma unroll
    for (int r = 0; r < 16; ++r) S[r] = lat ? PIN(5)[sbase + (size_t)(tm * 32 + crow(r, hi)) * 128 + tn * 32 + r32] : 0.f;
    u32x4 stg[6], stg2[6]; unsigned ow[8], n0[8], now[8], nn0[8];
#define DN_GLOAD(STG, cc) do { const int unit_ = ((slot0 + (cc)) * 4 + h) * 2 + d; const bf16_t* mc_ = (const bf16_t*)(ws + WS_MC) + (size_t)unit_ * 16384; const bf16_t* qe_ = (const bf16_t*)(ws + WS_QE) + (size_t)unit_ * 8192; \
        _Pragma("unroll") for (int j_ = 0; j_ < 4; ++j_) STG[j_] = *(const u32x4*)(mc_ + (size_t)(tid + 512 * j_) * 8); \
        _Pragma("unroll") for (int j_ = 0; j_ < 2; ++j_) STG[4 + j_] = *(const u32x4*)(qe_ + (size_t)(tid + 512 * j_) * 8); } while (0)
#define DN_TLOAD(OW, N0, cc) do { const int unit_ = ((slot0 + (cc)) * 4 + h) * 2 + d; \
        acc_load_pk((const unsigned*)(ws + WS_OL) + (size_t)unit_ * 4096 + (tmo * 4 + tno) * 512, OW, lane); acc_load_pk((const unsigned*)(ws + WS_NC) + (size_t)unit_ * 8192 + (tm * 4 + tn) * 512, N0, lane); } while (0)
#define DN_SWRITE(buf) do { LAS bf16_t* am_ = AMb + (buf) * 26112; LAS bf16_t* aq_ = am_ + 128 * 136; \
        _Pragma("unroll") for (int j_ = 0; j_ < 4; ++j_) { const int q_ = tid + 512 * j_; *(LAS u32x4*)(am_ + (q_ >> 4) * 136 + (q_ & 15) * 8) = stg[j_]; } \
        _Pragma("unroll") for (int j_ = 0; j_ < 2; ++j_) { const int q_ = tid + 512 * j_; *(LAS u32x4*)(aq_ + (q_ >> 4) * 136 + (q_ & 15) * 8) = stg[4 + j_]; } } while (0)
    DN_GLOAD(stg, 0); DN_SWRITE(0);
    DN_TLOAD(ow, n0, 0); DN_TLOAD(now, nn0, 1);
    DN_GLOAD(stg2, 1); DN_GLOAD(stg, (nch > 2 ? 2 : 1));
#define DN_STEP(c, OW, N0, STGN, STGNAME_IS_STG2) do { \
        acc_to_ST(ST, 136, tm * 32, tnl * 32, S, lane); \
        LDS_BARRIER(); \
        const LAS bf16_t* am = AMb + ((c) & 1) * 26112; const LAS bf16_t* aq = am + 128 * 136; \
        _Pragma("unroll") for (int r2 = 0; r2 < 8; ++r2) { S[2 * r2] = bflo(N0[r2]); S[2 * r2 + 1] = bfhi(N0[r2]); } \
        f32x16 o; \
        if (ow_) { _Pragma("unroll") for (int r2 = 0; r2 < 8; ++r2) { o[2 * r2] = bflo(OW[r2]); o[2 * r2 + 1] = bfhi(OW[r2]); } } \
        { const int cn_ = (c) + 2 < nch ? (c) + 2 : nch - 1; DN_TLOAD(OW, N0, cn_); }     \
        if (ow_) { o = mm_tile<128>(aq, 136, ST, 136, tmo, tnlo, lane, o); \
            const int s0_ = (c) * 64 + tmo * 32 + 4 * hi; store_o_tile_pk((unsigned*)OD, o, (long long)((size_t)d * NTOK + rowbase + (d ? L - 1 - s0_ : s0_)), d ? -1 : 1, h * 128 + tno * 32, lane); } \
        S = mm_tile<128>(am, 136, ST, 136, tm, tnl, lane, S); \
        { LAS bf16_t* am_ = AMb + (((c) + 1) & 1) * 26112; LAS bf16_t* aq_ = am_ + 128 * 136;     \
          _Pragma("unroll") for (int j_ = 0; j_ < 4; ++j_) { const int q_ = tid + 512 * j_; *(LAS u32x4*)(am_ + (q_ >> 4) * 136 + (q_ & 15) * 8) = STGN[j_]; } \
          _Pragma("unroll") for (int j_ = 0; j_ < 2; ++j_) { const int q_ = tid + 512 * j_; *(LAS u32x4*)(aq_ + (q_ >> 4) * 136 + (q_ & 15) * 8) = STGN[4 + j_]; } } \
        { const int cn_ = (c) + 3 < nch ? (c) + 3 : nch - 1; DN_GLOAD(STGN, cn_); }     \
        LDS_BARRIER(); } while (0)
    for (int c = 0; c < nch; c += 2) {
        DN_STEP(c, ow, n0, stg2, 1);
        DN_STEP(c + 1, now, nn0, stg, 0);
    }
#undef DN_STEP
#undef DN_GLOAD
#undef DN_TLOAD
#undef DN_SWRITE
    if (!lat) {
#pragma unroll
        for (int r = 0; r < 16; ++r) POUT[OUT_SD + sbase + (size_t)(tm * 32 + crow(r, hi)) * 128 + tn * 32 + r32] = S[r]; }
}
__device__ __forceinline__ void mixer1_phase(ptab_t pt, int l, unsigned char* lds_generic, int bid, int nb, int rep) {
    LAS unsigned char* l3 = (LAS unsigned char*)lds_generic;
    LAS int* qslot = (LAS int*)(l3 + PTAB_OFF + 272);
    unsigned* qctr = (unsigned*)(PWS + WS_QUEUE) + (l * 4 + rep) * 64;
    constexpr int N_ITEMS = 2048;
    int it = bid, itn = bid + nb;
    UnitPre pc, pn;
    if (it < N_ITEMS) { if (it < 1024) dn_unit_load(pt, it, pc); else gla_unit_load(pt, it - 1024, pc); }
    while (it < N_ITEMS) {
        int nxt2 = 0;
        if (threadIdx.x == 0) nxt2 = 2 * nb + (int)atomicAdd(qctr, 1u);
        if (itn < N_ITEMS) { if (itn < 1024) dn_unit_load(pt, itn, pn); else gla_unit_load(pt, itn - 1024, pn); }
        if (it < 1024) { for (int q_ = 0; q_ < (PROBE_DUP == 8 ? 2 : 1); ++q_) dn_chunk_unit(pt, it, l3, pc); }
        else { for (int q_ = 0; q_ < (PROBE_DUP == 9 ? 2 : 1); ++q_) gla_chunk_unit(pt, it - 1024, l3, pc); }
        LDS_BARRIER();
        if (threadIdx.x == 0) *qslot = nxt2;
        LDS_BARRIER();
        it = itn; itn = *qslot;
#pragma unroll
        for (int q = 0; q < 6; ++q) pc.r[q] = pn.r[q];
        pc.f[0] = pn.f[0]; pc.f[1] = pn.f[1];
    }
}
__device__ __forceinline__ void mixer2_phase(ptab_t pt, int l, unsigned char* lds_generic, int bid, int nb, int rep) {
    LAS unsigned char* l3 = (LAS unsigned char*)lds_generic;
    LAS int* qslot = (LAS int*)(l3 + PTAB_OFF + 272);
    unsigned* qctr = (unsigned*)(PWS + WS_QUEUE) + (l * 4 + 2 + rep) * 64;
    const int n_tr = (l == 0 && rep == 0) ? (TI_OUT + TI_F1) / 8 : 0;
    const int N_ITEMS = 736 + n_tr;
    int it = bid;
    while (it < N_ITEMS) {
        int nxt = 0;
        if (threadIdx.x == 0) nxt = nb + (int)atomicAdd(qctr, 1u);
        if (it < 128 || (it >= 224 && it < 352)) {
            unsigned char* ws = PWS;
            const bf16_t* QN = (const bf16_t*)(ws + WS_QN); const bf16_t* KB = (const bf16_t*)(ws + WS_KB); const bf16_t* VB = (const bf16_t*)(ws + WS_VB); bf16_t* MIX = (bf16_t*)(ws + WS_MIX);
            const bool lat = it < 128; const int i = lat ? it : it - 224;
            const int b = lat ? i >> 5 : i >> 3, h = lat ? (i >> 2) & 7 : i & 7, qb = lat ? i & 3 : 0;
            const size_t row0 = lat ? 4096 + (size_t)b * 1024 + qb * 256 : (size_t)b * 256;
            const size_t krow0 = lat ? (size_t)4096 + (size_t)b * 1280 : (size_t)b * 256;
            att::attn_dense_body<1024, 256, 2048>(QN + row0 * 1024 + h * 128, KB + krow0 * 256 + (h >> 2) * 128, VB + krow0 * 256 + (h >> 2) * 128, MIX + row0 * 2048 + 512 + h * 128, lat ? 1280 : 256, (char*)lds_generic);
        } else if (it < 192 || (it >= 352 && it < 608)) { const bool lat = it < 192; const int j = lat ? it - 128 : it - 352; const int vh = j & 1, q = j >> 1;
            dn_scan_item(pt, l, lat, q >> 3, (q >> 1) & 3, q & 1, vh, l3);
        } else if (it < 736) { const bool lat = it < 224; const int q = lat ? it - 192 : it - 608;
            gla_scan_item(pt, l, lat, q >> 3, (q >> 1) & 3, q & 1, l3);
        } else { const int wv = __builtin_amdgcn_readfirstlane((int)threadIdx.x >> 6);
            do_transposes(pt, l3, TI_L + TI_IN + (it - 736) * 8, 8, wv, 8);
        }
        LDS_BARRIER();
        if (threadIdx.x == 0) *qslot = nxt;
        LDS_BARRIER();
        it = *qslot;
    }
}

__device__ __forceinline__ void postmix_phase(ptab_t pt, int l, int bid, int nb) {
    const int tid = tid_opaque(), lane = tid & 63, wave = tid >> 6;
    unsigned char* ws = PWS;
    const bf16_t* P = (const bf16_t*)(ws + WS_P); const float* OG = (const float*)(ws + WS_OG); const float* OD = (const float*)(ws + WS_OD); bf16_t* MIX = (bf16_t*)(ws + WS_MIX);
    const f32x2 gg = *(const f32x2*)(PIN(15) + l * 128 + 2 * lane), dg = *(const f32x2*)(PIN(21) + l * 128 + 2 * lane);
    constexpr int NT = 4;
    for (int r0 = bid * 8 + wave; r0 < NTOK / NT; r0 += nb * 8) {
        float a0[NT * 8], a1[NT * 8], ss[NT * 8]; unsigned zw[NT * 8];
#pragma unroll
        for (int u = 0; u < NT; ++u) { const size_t r = (size_t)(r0 + u * (NTOK / NT));
#pragma unroll
            for (int blk = 0; blk < 8; ++blk) { const bool dn = blk >= 4; const int hb = blk & 3;
                const unsigned* o0 = (const unsigned*)(dn ? OD : OG) + r * 256 + hb * 64 + lane; const unsigned p = o0[0], q = o0[(size_t)NTOK * 256];
                zw[u * 8 + blk] = *(const unsigned*)(P + r * PLD + (dn ? 4608 : 1024) + hb * 128 + 2 * lane);
                a0[u * 8 + blk] = bflo(p) + bflo(q); a1[u * 8 + blk] = bfhi(p) + bfhi(q); ss[u * 8 + blk] = a0[u * 8 + blk] * a0[u * 8 + blk] + a1[u * 8 + blk] * a1[u * 8 + blk]; } }
        wave_sum_n<NT * 8>(ss);
#pragma unroll
        for (int u = 0; u < NT; ++u) { const size_t r = (size_t)(r0 + u * (NTOK / NT));
#pragma unroll
            for (int blk = 0; blk < 8; ++blk) { const bool dn = blk >= 4; const int hb = blk & 3; const int i = u * 8 + blk;
                const float rstd = rsqrtf(ss[i] * (1.f / 128.f) + EPS); const f32x2 g = dn ? dg : gg;
                *(unsigned*)(MIX + r * 2048 + (dn ? 1536 : 0) + hb * 128 + 2 * lane) = pk2(a0[i] * rstd * g.x * silu_f(bflo(zw[i])), a1[i] * rstd * g.y * silu_f(bfhi(zw[i]))); } }
    }
}

#define RLX_AGENT __ATOMIC_RELAXED, __HIP_MEMORY_SCOPE_AGENT
#define XB_TMO      128
#define XB_XCNT(j)  (256  + 64 * (j))
#define XB_XSUB(j)  (1280 + 64 * (j))
#define XB_XGEN(j)  (2304 + 64 * (j))
#define XB_TOP      3328
#define XB_TOPGEN   3392
#define XCD_BAR_WORDS 3456
#define XB_SPIN_CAP (1u << 18)

__device__ __forceinline__ unsigned xb_ld(unsigned* p)              { return __hip_atomic_load(p, __ATOMIC_RELAXED, __HIP_MEMORY_SCOPE_AGENT); }
__device__ __forceinline__ unsigned xb_add(unsigned* p, unsigned v) { return __hip_atomic_fetch_add(p, v, __ATOMIC_RELAXED, __HIP_MEMORY_SCOPE_AGENT); }
__device__ __forceinline__ unsigned xb_xcc_id() { return (unsigned)__builtin_amdgcn_s_getreg((3 << 11) | 20) & 0xFu; }
#define XB_SPIN(cond, bar) do { unsigned _sp = 0; while (cond) { __builtin_amdgcn_s_sleep(1); \
    if ((++_sp & 255u) == 0u) { if (xb_ld(&(bar)[XB_TMO])) break; if (_sp > XB_SPIN_CAP) { atomicAdd(&(bar)[XB_TMO], 1u); break; } } } } while (0)

struct XcdBarrier {
    unsigned* bar; unsigned x;
    volatile LAS unsigned* st;
};

__device__ __forceinline__ XcdBarrier xcd_barrier_post(unsigned* bar, volatile LAS unsigned* st) {
    XcdBarrier b; b.bar = bar; b.x = xb_xcc_id(); b.st = st;
    if (threadIdx.x == 0) (void)xb_add(&bar[XB_XCNT(b.x)], 1u);
    return b;
}
__device__ __forceinline__ void xcd_barrier_complete(unsigned* bar, unsigned x, unsigned& nloc, unsigned& nx) {
    const unsigned G = gridDim.x * gridDim.y * gridDim.z;
    unsigned sum, cnt, mine, sp = 0u;
    for (;;) {
        sum = 0u; cnt = 0u; mine = 0u;
#pragma unroll
        for (unsigned j = 0; j < 16; ++j) { const unsigned c = xb_ld(&bar[XB_XCNT(j)]); sum += c; cnt += (c > 0u) ? 1u : 0u; mine = (j == x) ? c : mine; }
        if (sum == G) break;
        __builtin_amdgcn_s_sleep(1);
        if ((++sp & 255u) == 0u) { if (xb_ld(&bar[XB_TMO])) break; if (sp > XB_SPIN_CAP) { atomicAdd(&bar[XB_TMO], 1u); break; } }
    }
    nloc = mine > 0u ? mine : 1u; nx = cnt > 0u ? cnt : 1u;
}

__device__ __forceinline__ void xcd_barrier(const XcdBarrier& b) {
    asm volatile("s_waitcnt vmcnt(0)" ::: "memory");
    __syncthreads();
    if (threadIdx.x == 0) {
        unsigned* bar = b.bar;
        __builtin_amdgcn_s_waitcnt(0);
        unsigned nloc = b.st[0], nx = b.st[1];
        if (nloc == 0u) { xcd_barrier_complete(bar, b.x, nloc, nx); b.st[0] = nloc; b.st[1] = nx; }
        const unsigned old = xb_add(&bar[XB_XSUB(b.x)], 1u);
        const unsigned gen = old / nloc;
        if (old + 1u == (gen + 1u) * nloc) {
            __builtin_amdgcn_fence(__ATOMIC_RELEASE, "agent");
            asm volatile("s_waitcnt vmcnt(0)" ::: "memory");
            const unsigned og = xb_add(&bar[XB_TOP], 1u);
            const unsigned tg = og / nx;
            if (og + 1u == (tg + 1u) * nx) xb_add(&bar[XB_TOPGEN], 1u);
            else XB_SPIN(xb_ld(&bar[XB_TOPGEN]) == tg, bar);
            __builtin_amdgcn_fence(__ATOMIC_ACQUIRE, "agent");
            xb_add(&bar[XB_XGEN(b.x)], 1u);
            asm volatile("s_waitcnt vmcnt(0)" ::: "memory");
        } else {
            XB_SPIN(xb_ld(&bar[XB_XGEN(b.x)]) == gen, bar);
            __builtin_amdgcn_fence(__ATOMIC_ACQUIRE, "agent");
            asm volatile("s_waitcnt vmcnt(0)" ::: "memory");
        }
    }
    __syncthreads();
}

__global__ void __launch_bounds__(512, 2) mega(Params p) {
    extern __shared__ __attribute__((aligned(16))) unsigned char lds[];
    cg::grid_group grid = cg::this_grid();
    const int bid = blockIdx.x, nb = gridDim.x;
    LAS unsigned char* l3 = (LAS unsigned char*)lds;
    ptab_t pt = (ptab_t)(l3 + PTAB_OFF);
    if (threadIdx.x < 27) { const int i = threadIdx.x; const void* v = i < 25 ? (const void*)p.in[i] : (i == 25 ? (const void*)p.out : (const void*)p.ws);
        ((LAS unsigned long long*)(l3 + PTAB_OFF))[i] = (unsigned long long)v; }
    if (threadIdx.x < 2) ((LAS unsigned*)(l3 + PTAB_OFF + 256))[threadIdx.x] = 0u;
    if (PROBE_SUB != 0 && threadIdx.x == 0) *(volatile LAS unsigned long long*)(l3 + PTAB_OFF + 320) = 0;
    __syncthreads();
    { unsigned* ctl = (unsigned*)PWS; for (int i = bid * 512 + (int)threadIdx.x; i < 40960; i += nb * 512) ctl[i] = 0u; }
#define TSTAMP() do { if (PROBE_MASK != 0u && blockIdx.x == 0 && threadIdx.x == 0) { volatile LAS unsigned long long* ts_ = (volatile LAS unsigned long long*)(l3 + PTAB_OFF + 288); \
        const unsigned long long now_ = __builtin_amdgcn_s_memrealtime(); const unsigned s_ = (unsigned)ts_[2]; if ((PROBE_MASK >> s_) & 1u) ts_[1] += now_ - ts_[0]; ts_[0] = now_; ts_[2] = s_ + 1; } } while (0)
#define GSYNC() do { xcd_barrier(xbar); TSTAMP(); } while (0)
    if (PROBE_MASK != 0u && blockIdx.x == 0 && threadIdx.x == 0) { volatile LAS unsigned long long* ts_ = (volatile LAS unsigned long long*)(l3 + PTAB_OFF + 288); ts_[0] = __builtin_amdgcn_s_memrealtime(); ts_[1] = 0; ts_[2] = 0; }
    p0_prologue(pt, l3, bid, nb, true);
    asm volatile("s_waitcnt vmcnt(0)" ::: "memory"); __syncthreads();
    grid.sync();
    XcdBarrier xbar = xcd_barrier_post((unsigned*)PWS + 1024, (volatile LAS unsigned*)(l3 + PTAB_OFF + 256));
    TSTAMP();
    if (PROBE_DUP == 3) { p0_prologue(pt, l3, bid, nb, false); }
    if (PROBE_DUP == 5) { for (int i = 0; i < 20; ++i) GSYNC(); }
#define REP(code) for (int rep_ = 0; rep_ < ((PROBE_DUP == (code)) ? 2 : 1); ++rep_)
#pragma unroll 1
    for (int l = 0; l < 2; ++l) {
        if (l == 0) { REP(4) { unsigned char* ws = PWS; const float* mods_l = (const float*)(ws + WS_MODS);
          norm_phase(PIN(0), PIN(1) - (size_t)4096 * DM, PIN(8), mods_l, 0, 1, (bf16_t*)(ws + WS_H), bid, nb);
          if (rep_ == 0) bias_phase(mods_l + 3 * DM, (const bf16_t*)(ws + WS_WFF1), FFD, (float*)(ws + WS_BIAS), l3, bid, nb);
          GSYNC(); } }
        REP(2) { unsigned char* ws = PWS; pg8::Gemm g{(const bf16_t*)(ws + WS_H), (const bf16_t*)(ws + WS_WIN) + (size_t)l * PNW * 2048, NTOK, PNW, 2048}; pg8::StaticOrder S; S.init(NTOK, PNW, nb, bid, WGM_IN);
          pg8::EpiP E{(bf16_t*)(ws + WS_P), (float*)(ws + WS_G), l == 0 ? (const float*)nullptr : (const float*)(ws + WS_RS) + 8192, (const float*)(ws + WS_BIAS) + 5 * 8192};
          pg8::gemm_phase<pg8::EpiP, pg8::StaticOrder, true, true>(l3, g, S, E);
          if (rep_ == 0 && bid + 2 * nb >= 672) { const int nidle = nb - (672 - 2 * nb); const int wv = __builtin_amdgcn_readfirstlane((int)threadIdx.x >> 6);
              __syncthreads();
              if (l == 0) do_transposes(pt, l3, TI_L, TI_IN, (bid - (672 - 2 * nb)) * 8 + wv, nidle * 8);
              else do_transposes(pt, l3, TI_L + TI_IN + TI_OUT + TI_F1 + TI_F2 / 3, TI_F2 - TI_F2 / 3, (bid - (672 - 2 * nb)) * 8 + wv, nidle * 8); }
          GSYNC(); }
        REP(4) { prep_phase(pt, l, l3, bid, nb);
          if (l == 0 && rep_ == 0) { unsigned char* ws = PWS; __syncthreads();
              bias_phase((const float*)(ws + WS_MODS) + (size_t)5 * NMOD, (const bf16_t*)(ws + WS_WIN) + (size_t)PNW * 2048, PNW, (float*)(ws + WS_BIAS) + 5 * 8192, l3, bid, nb); }
          GSYNC(); }
        REP(6) { mixer1_phase(pt, l, lds, bid, nb, rep_);
          GSYNC(); }
        REP(7) { mixer2_phase(pt, l, lds, bid, nb, rep_);
          GSYNC(); }
        REP(4) { postmix_phase(pt, l, bid, nb);
          if (l == 0 && rep_ == 0) { unsigned char* ws = PWS;
              bias_phase((const float*)(ws + WS_MODS) + (size_t)5 * NMOD + 3 * DM, (const bf16_t*)(ws + WS_WFF1) + (size_t)FFD * 2048, FFD, (float*)(ws + WS_BIAS) + 10 * 8192, l3, bid, nb); }
          GSYNC(); }
        REP(2) { unsigned char* ws = PWS; const float* mods_l = (const float*)(ws + WS_MODS) + (size_t)l * 5 * NMOD;
          const void* xin0 = l == 0 ? (const void*)PIN(0) : (const void*)(ws + WS_XB); const void* xin1 = l == 0 ? (const void*)(PIN(1) - (size_t)4096 * DM) : (const void*)(ws + WS_XB);
          pg8::Gemm g{(const bf16_t*)(ws + WS_MIX), (const bf16_t*)(ws + WS_WOUT) + (size_t)l * 2048 * 2048, NTOK, 2048, 2048}; pg8::StaticOrder S; S.init(NTOK, 2048, nb, bid, WGM_OUT);
          pg8::EpiRes E{xin0, xin1, (void*)(ws + WS_XA), mods_l + 2 * DM, rep_ == 0 ? (bf16_t*)(ws + WS_H) : (bf16_t*)nullptr, PIN(9) + l * DM, mods_l + 4 * DM, (float*)(ws + WS_RS) + (l == 0 ? 0 : 2 * 8192), l == 0 ? 0 : 1, 1};
          pg8::gemm_phase<pg8::EpiRes, pg8::StaticOrder, true, true>(l3, g, S, E);
          GSYNC(); }
        REP(2) { unsigned char* ws = PWS; pg8::Gemm g{(const bf16_t*)(ws + WS_H), (const bf16_t*)(ws + WS_WFF1) + (size_t)l * 8192 * 2048, NTOK, FFD, 2048}; pg8::StaticOrder S; S.init(NTOK, FFD, nb, bid, WGM_F1);
          pg8::EpiSqRelu E{(bf16_t*)(ws + WS_H2), FFD, (const float*)(ws + WS_RS) + (l == 0 ? 0 : 2 * 8192), (const float*)(ws + WS_BIAS) + (l == 0 ? 0 : 10 * 8192)};
          pg8::gemm_phase<pg8::EpiSqRelu, pg8::StaticOrder, true, true>(l3, g, S, E);
          GSYNC(); }
        REP(2) { unsigned char* ws = PWS; const float* mods_l = (const float*)(ws + WS_MODS) + (size_t)l * 5 * NMOD; const float* XA = (const float*)(ws + WS_XA);
          pg8::Gemm g{(const bf16_t*)(ws + WS_H2), (const bf16_t*)(ws + WS_WFF2) + (size_t)l * 2048 * 8192, NTOK, 2048, FFD}; pg8::StaticOrder S; S.init(NTOK, 2048, nb, bid, WGM_F2);
          pg8::EpiRes E{(const void*)XA, (const void*)XA, l == 0 ? (void*)(ws + WS_XB) : (void*)(POUT + OUT_Y), mods_l + 5 * DM, (l == 0 && rep_ == 0) ? (bf16_t*)(ws + WS_H) : (bf16_t*)nullptr, PIN(8) + DM, mods_l + 5 * NMOD + 1 * DM, (float*)(ws + WS_RS) + 8192, 1, l == 0 ? 1 : 0};
          pg8::gemm_phase<pg8::EpiRes, pg8::StaticOrder, true, true>(l3, g, S, E);
          if (l == 0 || rep_ + 1 < ((PROBE_DUP == 2) ? 2 : 1)) GSYNC(); }
    }
    if (PROBE_SUB != 0) { __syncthreads(); if (blockIdx.x == 0 && threadIdx.x == 0) { const unsigned long long t0_ = __builtin_amdgcn_s_memrealtime(), w_ = *(volatile LAS unsigned long long*)(l3 + PTAB_OFF + 320);
            while (__builtin_amdgcn_s_memrealtime() - t0_ < w_) __builtin_amdgcn_s_sleep(8); } }
    if (PROBE_MASK != 0u) { __syncthreads(); TSTAMP();
        if (blockIdx.x == 0 && threadIdx.x == 0) { volatile LAS unsigned long long* ts_ = (volatile LAS unsigned long long*)(l3 + PTAB_OFF + 288); const unsigned long long t0_ = __builtin_amdgcn_s_memrealtime(), w_ = ts_[1];
            while (__builtin_amdgcn_s_memrealtime() - t0_ < w_) __builtin_amdgcn_s_sleep(8); } }
}

extern "C" void kernel_launch(void* const* d_in, const int* in_sizes, int n_in, void* d_out, int out_size, void* d_ws, size_t ws_size, hipStream_t stream) {
    static int grid_blocks = 0;
    if (grid_blocks == 0) {
        if (n_in != 25 || out_size != (int)OUT_TOTAL || ws_size < WS_END) { fprintf(stderr, "kernel_launch: unexpected shapes: n_in %d out %d ws %zu (need %zu)\n", n_in, out_size, ws_size, (size_t)WS_END); grid_blocks = -1; return; }
        int dev = 0, cus = 0, per_cu = 0;
        if (hipGetDevice(&dev) != hipSuccess || hipDeviceGetAttribute(&cus, hipDeviceAttributeMultiprocessorCount, dev) != hipSuccess) { grid_blocks = -1; return; }
        if (hipFuncSetAttribute((const void*)mega, hipFuncAttributeMaxDynamicSharedMemorySize, LDS_BYTES) != hipSuccess) { fprintf(stderr, "kernel_launch: hipFuncSetAttribute failed\n"); grid_blocks = -1; return; }
        if (hipOccupancyMaxActiveBlocksPerMultiprocessor(&per_cu, (const void*)mega, 512, LDS_BYTES) != hipSuccess || per_cu < 1) { fprintf(stderr, "kernel_launch: occupancy query says %d blocks per CU\n", per_cu); (void)hipGetLastError(); grid_blocks = -1; return; }
        grid_blocks = cus;
    }
    if (grid_blocks < 0) return;
    Params p{};
    for (int i = 0; i < 25; ++i) p.in[i] = (const float*)d_in[i];
    p.out = (float*)d_out; p.ws = (unsigned char*)d_ws;
    void* args[] = {&p};
    const hipError_t e = hipLaunchCooperativeKernel((void*)mega, dim3(grid_blocks), dim3(512), args, LDS_BYTES, stream);
    if (e != hipSuccess) fprintf(stderr, "kernel_launch: cooperative launch failed: %s (grid %d)\n", hipGetErrorString(e), grid_blocks);
}
```

```cpp
#include <hip/hip_runtime.h>
#include <hip/hip_cooperative_groups.h>
#include <cstdio>
#include <cstdint>
namespace cg = cooperative_groups;
#ifndef WGM_IN
#define WGM_IN 8
#endif
#ifndef WGM_OUT
#define WGM_OUT 4
#endif
#ifndef WGM_F1
#define WGM_F1 4
#endif
#ifndef WGM_F2
#define WGM_F2 4
#endif
#ifndef PROBE_DUP
#define PROBE_DUP 0
#endif
#ifndef PROBE_SUB
#define PROBE_SUB 0
#endif
#ifndef PROBE_MASK
#define PROBE_MASK 0u
#endif
namespace pg8 {
#define PG8_LAS __attribute__((address_space(3)))
typedef unsigned short bf16_t;
typedef short bf16x8 __attribute__((ext_vector_type(8)));
typedef float f32x4 __attribute__((ext_vector_type(4)));
typedef unsigned u32x4 __attribute__((ext_vector_type(4)));
typedef unsigned u32x2 __attribute__((ext_vector_type(2)));
constexpr int BM = 256, BK = 64, HALF = 128, HTB = HALF * BK * 2  , STAGE_BYTES = 8 * HTB, NXCD = 8, WGM = 1;

__host__ __device__ __forceinline__ int lds_byte(int r, int c) { const int st = (r >> 4) * 2 + (c >> 5), rr = r & 15, cc = c & 31, ob = rr * 64 + cc * 2; return st * 1024 + (ob ^ (((ob >> 9) & 1) << 5)); }
__host__ __device__ __forceinline__ void stage_rc(int b, int& R, int& C) { const int st = b / 1024, sb = b % 1024, swz = sb ^ (((sb >> 9) & 1) << 5); R = (st >> 1) * 16 + swz / 64; C = (st & 1) * 32 + (swz % 64) / 2; }
__host__ __device__ __forceinline__ int perm32(int rho) { const int n = rho >> 4, i = rho & 15; return 8 * (i >> 2) + 4 * n + (i & 3); }

struct Unit { int pm, pn; };
struct Gemm { const bf16_t* A; const bf16_t* Bt; int M, N, K; };

struct StaticOrder {
    int nM, nN, nwg, G, c, wgm;
    __host__ __device__ void init(int M, int N, int G_, int c_, int wgm_ = WGM) { nM = M / BM; nN = N / BM; nwg = nM * nN; G = G_; c = c_; wgm = wgm_; }
    __host__ __device__ bool next(int i, Unit& u) const {
        const long L = (long)i * G + c; if (L >= nwg) return false;
        int wgid = (int)L; { const int q = nwg / NXCD, r = nwg % NXCD, xcd = wgid % NXCD, off = wgid / NXCD; wgid = (xcd < r ? xcd * (q + 1) : r * (q + 1) + (xcd - r) * q) + off; }
        const int nig = wgm * nN, gid = wgid / nig, fm = gid * wgm, gsz = (nM - fm) < wgm ? (nM - fm) : wgm;
        u.pm = fm + ((wgid % nig) % gsz); u.pn = (wgid % nig) / gsz; return true;
    }
    __device__ __forceinline__ void a_ready(const Unit&) const {}
    __device__ __forceinline__ void done(const Unit&) const {}
};

__device__ __forceinline__ unsigned cvt_pk_bf16(float lo, float hi) { unsigned r; asm volatile("v_cvt_pk_bf16_f32 %0, %1, %2" : "=v"(r) : "v"(lo), "v"(hi)); return r; }
struct EpiP {
    static constexpr bool PERM = true, AFTER_DRAIN = false;
    bf16_t* P; float* G; const float* RS; const float* bias;
    __device__ __forceinline__ void operator()(const f32x4 (&acc)[2][2][4][2], const Unit& u, int wr, int wc, int fr, int fq) const {
        const int row0 = u.pm * BM + wr * 64 + fr; const int cond = (u.pm < 16) ? 0 : 1 + ((u.pm - 16) >> 2);
        const int col0 = u.pn * BM + wc * 32 + 8 * fq;
        const float* bp = bias + (size_t)cond * 5376 + col0;
        if (u.pn < 20) {
#pragma unroll
            for (int ai = 0; ai < 2; ++ai)
#pragma unroll
                for (int m = 0; m < 4; ++m) { const int row = row0 + ai * HALF + m * 16; bf16_t* rowp = P + (size_t)row * 5120 + col0;
                    const float rs = RS ? rsqrtf(RS[row] * (1.f / 2048.f) + 1e-6f) : 1.f;
#pragma unroll
                    for (int bj = 0; bj < 2; ++bj) { f32x4 v0 = acc[ai][bj][m][0] * rs, v1 = acc[ai][bj][m][1] * rs;
                        if (RS) { v0 += *(const f32x4*)(bp + bj * HALF); v1 += *(const f32x4*)(bp + bj * HALF + 4); }
                        u32x4 w; w.x = cvt_pk_bf16(v0[0], v0[1]); w.y = cvt_pk_bf16(v0[2], v0[3]); w.z = cvt_pk_bf16(v1[0], v1[1]); w.w = cvt_pk_bf16(v1[2], v1[3]);
                        *(u32x4*)(rowp + bj * HALF) = w; } }
        } else if (wc < 2) {
            const int gc0 = wc * 32 + 8 * fq;
#pragma unroll
            for (int ai = 0; ai < 2; ++ai)
#pragma unroll
                for (int m = 0; m < 4; ++m) { const int row = row0 + ai * HALF + m * 16; float* rowp = G + (size_t)row * 64 + gc0;
                    const float rs = RS ? rsqrtf(RS[row] * (1.f / 2048.f) + 1e-6f) : 1.f;
                    f32x4 v0 = acc[ai][0][m][0] * rs, v1 = acc[ai][0][m][1] * rs;
                    if (RS) { v0 += *(const f32x4*)(bp); v1 += *(const f32x4*)(bp + 4); }
                    *(f32x4*)(rowp) = v0; *(f32x4*)(rowp + 4) = v1; }
        }
    }
};
struct EpiRes {
    static constexpr bool PERM = true, AFTER_DRAIN = false;
    const void* base0; const void* base1; void* out; const float* gate;
    bf16_t* Hn; const float* gnorm; const float* scale; float* RS;
    int base_bf16, out_bf16;
    __device__ __forceinline__ void operator()(const f32x4 (&acc)[2][2][4][2], const Unit& u, int wr, int wc, int fr, int fq) const {
        const int row0 = u.pm * BM + wr * 64 + fr; const int col0 = u.pn * BM + wc * 32 + 8 * fq;
        const int cond = (u.pm < 16) ? 0 : 1 + ((u.pm - 16) >> 2);
        const void* base = (u.pm < 16) ? base0 : base1;
        const float* gp = gate + (size_t)cond * 6 * 2048 + col0;
        f32x4 gv[2][2], gs[2][2];
#pragma unroll
        for (int bj = 0; bj < 2; ++bj)
#pragma unroll
            for (int n = 0; n < 2; ++n) { gv[bj][n] = *(const f32x4*)(gp + bj * HALF + n * 4);
                if (Hn) gs[bj][n] = *(const f32x4*)(gnorm + col0 + bj * HALF + n * 4) * (*(const f32x4*)(scale + (size_t)cond * 6 * 2048 + col0 + bj * HALF + n * 4) + 1.f); }
#pragma unroll
        for (int ai = 0; ai < 2; ++ai)
#pragma unroll
            for (int m = 0; m < 4; ++m) { const int row = row0 + ai * HALF + m * 16; const size_t off = (size_t)row * 2048 + col0; float ss = 0.f;
#pragma unroll
                for (int bj = 0; bj < 2; ++bj) { f32x4 b0, b1;
                    if (base_bf16) { const u32x4 w = *(const u32x4*)((const bf16_t*)base + off + bj * HALF);
                        b0 = (f32x4){__uint_as_float(w.x << 16), __uint_as_float(w.x & 0xffff0000u), __uint_as_float(w.y << 16), __uint_as_float(w.y & 0xffff0000u)};
                        b1 = (f32x4){__uint_as_float(w.z << 16), __uint_as_float(w.z & 0xffff0000u), __uint_as_float(w.w << 16), __uint_as_float(w.w & 0xffff0000u)}; }
                    else { b0 = *(const f32x4*)((const float*)base + off + bj * HALF); b1 = *(const f32x4*)((const float*)base + off + bj * HALF + 4); }
                    const f32x4 x0 = b0 + gv[bj][0] * acc[ai][bj][m][0], x1 = b1 + gv[bj][1] * acc[ai][bj][m][1];
                    if (out_bf16) { u32x4 w; w.x = cvt_pk_bf16(x0[0], x0[1]); w.y = cvt_pk_bf16(x0[2], x0[3]); w.z = cvt_pk_bf16(x1[0], x1[1]); w.w = cvt_pk_bf16(x1[2], x1[3]); *(u32x4*)((bf16_t*)out + off + bj * HALF) = w; }
                    else { *(f32x4*)((float*)out + off + bj * HALF) = x0; *(f32x4*)((float*)out + off + bj * HALF + 4) = x1; }
                    if (Hn) { ss += ((x0[0] * x0[0] + x0[1] * x0[1]) + (x0[2] * x0[2] + x0[3] * x0[3])) + ((x1[0] * x1[0] + x1[1] * x1[1]) + (x1[2] * x1[2] + x1[3] * x1[3]));
                        const f32x4 y0 = x0 * gs[bj][0], y1 = x1 * gs[bj][1];
                        u32x4 w; w.x = cvt_pk_bf16(y0[0], y0[1]); w.y = cvt_pk_bf16(y0[2], y0[3]); w.z = cvt_pk_bf16(y1[0], y1[1]); w.w = cvt_pk_bf16(y1[2], y1[3]);
                        *(u32x4*)(Hn + off + bj * HALF) = w; } }
                if (Hn) { ss += __shfl_xor(ss, 16); ss += __shfl_xor(ss, 32); if (fq == 0) atomicAdd(RS + row, ss); } }
    }
};
struct EpiSqRelu {
    static constexpr bool PERM = true, AFTER_DRAIN = false;
    bf16_t* O; int ldc; const float* RS; const float* bias;
    __device__ __forceinline__ void operator()(const f32x4 (&acc)[2][2][4][2], const Unit& u, int wr, int wc, int fr, int fq) const {
        const int row0 = u.pm * BM + wr * 64 + fr; const int col0 = u.pn * BM + wc * 32 + 8 * fq;
        const int cond = (u.pm < 16) ? 0 : 1 + ((u.pm - 16) >> 2);
        const float* bp = bias + (size_t)cond * ldc + col0;
        f32x4 bv[2][2];
#pragma unroll
        for (int bj = 0; bj < 2; ++bj)
#pragma unroll
            for (int n = 0; n < 2; ++n) bv[bj][n] = *(const f32x4*)(bp + bj * HALF + 4 * n);
#pragma unroll
        for (int ai = 0; ai < 2; ++ai)
#pragma unroll
            for (int m = 0; m < 4; ++m) { const int row = row0 + ai * HALF + m * 16; bf16_t* rowp = O + (size_t)row * ldc + col0;
                const float rs = rsqrtf(RS[row] * (1.f / 2048.f) + 1e-6f);
#pragma unroll
                for (int bj = 0; bj < 2; ++bj) { f32x4 v0 = acc[ai][bj][m][0] * rs + bv[bj][0], v1 = acc[ai][bj][m][1] * rs + bv[bj][1];
#pragma unroll
                    for (int e = 0; e < 4; ++e) { const float a = fmaxf(v0[e], 0.f), b = fmaxf(v1[e], 0.f); v0[e] = a * a; v1[e] = b * b; }
                    u32x4 w; w.x = cvt_pk_bf16(v0[0], v0[1]); w.y = cvt_pk_bf16(v0[2], v0[3]); w.z = cvt_pk_bf16(v1[0], v1[1]); w.w = cvt_pk_bf16(v1[2], v1[3]);
                    *(u32x4*)(rowp + bj * HALF) = w; } }
    }
};

template <class Epi, class Sched, bool ALIGN_EPI = false, bool SP2 = false>
__device__ __forceinline__ void gemm_phase(PG8_LAS unsigned char* lds, const Gemm g, const Sched& S, const Epi& E) {
    int tid = threadIdx.x; asm volatile("" : "+v"(tid)); const int wid = __builtin_amdgcn_readfirstlane(tid >> 6), lane = tid & 63, wr = wid >> 2, wc = wid & 3, fr = lane & 15, fq = lane >> 4;
    const int K = g.K, nt = K / BK;
    unsigned voffA[2], voffB[2];
#pragma unroll
    for (int i = 0; i < 2; ++i) { int R, C; stage_rc(tid * 16 + i * 8192, R, C); const int Rb = Epi::PERM ? ((R & ~31) + perm32(R & 31)) : R;
        voffA[i] = (unsigned)(R * K + C) * 2u; voffB[i] = (unsigned)(Rb * K + C) * 2u; }
    const size_t kstep = (size_t)(BK * 2);
    const size_t hstep = (size_t)HALF * K * 2;
    const size_t tstep = 2 * hstep;
    const unsigned ldsw = (unsigned)wid * 1024u;
    const int aoff = lds_byte(wr * 64 + fr, fq * 8), boff = lds_byte(wc * 32 + fr, fq * 8);
#define PG8_SA(b, h) (((b) * 2 + (h)) * HTB)
#define PG8_SB(b, h) ((4 + (b) * 2 + (h)) * HTB)
#define PG8_STAGE(bufoff, gbase, voff) do { _Pragma("unroll") for (int _i = 0; _i < 2; ++_i) \
        __builtin_amdgcn_global_load_lds((const unsigned*)((const char*)(gbase) + (voff)[_i]), (PG8_LAS unsigned*)(lds + (bufoff) + ldsw + _i * 8192), 16, 0, 0); } while (0)
#define PG8_LDA(dst, b, h) do { _Pragma("unroll") for (int m = 0; m < 4; ++m) _Pragma("unroll") for (int k = 0; k < 2; ++k) dst[m][k] = *(const PG8_LAS bf16x8*)(lds + PG8_SA(b, h) + aoff + m * 2048 + k * 1024); } while (0)
#define PG8_LDB(dst, b, h) do { _Pragma("unroll") for (int n = 0; n < 2; ++n) _Pragma("unroll") for (int k = 0; k < 2; ++k) dst[n][k] = *(const PG8_LAS bf16x8*)(lds + PG8_SB(b, h) + boff + n * 2048 + k * 1024); } while (0)
#define PG8_MMA(ai, bj, At, Bt) do { __builtin_amdgcn_s_setprio(1); _Pragma("unroll") for (int m = 0; m < 4; ++m) _Pragma("unroll") for (int n = 0; n < 2; ++n) _Pragma("unroll") for (int k = 0; k < 2; ++k) \
        acc[ai][bj][m][n] = __builtin_amdgcn_mfma_f32_16x16x32_bf16(Bt[n][k], At[m][k], acc[ai][bj][m][n], 0, 0, 0); __builtin_amdgcn_s_setprio(0); } while (0)
#define PG8_WAIT_V(n) asm volatile("s_waitcnt vmcnt(" #n ")" ::: "memory")
#define PG8_WAIT_L(n) asm volatile("s_waitcnt lgkmcnt(" #n ")" ::: "memory")
#define PG8_BAR __builtin_amdgcn_s_barrier()
#define PG8_SCHED __builtin_amdgcn_sched_barrier(0)
    Unit cur, nxt; int ui = 0;
    if (!S.next(0, cur)) return;
    f32x4 acc[2][2][4][2];
#pragma unroll
    for (int a = 0; a < 2; ++a)
#pragma unroll
        for (int b = 0; b < 2; ++b)
#pragma unroll
            for (int m = 0; m < 4; ++m)
#pragma unroll
                for (int n = 0; n < 2; ++n) acc[a][b][m][n] = (f32x4){0.f, 0.f, 0.f, 0.f};
    bf16x8 At[4][2], B0[2][2], B1[2][2];
    const char* cA = (const char*)g.A + (size_t)cur.pm * tstep; const char* cB = (const char*)g.Bt + (size_t)cur.pn * tstep;
    S.a_ready(cur);
    if constexpr (SP2) {
        PG8_STAGE(PG8_SB(0, 0), cB, voffB); PG8_STAGE(PG8_SB(0, 1), cB + hstep, voffB); PG8_STAGE(PG8_SA(0, 0), cA, voffA); PG8_STAGE(PG8_SA(0, 1), cA + hstep, voffA);
        if (wr == 1) PG8_BAR;
        PG8_WAIT_V(2); PG8_BAR;
        PG8_STAGE(PG8_SB(1, 0), cB + kstep, voffB); PG8_STAGE(PG8_SA(1, 0), cA + kstep, voffA); PG8_STAGE(PG8_SB(1, 1), cB + hstep + kstep, voffB);
        PG8_WAIT_V(6); PG8_BAR;
    } else {
        PG8_STAGE(PG8_SB(0, 0), cB, voffB); PG8_STAGE(PG8_SA(0, 0), cA, voffA); PG8_STAGE(PG8_SB(0, 1), cB + hstep, voffB); PG8_STAGE(PG8_SA(0, 1), cA + hstep, voffA);
        if (wr == 1) PG8_BAR;
        PG8_WAIT_V(4); PG8_BAR;
        PG8_STAGE(PG8_SB(1, 0), cB + kstep, voffB); PG8_STAGE(PG8_SA(1, 0), cA + kstep, voffA); PG8_STAGE(PG8_SB(1, 1), cB + hstep + kstep, voffB);
        PG8_WAIT_V(6); PG8_BAR;
    }
    for (;;) {
        const bool has_next = S.next(ui + 1, nxt);
        const char* nA = has_next ? (const char*)g.A + (size_t)nxt.pm * tstep : cA; const char* nB = has_next ? (const char*)g.Bt + (size_t)nxt.pn * tstep : cB;
        for (int t = 0; t < nt; t += 2) {
            const bool last = (t == nt - 2);
            const char* a1 = cA + (size_t)(t + 1) * kstep;
            const char* a2 = last ? nA : cA + (size_t)(t + 2) * kstep; const char* b2 = last ? nB : cB + (size_t)(t + 2) * kstep;
            const char* a3 = a2 + kstep; const char* b3 = b2 + kstep;
            if (last && has_next) S.a_ready(nxt);
            if constexpr (SP2) {
            PG8_LDB(B0, 0, 0); PG8_LDB(B1, 0, 1); PG8_SCHED; PG8_LDA(At, 0, 0); PG8_STAGE(PG8_SA(1, 1), a1 + hstep, voffA);
            PG8_WAIT_V(8); PG8_WAIT_L(0); PG8_BAR; PG8_MMA(0, 0, At, B0); PG8_MMA(0, 1, At, B1); PG8_BAR; PG8_SCHED;
            PG8_LDA(At, 0, 1); PG8_STAGE(PG8_SB(0, 0), b2, voffB); PG8_STAGE(PG8_SB(0, 1), b2 + hstep, voffB); PG8_STAGE(PG8_SA(0, 0), a2, voffA);
            PG8_WAIT_V(8); PG8_WAIT_L(0); PG8_BAR; PG8_MMA(1, 0, At, B0); PG8_MMA(1, 1, At, B1); PG8_BAR; PG8_SCHED;
            PG8_LDB(B0, 1, 0); PG8_LDB(B1, 1, 1); PG8_SCHED; PG8_LDA(At, 1, 0); PG8_STAGE(PG8_SA(0, 1), a2 + hstep, voffA);
            PG8_WAIT_V(8); PG8_WAIT_L(0); PG8_BAR; PG8_MMA(0, 0, At, B0); PG8_MMA(0, 1, At, B1); PG8_BAR; PG8_SCHED;
            PG8_LDA(At, 1, 1); PG8_STAGE(PG8_SB(1, 0), b3, voffB); PG8_STAGE(PG8_SB(1, 1), b3 + hstep, voffB); PG8_STAGE(PG8_SA(1, 0), a3, voffA);
            PG8_WAIT_V(8); PG8_WAIT_L(0); PG8_BAR; PG8_MMA(1, 0, At, B0); PG8_MMA(1, 1, At, B1); PG8_BAR; PG8_SCHED;
            } else {
            PG8_LDB(B0, 0, 0); PG8_SCHED; PG8_LDA(At, 0, 0); PG8_STAGE(PG8_SA(1, 1), a1 + hstep, voffA);
            PG8_WAIT_L(8); PG8_BAR; PG8_WAIT_L(0); PG8_MMA(0, 0, At, B0); PG8_BAR; PG8_SCHED;
            PG8_LDB(B1, 0, 1); PG8_STAGE(PG8_SB(0, 0), b2, voffB);
            PG8_BAR; PG8_WAIT_L(0); PG8_MMA(0, 1, At, B1); PG8_BAR;
            PG8_LDA(At, 0, 1); PG8_STAGE(PG8_SA(0, 0), a2, voffA);
            PG8_BAR; PG8_WAIT_L(0); PG8_MMA(1, 0, At, B0); PG8_BAR; PG8_SCHED;
            PG8_STAGE(PG8_SB(0, 1), b2 + hstep, voffB);
            PG8_WAIT_V(6); PG8_BAR; PG8_MMA(1, 1, At, B1); PG8_BAR;
            PG8_LDB(B0, 1, 0); PG8_SCHED; PG8_LDA(At, 1, 0); PG8_STAGE(PG8_SA(0, 1), a2 + hstep, voffA);
            PG8_WAIT_L(8); PG8_BAR; PG8_WAIT_L(0); PG8_MMA(0, 0, At, B0); PG8_BAR; PG8_SCHED;
            PG8_LDB(B1, 1, 1); PG8_STAGE(PG8_SB(1, 0), b3, voffB);
            PG8_BAR; PG8_WAIT_L(0); PG8_MMA(0, 1, At, B1); PG8_BAR;
            PG8_LDA(At, 1, 1); PG8_STAGE(PG8_SA(1, 0), a3, voffA);
            PG8_BAR; PG8_WAIT_L(0); PG8_MMA(1, 0, At, B0); PG8_BAR; PG8_SCHED;
            PG8_STAGE(PG8_SB(1, 1), b3 + hstep, voffB);
            PG8_WAIT_V(6); PG8_BAR; PG8_MMA(1, 1, At, B1); PG8_BAR;
            }
        }
        if constexpr (ALIGN_EPI) { if (wr == 0) PG8_BAR; }
        if constexpr (!Epi::AFTER_DRAIN) { E(acc, cur, wr, wc, fr, fq); S.done(cur); }
        if (!has_next) break;
#pragma unroll
        for (int a = 0; a < 2; ++a)
#pragma unroll
            for (int b = 0; b < 2; ++b)
#pragma unroll
                for (int m = 0; m < 4; ++m)
#pragma unroll
                    for (int n = 0; n < 2; ++n) acc[a][b][m][n] = (f32x4){0.f, 0.f, 0.f, 0.f};
        cur = nxt; cA = nA; cB = nB; ++ui;
        if constexpr (ALIGN_EPI) { if (wr == 1) PG8_BAR; }
    }
    PG8_WAIT_V(0);
    if constexpr (!ALIGN_EPI) { if (wr == 0) PG8_BAR; }
    PG8_BAR;
    if constexpr (Epi::AFTER_DRAIN) { E.fused(acc, cur, wr, wc, fr, fq, lds, wid, lane); S.done(cur); }
#undef PG8_SA
#undef PG8_SB
#undef PG8_STAGE
#undef PG8_LDA
#undef PG8_LDB
#undef PG8_MMA
#undef PG8_WAIT_V
#undef PG8_WAIT_L
#undef PG8_BAR
#undef PG8_SCHED
}
}
namespace att {
typedef unsigned short bf16;
constexpr int   D = 128, NW = 8, QBLK = 32, KVBLK = 64;
constexpr float SCALE = 0.088388347648318440f;
constexpr float THR = 8.f;
constexpr int SDEPTH = 2;
constexpr size_t SHM_V = KVBLK * D * 2, SHM_K = KVBLK * D * 2, SHM_ATTN = 2 * SHM_V + 2 * SHM_K + NW * 64 * 4;
__device__ __forceinline__ bf16 f2bf_s(float f) { unsigned u = __builtin_bit_cast(unsigned, f); return (bf16)((u + 0x7fffu + ((u >> 16) & 1u)) >> 16); }
using bf16x8 = __attribute__((ext_vector_type(8))) short;
using s16x4  = __attribute__((ext_vector_type(4))) short;
using f32x16 = __attribute__((ext_vector_type(16))) float;
using f32x8  = __attribute__((ext_vector_type(8))) float;
using u32x4  = __attribute__((ext_vector_type(4))) unsigned;
#define KSWZ(row, colB) ((row) * 256 + ((colB) ^ (((row) & 7) << 4)))
#define SBAR() __builtin_amdgcn_sched_barrier(0)
__device__ __forceinline__ int crow(int r, int hi) { return (r & 3) + 8 * (r >> 2) + 4 * hi; }
__device__ __forceinline__ unsigned cvtpk(float lo, float hi) {
  unsigned r; asm volatile("v_cvt_pk_bf16_f32 %0, %1, %2" : "=v"(r) : "v"(lo), "v"(hi)); return r;
}
__device__ __forceinline__ void partialSM(f32x16& p0, f32x16& p1, float& m_reg, float& mn, float& alpha) {
  constexpr float C = SCALE * 1.4426950408889634f;
  float pmax = p0[0]; for (int r = 1; r < 16; ++r) pmax = fmaxf(pmax, p0[r]); for (int r = 0; r < 16; ++r) pmax = fmaxf(pmax, p1[r]);
  { auto rr = __builtin_amdgcn_permlane32_swap(__float_as_uint(pmax), __float_as_uint(pmax), false, false);
    pmax = fmaxf(__uint_as_float(rr[0]), __uint_as_float(rr[1])); }
  if (__builtin_expect(__all(pmax - m_reg <= THR / SCALE), 1)) { mn = m_reg; alpha = 1.f; }
  else { mn = fmaxf(m_reg, pmax); alpha = __builtin_amdgcn_exp2f((m_reg - mn) * C); m_reg = mn; }
  float mnC = -mn * C;
  for (int r = 0; r < 16; ++r) p0[r] = fmaf(p0[r], C, mnC); for (int r = 0; r < 16; ++r) p1[r] = fmaf(p1[r], C, mnC);
  for (int r = 0; r < 16; ++r) p0[r] = __builtin_amdgcn_exp2f(p0[r]);
}
__device__ __forceinline__ void finishSM(f32x16& p0, f32x16& p1, float alpha, float& l_reg, bf16x8& pa0, bf16x8& pa1, bf16x8& pa2, bf16x8& pa3) {
  for (int r = 0; r < 16; ++r) p1[r] = __builtin_amdgcn_exp2f(p1[r]);
  float ps = 0; for (int r = 0; r < 16; ++r) ps += p0[r]; for (int r = 0; r < 16; ++r) ps += p1[r];
  { auto rr = __builtin_amdgcn_permlane32_swap(__float_as_uint(ps), __float_as_uint(ps), false, false);
    ps = __uint_as_float(rr[0]) + __uint_as_float(rr[1]); }
  l_reg = l_reg * alpha + ps;
#define PK4(P, BASE, OUT) do { unsigned a0 = cvtpk(P[BASE + 0], P[BASE + 1]), a1 = cvtpk(P[BASE + 2], P[BASE + 3]);   \
    unsigned b0 = cvtpk(P[BASE + 4], P[BASE + 5]), b1 = cvtpk(P[BASE + 6], P[BASE + 7]);                              \
    auto r0 = __builtin_amdgcn_permlane32_swap(a0, b0, false, false); auto r1 = __builtin_amdgcn_permlane32_swap(a1, b1, false, false); \
    u32x4 w = {r0[0], r1[0], r0[1], r1[1]}; OUT = *reinterpret_cast<bf16x8*>(&w); } while (0)
  PK4(p0, 0, pa0); PK4(p0, 8, pa1); PK4(p1, 0, pa2); PK4(p1, 8, pa3);
#undef PK4
}
__device__ __forceinline__ void qkt(f32x16& p0, f32x16& p1, const bf16* Ks, const bf16x8* qr, int r32, int hi) {
  p0 = f32x16{}; p1 = f32x16{};
  for (int d0 = 0; d0 < 8; ++d0) { int cb = (d0 * 16 + hi * 8) * 2;
    bf16x8 b0 = *reinterpret_cast<const bf16x8*>((const char*)Ks + KSWZ(r32, cb));
    bf16x8 b1 = *reinterpret_cast<const bf16x8*>((const char*)Ks + KSWZ(32 + r32, cb));
    p0 = __builtin_amdgcn_mfma_f32_32x32x16_bf16(b0, qr[d0], p0, 0, 0, 0);
    p1 = __builtin_amdgcn_mfma_f32_32x32x16_bf16(b1, qr[d0], p1, 0, 0, 0); }
}
__device__ __forceinline__ int v_st(int k, int c) { const int kk = (k & ~0xC) | ((k & 4) << 1) | ((k & 8) >> 1); return ((kk >> 3) * 4 + (c >> 5)) * 512 + ((kk & 7) * 32 + (c & 31)) * 2; }
__device__ __forceinline__ int v_rd_base(int lane) { return ((lane & 3) << 3) | (((lane >> 2) & 3) << 6) | (((lane >> 4) & 1) << 5) | (((lane >> 5) & 1) << 8); }
constexpr int v_rd_off(int d0, int ks, int half) { return d0 * 512 + ks * 4096 + half * 2048; }
template <int OFF> __device__ __forceinline__ s16x4 tr_read(int vb) {
  s16x4 r; asm volatile("ds_read_b64_tr_b16 %0, %1 offset:%2" : "=&v"(r) : "v"(vb), "i"(OFF) : "memory"); return r;
}
template <int D0> __device__ __forceinline__ void pv_one(f32x16& od, int vb, bf16x8 pa0, bf16x8 pa1, bf16x8 pa2, bf16x8 pa3) {
  const s16x4 l0 = tr_read<v_rd_off(D0, 0, 0)>(vb), h0 = tr_read<v_rd_off(D0, 0, 1)>(vb), l1 = tr_read<v_rd_off(D0, 1, 0)>(vb), h1 = tr_read<v_rd_off(D0, 1, 1)>(vb);
  const s16x4 l2 = tr_read<v_rd_off(D0, 2, 0)>(vb), h2 = tr_read<v_rd_off(D0, 2, 1)>(vb), l3 = tr_read<v_rd_off(D0, 3, 0)>(vb), h3 = tr_read<v_rd_off(D0, 3, 1)>(vb);
  asm volatile("s_waitcnt lgkmcnt(0)" ::: "memory"); SBAR();
#define PK(L, H) (bf16x8){L[0], L[1], L[2], L[3], H[0], H[1], H[2], H[3]}
  od = __builtin_amdgcn_mfma_f32_32x32x16_bf16(pa0, PK(l0, h0), od, 0, 0, 0);
  od = __builtin_amdgcn_mfma_f32_32x32x16_bf16(pa1, PK(l1, h1), od, 0, 0, 0);
  od = __builtin_amdgcn_mfma_f32_32x32x16_bf16(pa2, PK(l2, h2), od, 0, 0, 0);
  od = __builtin_amdgcn_mfma_f32_32x32x16_bf16(pa3, PK(l3, h3), od, 0, 0, 0);
#undef PK
}
__device__ __forceinline__ void pv_d0(f32x16* o, int vb, bf16x8 pa0, bf16x8 pa1, bf16x8 pa2, bf16x8 pa3) {
  pv_one<0>(o[0], vb, pa0, pa1, pa2, pa3); pv_one<1>(o[1], vb, pa0, pa1, pa2, pa3); pv_one<2>(o[2], vb, pa0, pa1, pa2, pa3); pv_one<3>(o[3], vb, pa0, pa1, pa2, pa3);
}

template <int LDQ, int LDK, int LDO>
__device__ __forceinline__ void attn_dense_body(const bf16* Qb, const bf16* Kh, const bf16* Vh,
                                                bf16* Ob, int seq, char* lds) {
  int tid = threadIdx.x; asm volatile("" : "+v"(tid)); const int wid = tid >> 6, lane = tid & 63, r32 = lane & 31, hi = lane >> 5;
  bf16* V_lds = (bf16*)lds; bf16* K_lds = (bf16*)(lds + 2 * SHM_V);
  float* ws = (float*)(lds + 2 * SHM_V + 2 * SHM_K) + wid * 64; float* li_l = ws; float* al_l = ws + 32;
  float m_reg = -1e30f, l_reg = 0; f32x16 o[4] = {}; bf16x8 qr[8];
  const bf16* Qw = Qb + (long)(wid * QBLK + r32) * LDQ + hi * 8;
#pragma unroll
  for (int d0 = 0; d0 < 8; ++d0) qr[d0] = *reinterpret_cast<const bf16x8*>(Qw + d0 * 16);
  const int sr = tid >> 4, sc = (tid & 15) * 8, vst0 = v_st(sr, sc), vst1 = v_st(32 + sr, sc);
  const int vb0 = (int)(uintptr_t)V_lds + v_rd_base(lane);
  struct { bf16x8 vs0, vs1, ks0, ks1; } sr_[SDEPTH];
#define SLOAD(i, k0) do { sr_[i].vs0 = (*reinterpret_cast<const bf16x8*>(&Vh[(long)((k0) + sr) * LDK + sc])); sr_[i].vs1 = (*reinterpret_cast<const bf16x8*>(&Vh[(long)((k0) + 32 + sr) * LDK + sc])); \
    sr_[i].ks0 = (*reinterpret_cast<const bf16x8*>(&Kh[(long)((k0) + sr) * LDK + sc])); sr_[i].ks1 = (*reinterpret_cast<const bf16x8*>(&Kh[(long)((k0) + 32 + sr) * LDK + sc])); } while (0)
#define SWRITE(b, i) do { *(bf16x8*)((char*)V_lds + (b) * SHM_V + vst0) = (sr_[i].vs0);          \
    *(bf16x8*)((char*)V_lds + (b) * SHM_V + vst1) = (sr_[i].vs1); int kc = sc * 2;               \
    *(bf16x8*)((char*)K_lds + (b) * SHM_K + KSWZ(sr, kc)) = (sr_[i].ks0);                       \
    *(bf16x8*)((char*)K_lds + (b) * SHM_K + KSWZ(32 + sr, kc)) = (sr_[i].ks1); } while (0)
#define SWAIT() do { if constexpr (SDEPTH == 2) asm volatile("s_waitcnt vmcnt(4)" ::: "memory"); else asm volatile("s_waitcnt vmcnt(0)" ::: "memory"); } while (0)
#define RESC(a) do { if (__any((a) < 1.f)) { if (hi == 0) al_l[r32] = (a); asm volatile("s_waitcnt lgkmcnt(0)" ::: "memory"); \
    for (int d = 0; d < 4; ++d) for (int r = 0; r < 16; ++r) o[d][r] *= al_l[crow(r, hi)]; } } while (0)
  f32x16 pA0, pA1, pB0, pB1; float mnA, mnB, alA, alB; bf16x8 pa0, pa1, pa2, pa3; const int NT = seq / KVBLK;
  constexpr int SE = 0, SO = SDEPTH - 1;
  SLOAD(SE, 0); asm volatile("s_waitcnt vmcnt(0)" ::: "memory"); SWRITE(0, SE); __syncthreads();
  qkt(pA0, pA1, K_lds, qr, r32, hi); partialSM(pA0, pA1, m_reg, mnA, alA);
  SLOAD(SO, KVBLK); if constexpr (SDEPTH == 2) { if (2 < NT) SLOAD(SE, 2 * KVBLK); }
  SWAIT(); SWRITE(1, SO); __syncthreads();
  for (int j = 1; j + 1 < NT; j += 2) {
    SBAR(); qkt(pB0, pB1, (bf16*)((char*)K_lds + SHM_K), qr, r32, hi);
    finishSM(pA0, pA1, alA, l_reg, pa0, pa1, pa2, pa3); SBAR();
    SLOAD(SO, (j + SDEPTH) * KVBLK); SBAR();
    pv_d0(o, vb0, pa0, pa1, pa2, pa3); partialSM(pB0, pB1, m_reg, mnB, alB);
    __syncthreads(); SWAIT(); SWRITE(0, SE);
    RESC(alB); __syncthreads();
    SBAR(); qkt(pA0, pA1, K_lds, qr, r32, hi);
    finishSM(pB0, pB1, alB, l_reg, pa0, pa1, pa2, pa3); SBAR();
    if (SDEPTH == 1 || j + 3 < NT) SLOAD(SE, (j + 1 + SDEPTH) * KVBLK); SBAR();
    pv_d0(o, vb0 + (int)SHM_V, pa0, pa1, pa2, pa3); partialSM(pA0, pA1, m_reg, mnA, alA);
    __syncthreads(); SWAIT(); SWRITE(1, SO);
    RESC(alA); __syncthreads();
  }
  SBAR(); qkt(pB0, pB1, (bf16*)((char*)K_lds + SHM_K), qr, r32, hi);
  finishSM(pA0, pA1, alA, l_reg, pa0, pa1, pa2, pa3); SBAR();
  pv_d0(o, vb0, pa0, pa1, pa2, pa3); partialSM(pB0, pB1, m_reg, mnB, alB);
  __syncthreads(); RESC(alB);
  finishSM(pB0, pB1, alB, l_reg, pa0, pa1, pa2, pa3); SBAR();
  pv_d0(o, vb0 + (int)SHM_V, pa0, pa1, pa2, pa3);
  if (hi == 0) li_l[r32] = l_reg; asm volatile("s_waitcnt lgkmcnt(0)" ::: "memory");
  float rli[16];
#pragma unroll
  for (int r = 0; r < 16; ++r) rli[r] = __builtin_amdgcn_rcpf(li_l[crow(r, hi)]);
  bf16* Ow = Ob + (long)(wid * QBLK) * LDO;
#pragma unroll
  for (int r = 0; r < 16; ++r) { int orow = crow(r, hi);
    for (int d0 = 0; d0 < 4; ++d0) Ow[(long)orow * LDO + d0 * 32 + r32] = f2bf_s(o[d0][r] * rli[r]); }
#undef SLOAD
#undef SWRITE
#undef SWAIT
#undef RESC
}
#undef KSWZ
#undef SBAR
}
typedef unsigned short bf16_t;
typedef float f32x4 __attribute__((ext_vector_type(4)));
typedef float f32x2 __attribute__((ext_vector_type(2)));
typedef unsigned u32x4 __attribute__((ext_vector_type(4)));
typedef unsigned u32x2 __attribute__((ext_vector_type(2)));
#define LAS __attribute__((address_space(3)))
constexpr int DM = 2048, NTOK = 8192, INC = 5168, PNW = 5376, PLD = 5120, FFD = 8192, NMOD = 12288;
constexpr size_t MiB = 1u << 20;
constexpr size_t WS_CTL = 0, WS_MODS = 1 * MiB, WS_WIN = 2 * MiB, WS_WOUT = 44 * MiB, WS_WFF1 = 60 * MiB, WS_WFF2 = 124 * MiB, WS_H = 188 * MiB, WS_XA = 220 * MiB, WS_XB = 284 * MiB,
    WS_P = 348 * MiB, WS_G = 428 * MiB, WS_QN = 430 * MiB, WS_KB = 446 * MiB, WS_VB = 451 * MiB, WS_LA = 456 * MiB, WS_DQKV = 472 * MiB, WS_GB = 496 * MiB, WS_OG = 497 * MiB, WS_OD = 529 * MiB,
    WS_MIX = 561 * MiB, WS_GQ = 593 * MiB, WS_GO = 601 * MiB, WS_GU = 617 * MiB, WS_GD = 633 * MiB, WS_END = 634 * MiB;
constexpr size_t WS_MC = 188 * MiB, WS_NC = 220 * MiB, WS_QE = 252 * MiB, WS_OL = 268 * MiB;
constexpr size_t WS_QUEUE = 32768;
constexpr size_t WS_RS = 65536;
constexpr size_t WS_BIAS = 1 * MiB + 524288;
constexpr size_t WS_H2 = 348 * MiB;
constexpr size_t ZERO_BYTES = 2 * MiB;
constexpr size_t OUT_Y = 0, OUT_CK = 16777216, OUT_CV = 18874368, OUT_SG = 20971520, OUT_SD = 23068672, OUT_TOTAL = 27262976;
constexpr int LDS_BYTES = 147456;
constexpr float EPS = 1e-6f;

struct Params { const float* in[25]; float* out; unsigned char* ws; };
constexpr int PTAB_OFF = 147456 - 512;
typedef __attribute__((address_space(3))) const unsigned* ptab_t;
__device__ __forceinline__ const void* ldp(ptab_t pt, int i) { unsigned a; asm volatile("v_mov_b32 %0, %1" : "=v"(a) : "s"((unsigned)(unsigned long long)pt + 8u * (unsigned)i));
    const ptab_t q = (ptab_t)(unsigned long long)a; const unsigned lo = __builtin_amdgcn_readfirstlane(q[0]), hi = __builtin_amdgcn_readfirstlane(q[1]); return (const void*)(__attribute__((address_space(1))) const unsigned char*)(((unsigned long long)hi << 32) | lo); }
#define PIN(i) ((const float*)ldp(pt, (i)))
#define POUT ((float*)ldp(pt, 25))
#define PWS ((unsigned char*)ldp(pt, 26))

__device__ __forceinline__ float bf2f(unsigned short v) { return __uint_as_float(((unsigned)v) << 16); }
__device__ __forceinline__ float bflo(unsigned w) { return __uint_as_float(w << 16); }
__device__ __forceinline__ float bfhi(unsigned w) { return __uint_as_float(w & 0xffff0000u); }
__device__ __forceinline__ unsigned short f2bf(float f) { unsigned u = __float_as_uint(f); return (unsigned short)((u + 0x7fffu + ((u >> 16) & 1u)) >> 16); }
typedef __bf16 bf16x2_hw __attribute__((ext_vector_type(2)));
__device__ __forceinline__ unsigned pk2(float lo, float hi) { const f32x2 v = {lo, hi}; return __builtin_bit_cast(unsigned, __builtin_convertvector(v, bf16x2_hw)); }
__device__ __forceinline__ float wave_sum(float v) {
#pragma unroll
    for (int o = 1; o < 64; o <<= 1) v += __shfl_xor(v, o);
    return v;
}
template <int N> __device__ __forceinline__ void wave_sum_n(float (&v)[N]) {
#pragma unroll
    for (int o = 1; o < 64; o <<= 1) {
        float t[N];
#pragma unroll
        for (int i = 0; i < N; ++i) t[i] = __shfl_xor(v[i], o);
#pragma unroll
        for (int i = 0; i < N; ++i) v[i] += t[i];
    }
}
__device__ __forceinline__ float silu_f(float x) { return x * __builtin_amdgcn_rcpf(1.f + __expf(-x)); }
__device__ __forceinline__ float softplus_f(float x) { return fmaxf(x, 0.f) + __logf(1.f + __expf(-fabsf(x))); }
__device__ __forceinline__ float logsigmoid_f(float x) { return fminf(x, 0.f) - __logf(1.f + __expf(-fabsf(x))); }
#define LDS_WAIT() asm volatile("s_waitcnt lgkmcnt(0)" ::: "memory")
#define LDS_BARRIER() do { asm volatile("s_waitcnt lgkmcnt(0)" ::: "memory"); __builtin_amdgcn_s_barrier(); asm volatile("" ::: "memory"); } while (0)
__device__ __forceinline__ int tid_opaque() { int t = threadIdx.x; asm volatile("" : "+v"(t)); return t; }

template <int MODE  >
__device__ __forceinline__ void transpose_item(const float* W, int ldw, int o0, int K, bf16_t* WT, int n0, int k0, LAS float* scr, int lane) {
    const int krow = lane >> 4, n4 = (lane & 15) * 4;
    if (MODE == 0) {
        f32x4 v[16];
#pragma unroll
        for (int i = 0; i < 16; ++i) v[i] = *(const f32x4*)(W + (size_t)(k0 + 4 * i + krow) * ldw + o0 + n4);
#pragma unroll
        for (int i = 0; i < 16; ++i) { LAS float* s = scr + (4 * i + krow) * 65 + n4; s[0] = v[i].x; s[1] = v[i].y; s[2] = v[i].z; s[3] = v[i].w; }
    } else {
#pragma unroll 4
        for (int i = 0; i < 16; ++i) { LAS float* s = scr + (4 * i + krow) * 65 + n4;
#pragma unroll
            for (int e = 0; e < 4; ++e) { const int c = n4 + e; float x = 0.f;
                if (MODE == 1 && c < 48) x = W[(size_t)(k0 + 4 * i + krow) * ldw + (c < 32 ? 1536 + c : 5152 + (c - 32))];
                s[e] = x; } }
    }
    LDS_WAIT(); asm volatile("" ::: "memory");
    const int c8 = lane & 7;
#pragma unroll
    for (int j = 0; j < 8; ++j) { const int n = (lane >> 3) + 8 * j; const LAS float* s = scr + (8 * c8) * 65 + n;
        u32x4 o; o.x = pk2(s[0 * 65], s[1 * 65]); o.y = pk2(s[2 * 65], s[3 * 65]); o.z = pk2(s[4 * 65], s[5 * 65]); o.w = pk2(s[6 * 65], s[7 * 65]);
        *(u32x4*)(WT + (size_t)(n0 + n) * K + k0 + 8 * c8) = o; }
    LDS_WAIT(); asm volatile("" ::: "memory");
}
constexpr int TI_IN = 32 * 84, TI_OUT = 32 * 32, TI_F1 = 32 * 128, TI_F2 = 128 * 32, TI_L = TI_IN + TI_OUT + TI_F1 + TI_F2;
__device__ __forceinline__ void do_transposes(ptab_t pt, LAS unsigned char* lds, int first, int count, int worker, int n_workers) {
    const int tid = tid_opaque(), lane = tid & 63, wave = __builtin_amdgcn_readfirstlane(tid >> 6);
    unsigned char* ws = PWS;
    LAS float* scr = (LAS float*)(lds + wave * 16640);
    for (int it = first + worker; it < first + count; it += n_workers) {
        const int l = it / TI_L; int r = it - l * TI_L;
        const float* W; bf16_t* WT; int ldw, K, kb, nbk, o0, mode = 0;
        if (r < TI_IN) { kb = r / 84; nbk = r % 84; const int n0 = 64 * nbk; W = PIN(12) + (size_t)l * 2048 * INC; WT = (bf16_t*)(ws + WS_WIN) + (size_t)l * PNW * 2048; ldw = INC; K = 2048;
            o0 = n0 < 1536 ? n0 : n0 + 32; mode = n0 < 5120 ? 0 : (n0 == 5120 ? 1 : 2); }
        else if ((r -= TI_IN) < TI_OUT) { kb = r / 32; nbk = r % 32; W = PIN(22) + (size_t)l * 2048 * 2048; WT = (bf16_t*)(ws + WS_WOUT) + (size_t)l * 2048 * 2048; ldw = 2048; K = 2048; o0 = 64 * nbk; }
        else if ((r -= TI_OUT) < TI_F1) { kb = r / 128; nbk = r % 128; W = PIN(23) + (size_t)l * 2048 * 8192; WT = (bf16_t*)(ws + WS_WFF1) + (size_t)l * 8192 * 2048; ldw = 8192; K = 2048; o0 = 64 * nbk; }
        else { r -= TI_F1; kb = r / 32; nbk = r % 32; W = PIN(24) + (size_t)l * 8192 * 2048; WT = (bf16_t*)(ws + WS_WFF2) + (size_t)l * 2048 * 8192; ldw = 2048; K = 8192; o0 = 64 * nbk; }
        if (mode == 0) transpose_item<0>(W, ldw, o0, K, WT, 64 * nbk, 64 * kb, scr, lane);
        else if (mode == 1) transpose_item<1>(W, ldw, o0, K, WT, 64 * nbk, 64 * kb, scr, lane);
        else transpose_item<2>(W, ldw, o0, K, WT, 64 * nbk, 64 * kb, scr, lane);
    }
}
__device__ __forceinline__ void p0_prologue(ptab_t pt, LAS unsigned char* lds, int bid, int nb, bool do_mods) {
    const int tid = tid_opaque(), lane = tid & 63, wave = __builtin_amdgcn_readfirstlane(tid >> 6);
    unsigned char* ws = PWS;
    do_transposes(pt, lds, 0, TI_L, bid * 8 + wave, nb * 8);
    do_transposes(pt, lds, TI_L + TI_IN + TI_OUT + TI_F1, TI_F2 / 3, bid * 8 + wave, nb * 8);
    __syncthreads();
    if (do_mods) {
        LAS float* sc = (LAS float*)lds;
        LAS float* red = (LAS float*)(lds + 40960);
        float* mods = (float*)(ws + WS_MODS);
        for (int idx = tid; idx < 5 * 2048; idx += 512) { const int j = idx >> 11, k = idx & 2047; const float cv = (j == 0) ? PIN(7)[k] : PIN(6)[(j - 1) * 2048 + k]; sc[idx] = silu_f(cv); }
        __syncthreads();
        const bool act = lane < 48; const int half = act ? lane / 24 : 0, c4 = act ? (lane % 24) * 4 : 0;
        for (int it = bid; it < 256; it += nb) {
            const int l = it >> 7, nc = it & 127;
            const float* Wp = PIN(10) + ((size_t)l * 2048 + wave * 256 + half) * NMOD + nc * 96 + c4;
            f32x4 acc[5];
#pragma unroll
            for (int j = 0; j < 5; ++j) acc[j] = (f32x4){0.f, 0.f, 0.f, 0.f};
#pragma unroll 8
            for (int i = 0; i < 128; ++i) { const f32x4 w = *(const f32x4*)(Wp + (size_t)(2 * i) * NMOD); const int row = wave * 256 + 2 * i + half;
#pragma unroll
                for (int j = 0; j < 5; ++j) acc[j] += sc[j * 2048 + row] * w; }
            if (act) {
#pragma unroll
                for (int j = 0; j < 5; ++j) *(LAS f32x4*)(red + ((wave * 2 + half) * 5 + j) * 96 + c4) = acc[j]; }
            __syncthreads();
            if (tid < 480) { const int j = tid / 96, col = tid % 96; float s = PIN(11)[(size_t)l * NMOD + nc * 96 + col];
#pragma unroll
                for (int g = 0; g < 16; ++g) s += red[(g * 5 + j) * 96 + col];
                mods[((size_t)l * 5 + j) * NMOD + nc * 96 + col] = s; }
            __syncthreads();
        }
    }
}

__device__ __forceinline__ void norm_phase(const float* x0, const float* x1, const float* g, const float* mods_l, int shift_i, int scale_i, bf16_t* H, int bid, int nb) {
    const int tid = tid_opaque(), lane = tid & 63, wave = tid >> 6;
    constexpr int NR = 4; const int qrows = NTOK / NR;
    for (int r0 = bid * 8 + wave; r0 < qrows; r0 += nb * 8) {
        f32x4 v[NR][8]; float ss[NR];
#pragma unroll
        for (int u = 0; u < NR; ++u) { const int r = r0 + u * qrows; const float* xr = (r < 4096 ? x0 : x1) + (size_t)r * DM;
#pragma unroll
            for (int j = 0; j < 8; ++j) v[u][j] = *(const f32x4*)(xr + 4 * (lane + 64 * j)); }
#pragma unroll
        for (int u = 0; u < NR; ++u) { ss[u] = 0.f;
#pragma unroll
            for (int j = 0; j < 8; ++j) ss[u] += (v[u][j].x * v[u][j].x + v[u][j].y * v[u][j].y) + (v[u][j].z * v[u][j].z + v[u][j].w * v[u][j].w); }
        wave_sum_n<NR>(ss);
#pragma unroll
        for (int u = 0; u < NR; ++u) { const int r = r0 + u * qrows; const float rstd = rsqrtf(ss[u] * (1.f / DM) + EPS);
            const int cond = r < 4096 ? 0 : 1 + ((r - 4096) >> 10);
            const float* sh = mods_l + ((size_t)cond * 6 + shift_i) * DM; const float* sc = mods_l + ((size_t)cond * 6 + scale_i) * DM;
#pragma unroll
            for (int j = 0; j < 8; ++j) { const int col = 4 * (lane + 64 * j); const f32x4 gg = *(const f32x4*)(g + col), s = *(const f32x4*)(sc + col), h = *(const f32x4*)(sh + col);
                const f32x4 o = v[u][j] * rstd * gg * (s + 1.f) + h; u32x2 w; w.x = pk2(o.x, o.y); w.y = pk2(o.z, o.w); *(u32x2*)(H + (size_t)r * DM + col) = w; } }
    }
}

__device__ __forceinline__ void bias_phase(const float* shift  , const bf16_t* WT, int N, float* out  , LAS unsigned char* lds, int bid, int nb) {
    const int tid = tid_opaque(), lane = tid & 63, wave = tid >> 6;
    LAS float* sh = (LAS float*)(lds + 65536);
    for (int idx = tid; idx < 5 * 2048; idx += 512) sh[idx] = shift[(size_t)(idx >> 11) * 6 * 2048 + (idx & 2047)];
    __syncthreads();
    const int NGW = nb * 8;
    for (int n0 = bid * 8 + wave; n0 < N; n0 += 2 * NGW) {
        u32x4 w[2][4]; float a[2][5];
#pragma unroll
        for (int u = 0; u < 2; ++u) { const int n = n0 + u * NGW < N ? n0 + u * NGW : n0; const bf16_t* row = WT + (size_t)n * 2048;
#pragma unroll
            for (int j = 0; j < 4; ++j) w[u][j] = *(const u32x4*)(row + (j * 64 + lane) * 8);
#pragma unroll
            for (int c = 0; c < 5; ++c) a[u][c] = 0.f; }
#pragma unroll
        for (int j = 0; j < 4; ++j) { const int k0 = (j * 64 + lane) * 8;
#pragma unroll
            for (int c = 0; c < 5; ++c) { const f32x4 s0 = *(const LAS f32x4*)(sh + c * 2048 + k0), s1 = *(const LAS f32x4*)(sh + c * 2048 + k0 + 4);
#pragma unroll
                for (int u = 0; u < 2; ++u) { const u32x4 ww = w[u][j];
                    a[u][c] += (bflo(ww.x) * s0.x + bfhi(ww.x) * s0.y) + (bflo(ww.y) * s0.z + bfhi(ww.y) * s0.w) + (bflo(ww.z) * s1.x + bfhi(ww.z) * s1.y) + (bflo(ww.w) * s1.z + bfhi(ww.w) * s1.w); } } }
        float f[10];
#pragma unroll
        for (int u = 0; u < 2; ++u)
#pragma unroll
            for (int c = 0; c < 5; ++c) f[u * 5 + c] = a[u][c];
        wave_sum_n<10>(f);
#pragma unroll
        for (int u = 0; u < 2; ++u) { const int n = n0 + u * NGW;
            if (n < N && lane < 5) out[(size_t)lane * N + n] = lane == 0 ? f[u * 5] : (lane == 1 ? f[u * 5 + 1] : (lane == 2 ? f[u * 5 + 2] : (lane == 3 ? f[u * 5 + 3] : f[u * 5 + 4]))); }
    }
    __syncthreads();
}

struct PrepPtrs { const bf16_t* P; const float* G; bf16_t* QN; bf16_t* KB; bf16_t* VB; float* LA; bf16_t* DQKV; float* GB; float* out_ck; float* out_cv; const float* cw; const float* alog; const float* dtb; };
template <bool LAT, int NT>
__device__ __forceinline__ void prep_tok(const int (&r)[NT], int l, int lane, const PrepPtrs& pp, const LAS float* w2s, f32x2 qg, f32x2 kg, float inv0, float inv1) {
    int bq[NT], tq[NT]; const bf16_t* Pr[NT];
#pragma unroll
    for (int u = 0; u < NT; ++u) { const int rr = LAT ? r[u] - 4096 : r[u]; bq[u] = LAT ? rr >> 10 : rr >> 8; tq[u] = LAT ? rr & 1023 : rr & 255; Pr[u] = pp.P + (size_t)r[u] * PLD; }
    const int L = LAT ? 1024 : 256;
    float c0[NT], s0[NT], c1[NT], s1[NT];
    const float sgn = (lane & 16) ? 1.f : -1.f;
#pragma unroll
    for (int u = 0; u < NT; ++u) { const float pos = (float)(lane < 32 ? tq[u] >> 6 : tq[u] & 63); const float a0 = pos * inv0, a1 = pos * inv1;
        c0[u] = LAT ? __cosf(a0) : 1.f; s0[u] = LAT ? __sinf(a0) : 0.f; c1[u] = LAT ? __cosf(a1) : 1.f; s1[u] = LAT ? __sinf(a1) : 0.f; }
    {
        unsigned xw[NT][10], vw[NT][2];
#pragma unroll
        for (int u = 0; u < NT; ++u) {
#pragma unroll
            for (int h = 0; h < 10; ++h) xw[u][h] = *(const unsigned*)(Pr[u] + 1536 + h * 128 + 2 * lane);
#pragma unroll
            for (int h = 0; h < 2; ++h) vw[u][h] = *(const unsigned*)(Pr[u] + 2816 + h * 128 + 2 * lane); }
        float ss[NT * 10];
#pragma unroll
        for (int u = 0; u < NT; ++u)
#pragma unroll
            for (int h = 0; h < 10; ++h) { const float x0 = bflo(xw[u][h]), x1 = bfhi(xw[u][h]); ss[u * 10 + h] = x0 * x0 + x1 * x1; }
        wave_sum_n<NT * 10>(ss);
        float y0[NT * 10], y1[NT * 10];
#pragma unroll
        for (int u = 0; u < NT; ++u)
#pragma unroll
            for (int h = 0; h < 10; ++h) { const float rstd = rsqrtf(ss[u * 10 + h] * (1.f / 128.f) + EPS); const f32x2 g = h < 8 ? qg : kg;
                y0[u * 10 + h] = bflo(xw[u][h]) * rstd * g.x; y1[u * 10 + h] = bfhi(xw[u][h]) * rstd * g.y; }
        if (!LAT) {
#pragma unroll
            for (int u = 0; u < NT; ++u)
#pragma unroll
                for (int hk = 0; hk < 2; ++hk) { const size_t o = ((((size_t)bq[u] * 2 + l) * 256 + tq[u]) * 2 + hk) * 128 + 2 * lane;
                    *(f32x2*)(pp.out_ck + o) = (f32x2){y0[u * 10 + 8 + hk], y1[u * 10 + 8 + hk]}; *(f32x2*)(pp.out_cv + o) = (f32x2){bflo(vw[u][hk]), bfhi(vw[u][hk])}; }
        } else {
            float p0[NT * 10], p1[NT * 10];
#pragma unroll
            for (int i = 0; i < NT * 10; ++i) { p0[i] = __shfl_xor(y0[i], 16); p1[i] = __shfl_xor(y1[i], 16); }
#pragma unroll
            for (int u = 0; u < NT; ++u)
#pragma unroll
                for (int h = 0; h < 10; ++h) { const int i = u * 10 + h; const float n0 = y0[i] * c0[u] + sgn * p0[i] * s0[u], n1 = y1[i] * c1[u] + sgn * p1[i] * s1[u]; y0[i] = n0; y1[i] = n1; }
        }
#pragma unroll
        for (int u = 0; u < NT; ++u) {
#pragma unroll
            for (int h = 0; h < 8; ++h) *(unsigned*)(pp.QN + (size_t)r[u] * 1024 + h * 128 + 2 * lane) = pk2(y0[u * 10 + h], y1[u * 10 + h]);
            const size_t krow = LAT ? ((size_t)4096 + (size_t)bq[u] * 1280 + 256 + tq[u]) : (size_t)r[u];
#pragma unroll
            for (int hk = 0; hk < 2; ++hk) { *(unsigned*)(pp.KB + krow * 256 + hk * 128 + 2 * lane) = pk2(y0[u * 10 + 8 + hk], y1[u * 10 + 8 + hk]); *(unsigned*)(pp.VB + krow * 256 + hk * 128 + 2 * lane) = vw[u][hk]; } }
    }
#pragma unroll
    for (int d = 0; d < 2; ++d) {
        float lr[NT][16];
#pragma unroll
        for (int u = 0; u < NT; ++u)
#pragma unroll
            for (int j = 0; j < 4; ++j) { const f32x4 t4 = *(const f32x4*)(pp.G + (size_t)r[u] * 64 + d * 16 + 4 * j); lr[u][4 * j] = t4.x; lr[u][4 * j + 1] = t4.y; lr[u][4 * j + 2] = t4.z; lr[u][4 * j + 3] = t4.w; }
#pragma unroll
        for (int jj = 0; jj < 4; ++jj) { const int n = lane + 64 * jj; float a[NT]; const float b0 = w2s[8192 + d * 256 + n];
#pragma unroll
            for (int u = 0; u < NT; ++u) a[u] = b0;
#pragma unroll
            for (int q = 0; q < 16; ++q) { const float w = w2s[(d * 16 + q) * 256 + n];
#pragma unroll
                for (int u = 0; u < NT; ++u) a[u] += lr[u][q] * w; }
#pragma unroll
            for (int u = 0; u < NT; ++u) pp.LA[(size_t)r[u] * 512 + d * 256 + n] = logsigmoid_f(a[u]) * (1.f / 16.f); }
    }
    {
        float ym[NT], yp[NT];
        const bf16_t* Pm[NT]; const bf16_t* Pp[NT];
#pragma unroll
        for (int u = 0; u < NT; ++u) { ym[u] = tq[u] > 0 ? 1.f : 0.f; yp[u] = tq[u] < L - 1 ? 1.f : 0.f; Pm[u] = tq[u] > 0 ? Pr[u] - PLD : Pr[u]; Pp[u] = tq[u] < L - 1 ? Pr[u] + PLD : Pr[u]; }
#pragma unroll
        for (int g4 = 0; g4 < 3; ++g4) {
            float y0[NT * 4], y1[NT * 4], ss[NT * 4];
#pragma unroll
            for (int bb = 0; bb < 4; ++bb) { const int c = (g4 * 4 + bb) * 128 + 2 * lane;
                const f32x2 w0 = *(const f32x2*)(pp.cw + c), w1 = *(const f32x2*)(pp.cw + 1536 + c), w2 = *(const f32x2*)(pp.cw + 3072 + c);
#pragma unroll
                for (int u = 0; u < NT; ++u) { const unsigned xm = *(const unsigned*)(Pm[u] + 3072 + c), xc = *(const unsigned*)(Pr[u] + 3072 + c), xp = *(const unsigned*)(Pp[u] + 3072 + c);
                    const float a0 = silu_f(w0.x * bflo(xm) * ym[u] + w1.x * bflo(xc) + w2.x * bflo(xp) * yp[u]), a1 = silu_f(w0.y * bfhi(xm) * ym[u] + w1.y * bfhi(xc) + w2.y * bfhi(xp) * yp[u]);
                    y0[u * 4 + bb] = a0; y1[u * 4 + bb] = a1; ss[u * 4 + bb] = a0 * a0 + a1 * a1; } }
            if (g4 < 2) { wave_sum_n<NT * 4>(ss);
#pragma unroll
                for (int i = 0; i < NT * 4; ++i) { const float sc = rsqrtf(ss[i] + EPS) * (g4 == 0 ? 0.08838834764831845f : 1.f); y0[i] *= sc; y1[i] *= sc; } }
#pragma unroll
            for (int u = 0; u < NT; ++u)
#pragma unroll
                for (int bb = 0; bb < 4; ++bb) *(unsigned*)(pp.DQKV + (size_t)r[u] * 1536 + (g4 * 4 + bb) * 128 + 2 * lane) = pk2(y0[u * 4 + bb], y1[u * 4 + bb]);
        }
    }
    if (lane < 8) {
#pragma unroll
        for (int u = 0; u < NT; ++u) { const float a = pp.G[(size_t)r[u] * 64 + 32 + lane], bb = pp.G[(size_t)r[u] * 64 + 40 + lane];
            pp.GB[(size_t)r[u] * 16 + lane] = -__expf(pp.alog[l * 8 + lane]) * softplus_f(a + pp.dtb[l * 8 + lane]); pp.GB[(size_t)r[u] * 16 + 8 + lane] = 1.f / (1.f + __expf(-bb)); } }
}
__device__ __forceinline__ void prep_phase(ptab_t pt, int l, LAS unsigned char* lds, int bid, int nb) {
    const int tid = tid_opaque(), lane = tid & 63, wave = tid >> 6;
    unsigned char* ws = PWS;
    PrepPtrs pp; pp.P = (const bf16_t*)(ws + WS_P); pp.G = (const float*)(ws + WS_G); pp.QN = (bf16_t*)(ws + WS_QN); pp.KB = (bf16_t*)(ws + WS_KB); pp.VB = (bf16_t*)(ws + WS_VB);
    pp.LA = (float*)(ws + WS_LA); pp.DQKV = (bf16_t*)(ws + WS_DQKV); pp.GB = (float*)(ws + WS_GB); pp.out_ck = POUT + OUT_CK; pp.out_cv = POUT + OUT_CV;
    pp.cw = PIN(18) + (size_t)l * 3 * 1536; pp.alog = PIN(19); pp.dtb = PIN(20);
    LAS float* w2s = (LAS float*)lds;
    for (int i = tid; i < 8192; i += 512) w2s[i] = PIN(13)[(size_t)l * 8192 + i];
    for (int i = tid; i < 512; i += 512) w2s[8192 + i] = PIN(14)[(size_t)l * 512 + i];
    __syncthreads();
    const f32x2 qg = *(const f32x2*)(PIN(16) + l * 128 + 2 * lane), kg = *(const f32x2*)(PIN(17) + l * 128 + 2 * lane);
    const float inv0 = exp2f(-(float)((2 * lane) & 31) * (13.287712379549449f / 32.f)), inv1 = exp2f(-(float)((2 * lane + 1) & 31) * (13.287712379549449f / 32.f));
    const int gw = bid * 8 + wave, NGW = nb * 8;
    for (int r = gw; r < 2048; r += NGW) { const int rc[2] = {r, r + 2048}; prep_tok<false, 2>(rc, l, lane, pp, w2s, qg, kg, inv0, inv1);
        const int rl[2] = {4096 + r, 4096 + r + 2048}; prep_tok<true, 2>(rl, l, lane, pp, w2s, qg, kg, inv0, inv1); }
    for (int i = bid * 512 + tid; i < 65536; i += nb * 512) { const int b = i >> 14, rem = i & 16383, pq = rem >> 6, c4 = rem & 63;
        const size_t srcx = (((size_t)b * 2 + l) * 256 + pq) * 256 + c4 * 4, dst = ((size_t)4096 + (size_t)b * 1280 + pq) * 256 + c4 * 4;
        const f32x4 k4 = *(const f32x4*)(PIN(2) + srcx), v4 = *(const f32x4*)(PIN(3) + srcx);
        u32x2 kw, vw; kw.x = pk2(k4.x, k4.y); kw.y = pk2(k4.z, k4.w); vw.x = pk2(v4.x, v4.y); vw.y = pk2(v4.z, v4.w);
        *(u32x2*)(pp.KB + dst) = kw; *(u32x2*)(pp.VB + dst) = vw; }
}

__device__ __forceinline__ void gla_naive_item(ptab_t pt, int l, bool lat, int b, int h, int d, LAS float* red) {
    const int tid = tid_opaque(), vq = tid & 127, kg = tid >> 7;
    unsigned char* ws = PWS;
    const bf16_t* P = (const bf16_t*)(ws + WS_P); const float* LA = (const float*)(ws + WS_LA); float* OG = (float*)(ws + WS_OG);
    const int L = lat ? 1024 : 256, rowbase = lat ? 4096 + b * 1024 : b * 256;
    float S[16];
    const size_t sidx = ((((size_t)b * 2 + l) * 2 + d) * 4 + h) * 8192 + (size_t)(kg * 16) * 128 + vq;
#pragma unroll
    for (int j = 0; j < 16; ++j) S[j] = lat ? PIN(4)[sidx + j * 128] : 0.f;
    f32x4 la[4], nla[4]; u32x4 kq[4], nkq[4]; unsigned short vv, nvv;
#define GLA_LOAD(LAv, KQv, Vv, step) do { const int t_ = d ? L - 1 - (step) : (step); const size_t r_ = (size_t)(rowbase + t_); \
        const float* lp_ = LA + r_ * 512 + d * 256 + h * 64 + kg * 16; const bf16_t* pr_ = P + r_ * PLD; \
        _Pragma("unroll") for (int j_ = 0; j_ < 4; ++j_) LAv[j_] = *(const f32x4*)(lp_ + 4 * j_); \
        KQv[0] = *(const u32x4*)(pr_ + 256 + h * 64 + kg * 16); KQv[1] = *(const u32x4*)(pr_ + 256 + h * 64 + kg * 16 + 8); \
        KQv[2] = *(const u32x4*)(pr_ + h * 64 + kg * 16); KQv[3] = *(const u32x4*)(pr_ + h * 64 + kg * 16 + 8); Vv = pr_[512 + h * 128 + vq]; } while (0)
    GLA_LOAD(la, kq, vv, 0);
    for (int step = 0; step < L; ++step) {
        const int sn = step + 1 < L ? step + 1 : step;
        GLA_LOAD(nla, nkq, nvv, sn);
        const float v = bf2f(vv); float part = 0.f;
#pragma unroll
        for (int j = 0; j < 16; ++j) { const unsigned kw = kq[j >> 3][(j >> 1) & 3], qw = kq[2 + (j >> 3)][(j >> 1) & 3];
            const float kk = (j & 1) ? bfhi(kw) : bflo(kw), qq = (j & 1) ? bfhi(qw) : bflo(qw);
            S[j] = __expf(la[j >> 2][j & 3]) * S[j] + kk * v; part += S[j] * qq; }
        red[((step & 1) * 4 + kg) * 128 + vq] = part * 0.125f;
        __syncthreads();
        if (kg == 0) { const LAS float* rp = red + (step & 1) * 512 + vq; const int t = d ? L - 1 - step : step;
            OG[((size_t)d * NTOK + rowbase + t) * 512 + h * 128 + vq] = (rp[0] + rp[128]) + (rp[256] + rp[384]); }
#pragma unroll
        for (int j = 0; j < 4; ++j) { la[j] = nla[j]; kq[j] = nkq[j]; } vv = nvv;
    }
#undef GLA_LOAD
    if (!lat) {
#pragma unroll
        for (int j = 0; j < 16; ++j) POUT[OUT_SG + sidx + j * 128] = S[j]; }
    __syncthreads();
}
__device__ __forceinline__ void dn_naive_item(ptab_t pt, int l, bool lat, int b, int h, int d, LAS float* red) {
    const int tid = tid_opaque(), vq = tid & 127, kg = tid >> 7;
    unsigned char* ws = PWS;
    const bf16_t* DQKV = (const bf16_t*)(ws + WS_DQKV); const float* GB = (const float*)(ws + WS_GB); float* OD = (float*)(ws + WS_OD);
    const int L = lat ? 1024 : 256, rowbase = lat ? 4096 + b * 1024 : b * 256;
    LAS float* redR = red; LAS float* redO = red + 1024;
    float S[32];
    const size_t sidx = ((((size_t)b * 2 + l) * 2 + d) * 4 + h) * 16384 + (size_t)(kg * 32) * 128 + vq;
#pragma unroll
    for (int j = 0; j < 32; ++j) S[j] = lat ? PIN(5)[sidx + j * 128] : 0.f;
    u32x4 kq[8], nkq[8]; unsigned short vv, nvv; float gg, ngg, be, nbe;
#define DN_LOAD(KQv, Vv, Gv, Bv, step) do { const int t_ = d ? L - 1 - (step) : (step); const size_t r_ = (size_t)(rowbase + t_); const bf16_t* pr_ = DQKV + r_ * 1536; \
        _Pragma("unroll") for (int j_ = 0; j_ < 4; ++j_) { KQv[j_] = *(const u32x4*)(pr_ + 512 + h * 128 + kg * 32 + 8 * j_); KQv[4 + j_] = *(const u32x4*)(pr_ + h * 128 + kg * 32 + 8 * j_); } \
        Vv = pr_[1024 + h * 128 + vq]; Gv = GB[r_ * 16 + d * 4 + h]; Bv = GB[r_ * 16 + 8 + d * 4 + h]; } while (0)
    DN_LOAD(kq, vv, gg, be, 0);
    for (int step = 0; step < L; ++step) {
        const int sn = step + 1 < L ? step + 1 : step;
        DN_LOAD(nkq, nvv, ngg, nbe, sn);
        float kf[32], rp = 0.f;
#pragma unroll
        for (int j = 0; j < 32; ++j) { const unsigned kw = kq[j >> 3][(j >> 1) & 3]; kf[j] = (j & 1) ? bfhi(kw) : bflo(kw); rp += kf[j] * S[j]; }
        redR[((step & 1) * 4 + kg) * 128 + vq] = rp;
        __syncthreads();
        if (step > 0 && kg == 0) { const LAS float* op = redO + ((step - 1) & 1) * 512 + vq; const int t = d ? L - step : step - 1;
            OD[((size_t)d * NTOK + rowbase + t) * 512 + h * 128 + vq] = (op[0] + op[128]) + (op[256] + op[384]); }
        const LAS float* rr = redR + (step & 1) * 512 + vq;
        const float rs = (rr[0] + rr[128]) + (rr[256] + rr[384]);
        const float eg = __expf(gg), w = be * (bf2f(vv) - eg * rs);
        float op = 0.f;
#pragma unroll
        for (int j = 0; j < 32; ++j) { const unsigned qw = kq[4 + (j >> 3)][(j >> 1) & 3]; const float qq = (j & 1) ? bfhi(qw) : bflo(qw);
            S[j] = eg * S[j] + kf[j] * w; op += qq * S[j]; }
        redO[((step & 1) * 4 + kg) * 128 + vq] = op;
#pragma unroll
        for (int j = 0; j < 8; ++j) kq[j] = nkq[j];
        vv = nvv; gg = ngg; be = nbe;
    }
#undef DN_LOAD
    __syncthreads();
    if (kg == 0) { const LAS float* op = redO + ((L - 1) & 1) * 512 + vq; const int t = d ? 0 : L - 1;
        OD[((size_t)d * NTOK + rowbase + t) * 512 + h * 128 + vq] = (op[0] + op[128]) + (op[256] + op[384]); }
    if (!lat) {
#pragma unroll
        for (int j = 0; j < 32; ++j) POUT[OUT_SD + sidx + j * 128] = S[j]; }
    __syncthreads();
}

typedef short bf16x8 __attribute__((ext_vector_type(8)));
typedef float f32x16 __attribute__((ext_vector_type(16)));
__device__ __forceinline__ int crow(int r, int hi) { return (r & 3) + 8 * (r >> 2) + 4 * hi; }
template <int K>
__device__ __forceinline__ f32x16 mm_tile(const LAS bf16_t* A, int lda, const LAS bf16_t* Bt, int ldb, int tm, int tn, int lane, f32x16 acc) {
    const int r32 = lane & 31, hi = lane >> 5;
    const LAS bf16_t* ap = A + (tm * 32 + r32) * lda + hi * 8; const LAS bf16_t* bp = Bt + (tn * 32 + r32) * ldb + hi * 8;
#pragma unroll
    for (int k0 = 0; k0 < K; k0 += 16) { const bf16x8 a = *(const LAS bf16x8*)(ap + k0), b = *(const LAS bf16x8*)(bp + k0); acc = __builtin_amdgcn_mfma_f32_32x32x16_bf16(a, b, acc, 0, 0, 0); }
    return acc;
}
template <int K>
__device__ __forceinline__ f32x16 mm_tile_ga(const bf16_t* A, int lda, const LAS bf16_t* Bt, int ldb, int tm, int tn, int lane, f32x16 acc) {
    const int r32 = lane & 31, hi = lane >> 5;
    const bf16_t* ap = A + (size_t)(tm * 32 + r32) * lda + hi * 8; const LAS bf16_t* bp = Bt + (tn * 32 + r32) * ldb + hi * 8;
    bf16x8 a[K / 16];
#pragma unroll
    for (int k = 0; k < K / 16; ++k) a[k] = *(const bf16x8*)(ap + 16 * k);
#pragma unroll
    for (int k = 0; k < K / 16; ++k) { const bf16x8 b = *(const LAS bf16x8*)(bp + 16 * k); acc = __builtin_amdgcn_mfma_f32_32x32x16_bf16(a[k], b, acc, 0, 0, 0); }
    return acc;
}
__device__ __forceinline__ void acc_store_pk(unsigned* dst, const f32x16& acc, int lane) {
#pragma unroll
    for (int r2 = 0; r2 < 8; ++r2) dst[r2 * 64 + lane] = pk2(acc[2 * r2], acc[2 * r2 + 1]);
}
__device__ __forceinline__ void acc_load_pk(const unsigned* src, unsigned (&w)[8], int lane) {
#pragma unroll
    for (int r2 = 0; r2 < 8; ++r2) w[r2] = src[r2 * 64 + lane];
}
__device__ __forceinline__ void acc_to_ST(LAS bf16_t* ST, int ld, int row0, int col0, const f32x16& s, int lane) {
    const int r32 = lane & 31, hi = lane >> 5;
#pragma unroll
    for (int g = 0; g < 4; ++g) { u32x2 w; w.x = pk2(s[4 * g], s[4 * g + 1]); w.y = pk2(s[4 * g + 2], s[4 * g + 3]);
        *(LAS u32x2*)(ST + (col0 + r32) * ld + row0 + 8 * g + 4 * hi) = w; }
}
__device__ __forceinline__ void store_o_tile_pk(unsigned* dst, const f32x16& o, long long row0, int st, int col0  , int lane) {
    const int odd = lane & 1; long long wb = row0 * 256 + ((col0 + (lane & 31)) >> 1);
    asm volatile("" : "+v"(wb));
#pragma unroll
    for (int r2 = 0; r2 < 8; ++r2) { const float send = odd ? o[2 * r2] : o[2 * r2 + 1]; const float recv = __shfl_xor(send, 1);
        const unsigned w = odd ? pk2(recv, o[2 * r2 + 1]) : pk2(o[2 * r2], recv);
        const int r = 2 * r2 + odd; dst[wb + (long long)st * 256 * ((r & 3) + 8 * (r >> 2))] = w; }
}
constexpr int N_CH_UNITS = 1024;
struct UnitPre { u32x4 r[6]; float f[2]; };
__device__ __forceinline__ void unit_geom(int unit, int& d, int& h, bool& lat, int& c, int& L, int& rowbase) {
    d = unit & 1; h = (unit >> 1) & 3; const int slot = unit >> 3; lat = slot >= 64; const int b = lat ? (slot - 64) >> 4 : slot >> 2; c = lat ? (slot - 64) & 15 : slot & 3;
    L = lat ? 1024 : 256; rowbase = lat ? 4096 + b * 1024 : b * 256;
}
__device__ __forceinline__ void gla_unit_load(ptab_t pt, int unit, UnitPre& p) {
    const int tid = tid_opaque(); unsigned char* ws = PWS; const bf16_t* P = (const bf16_t*)(ws + WS_P); const float* LA = (const float*)(ws + WS_LA);
    int d, h, c, L, rowbase; bool lat; unit_geom(unit, d, h, lat, c, L, rowbase);
#pragma unroll
    for (int q = 0; q < 2; ++q) { const int idx = tid + 512 * q, i = idx >> 4, c4 = idx & 15; const int s = c * 64 + i, t = d ? L - 1 - s : s;
        p.r[q] = *(const u32x4*)(LA + (size_t)(rowbase + t) * 512 + d * 256 + h * 64 + c4 * 4); }
    { const int i = tid >> 3, k0 = (tid & 7) * 8, v0 = (tid & 7) * 16; const int s = c * 64 + i, t = d ? L - 1 - s : s; const bf16_t* Pr = P + (size_t)(rowbase + t) * PLD;
      p.r[2] = *(const u32x4*)(Pr + h * 64 + k0); p.r[3] = *(const u32x4*)(Pr + 256 + h * 64 + k0); p.r[4] = *(const u32x4*)(Pr + 512 + h * 128 + v0); p.r[5] = *(const u32x4*)(Pr + 512 + h * 128 + v0 + 8); }
    p.f[0] = 0.f; p.f[1] = 0.f;
}
__device__ __forceinline__ void dn_unit_load(ptab_t pt, int unit, UnitPre& p) {
    const int tid = tid_opaque(); unsigned char* ws = PWS; const bf16_t* DQKV = (const bf16_t*)(ws + WS_DQKV); const float* GB = (const float*)(ws + WS_GB);
    int d, h, c, L, rowbase; bool lat; unit_geom(unit, d, h, lat, c, L, rowbase);
    { const int i = tid >> 3, c16 = (tid & 7) * 16; const int s = c * 64 + i, t = d ? L - 1 - s : s; const bf16_t* pr = DQKV + (size_t)(rowbase + t) * 1536 + h * 128 + c16;
      p.r[0] = *(const u32x4*)(pr); p.r[1] = *(const u32x4*)(pr + 8); p.r[2] = *(const u32x4*)(pr + 512); p.r[3] = *(const u32x4*)(pr + 520); p.r[4] = *(const u32x4*)(pr + 1024); p.r[5] = *(const u32x4*)(pr + 1032); }
    { const int i = tid & 63; const int s = c * 64 + i, t = d ? L - 1 - s : s; const float* gp = GB + (size_t)(rowbase + t) * 16 + d * 4 + h; p.f[0] = gp[0]; p.f[1] = gp[8]; }
}
__device__ __forceinline__ void gla_chunk_unit(ptab_t pt, int unit, LAS unsigned char* lds, const UnitPre& pre) {
    const int tid = tid_opaque(), lane = tid & 63, wave = tid >> 6;
    unsigned char* ws = PWS;
    const bf16_t* P = (const bf16_t*)(ws + WS_P); const float* LA = (const float*)(ws + WS_LA);
    bf16_t* GQ = (bf16_t*)(ws + WS_GQ) + (size_t)unit * 4096; unsigned* GO = (unsigned*)(ws + WS_GO) + (size_t)unit * 4096; unsigned* GU = (unsigned*)(ws + WS_GU) + (size_t)unit * 4096; float* GD = (float*)(ws + WS_GD) + (size_t)unit * 64;
    const int d = unit & 1, h = (unit >> 1) & 3, slot = unit >> 3;
    const bool lat = slot >= 64; const int b = lat ? (slot - 64) >> 4 : slot >> 2, c = lat ? (slot - 64) & 15 : slot & 3;
    const int L = lat ? 1024 : 256, rowbase = lat ? 4096 + b * 1024 : b * 256;
    LAS float* Bs = (LAS float*)lds;
    LAS bf16_t* Qt = (LAS bf16_t*)(lds + 16640);
    LAS bf16_t* Kt = Qt + 64 * 72;
    LAS bf16_t* KhT = Kt + 64 * 72;
    LAS bf16_t* VT = KhT + 64 * 72;
    LAS bf16_t* Am = VT + 128 * 72;
#pragma unroll
    for (int q = 0; q < 2; ++q) { const int idx = tid + 512 * q, i = idx >> 4, c4 = idx & 15; const u32x4 v = pre.r[q];
        Bs[i * 65 + c4 * 4] = __uint_as_float(v.x); Bs[i * 65 + c4 * 4 + 1] = __uint_as_float(v.y); Bs[i * 65 + c4 * 4 + 2] = __uint_as_float(v.z); Bs[i * 65 + c4 * 4 + 3] = __uint_as_float(v.w); }
    LDS_BARRIER();
    {
        const int k = tid & 63, s = tid >> 6; LAS float* tot = (LAS float*)(lds + 16640);
        float v[8]; float a = 0.f;
#pragma unroll
        for (int i = 0; i < 8; ++i) { a += Bs[(s * 8 + i) * 65 + k]; v[i] = a; }
        tot[s * 64 + k] = a;
        LDS_BARRIER();
        float off = 0.f;
#pragma unroll
        for (int q = 0; q < 7; ++q) off += (q < s) ? tot[q * 64 + k] : 0.f;
#pragma unroll
        for (int i = 0; i < 8; ++i) Bs[(s * 8 + i) * 65 + k] = v[i] + off;
    }
    LDS_BARRIER();
    { const int i = tid >> 3, k0 = (tid & 7) * 8;
      const u32x4 qw = pre.r[2], kw = pre.r[3];
#pragma unroll
      for (int e = 0; e < 8; ++e) { const float bb = Bs[i * 65 + k0 + e], bl = Bs[63 * 65 + k0 + e];
          const float qv = (e & 1) ? bfhi(qw[e >> 1]) : bflo(qw[e >> 1]), kv = (e & 1) ? bfhi(kw[e >> 1]) : bflo(kw[e >> 1]);
          Qt[i * 72 + k0 + e] = f2bf(qv * 0.125f * __expf(bb)); Kt[i * 72 + k0 + e] = f2bf(kv * __expf(-bb)); KhT[(k0 + e) * 72 + i] = f2bf(kv * __expf(bl - bb)); }
      const int v0 = (tid & 7) * 16;
      const u32x4 va = pre.r[4], vb = pre.r[5];
#pragma unroll
      for (int e = 0; e < 8; ++e) { VT[(v0 + e) * 72 + i] = (bf16_t)((e & 1) ? (va[e >> 1] >> 16) : (va[e >> 1] & 0xffffu)); VT[(v0 + 8 + e) * 72 + i] = (bf16_t)((e & 1) ? (vb[e >> 1] >> 16) : (vb[e >> 1] & 0xffffu)); }
      if (tid < 64) GD[tid] = __expf(Bs[63 * 65 + tid]); }
    LDS_BARRIER();
    { f32x16 acc = {}; acc = mm_tile<64>(KhT, 72, VT, 72, wave >> 2, wave & 3, lane, acc); acc_store_pk(GU + wave * 512, acc, lane); }
    if (wave < 4) { f32x16 acc = {}; const int tm = wave >> 1, tn = wave & 1; acc = mm_tile<64>(Qt, 72, Kt, 72, tm, tn, lane, acc);
        const int r32 = lane & 31, hi = lane >> 5;
#pragma unroll
        for (int r = 0; r < 16; ++r) { const int i = tm * 32 + crow(r, hi), j = tn * 32 + r32; Am[i * 72 + j] = f2bf(j <= i ? acc[r] : 0.f); } }
    { const int i = tid >> 3, k0 = (tid & 7) * 8; *(u32x4*)(GQ + i * 64 + k0) = *(const LAS u32x4*)(Qt + i * 72 + k0); }
    LDS_BARRIER();
    { f32x16 acc = {}; acc = mm_tile<64>(Am, 72, VT, 72, wave >> 2, wave & 3, lane, acc); acc_store_pk(GO + wave * 512, acc, lane); }
    LDS_BARRIER();
}
__device__ __forceinline__ void gla_scan_item(ptab_t pt, int l, bool lat, int b, int h, int d, LAS unsigned char* lds) {
    const int tid = tid_opaque(), lane = tid & 63, wave = tid >> 6, r32 = lane & 31, hi = lane >> 5;
    unsigned char* ws = PWS;
    float* OG = (float*)(ws + WS_OG);
    const int L = lat ? 1024 : 256, rowbase = lat ? 4096 + b * 1024 : b * 256, nch = L >> 6, slot0 = lat ? 64 + b * 16 : b * 4;
    const int tm = wave >> 2, tn = wave & 3;
    LAS bf16_t* ST = (LAS bf16_t*)lds;
    f32x16 S;
    const size_t sbase = ((((size_t)b * 2 + l) * 2 + d) * 4 + h) * 8192;
#pragma unroll
    for (int r = 0; r < 16; ++r) S[r] = lat ? PIN(4)[sbase + (size_t)(tm * 32 + crow(r, hi)) * 128 + tn * 32 + r32] : 0.f;
    unsigned ow[8], uw[8], now[8], nuw[8]; float dec[16], ndec[16]; bf16x8 qa[4], nqa[4];
#define GLA_SLOAD(OW, UW, DEC, QA, cc) do { const int unit_ = ((slot0 + (cc)) * 4 + h) * 2 + d; \
        acc_load_pk((const unsigned*)(ws + WS_GO) + (size_t)unit_ * 4096 + wave * 512, OW, lane); acc_load_pk((const unsigned*)(ws + WS_GU) + (size_t)unit_ * 4096 + wave * 512, UW, lane); \
        const float* gd_ = (const float*)(ws + WS_GD) + (size_t)unit_ * 64; _Pragma("unroll") for (int r_ = 0; r_ < 16; ++r_) DEC[r_] = gd_[tm * 32 + crow(r_, hi)]; \
        const bf16_t* gq_ = (const bf16_t*)(ws + WS_GQ) + (size_t)unit_ * 4096 + (size_t)(tm * 32 + r32) * 64 + hi * 8; _Pragma("unroll") for (int k_ = 0; k_ < 4; ++k_) QA[k_] = *(const bf16x8*)(gq_ + 16 * k_); } while (0)
    GLA_SLOAD(ow, uw, dec, qa, 0);
    GLA_SLOAD(now, nuw, ndec, nqa, 1);
#define GLA_STEP(c, OW, UW, DEC, QA) do { \
        acc_to_ST(ST, 72, tm * 32, tn * 32, S, lane); \
        LDS_BARRIER(); \
        f32x16 o; \
        _Pragma("unroll") for (int r2 = 0; r2 < 8; ++r2) { o[2 * r2] = bflo(OW[r2]); o[2 * r2 + 1] = bfhi(OW[r2]); } \
        { const LAS bf16_t* bp = ST + (tn * 32 + r32) * 72 + hi * 8; \
          _Pragma("unroll") for (int k = 0; k < 4; ++k) { const bf16x8 bb = *(const LAS bf16x8*)(bp + 16 * k); o = __builtin_amdgcn_mfma_f32_32x32x16_bf16(QA[k], bb, o, 0, 0, 0); } } \
        { const int s0_ = (c) * 64 + tm * 32 + 4 * hi; store_o_tile_pk((unsigned*)OG, o, (long long)((size_t)d * NTOK + rowbase + (d ? L - 1 - s0_ : s0_)), d ? -1 : 1, h * 128 + tn * 32, lane); } \
        _Pragma("unroll") for (int r2 = 0; r2 < 8; ++r2) { S[2 * r2] = DEC[2 * r2] * S[2 * r2] + bflo(UW[r2]); S[2 * r2 + 1] = DEC[2 * r2 + 1] * S[2 * r2 + 1] + bfhi(UW[r2]); } \
        { const int cn_ = (c) + 2 < nch ? (c) + 2 : nch - 1; GLA_SLOAD(OW, UW, DEC, QA, cn_); } \
        LDS_BARRIER(); } while (0)
    for (int c = 0; c < nch; c += 2) {
        GLA_STEP(c, ow, uw, dec, qa);
        GLA_STEP(c + 1, now, nuw, ndec, nqa);
    }
#undef GLA_STEP
#undef GLA_SLOAD
    if (!lat) {
#pragma unroll
        for (int r = 0; r < 16; ++r) POUT[OUT_SG + sbase + (size_t)(tm * 32 + crow(r, hi)) * 128 + tn * 32 + r32] = S[r]; }
}
template <int BLK>
__device__ __forceinline__ void solve_diag(float (&x)[64], const LAS float* Af) {
    f32x4 an[4];
    an[0] = *(const LAS f32x4*)(Af + (16 * BLK + 1) * 68 + 16 * BLK);
#pragma unroll
    for (int ii = 1; ii < 16; ++ii) { const int i = 16 * BLK + ii; f32x4 ac[4];
#pragma unroll
        for (int j4 = 0; j4 < (ii + 3) / 4; ++j4) ac[j4] = an[j4];
        if (ii + 1 < 16) {
#pragma unroll
            for (int j4 = 0; j4 < (ii + 4) / 4; ++j4) an[j4] = *(const LAS f32x4*)(Af + (i + 1) * 68 + 16 * BLK + 4 * j4); }
        float s0 = 0.f, s1 = 0.f, s2 = 0.f, s3 = 0.f;
#pragma unroll
        for (int j4 = 0; j4 < (ii + 3) / 4; ++j4) { s0 += ac[j4].x * x[16 * BLK + 4 * j4]; s1 += ac[j4].y * x[16 * BLK + 4 * j4 + 1]; s2 += ac[j4].z * x[16 * BLK + 4 * j4 + 2]; s3 += ac[j4].w * x[16 * BLK + 4 * j4 + 3]; }
        x[i] -= (s0 + s1) + (s2 + s3); asm("" : "+v"(x[i])); }
}
template <int BLK>
__device__ __forceinline__ void solve_offdiag(const LAS bf16_t* Ab, const LAS bf16_t* UT, const LAS bf16_t* WT, LAS float* Rb, int wave, int lane) {
    f32x16 acc = {};
    acc = mm_tile<16 * BLK>(Ab, 72, wave < 4 ? UT : WT, 72, BLK >> 1, wave & 3, lane, acc);
    const int r32 = lane & 31, hi = lane >> 5;
#pragma unroll
    for (int r = 0; r < 16; ++r) { const int rr = crow(r, hi) - (BLK & 1) * 16; if (rr >= 0 && rr < 16) Rb[rr * 260 + wave * 32 + r32] = acc[r]; }
}
template <int BLK>
__device__ __forceinline__ void solve_step(float (&x)[64], const LAS float* Af, const LAS bf16_t* Ab, LAS bf16_t* UT, LAS bf16_t* WT, LAS float* Rb, int tid, int wave, int lane) {
    if (BLK > 0) { solve_offdiag<(BLK > 0 ? BLK : 1)>(Ab, UT, WT, Rb, wave, lane); LDS_BARRIER(); }
    if (tid < 256) {
        if (BLK > 0) {
#pragma unroll
            for (int ii = 0; ii < 16; ++ii) { x[16 * BLK + ii] -= Rb[ii * 260 + tid]; asm("" : "+v"(x[16 * BLK + ii])); } }
        solve_diag<BLK>(x, Af);
        LAS bf16_t* dst = (tid < 128 ? UT + tid * 72 : WT + (tid - 128) * 72) + 16 * BLK;
        u32x4 w0, w1; w0.x = pk2(x[16 * BLK], x[16 * BLK + 1]); w0.y = pk2(x[16 * BLK + 2], x[16 * BLK + 3]); w0.z = pk2(x[16 * BLK + 4], x[16 * BLK + 5]); w0.w = pk2(x[16 * BLK + 6], x[16 * BLK + 7]);
        w1.x = pk2(x[16 * BLK + 8], x[16 * BLK + 9]); w1.y = pk2(x[16 * BLK + 10], x[16 * BLK + 11]); w1.z = pk2(x[16 * BLK + 12], x[16 * BLK + 13]); w1.w = pk2(x[16 * BLK + 14], x[16 * BLK + 15]);
        *(LAS u32x4*)(dst) = w0; *(LAS u32x4*)(dst + 8) = w1; }
    if (BLK < 3) LDS_BARRIER();
}
#define SUBA_BEGIN() unsigned long long tsa_ = 0; if (PROBE_SUB >= 10 && PROBE_SUB <= 14 && blockIdx.x == 0) { LDS_BARRIER(); tsa_ = __builtin_amdgcn_s_memrealtime(); }
#define SUBA_END(k) do { if (PROBE_SUB == (k) && blockIdx.x == 0) { LDS_BARRIER(); if (threadIdx.x == 0) *(volatile LAS unsigned long long*)(lds + PTAB_OFF + 320) += __builtin_amdgcn_s_memrealtime() - tsa_; } } while (0)
#define SUBA_MARK() do { if (PROBE_SUB >= 10 && PROBE_SUB <= 14 && blockIdx.x == 0) { LDS_BARRIER(); tsa_ = __builtin_amdgcn_s_memrealtime(); } } while (0)
__device__ __forceinline__ void dn_chunk_unit(ptab_t pt, int unit, LAS unsigned char* lds, const UnitPre& pre) {
    SUBA_BEGIN(); unsigned long long tsa0_ = tsa_;
    const int tid = tid_opaque(), lane = tid & 63, wave = tid >> 6, r32 = lane & 31, hi = lane >> 5;
    unsigned char* ws = PWS;
    const bf16_t* DQKV = (const bf16_t*)(ws + WS_DQKV); const float* GB = (const float*)(ws + WS_GB);
    bf16_t* MC = (bf16_t*)(ws + WS_MC) + (size_t)unit * 16384; unsigned* NC = (unsigned*)(ws + WS_NC) + (size_t)unit * 8192;
    bf16_t* QE = (bf16_t*)(ws + WS_QE) + (size_t)unit * 8192; unsigned* OL = (unsigned*)(ws + WS_OL) + (size_t)unit * 4096;
    const int d = unit & 1, h = (unit >> 1) & 3, slot = unit >> 3;
    const bool lat = slot >= 64; const int b = lat ? (slot - 64) >> 4 : slot >> 2, c = lat ? (slot - 64) & 15 : slot & 3;
    const int L = lat ? 1024 : 256, rowbase = lat ? 4096 + b * 1024 : b * 256;
    LAS bf16_t* Qs = (LAS bf16_t*)lds;
    LAS bf16_t* Ks = Qs + 64 * 136;
    LAS bf16_t* Vs = Ks + 64 * 136;
    LAS float* Af = (LAS float*)(lds + 52224);
    LAS bf16_t* Att = (LAS bf16_t*)(lds + 69632);
    LAS bf16_t* KhT = (LAS bf16_t*)(lds + 78848);
    LAS bf16_t* WT = (LAS bf16_t*)(lds + 97280);
    LAS bf16_t* UT = (LAS bf16_t*)(lds + 115712);
    LAS float* Gs = (LAS float*)(lds + 134144);
    LAS float* Bt = Gs + 64;
    LAS bf16_t* Ab = (LAS bf16_t*)(lds + 134656);
    LAS float* Rb = (LAS float*)(lds + 34816);
    { const int i = tid >> 3, c16 = (tid & 7) * 16;
      const u32x4 q0 = pre.r[0], q1 = pre.r[1], k0 = pre.r[2], k1 = pre.r[3], v0 = pre.r[4], v1 = pre.r[5];
      *(LAS u32x4*)(Qs + i * 136 + c16) = q0; *(LAS u32x4*)(Qs + i * 136 + c16 + 8) = q1; *(LAS u32x4*)(Ks + i * 136 + c16) = k0; *(LAS u32x4*)(Ks + i * 136 + c16 + 8) = k1;
      *(LAS u32x4*)(Vs + i * 136 + c16) = v0; *(LAS u32x4*)(Vs + i * 136 + c16 + 8) = v1; }
    if (tid < 64) { float x = pre.f[0]; const float be = pre.f[1];
#pragma unroll
        for (int o = 1; o < 64; o <<= 1) { const float n = __shfl_up(x, o); if (lane >= o) x += n; }
        Gs[tid] = x; Bt[tid] = be; }
    LDS_BARRIER();
    { const int w4 = wave & 3, tm = w4 >> 1, tn = w4 & 1; f32x16 acc = {};
      acc = mm_tile<128>(wave < 4 ? Ks : Qs, 136, Ks, 136, tm, tn, lane, acc);
      const int j = tn * 32 + r32; const float Gj = Gs[j];
#pragma unroll
      for (int r = 0; r < 16; ++r) { const int i = tm * 32 + crow(r, hi); const float e = __expf(Gs[i] - Gj);
          if (wave < 4) { const float av = (j < i) ? Bt[i] * acc[r] * e : 0.f; Af[i * 68 + j] = av; Ab[i * 72 + j] = f2bf(av); } else Att[i * 72 + j] = f2bf((j <= i) ? acc[r] * e : 0.f); } }
    LDS_BARRIER();
    SUBA_END(11); SUBA_MARK();
    {
        float x[64];
        if (tid < 128) {
#pragma unroll
            for (int j = 0; j < 64; ++j) x[j] = bf2f(Vs[j * 136 + tid]) * Bt[j];
        } else if (tid < 256) {
#pragma unroll
            for (int j = 0; j < 64; ++j) x[j] = bf2f(Ks[j * 136 + tid - 128]) * Bt[j] * __expf(Gs[j]);
        } else {
#pragma unroll
            for (int j = 0; j < 64; ++j) x[j] = 0.f;
            const int t2 = tid - 256, i = t2 >> 2, a0 = (t2 & 3) * 32; const float f = __expf(Gs[63] - Gs[i]);
#pragma unroll 8
            for (int e = 0; e < 32; ++e) KhT[(a0 + e) * 72 + i] = f2bf(bf2f(Ks[i * 136 + a0 + e]) * f);
        }
#pragma unroll
        for (int j = 0; j < 64; ++j) asm("" : "+v"(x[j]));
        LDS_BARRIER();
        solve_step<0>(x, Af, Ab, UT, WT, Rb, tid, wave, lane);
        solve_step<1>(x, Af, Ab, UT, WT, Rb, tid, wave, lane);
        solve_step<2>(x, Af, Ab, UT, WT, Rb, tid, wave, lane);
        solve_step<3>(x, Af, Ab, UT, WT, Rb, tid, wave, lane);
    }
    LDS_BARRIER();
    SUBA_END(12); SUBA_MARK();
    { const int tn = wave & 3, tmo = wave >> 2; const float eGl = __expf(Gs[63]);
      { f32x16 acc = {}; acc = mm_tile<64>(Att, 72, UT, 72, tmo, tn, lane, acc); acc_store_pk(OL + wave * 512, acc, lane); }
      { f32x16 acc = {}; acc = mm_tile<64>(Att, 72, WT, 72, tmo, tn, lane, acc);
#pragma unroll
        for (int r = 0; r < 16; ++r) { const int i = tmo * 32 + crow(r, hi), a = tn * 32 + r32; QE[i * 128 + a] = f2bf(bf2f(Qs[i * 136 + a]) * __expf(Gs[i]) - acc[r]); } }
#pragma unroll
      for (int q = 0; q < 2; ++q) { const int tm = tmo + 2 * q;
        { f32x16 acc = {}; acc = mm_tile<64>(KhT, 72, UT, 72, tm, tn, lane, acc); acc_store_pk(NC + (tm * 4 + tn) * 512, acc, lane); }
        { f32x16 acc = {}; acc = mm_tile<64>(KhT, 72, WT, 72, tm, tn, lane, acc);
#pragma unroll
          for (int r = 0; r < 16; ++r) { const int a = tm * 32 + crow(r, hi), a2 = tn * 32 + r32; MC[a * 128 + a2] = f2bf((a == a2 ? eGl : 0.f) - acc[r]); } } } }
    LDS_BARRIER();
    SUBA_END(13); tsa_ = tsa0_; SUBA_END(10);
    if (PROBE_SUB == 14 && blockIdx.x == 0 && threadIdx.x == 0) *(volatile LAS unsigned long long*)(lds + PTAB_OFF + 320) += 1000;
}
__device__ __forceinline__ void dn_scan_item(ptab_t pt, int l, bool lat, int b, int h, int d, int vh, LAS unsigned char* lds) {
    const int tid = tid_opaque(), lane = tid & 63, wave = tid >> 6, r32 = lane & 31, hi = lane >> 5;
    unsigned char* ws = PWS;
    float* OD = (float*)(ws + WS_OD);
    const int L = lat ? 1024 : 256, rowbase = lat ? 4096 + b * 1024 : b * 256, nch = L >> 6, slot0 = lat ? 64 + b * 16 : b * 4;
    const int tm = wave & 3, tnl = wave >> 2, tn = vh * 2 + tnl;
    const bool ow_ = wave < 4; const int tmo = wave & 1, tnlo = (wave >> 1) & 1, tno = vh * 2 + tnlo;
    LAS bf16_t* ST = (LAS bf16_t*)lds;
    LAS bf16_t* AMb = (LAS bf16_t*)(lds + 34816);
    f32x16 S;
    const size_t sbase = ((((size_t)b * 2 + l) * 2 + d) * 4 + h) * 16384;
#pragma unroll
    for (int r = 0; r < 16; ++r) S[r] = lat ? PIN(5)[sbase + (size_t)(tm * 32 + crow(r, hi)) * 128 + tn * 32 + r32] : 0.f;
    u32x4 stg[6], stg2[6]; unsigned ow[8], n0[8], now[8], nn0[8];
#define DN_GLOAD(STG, cc) do { const int unit_ = ((slot0 + (cc)) * 4 + h) * 2 + d; const bf16_t* mc_ = (const bf16_t*)(ws + WS_MC) + (size_t)unit_ * 16384; const bf16_t* qe_ = (const bf16_t*)(ws + WS_QE) + (size_t)unit_ * 8192; \
        _Pragma("unroll") for (int j_ = 0; j_ < 4; ++j_) STG[j_] = *(const u32x4*)(mc_ + (size_t)(tid + 512 * j_) * 8); \
        _Pragma("unroll") for (int j_ = 0; j_ < 2; ++j_) STG[4 + j_] = *(const u32x4*)(qe_ + (size_t)(tid + 512 * j_) * 8); } while (0)
#define DN_TLOAD(OW, N0, cc) do { const int unit_ = ((slot0 + (cc)) * 4 + h) * 2 + d; \
        acc_load_pk((const unsigned*)(ws + WS_OL) + (size_t)unit_ * 4096 + (tmo * 4 + tno) * 512, OW, lane); acc_load_pk((const unsigned*)(ws + WS_NC) + (size_t)unit_ * 8192 + (tm * 4 + tn) * 512, N0, lane); } while (0)
#define DN_SWRITE(buf) do { LAS bf16_t* am_ = AMb + (buf) * 26112; LAS bf16_t* aq_ = am_ + 128 * 136; \
        _Pragma("unroll") for (int j_ = 0; j_ < 4; ++j_) { const int q_ = tid + 512 * j_; *(LAS u32x4*)(am_ + (q_ >> 4) * 136 + (q_ & 15) * 8) = stg[j_]; } \
        _Pragma("unroll") for (int j_ = 0; j_ < 2; ++j_) { const int q_ = tid + 512 * j_; *(LAS u32x4*)(aq_ + (q_ >> 4) * 136 + (q_ & 15) * 8) = stg[4 + j_]; } } while (0)
    DN_GLOAD(stg, 0); DN_SWRITE(0);
    DN_TLOAD(ow, n0, 0); DN_TLOAD(now, nn0, 1);
    DN_GLOAD(stg2, 1); DN_GLOAD(stg, (nch > 2 ? 2 : 1));
#define DN_STEP(c, OW, N0, STGN, STGNAME_IS_STG2) do { \
        acc_to_ST(ST, 136, tm * 32, tnl * 32, S, lane); \
        LDS_BARRIER(); \
        const LAS bf16_t* am = AMb + ((c) & 1) * 26112; const LAS bf16_t* aq = am + 128 * 136; \
        _Pragma("unroll") for (int r2 = 0; r2 < 8; ++r2) { S[2 * r2] = bflo(N0[r2]); S[2 * r2 + 1] = bfhi(N0[r2]); } \
        f32x16 o; \
        if (ow_) { _Pragma("unroll") for (int r2 = 0; r2 < 8; ++r2) { o[2 * r2] = bflo(OW[r2]); o[2 * r2 + 1] = bfhi(OW[r2]); } } \
        { const int cn_ = (c) + 2 < nch ? (c) + 2 : nch - 1; DN_TLOAD(OW, N0, cn_); }     \
        if (ow_) { o = mm_tile<128>(aq, 136, ST, 136, tmo, tnlo, lane, o); \
            const int s0_ = (c) * 64 + tmo * 32 + 4 * hi; store_o_tile_pk((unsigned*)OD, o, (long long)((size_t)d * NTOK + rowbase + (d ? L - 1 - s0_ : s0_)), d ? -1 : 1, h * 128 + tno * 32, lane); } \
        S = mm_tile<128>(am, 136, ST, 136, tm, tnl, lane, S); \
        { LAS bf16_t* am_ = AMb + (((c) + 1) & 1) * 26112; LAS bf16_t* aq_ = am_ + 128 * 136;     \
          _Pragma("unroll") for (int j_ = 0; j_ < 4; ++j_) { const int q_ = tid + 512 * j_; *(LAS u32x4*)(am_ + (q_ >> 4) * 136 + (q_ & 15) * 8) = STGN[j_]; } \
          _Pragma("unroll") for (int j_ = 0; j_ < 2; ++j_) { const int q_ = tid + 512 * j_; *(LAS u32x4*)(aq_ + (q_ >> 4) * 136 + (q_ & 15) * 8) = STGN[4 + j_]; } } \
        { const int cn_ = (c) + 3 < nch ? (c) + 3 : nch - 1; DN_GLOAD(STGN, cn_); }     \
        LDS_BARRIER(); } while (0)
    for (int c = 0; c < nch; c += 2) {
        DN_STEP(c, ow, n0, stg2, 1);
        DN_STEP(c + 1, now, nn0, stg, 0);
    }
#undef DN_STEP
#undef DN_GLOAD
#undef DN_TLOAD
#undef DN_SWRITE
    if (!lat) {
#pragma unroll
        for (int r = 0; r < 16; ++r) POUT[OUT_SD + sbase + (size_t)(tm * 32 + crow(r, hi)) * 128 + tn * 32 + r32] = S[r]; }
}
__device__ __forceinline__ void mixer1_phase(ptab_t pt, int l, unsigned char* lds_generic, int bid, int nb, int rep) {
    LAS unsigned char* l3 = (LAS unsigned char*)lds_generic;
    LAS int* qslot = (LAS int*)(l3 + PTAB_OFF + 272);
    unsigned* qctr = (unsigned*)(PWS + WS_QUEUE) + (l * 4 + rep) * 64;
    constexpr int N_ITEMS = 2048;
    int it = bid, itn = bid + nb;
    UnitPre pc, pn;
    if (it < N_ITEMS) { if (it < 1024) dn_unit_load(pt, it, pc); else gla_unit_load(pt, it - 1024, pc); }
    while (it < N_ITEMS) {
        int nxt2 = 0;
        if (threadIdx.x == 0) nxt2 = 2 * nb + (int)atomicAdd(qctr, 1u);
        if (itn < N_ITEMS) { if (itn < 1024) dn_unit_load(pt, itn, pn); else gla_unit_load(pt, itn - 1024, pn); }
        if (it < 1024) { for (int q_ = 0; q_ < (PROBE_DUP == 8 ? 2 : 1); ++q_) dn_chunk_unit(pt, it, l3, pc); }
        else { for (int q_ = 0; q_ < (PROBE_DUP == 9 ? 2 : 1); ++q_) gla_chunk_unit(pt, it - 1024, l3, pc); }
        LDS_BARRIER();
        if (threadIdx.x == 0) *qslot = nxt2;
        LDS_BARRIER();
        it = itn; itn = *qslot;
#pragma unroll
        for (int q = 0; q < 6; ++q) pc.r[q] = pn.r[q];
        pc.f[0] = pn.f[0]; pc.f[1] = pn.f[1];
    }
}
__device__ __forceinline__ void mixer2_phase(ptab_t pt, int l, unsigned char* lds_generic, int bid, int nb, int rep) {
    LAS unsigned char* l3 = (LAS unsigned char*)lds_generic;
    LAS int* qslot = (LAS int*)(l3 + PTAB_OFF + 272);
    unsigned* qctr = (unsigned*)(PWS + WS_QUEUE) + (l * 4 + 2 + rep) * 64;
    const int n_tr = (l == 0 && rep == 0) ? (TI_OUT + TI_F1) / 8 : 0;
    const int N_ITEMS = 736 + n_tr;
    int it = bid;
    while (it < N_ITEMS) {
        int nxt = 0;
        if (threadIdx.x == 0) nxt = nb + (int)atomicAdd(qctr, 1u);
        if (it < 128 || (it >= 224 && it < 352)) {
            unsigned char* ws = PWS;
            const bf16_t* QN = (const bf16_t*)(ws + WS_QN); const bf16_t* KB = (const bf16_t*)(ws + WS_KB); const bf16_t* VB = (const bf16_t*)(ws + WS_VB); bf16_t* MIX = (bf16_t*)(ws + WS_MIX);
            const bool lat = it < 128; const int i = lat ? it : it - 224;
            const int b = lat ? i >> 5 : i >> 3, h = lat ? (i >> 2) & 7 : i & 7, qb = lat ? i & 3 : 0;
            const size_t row0 = lat ? 4096 + (size_t)b * 1024 + qb * 256 : (size_t)b * 256;
            const size_t krow0 = lat ? (size_t)4096 + (size_t)b * 1280 : (size_t)b * 256;
            att::attn_dense_body<1024, 256, 2048>(QN + row0 * 1024 + h * 128, KB + krow0 * 256 + (h >> 2) * 128, VB + krow0 * 256 + (h >> 2) * 128, MIX + row0 * 2048 + 512 + h * 128, lat ? 1280 : 256, (char*)lds_generic);
        } else if (it < 192 || (it >= 352 && it < 608)) { const bool lat = it < 192; const int j = lat ? it - 128 : it - 352; const int vh = j & 1, q = j >> 1;
            dn_scan_item(pt, l, lat, q >> 3, (q >> 1) & 3, q & 1, vh, l3);
        } else if (it < 736) { const bool lat = it < 224; const int q = lat ? it - 192 : it - 608;
            gla_scan_item(pt, l, lat, q >> 3, (q >> 1) & 3, q & 1, l3);
        } else { const int wv = __builtin_amdgcn_readfirstlane((int)threadIdx.x >> 6);
            do_transposes(pt, l3, TI_L + TI_IN + (it - 736) * 8, 8, wv, 8);
        }
        LDS_BARRIER();
        if (threadIdx.x == 0) *qslot = nxt;
        LDS_BARRIER();
        it = *qslot;
    }
}

__device__ __forceinline__ void postmix_phase(ptab_t pt, int l, int bid, int nb) {
    const int tid = tid_opaque(), lane = tid & 63, wave = tid >> 6;
    unsigned char* ws = PWS;
    const bf16_t* P = (const bf16_t*)(ws + WS_P); const float* OG = (const float*)(ws + WS_OG); const float* OD = (const float*)(ws + WS_OD); bf16_t* MIX = (bf16_t*)(ws + WS_MIX);
    const f32x2 gg = *(const f32x2*)(PIN(15) + l * 128 + 2 * lane), dg = *(const f32x2*)(PIN(21) + l * 128 + 2 * lane);
    constexpr int NT = 4;
    for (int r0 = bid * 8 + wave; r0 < NTOK / NT; r0 += nb * 8) {
        float a0[NT * 8], a1[NT * 8], ss[NT * 8]; unsigned zw[NT * 8];
#pragma unroll
        for (int u = 0; u < NT; ++u) { const size_t r = (size_t)(r0 + u * (NTOK / NT));
#pragma unroll
            for (int blk = 0; blk < 8; ++blk) { const bool dn = blk >= 4; const int hb = blk & 3;
                const unsigned* o0 = (const unsigned*)(dn ? OD : OG) + r * 256 + hb * 64 + lane; const unsigned p = o0[0], q = o0[(size_t)NTOK * 256];
                zw[u * 8 + blk] = *(const unsigned*)(P + r * PLD + (dn ? 4608 : 1024) + hb * 128 + 2 * lane);
                a0[u * 8 + blk] = bflo(p) + bflo(q); a1[u * 8 + blk] = bfhi(p) + bfhi(q); ss[u * 8 + blk] = a0[u * 8 + blk] * a0[u * 8 + blk] + a1[u * 8 + blk] * a1[u * 8 + blk]; } }
        wave_sum_n<NT * 8>(ss);
#pragma unroll
        for (int u = 0; u < NT; ++u) { const size_t r = (size_t)(r0 + u * (NTOK / NT));
#pragma unroll
            for (int blk = 0; blk < 8; ++blk) { const bool dn = blk >= 4; const int hb = blk & 3; const int i = u * 8 + blk;
                const float rstd = rsqrtf(ss[i] * (1.f / 128.f) + EPS); const f32x2 g = dn ? dg : gg;
                *(unsigned*)(MIX + r * 2048 + (dn ? 1536 : 0) + hb * 128 + 2 * lane) = pk2(a0[i] * rstd * g.x * silu_f(bflo(zw[i])), a1[i] * rstd * g.y * silu_f(bfhi(zw[i]))); } }
    }
}

#define RLX_AGENT __ATOMIC_RELAXED, __HIP_MEMORY_SCOPE_AGENT
#define XB_TMO      128
#define XB_XCNT(j)  (256  + 64 * (j))
#define XB_XSUB(j)  (1280 + 64 * (j))
#define XB_XGEN(j)  (2304 + 64 * (j))
#define XB_TOP      3328
#define XB_TOPGEN   3392
#define XCD_BAR_WORDS 3456
#define XB_SPIN_CAP (1u << 18)

__device__ __forceinline__ unsigned xb_ld(unsigned* p)              { return __hip_atomic_load(p, __ATOMIC_RELAXED, __HIP_MEMORY_SCOPE_AGENT); }
__device__ __forceinline__ unsigned xb_add(unsigned* p, unsigned v) { return __hip_atomic_fetch_add(p, v, __ATOMIC_RELAXED, __HIP_MEMORY_SCOPE_AGENT); }
__device__ __forceinline__ unsigned xb_xcc_id() { return (unsigned)__builtin_amdgcn_s_getreg((3 << 11) | 20) & 0xFu; }
#define XB_SPIN(cond, bar) do { unsigned _sp = 0; while (cond) { __builtin_amdgcn_s_sleep(1); \
    if ((++_sp & 255u) == 0u) { if (xb_ld(&(bar)[XB_TMO])) break; if (_sp > XB_SPIN_CAP) { atomicAdd(&(bar)[XB_TMO], 1u); break; } } } } while (0)

struct XcdBarrier {
    unsigned* bar; unsigned x;
    volatile LAS unsigned* st;
};

__device__ __forceinline__ XcdBarrier xcd_barrier_post(unsigned* bar, volatile LAS unsigned* st) {
    XcdBarrier b; b.bar = bar; b.x = xb_xcc_id(); b.st = st;
    if (threadIdx.x == 0) (void)xb_add(&bar[XB_XCNT(b.x)], 1u);
    return b;
}
__device__ __forceinline__ void xcd_barrier_complete(unsigned* bar, unsigned x, unsigned& nloc, unsigned& nx) {
    const unsigned G = gridDim.x * gridDim.y * gridDim.z;
    unsigned sum, cnt, mine, sp = 0u;
    for (;;) {
        sum = 0u; cnt = 0u; mine = 0u;
#pragma unroll
        for (unsigned j = 0; j < 16; ++j) { const unsigned c = xb_ld(&bar[XB_XCNT(j)]); sum += c; cnt += (c > 0u) ? 1u : 0u; mine = (j == x) ? c : mine; }
        if (sum == G) break;
        __builtin_amdgcn_s_sleep(1);
        if ((++sp & 255u) == 0u) { if (xb_ld(&bar[XB_TMO])) break; if (sp > XB_SPIN_CAP) { atomicAdd(&bar[XB_TMO], 1u); break; } }
    }
    nloc = mine > 0u ? mine : 1u; nx = cnt > 0u ? cnt : 1u;
}

__device__ __forceinline__ void xcd_barrier(const XcdBarrier& b) {
    asm volatile("s_waitcnt vmcnt(0)" ::: "memory");
    __syncthreads();
    if (threadIdx.x == 0) {
        unsigned* bar = b.bar;
        __builtin_amdgcn_s_waitcnt(0);
        unsigned nloc = b.st[0], nx = b.st[1];
        if (nloc == 0u) { xcd_barrier_complete(bar, b.x, nloc, nx); b.st[0] = nloc; b.st[1] = nx; }
        const unsigned old = xb_add(&bar[XB_XSUB(b.x)], 1u);
        const unsigned gen = old / nloc;
        if (old + 1u == (gen + 1u) * nloc) {
            __builtin_amdgcn_fence(__ATOMIC_RELEASE, "agent");
            asm volatile("s_waitcnt vmcnt(0)" ::: "memory");
            const unsigned og = xb_add(&bar[XB_TOP], 1u);
            const unsigned tg = og / nx;
            if (og + 1u == (tg + 1u) * nx) xb_add(&bar[XB_TOPGEN], 1u);
            else XB_SPIN(xb_ld(&bar[XB_TOPGEN]) == tg, bar);
            __builtin_amdgcn_fence(__ATOMIC_ACQUIRE, "agent");
            xb_add(&bar[XB_XGEN(b.x)], 1u);
            asm volatile("s_waitcnt vmcnt(0)" ::: "memory");
        } else {
            XB_SPIN(xb_ld(&bar[XB_XGEN(b.x)]) == gen, bar);
            __builtin_amdgcn_fence(__ATOMIC_ACQUIRE, "agent");
            asm volatile("s_waitcnt vmcnt(0)" ::: "memory");
        }
    }
    __syncthreads();
}

__global__ void __launch_bounds__(512, 2) mega(Params p) {
    extern __shared__ __attribute__((aligned(16))) unsigned char lds[];
    cg::grid_group grid = cg::this_grid();
    const int bid = blockIdx.x, nb = gridDim.x;
    LAS unsigned char* l3 = (LAS unsigned char*)lds;
    ptab_t pt = (ptab_t)(l3 + PTAB_OFF);
    if (threadIdx.x < 27) { const int i = threadIdx.x; const void* v = i < 25 ? (const void*)p.in[i] : (i == 25 ? (const void*)p.out : (const void*)p.ws);
        ((LAS unsigned long long*)(l3 + PTAB_OFF))[i] = (unsigned long long)v; }
    if (threadIdx.x < 2) ((LAS unsigned*)(l3 + PTAB_OFF + 256))[threadIdx.x] = 0u;
    if (PROBE_SUB != 0 && threadIdx.x == 0) *(volatile LAS unsigned long long*)(l3 + PTAB_OFF + 320) = 0;
    __syncthreads();
    { unsigned* ctl = (unsigned*)PWS; for (int i = bid * 512 + (int)threadIdx.x; i < 40960; i += nb * 512) ctl[i] = 0u; }
#define TSTAMP() do { if (PROBE_MASK != 0u && blockIdx.x == 0 && threadIdx.x == 0) { volatile LAS unsigned long long* ts_ = (volatile LAS unsigned long long*)(l3 + PTAB_OFF + 288); \
        const unsigned long long now_ = __builtin_amdgcn_s_memrealtime(); const unsigned s_ = (unsigned)ts_[2]; if ((PROBE_MASK >> s_) & 1u) ts_[1] += now_ - ts_[0]; ts_[0] = now_; ts_[2] = s_ + 1; } } while (0)
#define GSYNC() do { xcd_barrier(xbar); TSTAMP(); } while (0)
    if (PROBE_MASK != 0u && blockIdx.x == 0 && threadIdx.x == 0) { volatile LAS unsigned long long* ts_ = (volatile LAS unsigned long long*)(l3 + PTAB_OFF + 288); ts_[0] = __builtin_amdgcn_s_memrealtime(); ts_[1] = 0; ts_[2] = 0; }
    p0_prologue(pt, l3, bid, nb, true);
    asm volatile("s_waitcnt vmcnt(0)" ::: "memory"); __syncthreads();
    grid.sync();
    XcdBarrier xbar = xcd_barrier_post((unsigned*)PWS + 1024, (volatile LAS unsigned*)(l3 + PTAB_OFF + 256));
    TSTAMP();
    if (PROBE_DUP == 3) { p0_prologue(pt, l3, bid, nb, false); }
    if (PROBE_DUP == 5) { for (int i = 0; i < 20; ++i) GSYNC(); }
#define REP(code) for (int rep_ = 0; rep_ < ((PROBE_DUP == (code)) ? 2 : 1); ++rep_)
#pragma unroll 1
    for (int l = 0; l < 2; ++l) {
        if (l == 0) { REP(4) { unsigned char* ws = PWS; const float* mods_l = (const float*)(ws + WS_MODS);
          norm_phase(PIN(0), PIN(1) - (size_t)4096 * DM, PIN(8), mods_l, 0, 1, (bf16_t*)(ws + WS_H), bid, nb);
          if (rep_ == 0) bias_phase(mods_l + 3 * DM, (const bf16_t*)(ws + WS_WFF1), FFD, (float*)(ws + WS_BIAS), l3, bid, nb);
          GSYNC(); } }
        REP(2) { unsigned char* ws = PWS; pg8::Gemm g{(const bf16_t*)(ws + WS_H), (const bf16_t*)(ws + WS_WIN) + (size_t)l * PNW * 2048, NTOK, PNW, 2048}; pg8::StaticOrder S; S.init(NTOK, PNW, nb, bid, WGM_IN);
          pg8::EpiP E{(bf16_t*)(ws + WS_P), (float*)(ws + WS_G), l == 0 ? (const float*)nullptr : (const float*)(ws + WS_RS) + 8192, (const float*)(ws + WS_BIAS) + 5 * 8192};
          pg8::gemm_phase<pg8::EpiP, pg8::StaticOrder, true, true>(l3, g, S, E);
          if (rep_ == 0 && bid + 2 * nb >= 672) { const int nidle = nb - (672 - 2 * nb); const int wv = __builtin_amdgcn_readfirstlane((int)threadIdx.x >> 6);
              __syncthreads();
              if (l == 0) do_transposes(pt, l3, TI_L, TI_IN, (bid - (672 - 2 * nb)) * 8 + wv, nidle * 8);
              else do_transposes(pt, l3, TI_L + TI_IN + TI_OUT + TI_F1 + TI_F2 / 3, TI_F2 - TI_F2 / 3, (bid - (672 - 2 * nb)) * 8 + wv, nidle * 8); }
          GSYNC(); }
        REP(4) { prep_phase(pt, l, l3, bid, nb);
          if (l == 0 && rep_ == 0) { unsigned char* ws = PWS; __syncthreads();
              bias_phase((const float*)(ws + WS_MODS) + (size_t)5 * NMOD, (const bf16_t*)(ws + WS_WIN) + (size_t)PNW * 2048, PNW, (float*)(ws + WS_BIAS) + 5 * 8192, l3, bid, nb); }
          GSYNC(); }
        REP(6) { mixer1_phase(pt, l, lds, bid, nb, rep_);
          GSYNC(); }
        REP(7) { mixer2_phase(pt, l, lds, bid, nb, rep_);
          GSYNC(); }
        REP(4) { postmix_phase(pt, l, bid, nb);
          if (l == 0 && rep_ == 0) { unsigned char* ws = PWS;
              bias_phase((const float*)(ws + WS_MODS) + (size_t)5 * NMOD + 3 * DM, (const bf16_t*)(ws + WS_WFF1) + (size_t)FFD * 2048, FFD, (float*)(ws + WS_BIAS) + 10 * 8192, l3, bid, nb); }
          GSYNC(); }
        REP(2) { unsigned char* ws = PWS; const float* mods_l = (const float*)(ws + WS_MODS) + (size_t)l * 5 * NMOD;
          const void* xin0 = l == 0 ? (const void*)PIN(0) : (const void*)(ws + WS_XB); const void* xin1 = l == 0 ? (const void*)(PIN(1) - (size_t)4096 * DM) : (const void*)(ws + WS_XB);
          pg8::Gemm g{(const bf16_t*)(ws + WS_MIX), (const bf16_t*)(ws + WS_WOUT) + (size_t)l * 2048 * 2048, NTOK, 2048, 2048}; pg8::StaticOrder S; S.init(NTOK, 2048, nb, bid, WGM_OUT);
          pg8::EpiRes E{xin0, xin1, (void*)(ws + WS_XA), mods_l + 2 * DM, rep_ == 0 ? (bf16_t*)(ws + WS_H) : (bf16_t*)nullptr, PIN(9) + l * DM, mods_l + 4 * DM, (float*)(ws + WS_RS) + (l == 0 ? 0 : 2 * 8192), l == 0 ? 0 : 1, 1};
          pg8::gemm_phase<pg8::EpiRes, pg8::StaticOrder, true, true>(l3, g, S, E);
          GSYNC(); }
        REP(2) { unsigned char* ws = PWS; pg8::Gemm g{(const bf16_t*)(ws + WS_H), (const bf16_t*)(ws + WS_WFF1) + (size_t)l * 8192 * 2048, NTOK, FFD, 2048}; pg8::StaticOrder S; S.init(NTOK, FFD, nb, bid, WGM_F1);
          pg8::EpiSqRelu E{(bf16_t*)(ws + WS_H2), FFD, (const float*)(ws + WS_RS) + (l == 0 ? 0 : 2 * 8192), (const float*)(ws + WS_BIAS) + (l == 0 ? 0 : 10 * 8192)};
          pg8::gemm_phase<pg8::EpiSqRelu, pg8::StaticOrder, true, true>(l3, g, S, E);
          GSYNC(); }
        REP(2) { unsigned char* ws = PWS; const float* mods_l = (const float*)(ws + WS_MODS) + (size_t)l * 5 * NMOD; const float* XA = (const float*)(ws + WS_XA);
          pg8::Gemm g{(const bf16_t*)(ws + WS_H2), (const bf16_t*)(ws + WS_WFF2) + (size_t)l * 2048 * 8192, NTOK, 2048, FFD}; pg8::StaticOrder S; S.init(NTOK, 2048, nb, bid, WGM_F2);
          pg8::EpiRes E{(const void*)XA, (const void*)XA, l == 0 ? (void*)(ws + WS_XB) : (void*)(POUT + OUT_Y), mods_l + 5 * DM, (l == 0 && rep_ == 0) ? (bf16_t*)(ws + WS_H) : (bf16_t*)nullptr, PIN(8) + DM, mods_l + 5 * NMOD + 1 * DM, (float*)(ws + WS_RS) + 8192, 1, l == 0 ? 1 : 0};
          pg8::gemm_phase<pg8::EpiRes, pg8::StaticOrder, true, true>(l3, g, S, E);
          if (l == 0 || rep_ + 1 < ((PROBE_DUP == 2) ? 2 : 1)) GSYNC(); }
    }
    if (PROBE_SUB != 0) { __syncthreads(); if (blockIdx.x == 0 && threadIdx.x == 0) { const unsigned long long t0_ = __builtin_amdgcn_s_memrealtime(), w_ = *(volatile LAS unsigned long long*)(l3 + PTAB_OFF + 320);
            while (__builtin_amdgcn_s_memrealtime() - t0_ < w_) __builtin_amdgcn_s_sleep(8); } }
    if (PROBE_MASK != 0u) { __syncthreads(); TSTAMP();
        if (blockIdx.x == 0 && threadIdx.x == 0) { volatile LAS unsigned long long* ts_ = (volatile LAS unsigned long long*)(l3 + PTAB_OFF + 288); const unsigned long long t0_ = __builtin_amdgcn_s_memrealtime(), w_ = ts_[1];
            while (__builtin_amdgcn_s_memrealtime() - t0_ < w_) __builtin_amdgcn_s_sleep(8); } }
}

extern "C" void kernel_launch(void* const* d_in, const int* in_sizes, int n_in, void* d_out, int out_size, void* d_ws, size_t ws_size, hipStream_t stream) {
    static int grid_blocks = 0;
    if (grid_blocks == 0) {
        if (n_in != 25 || out_size != (int)OUT_TOTAL || ws_size < WS_END) { fprintf(stderr, "kernel_launch: unexpected shapes: n_in %d out %d ws %zu (need %zu)\n", n_in, out_size, ws_size, (size_t)WS_END); grid_blocks = -1; return; }
        int dev = 0, cus = 0, per_cu = 0;
        if (hipGetDevice(&dev) != hipSuccess || hipDeviceGetAttribute(&cus, hipDeviceAttributeMultiprocessorCount, dev) != hipSuccess) { grid_blocks = -1; return; }
        if (hipFuncSetAttribute((const void*)mega, hipFuncAttributeMaxDynamicSharedMemorySize, LDS_BYTES) != hipSuccess) { fprintf(stderr, "kernel_launch: hipFuncSetAttribute failed\n"); grid_blocks = -1; return; }
        if (hipOccupancyMaxActiveBlocksPerMultiprocessor(&per_cu, (const void*)mega, 512, LDS_BYTES) != hipSuccess || per_cu < 1) { fprintf(stderr, "kernel_launch: occupancy query says %d blocks per CU\n", per_cu); (void)hipGetLastError(); grid_blocks = -1; return; }
        grid_blocks = cus;
    }
    if (grid_blocks < 0) return;
    Params p{};
    for (int i = 0; i < 25; ++i) p.in[i] = (const float*)d_in[i];
    p.out = (float*)d_out; p.ws = (unsigned char*)d_ws;
    void* args[] = {&p};
    const hipError_t e = hipLaunchCooperativeKernel((void*)mega, dim3(grid_blocks), dim3(512), args, LDS_BYTES, stream);
    if (e != hipSuccess) fprintf(stderr, "kernel_launch: cooperative launch failed: %s (grid %d)\n", hipGetErrorString(e), grid_blocks);
}
```

```cpp
#include <hip/hip_runtime.h>
#include <hip/hip_cooperative_groups.h>
#include <cstdio>
#include <cstdint>
namespace cg = cooperative_groups;
#ifndef WGM_IN
#define WGM_IN 8
#endif
#ifndef WGM_OUT
#define WGM_OUT 4
#endif
#ifndef WGM_F1
#define WGM_F1 4
#endif
#ifndef WGM_F2
#define WGM_F2 4
#endif
#ifndef PREP_NT
#define PREP_NT 4
#endif
#ifndef PROBE_DUP
#define PROBE_DUP 0
#endif
#ifndef PROBE_SUB
#define PROBE_SUB 0
#endif
#ifndef PROBE_MASK
#define PROBE_MASK 0u
#endif
namespace pg8 {
#define PG8_LAS __attribute__((address_space(3)))
typedef unsigned short bf16_t;
typedef short bf16x8 __attribute__((ext_vector_type(8)));
typedef float f32x4 __attribute__((ext_vector_type(4)));
typedef unsigned u32x4 __attribute__((ext_vector_type(4)));
typedef unsigned u32x2 __attribute__((ext_vector_type(2)));
constexpr int BM = 256, BK = 64, HALF = 128, HTB = HALF * BK * 2  , STAGE_BYTES = 8 * HTB, NXCD = 8, WGM = 1;

__host__ __device__ __forceinline__ int lds_byte(int r, int c) { const int st = (r >> 4) * 2 + (c >> 5), rr = r & 15, cc = c & 31, ob = rr * 64 + cc * 2; return st * 1024 + (ob ^ (((ob >> 9) & 1) << 5)); }
__host__ __device__ __forceinline__ void stage_rc(int b, int& R, int& C) { const int st = b / 1024, sb = b % 1024, swz = sb ^ (((sb >> 9) & 1) << 5); R = (st >> 1) * 16 + swz / 64; C = (st & 1) * 32 + (swz % 64) / 2; }
__host__ __device__ __forceinline__ int perm32(int rho) { const int n = rho >> 4, i = rho & 15; return 8 * (i >> 2) + 4 * n + (i & 3); }

struct Unit { int pm, pn; };
struct Gemm { const bf16_t* A; const bf16_t* Bt; int M, N, K; };

struct StaticOrder {
    int nM, nN, nwg, G, c, wgm;
    __host__ __device__ void init(int M, int N, int G_, int c_, int wgm_ = WGM) { nM = M / BM; nN = N / BM; nwg = nM * nN; G = G_; c = c_; wgm = wgm_; }
    __host__ __device__ bool next(int i, Unit& u) const {
        const long L = (long)i * G + c; if (L >= nwg) return false;
        int wgid = (int)L; { const int q = nwg / NXCD, r = nwg % NXCD, xcd = wgid % NXCD, off = wgid / NXCD; wgid = (xcd < r ? xcd * (q + 1) : r * (q + 1) + (xcd - r) * q) + off; }
        const int nig = wgm * nN, gid = wgid / nig, fm = gid * wgm, gsz = (nM - fm) < wgm ? (nM - fm) : wgm;
        u.pm = fm + ((wgid % nig) % gsz); u.pn = (wgid % nig) / gsz; return true;
    }
    __device__ __forceinline__ void a_ready(const Unit&) const {}
    __device__ __forceinline__ void done(const Unit&) const {}
};

__device__ __forceinline__ unsigned cvt_pk_bf16(float lo, float hi) { unsigned r; asm volatile("v_cvt_pk_bf16_f32 %0, %1, %2" : "=v"(r) : "v"(lo), "v"(hi)); return r; }
struct EpiP {
    static constexpr bool PERM = true, AFTER_DRAIN = false;
    bf16_t* P; float* G; const float* RS; const float* bias;
    __device__ __forceinline__ void operator()(const f32x4 (&acc)[2][2][4][2], const Unit& u, int wr, int wc, int fr, int fq) const {
        const int row0 = u.pm * BM + wr * 64 + fr; const int cond = (u.pm < 16) ? 0 : 1 + ((u.pm - 16) >> 2);
        const int col0 = u.pn * BM + wc * 32 + 8 * fq;
        const float* bp = bias + (size_t)cond * 5376 + col0;
        if (u.pn < 20) {
#pragma unroll
            for (int ai = 0; ai < 2; ++ai)
#pragma unroll
                for (int m = 0; m < 4; ++m) { const int row = row0 + ai * HALF + m * 16; bf16_t* rowp = P + (size_t)row * 5120 + col0;
                    const float rs = RS ? rsqrtf(RS[row] * (1.f / 2048.f) + 1e-6f) : 1.f;
#pragma unroll
                    for (int bj = 0; bj < 2; ++bj) { f32x4 v0 = acc[ai][bj][m][0] * rs, v1 = acc[ai][bj][m][1] * rs;
                        if (RS) { v0 += *(const f32x4*)(bp + bj * HALF); v1 += *(const f32x4*)(bp + bj * HALF + 4); }
                        u32x4 w; w.x = cvt_pk_bf16(v0[0], v0[1]); w.y = cvt_pk_bf16(v0[2], v0[3]); w.z = cvt_pk_bf16(v1[0], v1[1]); w.w = cvt_pk_bf16(v1[2], v1[3]);
                        *(u32x4*)(rowp + bj * HALF) = w; } }
        } else if (wc < 2) {
            const int gc0 = wc * 32 + 8 * fq;
#pragma unroll
            for (int ai = 0; ai < 2; ++ai)
#pragma unroll
                for (int m = 0; m < 4; ++m) { const int row = row0 + ai * HALF + m * 16; float* rowp = G + (size_t)row * 64 + gc0;
                    const float rs = RS ? rsqrtf(RS[row] * (1.f / 2048.f) + 1e-6f) : 1.f;
                    f32x4 v0 = acc[ai][0][m][0] * rs, v1 = acc[ai][0][m][1] * rs;
                    if (RS) { v0 += *(const f32x4*)(bp); v1 += *(const f32x4*)(bp + 4); }
                    *(f32x4*)(rowp) = v0; *(f32x4*)(rowp + 4) = v1; }
        }
    }
};
struct EpiRes {
    static constexpr bool PERM = true, AFTER_DRAIN = false;
    const void* base0; const void* base1; void* out; const float* gate;
    bf16_t* Hn; const float* gnorm; const float* scale; float* RS;
    int base_bf16, out_bf16;
    __device__ __forceinline__ void operator()(const f32x4 (&acc)[2][2][4][2], const Unit& u, int wr, int wc, int fr, int fq) const {
        const int row0 = u.pm * BM + wr * 64 + fr; const int col0 = u.pn * BM + wc * 32 + 8 * fq;
        const int cond = (u.pm < 16) ? 0 : 1 + ((u.pm - 16) >> 2);
        const void* base = (u.pm < 16) ? base0 : base1;
        const float* gp = gate + (size_t)cond * 6 * 2048 + col0;
        f32x4 gv[2][2], gs[2][2];
#pragma unroll
        for (int bj = 0; bj < 2; ++bj)
#pragma unroll
            for (int n = 0; n < 2; ++n) { gv[bj][n] = *(const f32x4*)(gp + bj * HALF + n * 4);
                if (Hn) gs[bj][n] = *(const f32x4*)(gnorm + col0 + bj * HALF + n * 4) * (*(const f32x4*)(scale + (size_t)cond * 6 * 2048 + col0 + bj * HALF + n * 4) + 1.f); }
#pragma unroll
        for (int ai = 0; ai < 2; ++ai)
#pragma unroll
            for (int m = 0; m < 4; ++m) { const int row = row0 + ai * HALF + m * 16; const size_t off = (size_t)row * 2048 + col0; float ss = 0.f;
#pragma unroll
                for (int bj = 0; bj < 2; ++bj) { f32x4 b0, b1;
                    if (base_bf16) { const u32x4 w = *(const u32x4*)((const bf16_t*)base + off + bj * HALF);
                        b0 = (f32x4){__uint_as_float(w.x << 16), __uint_as_float(w.x & 0xffff0000u), __uint_as_float(w.y << 16), __uint_as_float(w.y & 0xffff0000u)};
                        b1 = (f32x4){__uint_as_float(w.z << 16), __uint_as_float(w.z & 0xffff0000u), __uint_as_float(w.w << 16), __uint_as_float(w.w & 0xffff0000u)}; }
                    else { b0 = *(const f32x4*)((const float*)base + off + bj * HALF); b1 = *(const f32x4*)((const float*)base + off + bj * HALF + 4); }
                    const f32x4 x0 = b0 + gv[bj][0] * acc[ai][bj][m][0], x1 = b1 + gv[bj][1] * acc[ai][bj][m][1];
                    if (out_bf16) { u32x4 w; w.x = cvt_pk_bf16(x0[0], x0[1]); w.y = cvt_pk_bf16(x0[2], x0[3]); w.z = cvt_pk_bf16(x1[0], x1[1]); w.w = cvt_pk_bf16(x1[2], x1[3]); *(u32x4*)((bf16_t*)out + off + bj * HALF) = w; }
                    else { *(f32x4*)((float*)out + off + bj * HALF) = x0; *(f32x4*)((float*)out + off + bj * HALF + 4) = x1; }
                    if (Hn) { ss += ((x0[0] * x0[0] + x0[1] * x0[1]) + (x0[2] * x0[2] + x0[3] * x0[3])) + ((x1[0] * x1[0] + x1[1] * x1[1]) + (x1[2] * x1[2] + x1[3] * x1[3]));
                        const f32x4 y0 = x0 * gs[bj][0], y1 = x1 * gs[bj][1];
                        u32x4 w; w.x = cvt_pk_bf16(y0[0], y0[1]); w.y = cvt_pk_bf16(y0[2], y0[3]); w.z = cvt_pk_bf16(y1[0], y1[1]); w.w = cvt_pk_bf16(y1[2], y1[3]);
                        *(u32x4*)(Hn + off + bj * HALF) = w; } }
                if (Hn) { ss += __shfl_xor(ss, 16); ss += __shfl_xor(ss, 32); if (fq == 0) atomicAdd(RS + row, ss); } }
    }
};
struct EpiSqRelu {
    static constexpr bool PERM = true, AFTER_DRAIN = false;
    bf16_t* O; int ldc; const float* RS; const float* bias;
    __device__ __forceinline__ void operator()(const f32x4 (&acc)[2][2][4][2], const Unit& u, int wr, int wc, int fr, int fq) const {
        const int row0 = u.pm * BM + wr * 64 + fr; const int col0 = u.pn * BM + wc * 32 + 8 * fq;
        const int cond = (u.pm < 16) ? 0 : 1 + ((u.pm - 16) >> 2);
        const float* bp = bias + (size_t)cond * ldc + col0;
        f32x4 bv[2][2];
#pragma unroll
        for (int bj = 0; bj < 2; ++bj)
#pragma unroll
            for (int n = 0; n < 2; ++n) bv[bj][n] = *(const f32x4*)(bp + bj * HALF + 4 * n);
#pragma unroll
        for (int ai = 0; ai < 2; ++ai)
#pragma unroll
            for (int m = 0; m < 4; ++m) { const int row = row0 + ai * HALF + m * 16; bf16_t* rowp = O + (size_t)row * ldc + col0;
                const float rs = rsqrtf(RS[row] * (1.f / 2048.f) + 1e-6f);
#pragma unroll
                for (int bj = 0; bj < 2; ++bj) { f32x4 v0 = acc[ai][bj][m][0] * rs + bv[bj][0], v1 = acc[ai][bj][m][1] * rs + bv[bj][1];
#pragma unroll
                    for (int e = 0; e < 4; ++e) { const float a = fmaxf(v0[e], 0.f), b = fmaxf(v1[e], 0.f); v0[e] = a * a; v1[e] = b * b; }
                    u32x4 w; w.x = cvt_pk_bf16(v0[0], v0[1]); w.y = cvt_pk_bf16(v0[2], v0[3]); w.z = cvt_pk_bf16(v1[0], v1[1]); w.w = cvt_pk_bf16(v1[2], v1[3]);
                    *(u32x4*)(rowp + bj * HALF) = w; } }
    }
};

template <class Epi, class Sched, bool ALIGN_EPI = false, bool SP2 = false>
__device__ __forceinline__ void gemm_phase(PG8_LAS unsigned char* lds, const Gemm g, const Sched& S, const Epi& E) {
    int tid = threadIdx.x; asm volatile("" : "+v"(tid)); const int wid = __builtin_amdgcn_readfirstlane(tid >> 6), lane = tid & 63, wr = wid >> 2, wc = wid & 3, fr = lane & 15, fq = lane >> 4;
    const int K = g.K, nt = K / BK;
    unsigned voffA[2], voffB[2];
#pragma unroll
    for (int i = 0; i < 2; ++i) { int R, C; stage_rc(tid * 16 + i * 8192, R, C); const int Rb = Epi::PERM ? ((R & ~31) + perm32(R & 31)) : R;
        voffA[i] = (unsigned)(R * K + C) * 2u; voffB[i] = (unsigned)(Rb * K + C) * 2u; }
    const size_t kstep = (size_t)(BK * 2);
    const size_t hstep = (size_t)HALF * K * 2;
    const size_t tstep = 2 * hstep;
    const unsigned ldsw = (unsigned)wid * 1024u;
    const int aoff = lds_byte(wr * 64 + fr, fq * 8), boff = lds_byte(wc * 32 + fr, fq * 8);
#define PG8_SA(b, h) (((b) * 2 + (h)) * HTB)
#define PG8_SB(b, h) ((4 + (b) * 2 + (h)) * HTB)
#define PG8_STAGE(bufoff, gbase, voff) do { _Pragma("unroll") for (int _i = 0; _i < 2; ++_i) \
        __builtin_amdgcn_global_load_lds((const unsigned*)((const char*)(gbase) + (voff)[_i]), (PG8_LAS unsigned*)(lds + (bufoff) + ldsw + _i * 8192), 16, 0, 0); } while (0)
#define PG8_LDA(dst, b, h) do { _Pragma("unroll") for (int m = 0; m < 4; ++m) _Pragma("unroll") for (int k = 0; k < 2; ++k) dst[m][k] = *(const PG8_LAS bf16x8*)(lds + PG8_SA(b, h) + aoff + m * 2048 + k * 1024); } while (0)
#define PG8_LDB(dst, b, h) do { _Pragma("unroll") for (int n = 0; n < 2; ++n) _Pragma("unroll") for (int k = 0; k < 2; ++k) dst[n][k] = *(const PG8_LAS bf16x8*)(lds + PG8_SB(b, h) + boff + n * 2048 + k * 1024); } while (0)
#define PG8_MMA(ai, bj, At, Bt) do { __builtin_amdgcn_s_setprio(1); _Pragma("unroll") for (int m = 0; m < 4; ++m) _Pragma("unroll") for (int n = 0; n < 2; ++n) _Pragma("unroll") for (int k = 0; k < 2; ++k) \
        acc[ai][bj][m][n] = __builtin_amdgcn_mfma_f32_16x16x32_bf16(Bt[n][k], At[m][k], acc[ai][bj][m][n], 0, 0, 0); __builtin_amdgcn_s_setprio(0); } while (0)
#define PG8_WAIT_V(n) asm volatile("s_waitcnt vmcnt(" #n ")" ::: "memory")
#define PG8_WAIT_L(n) asm volatile("s_waitcnt lgkmcnt(" #n ")" ::: "memory")
#define PG8_BAR __builtin_amdgcn_s_barrier()
#define PG8_SCHED __builtin_amdgcn_sched_barrier(0)
    Unit cur, nxt; int ui = 0;
    if (!S.next(0, cur)) return;
    f32x4 acc[2][2][4][2];
#pragma unroll
    for (int a = 0; a < 2; ++a)
#pragma unroll
        for (int b = 0; b < 2; ++b)
#pragma unroll
            for (int m = 0; m < 4; ++m)
#pragma unroll
                for (int n = 0; n < 2; ++n) acc[a][b][m][n] = (f32x4){0.f, 0.f, 0.f, 0.f};
    bf16x8 At[4][2], B0[2][2], B1[2][2];
    const char* cA = (const char*)g.A + (size_t)cur.pm * tstep; const char* cB = (const char*)g.Bt + (size_t)cur.pn * tstep;
    S.a_ready(cur);
    if constexpr (SP2) {
        PG8_STAGE(PG8_SB(0, 0), cB, voffB); PG8_STAGE(PG8_SB(0, 1), cB + hstep, voffB); PG8_STAGE(PG8_SA(0, 0), cA, voffA); PG8_STAGE(PG8_SA(0, 1), cA + hstep, voffA);
        if (wr == 1) PG8_BAR;
        PG8_WAIT_V(2); PG8_BAR;
        PG8_STAGE(PG8_SB(1, 0), cB + kstep, voffB); PG8_STAGE(PG8_SA(1, 0), cA + kstep, voffA); PG8_STAGE(PG8_SB(1, 1), cB + hstep + kstep, voffB);
        PG8_WAIT_V(6); PG8_BAR;
    } else {
        PG8_STAGE(PG8_SB(0, 0), cB, voffB); PG8_STAGE(PG8_SA(0, 0), cA, voffA); PG8_STAGE(PG8_SB(0, 1), cB + hstep, voffB); PG8_STAGE(PG8_SA(0, 1), cA + hstep, voffA);
        if (wr == 1) PG8_BAR;
        PG8_WAIT_V(4); PG8_BAR;
        PG8_STAGE(PG8_SB(1, 0), cB + kstep, voffB); PG8_STAGE(PG8_SA(1, 0), cA + kstep, voffA); PG8_STAGE(PG8_SB(1, 1), cB + hstep + kstep, voffB);
        PG8_WAIT_V(6); PG8_BAR;
    }
    for (;;) {
        const bool has_next = S.next(ui + 1, nxt);
        const char* nA = has_next ? (const char*)g.A + (size_t)nxt.pm * tstep : cA; const char* nB = has_next ? (const char*)g.Bt + (size_t)nxt.pn * tstep : cB;
        for (int t = 0; t < nt; t += 2) {
            const bool last = (t == nt - 2);
            const char* a1 = cA + (size_t)(t + 1) * kstep;
            const char* a2 = last ? nA : cA + (size_t)(t + 2) * kstep; const char* b2 = last ? nB : cB + (size_t)(t + 2) * kstep;
            const char* a3 = a2 + kstep; const char* b3 = b2 + kstep;
            if (last && has_next) S.a_ready(nxt);
            if constexpr (SP2) {
            PG8_LDB(B0, 0, 0); PG8_LDB(B1, 0, 1); PG8_SCHED; PG8_LDA(At, 0, 0); PG8_STAGE(PG8_SA(1, 1), a1 + hstep, voffA);
            PG8_WAIT_V(8); PG8_WAIT_L(0); PG8_BAR; PG8_MMA(0, 0, At, B0); PG8_MMA(0, 1, At, B1); PG8_BAR; PG8_SCHED;
            PG8_LDA(At, 0, 1); PG8_STAGE(PG8_SB(0, 0), b2, voffB); PG8_STAGE(PG8_SB(0, 1), b2 + hstep, voffB); PG8_STAGE(PG8_SA(0, 0), a2, voffA);
            PG8_WAIT_V(8); PG8_WAIT_L(0); PG8_BAR; PG8_MMA(1, 0, At, B0); PG8_MMA(1, 1, At, B1); PG8_BAR; PG8_SCHED;
            PG8_LDB(B0, 1, 0); PG8_LDB(B1, 1, 1); PG8_SCHED; PG8_LDA(At, 1, 0); PG8_STAGE(PG8_SA(0, 1), a2 + hstep, voffA);
            PG8_WAIT_V(8); PG8_WAIT_L(0); PG8_BAR; PG8_MMA(0, 0, At, B0); PG8_MMA(0, 1, At, B1); PG8_BAR; PG8_SCHED;
            PG8_LDA(At, 1, 1); PG8_STAGE(PG8_SB(1, 0), b3, voffB); PG8_STAGE(PG8_SB(1, 1), b3 + hstep, voffB); PG8_STAGE(PG8_SA(1, 0), a3, voffA);
            PG8_WAIT_V(8); PG8_WAIT_L(0); PG8_BAR; PG8_MMA(1, 0, At, B0); PG8_MMA(1, 1, At, B1); PG8_BAR; PG8_SCHED;
            } else {
            PG8_LDB(B0, 0, 0); PG8_SCHED; PG8_LDA(At, 0, 0); PG8_STAGE(PG8_SA(1, 1), a1 + hstep, voffA);
            PG8_WAIT_L(8); PG8_BAR; PG8_WAIT_L(0); PG8_MMA(0, 0, At, B0); PG8_BAR; PG8_SCHED;
            PG8_LDB(B1, 0, 1); PG8_STAGE(PG8_SB(0, 0), b2, voffB);
            PG8_BAR; PG8_WAIT_L(0); PG8_MMA(0, 1, At, B1); PG8_BAR;
            PG8_LDA(At, 0, 1); PG8_STAGE(PG8_SA(0, 0), a2, voffA);
            PG8_BAR; PG8_WAIT_L(0); PG8_MMA(1, 0, At, B0); PG8_BAR; PG8_SCHED;
            PG8_STAGE(PG8_SB(0, 1), b2 + hstep, voffB);
            PG8_WAIT_V(6); PG8_BAR; PG8_MMA(1, 1, At, B1); PG8_BAR;
            PG8_LDB(B0, 1, 0); PG8_SCHED; PG8_LDA(At, 1, 0); PG8_STAGE(PG8_SA(0, 1), a2 + hstep, voffA);
            PG8_WAIT_L(8); PG8_BAR; PG8_WAIT_L(0); PG8_MMA(0, 0, At, B0); PG8_BAR; PG8_SCHED;
            PG8_LDB(B1, 1, 1); PG8_STAGE(PG8_SB(1, 0), b3, voffB);
            PG8_BAR; PG8_WAIT_L(0); PG8_MMA(0, 1, At, B1); PG8_BAR;
            PG8_LDA(At, 1, 1); PG8_STAGE(PG8_SA(1, 0), a3, voffA);
            PG8_BAR; PG8_WAIT_L(0); PG8_MMA(1, 0, At, B0); PG8_BAR; PG8_SCHED;
            PG8_STAGE(PG8_SB(1, 1), b3 + hstep, voffB);
            PG8_WAIT_V(6); PG8_BAR; PG8_MMA(1, 1, At, B1); PG8_BAR;
            }
        }
        if constexpr (ALIGN_EPI) { if (wr == 0) PG8_BAR; }
        if constexpr (!Epi::AFTER_DRAIN) { E(acc, cur, wr, wc, fr, fq); S.done(cur); }
        if (!has_next) break;
#pragma unroll
        for (int a = 0; a < 2; ++a)
#pragma unroll
            for (int b = 0; b < 2; ++b)
#pragma unroll
                for (int m = 0; m < 4; ++m)
#pragma unroll
                    for (int n = 0; n < 2; ++n) acc[a][b][m][n] = (f32x4){0.f, 0.f, 0.f, 0.f};
        cur = nxt; cA = nA; cB = nB; ++ui;
        if constexpr (ALIGN_EPI) { if (wr == 1) PG8_BAR; }
    }
    PG8_WAIT_V(0);
    if constexpr (!ALIGN_EPI) { if (wr == 0) PG8_BAR; }
    PG8_BAR;
    if constexpr (Epi::AFTER_DRAIN) { E.fused(acc, cur, wr, wc, fr, fq, lds, wid, lane); S.done(cur); }
#undef PG8_SA
#undef PG8_SB
#undef PG8_STAGE
#undef PG8_LDA
#undef PG8_LDB
#undef PG8_MMA
#undef PG8_WAIT_V
#undef PG8_WAIT_L
#undef PG8_BAR
#undef PG8_SCHED
}
}
namespace att {
typedef unsigned short bf16;
constexpr int   D = 128, NW = 8, QBLK = 32, KVBLK = 64;
constexpr float SCALE = 0.088388347648318440f;
constexpr float THR = 8.f;
constexpr int SDEPTH = 2;
constexpr size_t SHM_V = KVBLK * D * 2, SHM_K = KVBLK * D * 2, SHM_ATTN = 2 * SHM_V + 2 * SHM_K + NW * 64 * 4;
__device__ __forceinline__ bf16 f2bf_s(float f) { unsigned u = __builtin_bit_cast(unsigned, f); return (bf16)((u + 0x7fffu + ((u >> 16) & 1u)) >> 16); }
using bf16x8 = __attribute__((ext_vector_type(8))) short;
using s16x4  = __attribute__((ext_vector_type(4))) short;
using f32x16 = __attribute__((ext_vector_type(16))) float;
using f32x8  = __attribute__((ext_vector_type(8))) float;
using u32x4  = __attribute__((ext_vector_type(4))) unsigned;
#define KSWZ(row, colB) ((row) * 256 + ((colB) ^ (((row) & 7) << 4)))
#define SBAR() __builtin_amdgcn_sched_barrier(0)
__device__ __forceinline__ int crow(int r, int hi) { return (r & 3) + 8 * (r >> 2) + 4 * hi; }
__device__ __forceinline__ unsigned cvtpk(float lo, float hi) {
  unsigned r; asm volatile("v_cvt_pk_bf16_f32 %0, %1, %2" : "=v"(r) : "v"(lo), "v"(hi)); return r;
}
__device__ __forceinline__ void partialSM(f32x16& p0, f32x16& p1, float& m_reg, float& mn, float& alpha) {
  constexpr float C = SCALE * 1.4426950408889634f;
  float pmax = p0[0]; for (int r = 1; r < 16; ++r) pmax = fmaxf(pmax, p0[r]); for (int r = 0; r < 16; ++r) pmax = fmaxf(pmax, p1[r]);
  { auto rr = __builtin_amdgcn_permlane32_swap(__float_as_uint(pmax), __float_as_uint(pmax), false, false);
    pmax = fmaxf(__uint_as_float(rr[0]), __uint_as_float(rr[1])); }
  if (__builtin_expect(__all(pmax - m_reg <= THR / SCALE), 1)) { mn = m_reg; alpha = 1.f; }
  else { mn = fmaxf(m_reg, pmax); alpha = __builtin_amdgcn_exp2f((m_reg - mn) * C); m_reg = mn; }
  float mnC = -mn * C;
  for (int r = 0; r < 16; ++r) p0[r] = fmaf(p0[r], C, mnC); for (int r = 0; r < 16; ++r) p1[r] = fmaf(p1[r], C, mnC);
  for (int r = 0; r < 16; ++r) p0[r] = __builtin_amdgcn_exp2f(p0[r]);
}
__device__ __forceinline__ void finishSM(f32x16& p0, f32x16& p1, float alpha, float& l_reg, bf16x8& pa0, bf16x8& pa1, bf16x8& pa2, bf16x8& pa3) {
  for (int r = 0; r < 16; ++r) p1[r] = __builtin_amdgcn_exp2f(p1[r]);
  float ps = 0; for (int r = 0; r < 16; ++r) ps += p0[r]; for (int r = 0; r < 16; ++r) ps += p1[r];
  { auto rr = __builtin_amdgcn_permlane32_swap(__float_as_uint(ps), __float_as_uint(ps), false, false);
    ps = __uint_as_float(rr[0]) + __uint_as_float(rr[1]); }
  l_reg = l_reg * alpha + ps;
#define PK4(P, BASE, OUT) do { unsigned a0 = cvtpk(P[BASE + 0], P[BASE + 1]), a1 = cvtpk(P[BASE + 2], P[BASE + 3]);   \
    unsigned b0 = cvtpk(P[BASE + 4], P[BASE + 5]), b1 = cvtpk(P[BASE + 6], P[BASE + 7]);                              \
    auto r0 = __builtin_amdgcn_permlane32_swap(a0, b0, false, false); auto r1 = __builtin_amdgcn_permlane32_swap(a1, b1, false, false); \
    u32x4 w = {r0[0], r1[0], r0[1], r1[1]}; OUT = *reinterpret_cast<bf16x8*>(&w); } while (0)
  PK4(p0, 0, pa0); PK4(p0, 8, pa1); PK4(p1, 0, pa2); PK4(p1, 8, pa3);
#undef PK4
}
__device__ __forceinline__ void qkt(f32x16& p0, f32x16& p1, const bf16* Ks, const bf16x8* qr, int r32, int hi) {
  p0 = f32x16{}; p1 = f32x16{};
  for (int d0 = 0; d0 < 8; ++d0) { int cb = (d0 * 16 + hi * 8) * 2;
    bf16x8 b0 = *reinterpret_cast<const bf16x8*>((const char*)Ks + KSWZ(r32, cb));
    bf16x8 b1 = *reinterpret_cast<const bf16x8*>((const char*)Ks + KSWZ(32 + r32, cb));
    p0 = __builtin_amdgcn_mfma_f32_32x32x16_bf16(b0, qr[d0], p0, 0, 0, 0);
    p1 = __builtin_amdgcn_mfma_f32_32x32x16_bf16(b1, qr[d0], p1, 0, 0, 0); }
}
__device__ __forceinline__ int v_st(int k, int c) { const int kk = (k & ~0xC) | ((k & 4) << 1) | ((k & 8) >> 1); return ((kk >> 3) * 4 + (c >> 5)) * 512 + ((kk & 7) * 32 + (c & 31)) * 2; }
__device__ __forceinline__ int v_rd_base(int lane) { return ((lane & 3) << 3) | (((lane >> 2) & 3) << 6) | (((lane >> 4) & 1) << 5) | (((lane >> 5) & 1) << 8); }
constexpr int v_rd_off(int d0, int ks, int half) { return d0 * 512 + ks * 4096 + half * 2048; }
template <int OFF> __device__ __forceinline__ s16x4 tr_read(int vb) {
  s16x4 r; asm volatile("ds_read_b64_tr_b16 %0, %1 offset:%2" : "=&v"(r) : "v"(vb), "i"(OFF) : "memory"); return r;
}
template <int D0> __device__ __forceinline__ void pv_one(f32x16& od, int vb, bf16x8 pa0, bf16x8 pa1, bf16x8 pa2, bf16x8 pa3) {
  const s16x4 l0 = tr_read<v_rd_off(D0, 0, 0)>(vb), h0 = tr_read<v_rd_off(D0, 0, 1)>(vb), l1 = tr_read<v_rd_off(D0, 1, 0)>(vb), h1 = tr_read<v_rd_off(D0, 1, 1)>(vb);
  const s16x4 l2 = tr_read<v_rd_off(D0, 2, 0)>(vb), h2 = tr_read<v_rd_off(D0, 2, 1)>(vb), l3 = tr_read<v_rd_off(D0, 3, 0)>(vb), h3 = tr_read<v_rd_off(D0, 3, 1)>(vb);
  asm volatile("s_waitcnt lgkmcnt(0)" ::: "memory"); SBAR();
#define PK(L, H) (bf16x8){L[0], L[1], L[2], L[3], H[0], H[1], H[2], H[3]}
  od = __builtin_amdgcn_mfma_f32_32x32x16_bf16(pa0, PK(l0, h0), od, 0, 0, 0);
  od = __builtin_amdgcn_mfma_f32_32x32x16_bf16(pa1, PK(l1, h1), od, 0, 0, 0);
  od = __builtin_amdgcn_mfma_f32_32x32x16_bf16(pa2, PK(l2, h2), od, 0, 0, 0);
  od = __builtin_amdgcn_mfma_f32_32x32x16_bf16(pa3, PK(l3, h3), od, 0, 0, 0);
#undef PK
}
__device__ __forceinline__ void pv_d0(f32x16* o, int vb, bf16x8 pa0, bf16x8 pa1, bf16x8 pa2, bf16x8 pa3) {
  pv_one<0>(o[0], vb, pa0, pa1, pa2, pa3); pv_one<1>(o[1], vb, pa0, pa1, pa2, pa3); pv_one<2>(o[2], vb, pa0, pa1, pa2, pa3); pv_one<3>(o[3], vb, pa0, pa1, pa2, pa3);
}

template <int LDQ, int LDK, int LDO>
__device__ __forceinline__ void attn_dense_body(const bf16* Qb, const bf16* Kh, const bf16* Vh,
                                                bf16* Ob, int seq, char* lds) {
  int tid = threadIdx.x; asm volatile("" : "+v"(tid)); const int wid = tid >> 6, lane = tid & 63, r32 = lane & 31, hi = lane >> 5;
  bf16* V_lds = (bf16*)lds; bf16* K_lds = (bf16*)(lds + 2 * SHM_V);
  float* ws = (float*)(lds + 2 * SHM_V + 2 * SHM_K) + wid * 64; float* li_l = ws; float* al_l = ws + 32;
  float m_reg = -1e30f, l_reg = 0; f32x16 o[4] = {}; bf16x8 qr[8];
  const bf16* Qw = Qb + (long)(wid * QBLK + r32) * LDQ + hi * 8;
#pragma unroll
  for (int d0 = 0; d0 < 8; ++d0) qr[d0] = *reinterpret_cast<const bf16x8*>(Qw + d0 * 16);
  const int sr = tid >> 4, sc = (tid & 15) * 8, vst0 = v_st(sr, sc), vst1 = v_st(32 + sr, sc);
  const int vb0 = (int)(uintptr_t)V_lds + v_rd_base(lane);
  struct { bf16x8 vs0, vs1, ks0, ks1; } sr_[SDEPTH];
#define SLOAD(i, k0) do { sr_[i].vs0 = (*reinterpret_cast<const bf16x8*>(&Vh[(long)((k0) + sr) * LDK + sc])); sr_[i].vs1 = (*reinterpret_cast<const bf16x8*>(&Vh[(long)((k0) + 32 + sr) * LDK + sc])); \
    sr_[i].ks0 = (*reinterpret_cast<const bf16x8*>(&Kh[(long)((k0) + sr) * LDK + sc])); sr_[i].ks1 = (*reinterpret_cast<const bf16x8*>(&Kh[(long)((k0) + 32 + sr) * LDK + sc])); } while (0)
#define SWRITE(b, i) do { *(bf16x8*)((char*)V_lds + (b) * SHM_V + vst0) = (sr_[i].vs0);          \
    *(bf16x8*)((char*)V_lds + (b) * SHM_V + vst1) = (sr_[i].vs1); int kc = sc * 2;               \
    *(bf16x8*)((char*)K_lds + (b) * SHM_K + KSWZ(sr, kc)) = (sr_[i].ks0);                       \
    *(bf16x8*)((char*)K_lds + (b) * SHM_K + KSWZ(32 + sr, kc)) = (sr_[i].ks1); } while (0)
#define SWAIT() do { if constexpr (SDEPTH == 2) asm volatile("s_waitcnt vmcnt(4)" ::: "memory"); else asm volatile("s_waitcnt vmcnt(0)" ::: "memory"); } while (0)
#define RESC(a) do { if (__any((a) < 1.f)) { if (hi == 0) al_l[r32] = (a); asm volatile("s_waitcnt lgkmcnt(0)" ::: "memory"); \
    for (int d = 0; d < 4; ++d) for (int r = 0; r < 16; ++r) o[d][r] *= al_l[crow(r, hi)]; } } while (0)
  f32x16 pA0, pA1, pB0, pB1; float mnA, mnB, alA, alB; bf16x8 pa0, pa1, pa2, pa3; const int NT = seq / KVBLK;
  constexpr int SE = 0, SO = SDEPTH - 1;
  SLOAD(SE, 0); asm volatile("s_waitcnt vmcnt(0)" ::: "memory"); SWRITE(0, SE); __syncthreads();
  qkt(pA0, pA1, K_lds, qr, r32, hi); partialSM(pA0, pA1, m_reg, mnA, alA);
  SLOAD(SO, KVBLK); if constexpr (SDEPTH == 2) { if (2 < NT) SLOAD(SE, 2 * KVBLK); }
  SWAIT(); SWRITE(1, SO); __syncthreads();
  for (int j = 1; j + 1 < NT; j += 2) {
    SBAR(); qkt(pB0, pB1, (bf16*)((char*)K_lds + SHM_K), qr, r32, hi);
    finishSM(pA0, pA1, alA, l_reg, pa0, pa1, pa2, pa3); SBAR();
    SLOAD(SO, (j + SDEPTH) * KVBLK); SBAR();
    pv_d0(o, vb0, pa0, pa1, pa2, pa3); partialSM(pB0, pB1, m_reg, mnB, alB);
    __syncthreads(); SWAIT(); SWRITE(0, SE);
    RESC(alB); __syncthreads();
    SBAR(); qkt(pA0, pA1, K_lds, qr, r32, hi);
    finishSM(pB0, pB1, alB, l_reg, pa0, pa1, pa2, pa3); SBAR();
    if (SDEPTH == 1 || j + 3 < NT) SLOAD(SE, (j + 1 + SDEPTH) * KVBLK); SBAR();
    pv_d0(o, vb0 + (int)SHM_V, pa0, pa1, pa2, pa3); partialSM(pA0, pA1, m_reg, mnA, alA);
    __syncthreads(); SWAIT(); SWRITE(1, SO);
    RESC(alA); __syncthreads();
  }
  SBAR(); qkt(pB0, pB1, (bf16*)((char*)K_lds + SHM_K), qr, r32, hi);
  finishSM(pA0, pA1, alA, l_reg, pa0, pa1, pa2, pa3); SBAR();
  pv_d0(o, vb0, pa0, pa1, pa2, pa3); partialSM(pB0, pB1, m_reg, mnB, alB);
  __syncthreads(); RESC(alB);
  finishSM(pB0, pB1, alB, l_reg, pa0, pa1, pa2, pa3); SBAR();
  pv_d0(o, vb0 + (int)SHM_V, pa0, pa1, pa2, pa3);
  if (hi == 0) li_l[r32] = l_reg; asm volatile("s_waitcnt lgkmcnt(0)" ::: "memory");
  float rli[16];
#pragma unroll
  for (int r = 0; r < 16; ++r) rli[r] = __builtin_amdgcn_rcpf(li_l[crow(r, hi)]);
  bf16* Ow = Ob + (long)(wid * QBLK) * LDO;
#pragma unroll
  for (int r = 0; r < 16; ++r) { int orow = crow(r, hi);
    for (int d0 = 0; d0 < 4; ++d0) Ow[(long)orow * LDO + d0 * 32 + r32] = f2bf_s(o[d0][r] * rli[r]); }
#undef SLOAD
#undef SWRITE
#undef SWAIT
#undef RESC
}
#undef KSWZ
#undef SBAR
}
typedef unsigned short bf16_t;
typedef float f32x4 __attribute__((ext_vector_type(4)));
typedef float f32x2 __attribute__((ext_vector_type(2)));
typedef unsigned u32x4 __attribute__((ext_vector_type(4)));
typedef unsigned u32x2 __attribute__((ext_vector_type(2)));
#define LAS __attribute__((address_space(3)))
constexpr int DM = 2048, NTOK = 8192, INC = 5168, PNW = 5376, PLD = 5120, FFD = 8192, NMOD = 12288;
constexpr size_t MiB = 1u << 20;
constexpr size_t WS_CTL = 0, WS_MODS = 1 * MiB, WS_WIN = 2 * MiB, WS_WOUT = 44 * MiB, WS_WFF1 = 60 * MiB, WS_WFF2 = 124 * MiB, WS_H = 188 * MiB, WS_XA = 220 * MiB, WS_XB = 284 * MiB,
    WS_P = 348 * MiB, WS_G = 428 * MiB, WS_QN = 430 * MiB, WS_KB = 446 * MiB, WS_VB = 451 * MiB, WS_LA = 456 * MiB, WS_DQKV = 472 * MiB, WS_GB = 496 * MiB, WS_OG = 497 * MiB, WS_OD = 529 * MiB,
    WS_MIX = 561 * MiB, WS_GQ = 593 * MiB, WS_GO = 601 * MiB, WS_GU = 617 * MiB, WS_GD = 633 * MiB, WS_END = 634 * MiB;
constexpr size_t WS_MC = 188 * MiB, WS_NC = 220 * MiB, WS_QE = 252 * MiB, WS_OL = 268 * MiB;
constexpr size_t WS_QUEUE = 32768;
constexpr size_t WS_RS = 65536;
constexpr size_t WS_BIAS = 1 * MiB + 524288;
constexpr size_t WS_H2 = 348 * MiB;
constexpr size_t ZERO_BYTES = 2 * MiB;
constexpr size_t OUT_Y = 0, OUT_CK = 16777216, OUT_CV = 18874368, OUT_SG = 20971520, OUT_SD = 23068672, OUT_TOTAL = 27262976;
constexpr int LDS_BYTES = 147456;
constexpr float EPS = 1e-6f;

struct Params { const float* in[25]; float* out; unsigned char* ws; };
constexpr int PTAB_OFF = 147456 - 512;
typedef __attribute__((address_space(3))) const unsigned* ptab_t;
__device__ __forceinline__ const void* ldp(ptab_t pt, int i) { unsigned a; asm volatile("v_mov_b32 %0, %1" : "=v"(a) : "s"((unsigned)(unsigned long long)pt + 8u * (unsigned)i));
    const ptab_t q = (ptab_t)(unsigned long long)a; const unsigned lo = __builtin_amdgcn_readfirstlane(q[0]), hi = __builtin_amdgcn_readfirstlane(q[1]); return (const void*)(__attribute__((address_space(1))) const unsigned char*)(((unsigned long long)hi << 32) | lo); }
#define PIN(i) ((const float*)ldp(pt, (i)))
#define POUT ((float*)ldp(pt, 25))
#define PWS ((unsigned char*)ldp(pt, 26))

__device__ __forceinline__ float bf2f(unsigned short v) { return __uint_as_float(((unsigned)v) << 16); }
__device__ __forceinline__ float bflo(unsigned w) { return __uint_as_float(w << 16); }
__device__ __forceinline__ float bfhi(unsigned w) { return __uint_as_float(w & 0xffff0000u); }
__device__ __forceinline__ unsigned short f2bf(float f) { unsigned u = __float_as_uint(f); return (unsigned short)((u + 0x7fffu + ((u >> 16) & 1u)) >> 16); }
typedef __bf16 bf16x2_hw __attribute__((ext_vector_type(2)));
__device__ __forceinline__ unsigned pk2(float lo, float hi) { const f32x2 v = {lo, hi}; return __builtin_bit_cast(unsigned, __builtin_convertvector(v, bf16x2_hw)); }
__device__ __forceinline__ float wave_sum(float v) {
#pragma unroll
    for (int o = 1; o < 64; o <<= 1) v += __shfl_xor(v, o);
    return v;
}
template <int N> __device__ __forceinline__ void wave_sum_n(float (&v)[N]) {
#pragma unroll
    for (int o = 1; o < 64; o <<= 1) {
        float t[N];
#pragma unroll
        for (int i = 0; i < N; ++i) t[i] = __shfl_xor(v[i], o);
#pragma unroll
        for (int i = 0; i < N; ++i) v[i] += t[i];
    }
}
__device__ __forceinline__ float silu_f(float x) { return x * __builtin_amdgcn_rcpf(1.f + __expf(-x)); }
__device__ __forceinline__ float softplus_f(float x) { return fmaxf(x, 0.f) + __logf(1.f + __expf(-fabsf(x))); }
__device__ __forceinline__ float logsigmoid_f(float x) { return fminf(x, 0.f) - __logf(1.f + __expf(-fabsf(x))); }
#define LDS_WAIT() asm volatile("s_waitcnt lgkmcnt(0)" ::: "memory")
#define LDS_BARRIER() do { asm volatile("s_waitcnt lgkmcnt(0)" ::: "memory"); __builtin_amdgcn_s_barrier(); asm volatile("" ::: "memory"); } while (0)
__device__ __forceinline__ int tid_opaque() { int t = threadIdx.x; asm volatile("" : "+v"(t)); return t; }

template <int MODE  >
__device__ __forceinline__ void transpose_item(const float* W, int ldw, int o0, int K, bf16_t* WT, int n0, int k0, LAS float* scr, int lane) {
    const int krow = lane >> 4, n4 = (lane & 15) * 4;
    if (MODE == 0) {
        f32x4 v[16];
#pragma unroll
        for (int i = 0; i < 16; ++i) v[i] = *(const f32x4*)(W + (size_t)(k0 + 4 * i + krow) * ldw + o0 + n4);
#pragma unroll
        for (int i = 0; i < 16; ++i) { LAS float* s = scr + (4 * i + krow) * 65 + n4; s[0] = v[i].x; s[1] = v[i].y; s[2] = v[i].z; s[3] = v[i].w; }
    } else {
#pragma unroll 4
        for (int i = 0; i < 16; ++i) { LAS float* s = scr + (4 * i + krow) * 65 + n4;
#pragma unroll
            for (int e = 0; e < 4; ++e) { const int c = n4 + e; float x = 0.f;
                if (MODE == 1 && c < 48) x = W[(size_t)(k0 + 4 * i + krow) * ldw + (c < 32 ? 1536 + c : 5152 + (c - 32))];
                s[e] = x; } }
    }
    LDS_WAIT(); asm volatile("" ::: "memory");
    const int c8 = lane & 7;
#pragma unroll
    for (int j = 0; j < 8; ++j) { const int n = (lane >> 3) + 8 * j; const LAS float* s = scr + (8 * c8) * 65 + n;
        u32x4 o; o.x = pk2(s[0 * 65], s[1 * 65]); o.y = pk2(s[2 * 65], s[3 * 65]); o.z = pk2(s[4 * 65], s[5 * 65]); o.w = pk2(s[6 * 65], s[7 * 65]);
        *(u32x4*)(WT + (size_t)(n0 + n) * K + k0 + 8 * c8) = o; }
    LDS_WAIT(); asm volatile("" ::: "memory");
}
constexpr int TI_IN = 32 * 84, TI_OUT = 32 * 32, TI_F1 = 32 * 128, TI_F2 = 128 * 32, TI_L = TI_IN + TI_OUT + TI_F1 + TI_F2;
__device__ __forceinline__ void do_transposes(ptab_t pt, LAS unsigned char* lds, int first, int count, int worker, int n_workers) {
    const int tid = tid_opaque(), lane = tid & 63, wave = __builtin_amdgcn_readfirstlane(tid >> 6);
    unsigned char* ws = PWS;
    LAS float* scr = (LAS float*)(lds + wave * 16640);
    for (int it = first + worker; it < first + count; it += n_workers) {
        const int l = it / TI_L; int r = it - l * TI_L;
        const float* W; bf16_t* WT; int ldw, K, kb, nbk, o0, mode = 0;
        if (r < TI_IN) { kb = r / 84; nbk = r % 84; const int n0 = 64 * nbk; W = PIN(12) + (size_t)l * 2048 * INC; WT = (bf16_t*)(ws + WS_WIN) + (size_t)l * PNW * 2048; ldw = INC; K = 2048;
            o0 = n0 < 1536 ? n0 : n0 + 32; mode = n0 < 5120 ? 0 : (n0 == 5120 ? 1 : 2); }
        else if ((r -= TI_IN) < TI_OUT) { kb = r / 32; nbk = r % 32; W = PIN(22) + (size_t)l * 2048 * 2048; WT = (bf16_t*)(ws + WS_WOUT) + (size_t)l * 2048 * 2048; ldw = 2048; K = 2048; o0 = 64 * nbk; }
        else if ((r -= TI_OUT) < TI_F1) { kb = r / 128; nbk = r % 128; W = PIN(23) + (size_t)l * 2048 * 8192; WT = (bf16_t*)(ws + WS_WFF1) + (size_t)l * 8192 * 2048; ldw = 8192; K = 2048; o0 = 64 * nbk; }
        else { r -= TI_F1; kb = r / 32; nbk = r % 32; W = PIN(24) + (size_t)l * 8192 * 2048; WT = (bf16_t*)(ws + WS_WFF2) + (size_t)l * 2048 * 8192; ldw = 2048; K = 8192; o0 = 64 * nbk; }
        if (mode == 0) transpose_item<0>(W, ldw, o0, K, WT, 64 * nbk, 64 * kb, scr, lane);
        else if (mode == 1) transpose_item<1>(W, ldw, o0, K, WT, 64 * nbk, 64 * kb, scr, lane);
        else transpose_item<2>(W, ldw, o0, K, WT, 64 * nbk, 64 * kb, scr, lane);
    }
}
__device__ __forceinline__ void p0_prologue(ptab_t pt, LAS unsigned char* lds, int bid, int nb, bool do_mods) {
    const int tid = tid_opaque(), lane = tid & 63, wave = __builtin_amdgcn_readfirstlane(tid >> 6);
    unsigned char* ws = PWS;
    do_transposes(pt, lds, 0, TI_L, bid * 8 + wave, nb * 8);
    do_transposes(pt, lds, TI_L + TI_IN + TI_OUT + TI_F1, TI_F2 / 3, bid * 8 + wave, nb * 8);
    __syncthreads();
    if (do_mods) {
        LAS float* sc = (LAS float*)lds;
        LAS float* red = (LAS float*)(lds + 40960);
        float* mods = (float*)(ws + WS_MODS);
        for (int idx = tid; idx < 5 * 2048; idx += 512) { const int j = idx >> 11, k = idx & 2047; const float cv = (j == 0) ? PIN(7)[k] : PIN(6)[(j - 1) * 2048 + k]; sc[idx] = silu_f(cv); }
        __syncthreads();
        const bool act = lane < 48; const int half = act ? lane / 24 : 0, c4 = act ? (lane % 24) * 4 : 0;
        for (int it = bid; it < 256; it += nb) {
            const int l = it >> 7, nc = it & 127;
            const float* Wp = PIN(10) + ((size_t)l * 2048 + wave * 256 + half) * NMOD + nc * 96 + c4;
            f32x4 acc[5];
#pragma unroll
            for (int j = 0; j < 5; ++j) acc[j] = (f32x4){0.f, 0.f, 0.f, 0.f};
#pragma unroll 8
            for (int i = 0; i < 128; ++i) { const f32x4 w = *(const f32x4*)(Wp + (size_t)(2 * i) * NMOD); const int row = wave * 256 + 2 * i + half;
#pragma unroll
                for (int j = 0; j < 5; ++j) acc[j] += sc[j * 2048 + row] * w; }
            if (act) {
#pragma unroll
                for (int j = 0; j < 5; ++j) *(LAS f32x4*)(red + ((wave * 2 + half) * 5 + j) * 96 + c4) = acc[j]; }
            __syncthreads();
            if (tid < 480) { const int j = tid / 96, col = tid % 96; float s = PIN(11)[(size_t)l * NMOD + nc * 96 + col];
#pragma unroll
                for (int g = 0; g < 16; ++g) s += red[(g * 5 + j) * 96 + col];
                mods[((size_t)l * 5 + j) * NMOD + nc * 96 + col] = s; }
            __syncthreads();
        }
    }
}

__device__ __forceinline__ void norm_phase(const float* x0, const float* x1, const float* g, const float* mods_l, int shift_i, int scale_i, bf16_t* H, int bid, int nb) {
    const int tid = tid_opaque(), lane = tid & 63, wave = tid >> 6;
    constexpr int NR = 4; const int qrows = NTOK / NR;
    for (int r0 = bid * 8 + wave; r0 < qrows; r0 += nb * 8) {
        f32x4 v[NR][8]; float ss[NR];
#pragma unroll
        for (int u = 0; u < NR; ++u) { const int r = r0 + u * qrows; const float* xr = (r < 4096 ? x0 : x1) + (size_t)r * DM;
#pragma unroll
            for (int j = 0; j < 8; ++j) v[u][j] = *(const f32x4*)(xr + 4 * (lane + 64 * j)); }
#pragma unroll
        for (int u = 0; u < NR; ++u) { ss[u] = 0.f;
#pragma unroll
            for (int j = 0; j < 8; ++j) ss[u] += (v[u][j].x * v[u][j].x + v[u][j].y * v[u][j].y) + (v[u][j].z * v[u][j].z + v[u][j].w * v[u][j].w); }
        wave_sum_n<NR>(ss);
#pragma unroll
        for (int u = 0; u < NR; ++u) { const int r = r0 + u * qrows; const float rstd = rsqrtf(ss[u] * (1.f / DM) + EPS);
            const int cond = r < 4096 ? 0 : 1 + ((r - 4096) >> 10);
            const float* sh = mods_l + ((size_t)cond * 6 + shift_i) * DM; const float* sc = mods_l + ((size_t)cond * 6 + scale_i) * DM;
#pragma unroll
            for (int j = 0; j < 8; ++j) { const int col = 4 * (lane + 64 * j); const f32x4 gg = *(const f32x4*)(g + col), s = *(const f32x4*)(sc + col), h = *(const f32x4*)(sh + col);
                const f32x4 o = v[u][j] * rstd * gg * (s + 1.f) + h; u32x2 w; w.x = pk2(o.x, o.y); w.y = pk2(o.z, o.w); *(u32x2*)(H + (size_t)r * DM + col) = w; } }
    }
}

__device__ __forceinline__ void bias_phase(const float* shift  , const bf16_t* WT, int N, float* out  , LAS unsigned char* lds, int bid, int nb) {
    const int tid = tid_opaque(), lane = tid & 63, wave = tid >> 6;
    LAS float* sh = (LAS float*)(lds + 65536);
    for (int idx = tid; idx < 5 * 2048; idx += 512) sh[idx] = shift[(size_t)(idx >> 11) * 6 * 2048 + (idx & 2047)];
    __syncthreads();
    const int NGW = nb * 8;
    for (int n0 = bid * 8 + wave; n0 < N; n0 += 2 * NGW) {
        u32x4 w[2][4]; float a[2][5];
#pragma unroll
        for (int u = 0; u < 2; ++u) { const int n = n0 + u * NGW < N ? n0 + u * NGW : n0; const bf16_t* row = WT + (size_t)n * 2048;
#pragma unroll
            for (int j = 0; j < 4; ++j) w[u][j] = *(const u32x4*)(row + (j * 64 + lane) * 8);
#pragma unroll
            for (int c = 0; c < 5; ++c) a[u][c] = 0.f; }
#pragma unroll
        for (int j = 0; j < 4; ++j) { const int k0 = (j * 64 + lane) * 8;
#pragma unroll
            for (int c = 0; c < 5; ++c) { const f32x4 s0 = *(const LAS f32x4*)(sh + c * 2048 + k0), s1 = *(const LAS f32x4*)(sh + c * 2048 + k0 + 4);
#pragma unroll
                for (int u = 0; u < 2; ++u) { const u32x4 ww = w[u][j];
                    a[u][c] += (bflo(ww.x) * s0.x + bfhi(ww.x) * s0.y) + (bflo(ww.y) * s0.z + bfhi(ww.y) * s0.w) + (bflo(ww.z) * s1.x + bfhi(ww.z) * s1.y) + (bflo(ww.w) * s1.z + bfhi(ww.w) * s1.w); } } }
        float f[10];
#pragma unroll
        for (int u = 0; u < 2; ++u)
#pragma unroll
            for (int c = 0; c < 5; ++c) f[u * 5 + c] = a[u][c];
        wave_sum_n<10>(f);
#pragma unroll
        for (int u = 0; u < 2; ++u) { const int n = n0 + u * NGW;
            if (n < N && lane < 5) out[(size_t)lane * N + n] = lane == 0 ? f[u * 5] : (lane == 1 ? f[u * 5 + 1] : (lane == 2 ? f[u * 5 + 2] : (lane == 3 ? f[u * 5 + 3] : f[u * 5 + 4]))); }
    }
    __syncthreads();
}

struct PrepPtrs { const bf16_t* P; const float* G; bf16_t* QN; bf16_t* KB; bf16_t* VB; float* LA; bf16_t* DQKV; float* GB; float* out_ck; float* out_cv; const float* cw; const float* alog; const float* dtb; };
template <int N> __device__ __forceinline__ void group16_sum_n(float (&v)[N]) {
#pragma unroll
    for (int o = 1; o < 16; o <<= 1) {
        float t[N];
#pragma unroll
        for (int i = 0; i < N; ++i) t[i] = __shfl_xor(v[i], o);
#pragma unroll
        for (int i = 0; i < N; ++i) v[i] += t[i];
    }
}
__device__ __forceinline__ void unpack8(const u32x4 w, float (&x)[8]) { x[0] = bflo(w.x); x[1] = bfhi(w.x); x[2] = bflo(w.y); x[3] = bfhi(w.y); x[4] = bflo(w.z); x[5] = bfhi(w.z); x[6] = bflo(w.w); x[7] = bfhi(w.w); }
__device__ __forceinline__ u32x4 pack8(const float (&x)[8]) { u32x4 w; w.x = pk2(x[0], x[1]); w.y = pk2(x[2], x[3]); w.z = pk2(x[4], x[5]); w.w = pk2(x[6], x[7]); return w; }
template <bool LAT, int NT>
__device__ __forceinline__ void prep_tok(const int (&r)[NT], int l, int lane, const PrepPtrs& pp, const LAS float* w2s, const float* qgp, const float* kgp) {
    const int g = lane >> 4, sub = lane & 15;
    int bq[NT], tq[NT]; const bf16_t* Pr[NT];
#pragma unroll
    for (int u = 0; u < NT; ++u) { const int rr = LAT ? r[u] - 4096 : r[u]; bq[u] = LAT ? rr >> 10 : rr >> 8; tq[u] = LAT ? rr & 1023 : rr & 255; Pr[u] = pp.P + (size_t)r[u] * PLD; }
    const int L = LAT ? 1024 : 256;
    {
        u32x4 xw[NT][3];
#pragma unroll
        for (int u = 0; u < NT; ++u)
#pragma unroll
            for (int j = 0; j < 3; ++j) xw[u][j] = *(const u32x4*)(Pr[u] + 1536 + j * 512 + lane * 8);
        const float sgn = (sub & 4) ? 1.f : -1.f;
        float cs[NT][8], sn[NT][8];
        if (LAT) {
#pragma unroll
            for (int e = 0; e < 8; ++e) { const float inv = exp2f(-(float)((sub & 3) * 8 + e) * (13.287712379549449f / 32.f));
#pragma unroll
                for (int u = 0; u < NT; ++u) { const float a = (float)(sub < 8 ? tq[u] >> 6 : tq[u] & 63) * inv; cs[u][e] = __cosf(a); sn[u][e] = __sinf(a); } } }
#pragma unroll
        for (int j = 0; j < 3; ++j) {
            float gn[8]; { const float* gp = (j < 2 ? qgp : kgp) + sub * 8; const f32x4 g0 = *(const f32x4*)gp, g1 = *(const f32x4*)(gp + 4);
#pragma unroll
                for (int e = 0; e < 4; ++e) { gn[e] = g0[e]; gn[4 + e] = g1[e]; } }
            float ss[NT];
#pragma unroll
            for (int u = 0; u < NT; ++u) { float x[8]; unpack8(xw[u][j], x); float s = 0.f;
#pragma unroll
                for (int e = 0; e < 8; ++e) s += x[e] * x[e];
                ss[u] = s; }
            group16_sum_n<NT>(ss);
#pragma unroll
            for (int u = 0; u < NT; ++u) { float x[8], y[8]; unpack8(xw[u][j], x); const float rstd = rsqrtf(ss[u] * (1.f / 128.f) + EPS);
                const size_t krow = LAT ? ((size_t)4096 + (size_t)bq[u] * 1280 + 256 + tq[u]) : (size_t)r[u];
#pragma unroll
                for (int e = 0; e < 8; ++e) y[e] = x[e] * rstd * gn[e];
                if (!LAT && j == 2) {
                    float* dst = (g < 2 ? pp.out_ck : pp.out_cv) + ((((size_t)bq[u] * 2 + l) * 256 + tq[u]) * 2 + (g & 1)) * 128 + sub * 8;
                    f32x4 o0, o1;
#pragma unroll
                    for (int e = 0; e < 4; ++e) { o0[e] = g < 2 ? y[e] : x[e]; o1[e] = g < 2 ? y[4 + e] : x[4 + e]; }
                    *(f32x4*)dst = o0; *(f32x4*)(dst + 4) = o1; }
                if (LAT) {
#pragma unroll
                    for (int e = 0; e < 8; ++e) { const float p = __shfl_xor(y[e], 4); y[e] = y[e] * cs[u][e] + sgn * p * sn[u][e]; } }
                if (j < 2) *(u32x4*)(pp.QN + (size_t)r[u] * 1024 + j * 512 + lane * 8) = pack8(y);
                else { bf16_t* dst = (g < 2 ? pp.KB : pp.VB) + krow * 256 + (g & 1) * 128 + sub * 8; const u32x4 yk = pack8(y); *(u32x4*)dst = g < 2 ? yk : xw[u][2]; } }
            asm volatile("" ::: "memory");
        }
    }
#pragma unroll
    for (int d = 0; d < 2; ++d) {
        float lr[NT][16];
#pragma unroll
        for (int u = 0; u < NT; ++u)
#pragma unroll
            for (int j = 0; j < 4; ++j) { const f32x4 t4 = *(const f32x4*)(pp.G + (size_t)r[u] * 64 + d * 16 + 4 * j); lr[u][4 * j] = t4.x; lr[u][4 * j + 1] = t4.y; lr[u][4 * j + 2] = t4.z; lr[u][4 * j + 3] = t4.w; }
#pragma unroll
        for (int jj = 0; jj < 4; ++jj) { const int n = lane + 64 * jj; float a[NT]; const float b0 = w2s[8192 + d * 256 + n];
#pragma unroll
            for (int u = 0; u < NT; ++u) a[u] = b0;
#pragma unroll
            for (int q = 0; q < 16; ++q) { const float w = w2s[(d * 16 + q) * 256 + n];
#pragma unroll
                for (int u = 0; u < NT; ++u) a[u] += lr[u][q] * w; }
#pragma unroll
            for (int u = 0; u < NT; ++u) pp.LA[(size_t)r[u] * 512 + d * 256 + n] = logsigmoid_f(a[u]) * (1.f / 16.f); }
    }
    {
        float ym[NT], yp[NT]; const bf16_t* Pm[NT]; const bf16_t* Pp[NT];
#pragma unroll
        for (int u = 0; u < NT; ++u) { ym[u] = tq[u] > 0 ? 1.f : 0.f; yp[u] = tq[u] < L - 1 ? 1.f : 0.f; Pm[u] = tq[u] > 0 ? Pr[u] - PLD : Pr[u]; Pp[u] = tq[u] < L - 1 ? Pr[u] + PLD : Pr[u]; }
#pragma unroll 1
        for (int j = 0; j < 3; ++j) { const int c = j * 512 + lane * 8;
            u32x4 xm[NT], xc[NT], xp[NT];
#pragma unroll
            for (int u = 0; u < NT; ++u) { xm[u] = *(const u32x4*)(Pm[u] + 3072 + c); xc[u] = *(const u32x4*)(Pr[u] + 3072 + c); xp[u] = *(const u32x4*)(Pp[u] + 3072 + c); }
            float w0[8], w1[8], w2[8];
#pragma unroll
            for (int q = 0; q < 2; ++q) { const f32x4 a0 = *(const f32x4*)(pp.cw + c + 4 * q), a1 = *(const f32x4*)(pp.cw + 1536 + c + 4 * q), a2 = *(const f32x4*)(pp.cw + 3072 + c + 4 * q);
#pragma unroll
                for (int e = 0; e < 4; ++e) { w0[4 * q + e] = a0[e]; w1[4 * q + e] = a1[e]; w2[4 * q + e] = a2[e]; } }
            float y[NT][8], ss[NT];
#pragma unroll
            for (int u = 0; u < NT; ++u) { float am[8], ac[8], ap[8]; unpack8(xm[u], am); unpack8(xc[u], ac); unpack8(xp[u], ap); float s = 0.f;
#pragma unroll
                for (int e = 0; e < 8; ++e) { const float v = silu_f(w0[e] * am[e] * ym[u] + w1[e] * ac[e] + w2[e] * ap[e] * yp[u]); y[u][e] = v; s += v * v; }
                ss[u] = s; }
            if (j < 2) { group16_sum_n<NT>(ss);
#pragma unroll
                for (int u = 0; u < NT; ++u) { const float sc = rsqrtf(ss[u] + EPS) * (j == 0 ? 0.08838834764831845f : 1.f);
#pragma unroll
                    for (int e = 0; e < 8; ++e) y[u][e] *= sc; } }
#pragma unroll
            for (int u = 0; u < NT; ++u) *(u32x4*)(pp.DQKV + (size_t)r[u] * 1536 + c) = pack8(y[u]);
        }
    }
    if (lane < 8) {
#pragma unroll
        for (int u = 0; u < NT; ++u) { const float a = pp.G[(size_t)r[u] * 64 + 32 + lane], bb = pp.G[(size_t)r[u] * 64 + 40 + lane];
            pp.GB[(size_t)r[u] * 16 + lane] = -__expf(pp.alog[l * 8 + lane]) * softplus_f(a + pp.dtb[l * 8 + lane]); pp.GB[(size_t)r[u] * 16 + 8 + lane] = 1.f / (1.f + __expf(-bb)); } }
}
__device__ __forceinline__ void prep_phase(ptab_t pt, int l, LAS unsigned char* lds, int bid, int nb) {
    const int tid = tid_opaque(), lane = tid & 63, wave = tid >> 6;
    unsigned char* ws = PWS;
    PrepPtrs pp; pp.P = (const bf16_t*)(ws + WS_P); pp.G = (const float*)(ws + WS_G); pp.QN = (bf16_t*)(ws + WS_QN); pp.KB = (bf16_t*)(ws + WS_KB); pp.VB = (bf16_t*)(ws + WS_VB);
    pp.LA = (float*)(ws + WS_LA); pp.DQKV = (bf16_t*)(ws + WS_DQKV); pp.GB = (float*)(ws + WS_GB); pp.out_ck = POUT + OUT_CK; pp.out_cv = POUT + OUT_CV;
    pp.cw = PIN(18) + (size_t)l * 3 * 1536; pp.alog = PIN(19); pp.dtb = PIN(20);
    LAS float* w2s = (LAS float*)lds;
    for (int i = tid; i < 8192; i += 512) w2s[i] = PIN(13)[(size_t)l * 8192 + i];
    for (int i = tid; i < 512; i += 512) w2s[8192 + i] = PIN(14)[(size_t)l * 512 + i];
    __syncthreads();
    const float* qgp = PIN(16) + l * 128; const float* kgp = PIN(17) + l * 128;
    constexpr int NT = PREP_NT, RQ = 4096 / NT;
    const int gw = bid * 8 + wave, NGW = nb * 8, HW = NGW >> 1;
    if (gw < HW) {
#pragma unroll 1
        for (int r = gw; r < RQ; r += HW) { int rc[NT];
#pragma unroll
            for (int u = 0; u < NT; ++u) rc[u] = r + u * RQ;
            prep_tok<false, NT>(rc, l, lane, pp, w2s, qgp, kgp); } }
    else {
#pragma unroll 1
        for (int r = gw - HW; r < RQ; r += HW) { int rl[NT];
#pragma unroll
            for (int u = 0; u < NT; ++u) rl[u] = 4096 + r + u * RQ;
            prep_tok<true, NT>(rl, l, lane, pp, w2s, qgp, kgp); } }
    for (int i = bid * 512 + tid; i < 65536; i += nb * 512) { const int b = i >> 14, rem = i & 16383, pq = rem >> 6, c4 = rem & 63;
        const size_t srcx = (((size_t)b * 2 + l) * 256 + pq) * 256 + c4 * 4, dst = ((size_t)4096 + (size_t)b * 1280 + pq) * 256 + c4 * 4;
        const f32x4 k4 = *(const f32x4*)(PIN(2) + srcx), v4 = *(const f32x4*)(PIN(3) + srcx);
        u32x2 kw, vw; kw.x = pk2(k4.x, k4.y); kw.y = pk2(k4.z, k4.w); vw.x = pk2(v4.x, v4.y); vw.y = pk2(v4.z, v4.w);
        *(u32x2*)(pp.KB + dst) = kw; *(u32x2*)(pp.VB + dst) = vw; }
}

__device__ __forceinline__ void gla_naive_item(ptab_t pt, int l, bool lat, int b, int h, int d, LAS float* red) {
    const int tid = tid_opaque(), vq = tid & 127, kg = tid >> 7;
    unsigned char* ws = PWS;
    const bf16_t* P = (const bf16_t*)(ws + WS_P); const float* LA = (const float*)(ws + WS_LA); float* OG = (float*)(ws + WS_OG);
    const int L = lat ? 1024 : 256, rowbase = lat ? 4096 + b * 1024 : b * 256;
    float S[16];
    const size_t sidx = ((((size_t)b * 2 + l) * 2 + d) * 4 + h) * 8192 + (size_t)(kg * 16) * 128 + vq;
#pragma unroll
    for (int j = 0; j < 16; ++j) S[j] = lat ? PIN(4)[sidx + j * 128] : 0.f;
    f32x4 la[4], nla[4]; u32x4 kq[4], nkq[4]; unsigned short vv, nvv;
#define GLA_LOAD(LAv, KQv, Vv, step) do { const int t_ = d ? L - 1 - (step) : (step); const size_t r_ = (size_t)(rowbase + t_); \
        const float* lp_ = LA + r_ * 512 + d * 256 + h * 64 + kg * 16; const bf16_t* pr_ = P + r_ * PLD; \
        _Pragma("unroll") for (int j_ = 0; j_ < 4; ++j_) LAv[j_] = *(const f32x4*)(lp_ + 4 * j_); \
        KQv[0] = *(const u32x4*)(pr_ + 256 + h * 64 + kg * 16); KQv[1] = *(const u32x4*)(pr_ + 256 + h * 64 + kg * 16 + 8); \
        KQv[2] = *(const u32x4*)(pr_ + h * 64 + kg * 16); KQv[3] = *(const u32x4*)(pr_ + h * 64 + kg * 16 + 8); Vv = pr_[512 + h * 128 + vq]; } while (0)
    GLA_LOAD(la, kq, vv, 0);
    for (int step = 0; step < L; ++step) {
        const int sn = step + 1 < L ? step + 1 : step;
        GLA_LOAD(nla, nkq, nvv, sn);
        const float v = bf2f(vv); float part = 0.f;
#pragma unroll
        for (int j = 0; j < 16; ++j) { const unsigned kw = kq[j >> 3][(j >> 1) & 3], qw = kq[2 + (j >> 3)][(j >> 1) & 3];
            const float kk = (j & 1) ? bfhi(kw) : bflo(kw), qq = (j & 1) ? bfhi(qw) : bflo(qw);
            S[j] = __expf(la[j >> 2][j & 3]) * S[j] + kk * v; part += S[j] * qq; }
        red[((step & 1) * 4 + kg) * 128 + vq] = part * 0.125f;
        __syncthreads();
        if (kg == 0) { const LAS float* rp = red + (step & 1) * 512 + vq; const int t = d ? L - 1 - step : step;
            OG[((size_t)d * NTOK + rowbase + t) * 512 + h * 128 + vq] = (rp[0] + rp[128]) + (rp[256] + rp[384]); }
#pragma unroll
        for (int j = 0; j < 4; ++j) { la[j] = nla[j]; kq[j] = nkq[j]; } vv = nvv;
    }
#undef GLA_LOAD
    if (!lat) {
#pragma unroll
        for (int j = 0; j < 16; ++j) POUT[OUT_SG + sidx + j * 128] = S[j]; }
    __syncthreads();
}
__device__ __forceinline__ void dn_naive_item(ptab_t pt, int l, bool lat, int b, int h, int d, LAS float* red) {
    const int tid = tid_opaque(), vq = tid & 127, kg = tid >> 7;
    unsigned char* ws = PWS;
    const bf16_t* DQKV = (const bf16_t*)(ws + WS_DQKV); const float* GB = (const float*)(ws + WS_GB); float* OD = (float*)(ws + WS_OD);
    const int L = lat ? 1024 : 256, rowbase = lat ? 4096 + b * 1024 : b * 256;
    LAS float* redR = red; LAS float* redO = red + 1024;
    float S[32];
    const size_t sidx = ((((size_t)b * 2 + l) * 2 + d) * 4 + h) * 16384 + (size_t)(kg * 32) * 128 + vq;
#pragma unroll
    for (int j = 0; j < 32; ++j) S[j] = lat ? PIN(5)[sidx + j * 128] : 0.f;
    u32x4 kq[8], nkq[8]; unsigned short vv, nvv; float gg, ngg, be, nbe;
#define DN_LOAD(KQv, Vv, Gv, Bv, step) do { const int t_ = d ? L - 1 - (step) : (step); const size_t r_ = (size_t)(rowbase + t_); const bf16_t* pr_ = DQKV + r_ * 1536; \
        _Pragma("unroll") for (int j_ = 0; j_ < 4; ++j_) { KQv[j_] = *(const u32x4*)(pr_ + 512 + h * 128 + kg * 32 + 8 * j_); KQv[4 + j_] = *(const u32x4*)(pr_ + h * 128 + kg * 32 + 8 * j_); } \
        Vv = pr_[1024 + h * 128 + vq]; Gv = GB[r_ * 16 + d * 4 + h]; Bv = GB[r_ * 16 + 8 + d * 4 + h]; } while (0)
    DN_LOAD(kq, vv, gg, be, 0);
    for (int step = 0; step < L; ++step) {
        const int sn = step + 1 < L ? step + 1 : step;
        DN_LOAD(nkq, nvv, ngg, nbe, sn);
        float kf[32], rp = 0.f;
#pragma unroll
        for (int j = 0; j < 32; ++j) { const unsigned kw = kq[j >> 3][(j >> 1) & 3]; kf[j] = (j & 1) ? bfhi(kw) : bflo(kw); rp += kf[j] * S[j]; }
        redR[((step & 1) * 4 + kg) * 128 + vq] = rp;
        __syncthreads();
        if (step > 0 && kg == 0) { const LAS float* op = redO + ((step - 1) & 1) * 512 + vq; const int t = d ? L - step : step - 1;
            OD[((size_t)d * NTOK + rowbase + t) * 512 + h * 128 + vq] = (op[0] + op[128]) + (op[256] + op[384]); }
        const LAS float* rr = redR + (step & 1) * 512 + vq;
        const float rs = (rr[0] + rr[128]) + (rr[256] + rr[384]);
        const float eg = __expf(gg), w = be * (bf2f(vv) - eg * rs);
        float op = 0.f;
#pragma unroll
        for (int j = 0; j < 32; ++j) { const unsigned qw = kq[4 + (j >> 3)][(j >> 1) & 3]; const float qq = (j & 1) ? bfhi(qw) : bflo(qw);
            S[j] = eg * S[j] + kf[j] * w; op += qq * S[j]; }
        redO[((step & 1) * 4 + kg) * 128 + vq] = op;
#pragma unroll
        for (int j = 0; j < 8; ++j) kq[j] = nkq[j];
        vv = nvv; gg = ngg; be = nbe;
    }
#undef DN_LOAD
    __syncthreads();
    if (kg == 0) { const LAS float* op = redO + ((L - 1) & 1) * 512 + vq; const int t = d ? 0 : L - 1;
        OD[((size_t)d * NTOK + rowbase + t) * 512 + h * 128 + vq] = (op[0] + op[128]) + (op[256] + op[384]); }
    if (!lat) {
#pragma unroll
        for (int j = 0; j < 32; ++j) POUT[OUT_SD + sidx + j * 128] = S[j]; }
    __syncthreads();
}

typedef short bf16x8 __attribute__((ext_vector_type(8)));
typedef float f32x16 __attribute__((ext_vector_type(16)));
__device__ __forceinline__ int crow(int r, int hi) { return (r & 3) + 8 * (r >> 2) + 4 * hi; }
template <int K>
__device__ __forceinline__ f32x16 mm_tile(const LAS bf16_t* A, int lda, const LAS bf16_t* Bt, int ldb, int tm, int tn, int lane, f32x16 acc) {
    const int r32 = lane & 31, hi = lane >> 5;
    const LAS bf16_t* ap = A + (tm * 32 + r32) * lda + hi * 8; const LAS bf16_t* bp = Bt + (tn * 32 + r32) * ldb + hi * 8;
#pragma unroll
    for (int k0 = 0; k0 < K; k0 += 16) { const bf16x8 a = *(const LAS bf16x8*)(ap + k0), b = *(const LAS bf16x8*)(bp + k0); acc = __builtin_amdgcn_mfma_f32_32x32x16_bf16(a, b, acc, 0, 0, 0); }
    return acc;
}
template <int K>
__device__ __forceinline__ f32x16 mm_tile_ga(const bf16_t* A, int lda, const LAS bf16_t* Bt, int ldb, int tm, int tn, int lane, f32x16 acc) {
    const int r32 = lane & 31, hi = lane >> 5;
    const bf16_t* ap = A + (size_t)(tm * 32 + r32) * lda + hi * 8; const LAS bf16_t* bp = Bt + (tn * 32 + r32) * ldb + hi * 8;
    bf16x8 a[K / 16];
#pragma unroll
    for (int k = 0; k < K / 16; ++k) a[k] = *(const bf16x8*)(ap + 16 * k);
#pragma unroll
    for (int k = 0; k < K / 16; ++k) { const bf16x8 b = *(const LAS bf16x8*)(bp + 16 * k); acc = __builtin_amdgcn_mfma_f32_32x32x16_bf16(a[k], b, acc, 0, 0, 0); }
    return acc;
}
__device__ __forceinline__ void acc_store_pk(unsigned* dst, const f32x16& acc, int lane) {
#pragma unroll
    for (int r2 = 0; r2 < 8; ++r2) dst[r2 * 64 + lane] = pk2(acc[2 * r2], acc[2 * r2 + 1]);
}
__device__ __forceinline__ void acc_load_pk(const unsigned* src, unsigned (&w)[8], int lane) {
#pragma unroll
    for (int r2 = 0; r2 < 8; ++r2) w[r2] = src[r2 * 64 + lane];
}
__device__ __forceinline__ void acc_to_ST(LAS bf16_t* ST, int ld, int row0, int col0, const f32x16& s, int lane) {
    const int r32 = lane & 31, hi = lane >> 5;
#pragma unroll
    for (int g = 0; g < 4; ++g) { u32x2 w; w.x = pk2(s[4 * g], s[4 * g + 1]); w.y = pk2(s[4 * g + 2], s[4 * g + 3]);
        *(LAS u32x2*)(ST + (col0 + r32) * ld + row0 + 8 * g + 4 * hi) = w; }
}
__device__ __forceinline__ void store_o_tile_pk(unsigned* dst, const f32x16& o, long long row0, int st, int col0  , int lane) {
    const int odd = lane & 1; long long wb = row0 * 256 + ((col0 + (lane & 31)) >> 1);
    asm volatile("" : "+v"(wb));
#pragma unroll
    for (int r2 = 0; r2 < 8; ++r2) { const float send = odd ? o[2 * r2] : o[2 * r2 + 1]; const float recv = __shfl_xor(send, 1);
        const unsigned w = odd ? pk2(recv, o[2 * r2 + 1]) : pk2(o[2 * r2], recv);
        const int r = 2 * r2 + odd; dst[wb + (long long)st * 256 * ((r & 3) + 8 * (r >> 2))] = w; }
}
constexpr int N_CH_UNITS = 1024;
struct UnitPre { u32x4 r[6]; float f[2]; };
__device__ __forceinline__ void unit_geom(int unit, int& d, int& h, bool& lat, int& c, int& L, int& rowbase) {
    d = unit & 1; h = (unit >> 1) & 3; const int slot = unit >> 3; lat = slot >= 64; const int b = lat ? (slot - 64) >> 4 : slot >> 2; c = lat ? (slot - 64) & 15 : slot & 3;
    L = lat ? 1024 : 256; rowbase = lat ? 4096 + b * 1024 : b * 256;
}
__device__ __forceinline__ void gla_unit_load(ptab_t pt, int unit, UnitPre& p) {
    const int tid = tid_opaque(); unsigned char* ws = PWS; const bf16_t* P = (const bf16_t*)(ws + WS_P); const float* LA = (const float*)(ws + WS_LA);
    int d, h, c, L, rowbase; bool lat; unit_geom(unit, d, h, lat, c, L, rowbase);
#pragma unroll
    for (int q = 0; q < 2; ++q) { const int idx = tid + 512 * q, i = idx >> 4, c4 = idx & 15; const int s = c * 64 + i, t = d ? L - 1 - s : s;
        p.r[q] = *(const u32x4*)(LA + (size_t)(rowbase + t) * 512 + d * 256 + h * 64 + c4 * 4); }
    { const int i = tid >> 3, k0 = (tid & 7) * 8, v0 = (tid & 7) * 16; const int s = c * 64 + i, t = d ? L - 1 - s : s; const bf16_t* Pr = P + (size_t)(rowbase + t) * PLD;
      p.r[2] = *(const u32x4*)(Pr + h * 64 + k0); p.r[3] = *(const u32x4*)(Pr + 256 + h * 64 + k0); p.r[4] = *(const u32x4*)(Pr + 512 + h * 128 + v0); p.r[5] = *(const u32x4*)(Pr + 512 + h * 128 + v0 + 8); }
    p.f[0] = 0.f; p.f[1] = 0.f;
}
__device__ __forceinline__ void dn_unit_load(ptab_t pt, int unit, UnitPre& p) {
    const int tid = tid_opaque(); unsigned char* ws = PWS; const bf16_t* DQKV = (const bf16_t*)(ws + WS_DQKV); const float* GB = (const float*)(ws + WS_GB);
    int d, h, c, L, rowbase; bool lat; unit_geom(unit, d, h, lat, c, L, rowbase);
    { const int i = tid >> 3, c16 = (tid & 7) * 16; const int s = c * 64 + i, t = d ? L - 1 - s : s; const bf16_t* pr = DQKV + (size_t)(rowbase + t) * 1536 + h * 128 + c16;
      p.r[0] = *(const u32x4*)(pr); p.r[1] = *(const u32x4*)(pr + 8); p.r[2] = *(const u32x4*)(pr + 512); p.r[3] = *(const u32x4*)(pr + 520); p.r[4] = *(const u32x4*)(pr + 1024); p.r[5] = *(const u32x4*)(pr + 1032); }
    { const int i = tid & 63; const int s = c * 64 + i, t = d ? L - 1 - s : s; const float* gp = GB + (size_t)(rowbase + t) * 16 + d * 4 + h; p.f[0] = gp[0]; p.f[1] = gp[8]; }
}
__device__ __forceinline__ void gla_chunk_unit(ptab_t pt, int unit, LAS unsigned char* lds, const UnitPre& pre) {
    const int tid = tid_opaque(), lane = tid & 63, wave = tid >> 6;
    unsigned char* ws = PWS;
    const bf16_t* P = (const bf16_t*)(ws + WS_P); const float* LA = (const float*)(ws + WS_LA);
    bf16_t* GQ = (bf16_t*)(ws + WS_GQ) + (size_t)unit * 4096; unsigned* GO = (unsigned*)(ws + WS_GO) + (size_t)unit * 4096; unsigned* GU = (unsigned*)(ws + WS_GU) + (size_t)unit * 4096; float* GD = (float*)(ws + WS_GD) + (size_t)unit * 64;
    const int d = unit & 1, h = (unit >> 1) & 3, slot = unit >> 3;
    const bool lat = slot >= 64; const int b = lat ? (slot - 64) >> 4 : slot >> 2, c = lat ? (slot - 64) & 15 : slot & 3;
    const int L = lat ? 1024 : 256, rowbase = lat ? 4096 + b * 1024 : b * 256;
    LAS float* Bs = (LAS float*)lds;
    LAS bf16_t* Qt = (LAS bf16_t*)(lds + 16640);
    LAS bf16_t* Kt = Qt + 64 * 72;
    LAS bf16_t* KhT = Kt + 64 * 72;
    LAS bf16_t* VT = KhT + 64 * 72;
    LAS bf16_t* Am = VT + 128 * 72;
#pragma unroll
    for (int q = 0; q < 2; ++q) { const int idx = tid + 512 * q, i = idx >> 4, c4 = idx & 15; const u32x4 v = pre.r[q];
        Bs[i * 65 + c4 * 4] = __uint_as_float(v.x); Bs[i * 65 + c4 * 4 + 1] = __uint_as_float(v.y); Bs[i * 65 + c4 * 4 + 2] = __uint_as_float(v.z); Bs[i * 65 + c4 * 4 + 3] = __uint_as_float(v.w); }
    LDS_BARRIER();
    {
        const int k = tid & 63, s = tid >> 6; LAS float* tot = (LAS float*)(lds + 16640);
        float v[8]; float a = 0.f;
#pragma unroll
        for (int i = 0; i < 8; ++i) { a += Bs[(s * 8 + i) * 65 + k]; v[i] = a; }
        tot[s * 64 + k] = a;
        LDS_BARRIER();
        float off = 0.f;
#pragma unroll
        for (int q = 0; q < 7; ++q) off += (q < s) ? tot[q * 64 + k] : 0.f;
#pragma unroll
        for (int i = 0; i < 8; ++i) Bs[(s * 8 + i) * 65 + k] = v[i] + off;
    }
    LDS_BARRIER();
    { const int i = tid >> 3, k0 = (tid & 7) * 8;
      const u32x4 qw = pre.r[2], kw = pre.r[3];
#pragma unroll
      for (int e = 0; e < 8; ++e) { const float bb = Bs[i * 65 + k0 + e], bl = Bs[63 * 65 + k0 + e];
          const float qv = (e & 1) ? bfhi(qw[e >> 1]) : bflo(qw[e >> 1]), kv = (e & 1) ? bfhi(kw[e >> 1]) : bflo(kw[e >> 1]);
          Qt[i * 72 + k0 + e] = f2bf(qv * 0.125f * __expf(bb)); Kt[i * 72 + k0 + e] = f2bf(kv * __expf(-bb)); KhT[(k0 + e) * 72 + i] = f2bf(kv * __expf(bl - bb)); }
      const int v0 = (tid & 7) * 16;
      const u32x4 va = pre.r[4], vb = pre.r[5];
#pragma unroll
      for (int e = 0; e < 8; ++e) { VT[(v0 + e) * 72 + i] = (bf16_t)((e & 1) ? (va[e >> 1] >> 16) : (va[e >> 1] & 0xffffu)); VT[(v0 + 8 + e) * 72 + i] = (bf16_t)((e & 1) ? (vb[e >> 1] >> 16) : (vb[e >> 1] & 0xffffu)); }
      if (tid < 64) GD[tid] = __expf(Bs[63 * 65 + tid]); }
    LDS_BARRIER();
    { f32x16 acc = {}; acc = mm_tile<64>(KhT, 72, VT, 72, wave >> 2, wave & 3, lane, acc); acc_store_pk(GU + wave * 512, acc, lane); }
    if (wave < 4) { f32x16 acc = {}; const int tm = wave >> 1, tn = wave & 1; acc = mm_tile<64>(Qt, 72, Kt, 72, tm, tn, lane, acc);
        const int r32 = lane & 31, hi = lane >> 5;
#pragma unroll
        for (int r = 0; r < 16; ++r) { const int i = tm * 32 + crow(r, hi), j = tn * 32 + r32; Am[i * 72 + j] = f2bf(j <= i ? acc[r] : 0.f); } }
    { const int i = tid >> 3, k0 = (tid & 7) * 8; *(u32x4*)(GQ + i * 64 + k0) = *(const LAS u32x4*)(Qt + i * 72 + k0); }
    LDS_BARRIER();
    { f32x16 acc = {}; acc = mm_tile<64>(Am, 72, VT, 72, wave >> 2, wave & 3, lane, acc); acc_store_pk(GO + wave * 512, acc, lane); }
    LDS_BARRIER();
}
__device__ __forceinline__ void gla_scan_item(ptab_t pt, int l, bool lat, int b, int h, int d, LAS unsigned char* lds) {
    const int tid = tid_opaque(), lane = tid & 63, wave = tid >> 6, r32 = lane & 31, hi = lane >> 5;
    unsigned char* ws = PWS;
    float* OG = (float*)(ws + WS_OG);
    const int L = lat ? 1024 : 256, rowbase = lat ? 4096 + b * 1024 : b * 256, nch = L >> 6, slot0 = lat ? 64 + b * 16 : b * 4;
    const int tm = wave >> 2, tn = wave & 3;
    LAS bf16_t* ST = (LAS bf16_t*)lds;
    f32x16 S;
    const size_t sbase = ((((size_t)b * 2 + l) * 2 + d) * 4 + h) * 8192;
#pragma unroll
    for (int r = 0; r < 16; ++r) S[r] = lat ? PIN(4)[sbase + (size_t)(tm * 32 + crow(r, hi)) * 128 + tn * 32 + r32] : 0.f;
    unsigned ow[8], uw[8], now[8], nuw[8]; float dec[16], ndec[16]; bf16x8 qa[4], nqa[4];
#define GLA_SLOAD(OW, UW, DEC, QA, cc) do { const int unit_ = ((slot0 + (cc)) * 4 + h) * 2 + d; \
        acc_load_pk((const unsigned*)(ws + WS_GO) + (size_t)unit_ * 4096 + wave * 512, OW, lane); acc_load_pk((const unsigned*)(ws + WS_GU) + (size_t)unit_ * 4096 + wave * 512, UW, lane); \
        const float* gd_ = (const float*)(ws + WS_GD) + (size_t)unit_ * 64; _Pragma("unroll") for (int r_ = 0; r_ < 16; ++r_) DEC[r_] = gd_[tm * 32 + crow(r_, hi)]; \
        const bf16_t* gq_ = (const bf16_t*)(ws + WS_GQ) + (size_t)unit_ * 4096 + (size_t)(tm * 32 + r32) * 64 + hi * 8; _Pragma("unroll") for (int k_ = 0; k_ < 4; ++k_) QA[k_] = *(const bf16x8*)(gq_ + 16 * k_); } while (0)
    GLA_SLOAD(ow, uw, dec, qa, 0);
    GLA_SLOAD(now, nuw, ndec, nqa, 1);
#define GLA_STEP(c, OW, UW, DEC, QA) do { \
        acc_to_ST(ST, 72, tm * 32, tn * 32, S, lane); \
        LDS_BARRIER(); \
        f32x16 o; \
        _Pragma("unroll") for (int r2 = 0; r2 < 8; ++r2) { o[2 * r2] = bflo(OW[r2]); o[2 * r2 + 1] = bfhi(OW[r2]); } \
        { const LAS bf16_t* bp = ST + (tn * 32 + r32) * 72 + hi * 8; \
          _Pragma("unroll") for (int k = 0; k < 4; ++k) { const bf16x8 bb = *(const LAS bf16x8*)(bp + 16 * k); o = __builtin_amdgcn_mfma_f32_32x32x16_bf16(QA[k], bb, o, 0, 0, 0); } } \
        { const int s0_ = (c) * 64 + tm * 32 + 4 * hi; store_o_tile_pk((unsigned*)OG, o, (long long)((size_t)d * NTOK + rowbase + (d ? L - 1 - s0_ : s0_)), d ? -1 : 1, h * 128 + tn * 32, lane); } \
        _Pragma("unroll") for (int r2 = 0; r2 < 8; ++r2) { S[2 * r2] = DEC[2 * r2] * S[2 * r2] + bflo(UW[r2]); S[2 * r2 + 1] = DEC[2 * r2 + 1] * S[2 * r2 + 1] + bfhi(UW[r2]); } \
        { const int cn_ = (c) + 2 < nch ? (c) + 2 : nch - 1; GLA_SLOAD(OW, UW, DEC, QA, cn_); } \
        LDS_BARRIER(); } while (0)
    for (int c = 0; c < nch; c += 2) {
        GLA_STEP(c, ow, uw, dec, qa);
        GLA_STEP(c + 1, now, nuw, ndec, nqa);
    }
#undef GLA_STEP
#undef GLA_SLOAD
    if (!lat) {
#pragma unroll
        for (int r = 0; r < 16; ++r) POUT[OUT_SG + sbase + (size_t)(tm * 32 + crow(r, hi)) * 128 + tn * 32 + r32] = S[r]; }
}
template <int BLK>
__device__ __forceinline__ void solve_diag(float (&x)[64], const LAS float* Af) {
    f32x4 an[4];
    an[0] = *(const LAS f32x4*)(Af + (16 * BLK + 1) * 68 + 16 * BLK);
#pragma unroll
    for (int ii = 1; ii < 16; ++ii) { const int i = 16 * BLK + ii; f32x4 ac[4];
#pragma unroll
        for (int j4 = 0; j4 < (ii + 3) / 4; ++j4) ac[j4] = an[j4];
        if (ii + 1 < 16) {
#pragma unroll
            for (int j4 = 0; j4 < (ii + 4) / 4; ++j4) an[j4] = *(const LAS f32x4*)(Af + (i + 1) * 68 + 16 * BLK + 4 * j4); }
        float s0 = 0.f, s1 = 0.f, s2 = 0.f, s3 = 0.f;
#pragma unroll
        for (int j4 = 0; j4 < (ii + 3) / 4; ++j4) { s0 += ac[j4].x * x[16 * BLK + 4 * j4]; s1 += ac[j4].y * x[16 * BLK + 4 * j4 + 1]; s2 += ac[j4].z * x[16 * BLK + 4 * j4 + 2]; s3 += ac[j4].w * x[16 * BLK + 4 * j4 + 3]; }
        x[i] -= (s0 + s1) + (s2 + s3); asm("" : "+v"(x[i])); }
}
template <int BLK>
__device__ __forceinline__ void solve_offdiag(const LAS bf16_t* Ab, const LAS bf16_t* UT, const LAS bf16_t* WT, LAS float* Rb, int wave, int lane) {
    f32x16 acc = {};
    acc = mm_tile<16 * BLK>(Ab, 72, wave < 4 ? UT : WT, 72, BLK >> 1, wave & 3, lane, acc);
    const int r32 = lane & 31, hi = lane >> 5;
#pragma unroll
    for (int r = 0; r < 16; ++r) { const int rr = crow(r, hi) - (BLK & 1) * 16; if (rr >= 0 && rr < 16) Rb[rr * 260 + wave * 32 + r32] = acc[r]; }
}
template <int BLK>
__device__ __forceinline__ void solve_step(float (&x)[64], const LAS float* Af, const LAS bf16_t* Ab, LAS bf16_t* UT, LAS bf16_t* WT, LAS float* Rb, int tid, int wave, int lane) {
    if (BLK > 0) { solve_offdiag<(BLK > 0 ? BLK : 1)>(Ab, UT, WT, Rb, wave, lane); LDS_BARRIER(); }
    if (tid < 256) {
        if (BLK > 0) {
#pragma unroll
            for (int ii = 0; ii < 16; ++ii) { x[16 * BLK + ii] -= Rb[ii * 260 + tid]; asm("" : "+v"(x[16 * BLK + ii])); } }
        solve_diag<BLK>(x, Af);
        LAS bf16_t* dst = (tid < 128 ? UT + tid * 72 : WT + (tid - 128) * 72) + 16 * BLK;
        u32x4 w0, w1; w0.x = pk2(x[16 * BLK], x[16 * BLK + 1]); w0.y = pk2(x[16 * BLK + 2], x[16 * BLK + 3]); w0.z = pk2(x[16 * BLK + 4], x[16 * BLK + 5]); w0.w = pk2(x[16 * BLK + 6], x[16 * BLK + 7]);
        w1.x = pk2(x[16 * BLK + 8], x[16 * BLK + 9]); w1.y = pk2(x[16 * BLK + 10], x[16 * BLK + 11]); w1.z = pk2(x[16 * BLK + 12], x[16 * BLK + 13]); w1.w = pk2(x[16 * BLK + 14], x[16 * BLK + 15]);
        *(LAS u32x4*)(dst) = w0; *(LAS u32x4*)(dst + 8) = w1; }
    if (BLK < 3) LDS_BARRIER();
}
#define SUBA_BEGIN() unsigned long long tsa_ = 0; if (PROBE_SUB >= 10 && PROBE_SUB <= 14 && blockIdx.x == 0) { LDS_BARRIER(); tsa_ = __builtin_amdgcn_s_memrealtime(); }
#define SUBA_END(k) do { if (PROBE_SUB == (k) && blockIdx.x == 0) { LDS_BARRIER(); if (threadIdx.x == 0) *(volatile LAS unsigned long long*)(lds + PTAB_OFF + 320) += __builtin_amdgcn_s_memrealtime() - tsa_; } } while (0)
#define SUBA_MARK() do { if (PROBE_SUB >= 10 && PROBE_SUB <= 14 && blockIdx.x == 0) { LDS_BARRIER(); tsa_ = __builtin_amdgcn_s_memrealtime(); } } while (0)
__device__ __forceinline__ void dn_chunk_unit(ptab_t pt, int unit, LAS unsigned char* lds, const UnitPre& pre) {
    SUBA_BEGIN(); unsigned long long tsa0_ = tsa_;
    const int tid = tid_opaque(), lane = tid & 63, wave = tid >> 6, r32 = lane & 31, hi = lane >> 5;
    unsigned char* ws = PWS;
    const bf16_t* DQKV = (const bf16_t*)(ws + WS_DQKV); const float* GB = (const float*)(ws + WS_GB);
    bf16_t* MC = (bf16_t*)(ws + WS_MC) + (size_t)unit * 16384; unsigned* NC = (unsigned*)(ws + WS_NC) + (size_t)unit * 8192;
    bf16_t* QE = (bf16_t*)(ws + WS_QE) + (size_t)unit * 8192; unsigned* OL = (unsigned*)(ws + WS_OL) + (size_t)unit * 4096;
    const int d = unit & 1, h = (unit >> 1) & 3, slot = unit >> 3;
    const bool lat = slot >= 64; const int b = lat ? (slot - 64) >> 4 : slot >> 2, c = lat ? (slot - 64) & 15 : slot & 3;
    const int L = lat ? 1024 : 256, rowbase = lat ? 4096 + b * 1024 : b * 256;
    LAS bf16_t* Qs = (LAS bf16_t*)lds;
    LAS bf16_t* Ks = Qs + 64 * 136;
    LAS bf16_t* Vs = Ks + 64 * 136;
    LAS float* Af = (LAS float*)(lds + 52224);
    LAS bf16_t* Att = (LAS bf16_t*)(lds + 69632);
    LAS bf16_t* KhT = (LAS bf16_t*)(lds + 78848);
    LAS bf16_t* WT = (LAS bf16_t*)(lds + 97280);
    LAS bf16_t* UT = (LAS bf16_t*)(lds + 115712);
    LAS float* Gs = (LAS float*)(lds + 134144);
    LAS float* Bt = Gs + 64;
    LAS bf16_t* Ab = (LAS bf16_t*)(lds + 134656);
    LAS float* Rb = (LAS float*)(lds + 34816);
    { const int i = tid >> 3, c16 = (tid & 7) * 16;
      const u32x4 q0 = pre.r[0], q1 = pre.r[1], k0 = pre.r[2], k1 = pre.r[3], v0 = pre.r[4], v1 = pre.r[5];
      *(LAS u32x4*)(Qs + i * 136 + c16) = q0; *(LAS u32x4*)(Qs + i * 136 + c16 + 8) = q1; *(LAS u32x4*)(Ks + i * 136 + c16) = k0; *(LAS u32x4*)(Ks + i * 136 + c16 + 8) = k1;
      *(LAS u32x4*)(Vs + i * 136 + c16) = v0; *(LAS u32x4*)(Vs + i * 136 + c16 + 8) = v1; }
    if (tid < 64) { float x = pre.f[0]; const float be = pre.f[1];
#pragma unroll
        for (int o = 1; o < 64; o <<= 1) { const float n = __shfl_up(x, o); if (lane >= o) x += n; }
        Gs[tid] = x; Bt[tid] = be; }
    LDS_BARRIER();
    { const int w4 = wave & 3, tm = w4 >> 1, tn = w4 & 1; f32x16 acc = {};
      acc = mm_tile<128>(wave < 4 ? Ks : Qs, 136, Ks, 136, tm, tn, lane, acc);
      const int j = tn * 32 + r32; const float Gj = Gs[j];
#pragma unroll
      for (int r = 0; r < 16; ++r) { const int i = tm * 32 + crow(r, hi); const float e = __expf(Gs[i] - Gj);
          if (wave < 4) { const float av = (j < i) ? Bt[i] * acc[r] * e : 0.f; Af[i * 68 + j] = av; Ab[i * 72 + j] = f2bf(av); } else Att[i * 72 + j] = f2bf((j <= i) ? acc[r] * e : 0.f); } }
    LDS_BARRIER();
    SUBA_END(11); SUBA_MARK();
    {
        float x[64];
        if (tid < 128) {
#pragma unroll
            for (int j = 0; j < 64; ++j) x[j] = bf2f(Vs[j * 136 + tid]) * Bt[j];
        } else if (tid < 256) {
#pragma unroll
            for (int j = 0; j < 64; ++j) x[j] = bf2f(Ks[j * 136 + tid - 128]) * Bt[j] * __expf(Gs[j]);
        } else {
#pragma unroll
            for (int j = 0; j < 64; ++j) x[j] = 0.f;
            const int t2 = tid - 256, i = t2 >> 2, a0 = (t2 & 3) * 32; const float f = __expf(Gs[63] - Gs[i]);
#pragma unroll 8
            for (int e = 0; e < 32; ++e) KhT[(a0 + e) * 72 + i] = f2bf(bf2f(Ks[i * 136 + a0 + e]) * f);
        }
#pragma unroll
        for (int j = 0; j < 64; ++j) asm("" : "+v"(x[j]));
        LDS_BARRIER();
        solve_step<0>(x, Af, Ab, UT, WT, Rb, tid, wave, lane);
        solve_step<1>(x, Af, Ab, UT, WT, Rb, tid, wave, lane);
        solve_step<2>(x, Af, Ab, UT, WT, Rb, tid, wave, lane);
        solve_step<3>(x, Af, Ab, UT, WT, Rb, tid, wave, lane);
    }
    LDS_BARRIER();
    SUBA_END(12); SUBA_MARK();
    { const int tn = wave & 3, tmo = wave >> 2; const float eGl = __expf(Gs[63]);
      { f32x16 acc = {}; acc = mm_tile<64>(Att, 72, UT, 72, tmo, tn, lane, acc); acc_store_pk(OL + wave * 512, acc, lane); }
      { f32x16 acc = {}; acc = mm_tile<64>(Att, 72, WT, 72, tmo, tn, lane, acc);
#pragma unroll
        for (int r = 0; r < 16; ++r) { const int i = tmo * 32 + crow(r, hi), a = tn * 32 + r32; QE[i * 128 + a] = f2bf(bf2f(Qs[i * 136 + a]) * __expf(Gs[i]) - acc[r]); } }
#pragma unroll
      for (int q = 0; q < 2; ++q) { const int tm = tmo + 2 * q;
        { f32x16 acc = {}; acc = mm_tile<64>(KhT, 72, UT, 72, tm, tn, lane, acc); acc_store_pk(NC + (tm * 4 + tn) * 512, acc, lane); }
        { f32x16 acc = {}; acc = mm_tile<64>(KhT, 72, WT, 72, tm, tn, lane, acc);
#pragma unroll
          for (int r = 0; r < 16; ++r) { const int a = tm * 32 + crow(r, hi), a2 = tn * 32 + r32; MC[a * 128 + a2] = f2bf((a == a2 ? eGl : 0.f) - acc[r]); } } } }
    LDS_BARRIER();
    SUBA_END(13); tsa_ = tsa0_; SUBA_END(10);
    if (PROBE_SUB == 14 && blockIdx.x == 0 && threadIdx.x == 0) *(volatile LAS unsigned long long*)(lds + PTAB_OFF + 320) += 1000;
}
__device__ __forceinline__ void dn_scan_item(ptab_t pt, int l, bool lat, int b, int h, int d, int vh, LAS unsigned char* lds) {
    const int tid = tid_opaque(), lane = tid & 63, wave = tid >> 6, r32 = lane & 31, hi = lane >> 5;
    unsigned char* ws = PWS;
    float* OD = (float*)(ws + WS_OD);
    const int L = lat ? 1024 : 256, rowbase = lat ? 4096 + b * 1024 : b * 256, nch = L >> 6, slot0 = lat ? 64 + b * 16 : b * 4;
    const int tm = wave & 3, tnl = wave >> 2, tn = vh * 2 + tnl;
    const bool ow_ = wave < 4; const int tmo = wave & 1, tnlo = (wave >> 1) & 1, tno = vh * 2 + tnlo;
    LAS bf16_t* ST = (LAS bf16_t*)lds;
    LAS bf16_t* AMb = (LAS bf16_t*)(lds + 34816);
    f32x16 S;
    const size_t sbase = ((((size_t)b * 2 + l) * 2 + d) * 4 + h) * 16384;
#pragma unroll
    for (int r = 0; r < 16; ++r) S[r] = lat ? PIN(5)[sbase + (size_t)(tm * 32 + crow(r, hi)) * 128 + tn * 32 + r32] : 0.f;
    u32x4 stg[6], stg2[6]; unsigned ow[8], n0[8], now[8], nn0[8];
#define DN_GLOAD(STG, cc) do { const int unit_ = ((slot0 + (cc)) * 4 + h) * 2 + d; const bf16_t* mc_ = (const bf16_t*)(ws + WS_MC) + (size_t)unit_ * 16384; const bf16_t* qe_ = (const bf16_t*)(ws + WS_QE) + (size_t)unit_ * 8192; \
        _Pragma("unroll") for (int j_ = 0; j_ < 4; ++j_) STG[j_] = *(const u32x4*)(mc_ + (size_t)(tid + 512 * j_) * 8); \
        _Pragma("unroll") for (int j_ = 0; j_ < 2; ++j_) STG[4 + j_] = *(const u32x4*)(qe_ + (size_t)(tid + 512 * j_) * 8); } while (0)
#define DN_TLOAD(OW, N0, cc) do { const int unit_ = ((slot0 + (cc)) * 4 + h) * 2 + d; \
        acc_load_pk((const unsigned*)(ws + WS_OL) + (size_t)unit_ * 4096 + (tmo * 4 + tno) * 512, OW, lane); acc_load_pk((const unsigned*)(ws + WS_NC) + (size_t)unit_ * 8192 + (tm * 4 + tn) * 512, N0, lane); } while (0)
#define DN_SWRITE(buf) do { LAS bf16_t* am_ = AMb + (buf) * 26112; LAS bf16_t* aq_ = am_ + 128 * 136; \
        _Pragma("unroll") for (int j_ = 0; j_ < 4; ++j_) { const int q_ = tid + 512 * j_; *(LAS u32x4*)(am_ + (q_ >> 4) * 136 + (q_ & 15) * 8) = stg[j_]; } \
        _Pragma("unroll") for (int j_ = 0; j_ < 2; ++j_) { const int q_ = tid + 512 * j_; *(LAS u32x4*)(aq_ + (q_ >> 4) * 136 + (q_ & 15) * 8) = stg[4 + j_]; } } while (0)
    DN_GLOAD(stg, 0); DN_SWRITE(0);
    DN_TLOAD(ow, n0, 0); DN_TLOAD(now, nn0, 1);
    DN_GLOAD(stg2, 1); DN_GLOAD(stg, (nch > 2 ? 2 : 1));
#define DN_STEP(c, OW, N0, STGN, STGNAME_IS_STG2) do { \
        acc_to_ST(ST, 136, tm * 32, tnl * 32, S, lane); \
        LDS_BARRIER(); \
        const LAS bf16_t* am = AMb + ((c) & 1) * 26112; const LAS bf16_t* aq = am + 128 * 136; \
        _Pragma("unroll") for (int r2 = 0; r2 < 8; ++r2) { S[2 * r2] = bflo(N0[r2]); S[2 * r2 + 1] = bfhi(N0[r2]); } \
        f32x16 o; \
        if (ow_) { _Pragma("unroll") for (int r2 = 0; r2 < 8; ++r2) { o[2 * r2] = bflo(OW[r2]); o[2 * r2 + 1] = bfhi(OW[r2]); } } \
        { const int cn_ = (c) + 2 < nch ? (c) + 2 : nch - 1; DN_TLOAD(OW, N0, cn_); }     \
        if (ow_) { o = mm_tile<128>(aq, 136, ST, 136, tmo, tnlo, lane, o); \
            const int s0_ = (c) * 64 + tmo * 32 + 4 * hi; store_o_tile_pk((unsigned*)OD, o, (long long)((size_t)d * NTOK + rowbase + (d ? L - 1 - s0_ : s0_)), d ? -1 : 1, h * 128 + tno * 32, lane); } \
        S = mm_tile<128>(am, 136, ST, 136, tm, tnl, lane, S); \
        { LAS bf16_t* am_ = AMb + (((c) + 1) & 1) * 26112; LAS bf16_t* aq_ = am_ + 128 * 136;     \
          _Pragma("unroll") for (int j_ = 0; j_ < 4; ++j_) { const int q_ = tid + 512 * j_; *(LAS u32x4*)(am_ + (q_ >> 4) * 136 + (q_ & 15) * 8) = STGN[j_]; } \
          _Pragma("unroll") for (int j_ = 0; j_ < 2; ++j_) { const int q_ = tid + 512 * j_; *(LAS u32x4*)(aq_ + (q_ >> 4) * 136 + (q_ & 15) * 8) = STGN[4 + j_]; } } \
        { const int cn_ = (c) + 3 < nch ? (c) + 3 : nch - 1; DN_GLOAD(STGN, cn_); }     \
        LDS_BARRIER(); } while (0)
    for (int c = 0; c < nch; c += 2) {
        DN_STEP(c, ow, n0, stg2, 1);
        DN_STEP(c + 1, now, nn0, stg, 0);
    }
#undef DN_STEP
#undef DN_GLOAD
#undef DN_TLOAD
#undef DN_SWRITE
    if (!lat) {
#pragma unroll
        for (int r = 0; r < 16; ++r) POUT[OUT_SD + sbase + (size_t)(tm * 32 + crow(r, hi)) * 128 + tn * 32 + r32] = S[r]; }
}
__device__ __forceinline__ void mixer1_phase(ptab_t pt, int l, unsigned char* lds_generic, int bid, int nb, int rep) {
    LAS unsigned char* l3 = (LAS unsigned char*)lds_generic;
    LAS int* qslot = (LAS int*)(l3 + PTAB_OFF + 272);
    unsigned* qctr = (unsigned*)(PWS + WS_QUEUE) + (l * 4 + rep) * 64;
    constexpr int N_ITEMS = 2048;
    int it = bid, itn = bid + nb;
    UnitPre pc, pn;
    if (it < N_ITEMS) { if (it < 1024) dn_unit_load(pt, it, pc); else gla_unit_load(pt, it - 1024, pc); }
    while (it < N_ITEMS) {
        int nxt2 = 0;
        if (threadIdx.x == 0) nxt2 = 2 * nb + (int)atomicAdd(qctr, 1u);
        if (itn < N_ITEMS) { if (itn < 1024) dn_unit_load(pt, itn, pn); else gla_unit_load(pt, itn - 1024, pn); }
        if (it < 1024) { for (int q_ = 0; q_ < (PROBE_DUP == 8 ? 2 : 1); ++q_) dn_chunk_unit(pt, it, l3, pc); }
        else { for (int q_ = 0; q_ < (PROBE_DUP == 9 ? 2 : 1); ++q_) gla_chunk_unit(pt, it - 1024, l3, pc); }
        LDS_BARRIER();
        if (threadIdx.x == 0) *qslot = nxt2;
        LDS_BARRIER();
        it = itn; itn = *qslot;
#pragma unroll
        for (int q = 0; q < 6; ++q) pc.r[q] = pn.r[q];
        pc.f[0] = pn.f[0]; pc.f[1] = pn.f[1];
    }
}
__device__ __forceinline__ void mixer2_phase(ptab_t pt, int l, unsigned char* lds_generic, int bid, int nb, int rep) {
    LAS unsigned char* l3 = (LAS unsigned char*)lds_generic;
    LAS int* qslot = (LAS int*)(l3 + PTAB_OFF + 272);
    unsigned* qctr = (unsigned*)(PWS + WS_QUEUE) + (l * 4 + 2 + rep) * 64;
    const int n_tr = (l == 0 && rep == 0) ? (TI_OUT + TI_F1) / 8 : 0;
    const int N_ITEMS = 736 + n_tr;
    int it = bid;
    while (it < N_ITEMS) {
        int nxt = 0;
        if (threadIdx.x == 0) nxt = nb + (int)atomicAdd(qctr, 1u);
        if (it < 128 || (it >= 224 && it < 352)) {
            unsigned char* ws = PWS;
            const bf16_t* QN = (const bf16_t*)(ws + WS_QN); const bf16_t* KB = (const bf16_t*)(ws + WS_KB); const bf16_t* VB = (const bf16_t*)(ws + WS_VB); bf16_t* MIX = (bf16_t*)(ws + WS_MIX);
            const bool lat = it < 128; const int i = lat ? it : it - 224;
            const int b = lat ? i >> 5 : i >> 3, h = lat ? (i >> 2) & 7 : i & 7, qb = lat ? i & 3 : 0;
            const size_t row0 = lat ? 4096 + (size_t)b * 1024 + qb * 256 : (size_t)b * 256;
            const size_t krow0 = lat ? (size_t)4096 + (size_t)b * 1280 : (size_t)b * 256;
            att::attn_dense_body<1024, 256, 2048>(QN + row0 * 1024 + h * 128, KB + krow0 * 256 + (h >> 2) * 128, VB + krow0 * 256 + (h >> 2) * 128, MIX + row0 * 2048 + 512 + h * 128, lat ? 1280 : 256, (char*)lds_generic);
        } else if (it < 192 || (it >= 352 && it < 608)) { const bool lat = it < 192; const int j = lat ? it - 128 : it - 352; const int vh = j & 1, q = j >> 1;
            dn_scan_item(pt, l, lat, q >> 3, (q >> 1) & 3, q & 1, vh, l3);
        } else if (it < 736) { const bool lat = it < 224; const int q = lat ? it - 192 : it - 608;
            gla_scan_item(pt, l, lat, q >> 3, (q >> 1) & 3, q & 1, l3);
        } else { const int wv = __builtin_amdgcn_readfirstlane((int)threadIdx.x >> 6);
            do_transposes(pt, l3, TI_L + TI_IN + (it - 736) * 8, 8, wv, 8);
        }
        LDS_BARRIER();
        if (threadIdx.x == 0) *qslot = nxt;
        LDS_BARRIER();
        it = *qslot;
    }
}

__device__ __forceinline__ void postmix_phase(ptab_t pt, int l, int bid, int nb) {
    const int tid = tid_opaque(), lane = tid & 63, wave = tid >> 6, sub = lane & 15;
    unsigned char* ws = PWS;
    const bf16_t* P = (const bf16_t*)(ws + WS_P); const unsigned* OG = (const unsigned*)(ws + WS_OG); const unsigned* OD = (const unsigned*)(ws + WS_OD); bf16_t* MIX = (bf16_t*)(ws + WS_MIX);
    const float* ggp = PIN(15) + l * 128 + sub * 8; const float* dgp = PIN(21) + l * 128 + sub * 8;
    constexpr int NT = 4;
#pragma unroll 1
    for (int r0 = bid * 8 + wave; r0 < NTOK / NT; r0 += nb * 8) {
#pragma unroll
        for (int part = 0; part < 2; ++part) {
            const unsigned* O = part ? OD : OG; const int gc = part ? 4608 : 1024, mc = part ? 1536 : 0;
            u32x4 p[NT], q[NT], z[NT];
#pragma unroll
            for (int u = 0; u < NT; ++u) { const size_t r = (size_t)(r0 + u * (NTOK / NT));
                p[u] = *(const u32x4*)(O + r * 256 + lane * 4); q[u] = *(const u32x4*)(O + ((size_t)NTOK + r) * 256 + lane * 4); z[u] = *(const u32x4*)(P + r * PLD + gc + lane * 8); }
            float a[NT][8], ss[NT];
#pragma unroll
            for (int u = 0; u < NT; ++u) { float x[8], y[8]; unpack8(p[u], x); unpack8(q[u], y); float s = 0.f;
#pragma unroll
                for (int e = 0; e < 8; ++e) { a[u][e] = x[e] + y[e]; s += a[u][e] * a[u][e]; }
                ss[u] = s; }
            group16_sum_n<NT>(ss);
            float gn[8]; { const float* gp = part ? dgp : ggp; const f32x4 g0 = *(const f32x4*)gp, g1 = *(const f32x4*)(gp + 4);
#pragma unroll
                for (int e = 0; e < 4; ++e) { gn[e] = g0[e]; gn[4 + e] = g1[e]; } }
#pragma unroll
            for (int u = 0; u < NT; ++u) { const size_t r = (size_t)(r0 + u * (NTOK / NT)); const float rstd = rsqrtf(ss[u] * (1.f / 128.f) + EPS); float zz[8], o[8]; unpack8(z[u], zz);
#pragma unroll
                for (int e = 0; e < 8; ++e) o[e] = a[u][e] * rstd * gn[e] * silu_f(zz[e]);
                *(u32x4*)(MIX + r * 2048 + mc + lane * 8) = pack8(o); }
        }
    }
}

#define RLX_AGENT __ATOMIC_RELAXED, __HIP_MEMORY_SCOPE_AGENT
#define XB_TMO      128
#define XB_XCNT(j)  (256  + 64 * (j))
#define XB_XSUB(j)  (1280 + 64 * (j))
#define XB_XGEN(j)  (2304 + 64 * (j))
#define XB_TOP      3328
#define XB_TOPGEN   3392
#define XCD_BAR_WORDS 3456
#define XB_SPIN_CAP (1u << 18)

__device__ __forceinline__ unsigned xb_ld(unsigned* p)              { return __hip_atomic_load(p, __ATOMIC_RELAXED, __HIP_MEMORY_SCOPE_AGENT); }
__device__ __forceinline__ unsigned xb_add(unsigned* p, unsigned v) { return __hip_atomic_fetch_add(p, v, __ATOMIC_RELAXED, __HIP_MEMORY_SCOPE_AGENT); }
__device__ __forceinline__ unsigned xb_xcc_id() { return (unsigned)__builtin_amdgcn_s_getreg((3 << 11) | 20) & 0xFu; }
#define XB_SPIN(cond, bar) do { unsigned _sp = 0; while (cond) { __builtin_amdgcn_s_sleep(1); \
    if ((++_sp & 255u) == 0u) { if (xb_ld(&(bar)[XB_TMO])) break; if (_sp > XB_SPIN_CAP) { atomicAdd(&(bar)[XB_TMO], 1u); break; } } } } while (0)

struct XcdBarrier {
    unsigned* bar; unsigned x;
    volatile LAS unsigned* st;
};

__device__ __forceinline__ XcdBarrier xcd_barrier_post(unsigned* bar, volatile LAS unsigned* st) {
    XcdBarrier b; b.bar = bar; b.x = xb_xcc_id(); b.st = st;
    if (threadIdx.x == 0) (void)xb_add(&bar[XB_XCNT(b.x)], 1u);
    return b;
}
__device__ __forceinline__ void xcd_barrier_complete(unsigned* bar, unsigned x, unsigned& nloc, unsigned& nx) {
    const unsigned G = gridDim.x * gridDim.y * gridDim.z;
    unsigned sum, cnt, mine, sp = 0u;
    for (;;) {
        sum = 0u; cnt = 0u; mine = 0u;
#pragma unroll
        for (unsigned j = 0; j < 16; ++j) { const unsigned c = xb_ld(&bar[XB_XCNT(j)]); sum += c; cnt += (c > 0u) ? 1u : 0u; mine = (j == x) ? c : mine; }
        if (sum == G) break;
        __builtin_amdgcn_s_sleep(1);
        if ((++sp & 255u) == 0u) { if (xb_ld(&bar[XB_TMO])) break; if (sp > XB_SPIN_CAP) { atomicAdd(&bar[XB_TMO], 1u); break; } }
    }
    nloc = mine > 0u ? mine : 1u; nx = cnt > 0u ? cnt : 1u;
}

__device__ __forceinline__ void xcd_barrier(const XcdBarrier& b) {
    asm volatile("s_waitcnt vmcnt(0)" ::: "memory");
    __syncthreads();
    if (threadIdx.x == 0) {
        unsigned* bar = b.bar;
        __builtin_amdgcn_s_waitcnt(0);
        unsigned nloc = b.st[0], nx = b.st[1];
        if (nloc == 0u) { xcd_barrier_complete(bar, b.x, nloc, nx); b.st[0] = nloc; b.st[1] = nx; }
        const unsigned old = xb_add(&bar[XB_XSUB(b.x)], 1u);
        const unsigned gen = old / nloc;
        if (old + 1u == (gen + 1u) * nloc) {
            __builtin_amdgcn_fence(__ATOMIC_RELEASE, "agent");
            asm volatile("s_waitcnt vmcnt(0)" ::: "memory");
            const unsigned og = xb_add(&bar[XB_TOP], 1u);
            const unsigned tg = og / nx;
            if (og + 1u == (tg + 1u) * nx) xb_add(&bar[XB_TOPGEN], 1u);
            else XB_SPIN(xb_ld(&bar[XB_TOPGEN]) == tg, bar);
            __builtin_amdgcn_fence(__ATOMIC_ACQUIRE, "agent");
            xb_add(&bar[XB_XGEN(b.x)], 1u);
            asm volatile("s_waitcnt vmcnt(0)" ::: "memory");
        } else {
            XB_SPIN(xb_ld(&bar[XB_XGEN(b.x)]) == gen, bar);
            __builtin_amdgcn_fence(__ATOMIC_ACQUIRE, "agent");
            asm volatile("s_waitcnt vmcnt(0)" ::: "memory");
        }
    }
    __syncthreads();
}

__global__ void __launch_bounds__(512, 2) mega(Params p) {
    extern __shared__ __attribute__((aligned(16))) unsigned char lds[];
    cg::grid_group grid = cg::this_grid();
    const int bid = blockIdx.x, nb = gridDim.x;
    LAS unsigned char* l3 = (LAS unsigned char*)lds;
    ptab_t pt = (ptab_t)(l3 + PTAB_OFF);
    if (threadIdx.x < 27) { const int i = threadIdx.x; const void* v = i < 25 ? (const void*)p.in[i] : (i == 25 ? (const void*)p.out : (const void*)p.ws);
        ((LAS unsigned long long*)(l3 + PTAB_OFF))[i] = (unsigned long long)v; }
    if (threadIdx.x < 2) ((LAS unsigned*)(l3 + PTAB_OFF + 256))[threadIdx.x] = 0u;
    if (PROBE_SUB != 0 && threadIdx.x == 0) *(volatile LAS unsigned long long*)(l3 + PTAB_OFF + 320) = 0;
    __syncthreads();
    { unsigned* ctl = (unsigned*)PWS; for (int i = bid * 512 + (int)threadIdx.x; i < 40960; i += nb * 512) ctl[i] = 0u; }
#define TSTAMP() do { if (PROBE_MASK != 0u && blockIdx.x == 0 && threadIdx.x == 0) { volatile LAS unsigned long long* ts_ = (volatile LAS unsigned long long*)(l3 + PTAB_OFF + 288); \
        const unsigned long long now_ = __builtin_amdgcn_s_memrealtime(); const unsigned s_ = (unsigned)ts_[2]; if ((PROBE_MASK >> s_) & 1u) ts_[1] += now_ - ts_[0]; ts_[0] = now_; ts_[2] = s_ + 1; } } while (0)
#define GSYNC() do { xcd_barrier(xbar); TSTAMP(); } while (0)
    if (PROBE_MASK != 0u && blockIdx.x == 0 && threadIdx.x == 0) { volatile LAS unsigned long long* ts_ = (volatile LAS unsigned long long*)(l3 + PTAB_OFF + 288); ts_[0] = __builtin_amdgcn_s_memrealtime(); ts_[1] = 0; ts_[2] = 0; }
    p0_prologue(pt, l3, bid, nb, true);
    asm volatile("s_waitcnt vmcnt(0)" ::: "memory"); __syncthreads();
    grid.sync();
    XcdBarrier xbar = xcd_barrier_post((unsigned*)PWS + 1024, (volatile LAS unsigned*)(l3 + PTAB_OFF + 256));
    TSTAMP();
    if (PROBE_DUP == 3) { p0_prologue(pt, l3, bid, nb, false); }
    if (PROBE_DUP == 5) { for (int i = 0; i < 20; ++i) GSYNC(); }
#define REP(code) for (int rep_ = 0; rep_ < ((PROBE_DUP == (code)) ? 2 : 1); ++rep_)
#pragma unroll 1
    for (int l = 0; l < 2; ++l) {
        if (l == 0) { REP(4) { unsigned char* ws = PWS; const float* mods_l = (const float*)(ws + WS_MODS);
          norm_phase(PIN(0), PIN(1) - (size_t)4096 * DM, PIN(8), mods_l, 0, 1, (bf16_t*)(ws + WS_H), bid, nb);
          if (rep_ == 0) bias_phase(mods_l + 3 * DM, (const bf16_t*)(ws + WS_WFF1), FFD, (float*)(ws + WS_BIAS), l3, bid, nb);
          GSYNC(); } }
        REP(2) { unsigned char* ws = PWS; pg8::Gemm g{(const bf16_t*)(ws + WS_H), (const bf16_t*)(ws + WS_WIN) + (size_t)l * PNW * 2048, NTOK, PNW, 2048}; pg8::StaticOrder S; S.init(NTOK, PNW, nb, bid, WGM_IN);
          pg8::EpiP E{(bf16_t*)(ws + WS_P), (float*)(ws + WS_G), l == 0 ? (const float*)nullptr : (const float*)(ws + WS_RS) + 8192, (const float*)(ws + WS_BIAS) + 5 * 8192};
          pg8::gemm_phase<pg8::EpiP, pg8::StaticOrder, true, true>(l3, g, S, E);
          if (rep_ == 0 && bid + 2 * nb >= 672) { const int nidle = nb - (672 - 2 * nb); const int wv = __builtin_amdgcn_readfirstlane((int)threadIdx.x >> 6);
              __syncthreads();
              if (l == 0) do_transposes(pt, l3, TI_L, TI_IN, (bid - (672 - 2 * nb)) * 8 + wv, nidle * 8);
              else do_transposes(pt, l3, TI_L + TI_IN + TI_OUT + TI_F1 + TI_F2 / 3, TI_F2 - TI_F2 / 3, (bid - (672 - 2 * nb)) * 8 + wv, nidle * 8); }
          GSYNC(); }
        REP(4) { prep_phase(pt, l, l3, bid, nb);
          if (l == 0 && rep_ == 0) { unsigned char* ws = PWS; __syncthreads();
              bias_phase((const float*)(ws + WS_MODS) + (size_t)5 * NMOD, (const bf16_t*)(ws + WS_WIN) + (size_t)PNW * 2048, PNW, (float*)(ws + WS_BIAS) + 5 * 8192, l3, bid, nb); }
          GSYNC(); }
        REP(6) { mixer1_phase(pt, l, lds, bid, nb, rep_);
          GSYNC(); }
        REP(7) { mixer2_phase(pt, l, lds, bid, nb, rep_);
          GSYNC(); }
        REP(4) { postmix_phase(pt, l, bid, nb);
          if (l == 0 && rep_ == 0) { unsigned char* ws = PWS;
              bias_phase((const float*)(ws + WS_MODS) + (size_t)5 * NMOD + 3 * DM, (const bf16_t*)(ws + WS_WFF1) + (size_t)FFD * 2048, FFD, (float*)(ws + WS_BIAS) + 10 * 8192, l3, bid, nb); }
          GSYNC(); }
        REP(2) { unsigned char* ws = PWS; const float* mods_l = (const float*)(ws + WS_MODS) + (size_t)l * 5 * NMOD;
          const void* xin0 = l == 0 ? (const void*)PIN(0) : (const void*)(ws + WS_XB); const void* xin1 = l == 0 ? (const void*)(PIN(1) - (size_t)4096 * DM) : (const void*)(ws + WS_XB);
          pg8::Gemm g{(const bf16_t*)(ws + WS_MIX), (const bf16_t*)(ws + WS_WOUT) + (size_t)l * 2048 * 2048, NTOK, 2048, 2048}; pg8::StaticOrder S; S.init(NTOK, 2048, nb, bid, WGM_OUT);
          pg8::EpiRes E{xin0, xin1, (void*)(ws + WS_XA), mods_l + 2 * DM, rep_ == 0 ? (bf16_t*)(ws + WS_H) : (bf16_t*)nullptr, PIN(9) + l * DM, mods_l + 4 * DM, (float*)(ws + WS_RS) + (l == 0 ? 0 : 2 * 8192), l == 0 ? 0 : 1, 1};
          pg8::gemm_phase<pg8::EpiRes, pg8::StaticOrder, true, true>(l3, g, S, E);
          GSYNC(); }
        REP(2) { unsigned char* ws = PWS; pg8::Gemm g{(const bf16_t*)(ws + WS_H), (const bf16_t*)(ws + WS_WFF1) + (size_t)l * 8192 * 2048, NTOK, FFD, 2048}; pg8::StaticOrder S; S.init(NTOK, FFD, nb, bid, WGM_F1);
          pg8::EpiSqRelu E{(bf16_t*)(ws + WS_H2), FFD, (const float*)(ws + WS_RS) + (l == 0 ? 0 : 2 * 8192), (const float*)(ws + WS_BIAS) + (l == 0 ? 0 : 10 * 8192)};
          pg8::gemm_phase<pg8::EpiSqRelu, pg8::StaticOrder, true, true>(l3, g, S, E);
          GSYNC(); }
        REP(2) { unsigned char* ws = PWS; const float* mods_l = (const float*)(ws + WS_MODS) + (size_t)l * 5 * NMOD; const float* XA = (const float*)(ws + WS_XA);
          pg8::Gemm g{(const bf16_t*)(ws + WS_H2), (const bf16_t*)(ws + WS_WFF2) + (size_t)l * 2048 * 8192, NTOK, 2048, FFD}; pg8::StaticOrder S; S.init(NTOK, 2048, nb, bid, WGM_F2);
          pg8::EpiRes E{(const void*)XA, (const void*)XA, l == 0 ? (void*)(ws + WS_XB) : (void*)(POUT + OUT_Y), mods_l + 5 * DM, (l == 0 && rep_ == 0) ? (bf16_t*)(ws + WS_H) : (bf16_t*)nullptr, PIN(8) + DM, mods_l + 5 * NMOD + 1 * DM, (float*)(ws + WS_RS) + 8192, 1, l == 0 ? 1 : 0};
          pg8::gemm_phase<pg8::EpiRes, pg8::StaticOrder, true, true>(l3, g, S, E);
          if (l == 0 || rep_ + 1 < ((PROBE_DUP == 2) ? 2 : 1)) GSYNC(); }
    }
    if (PROBE_SUB != 0) { __syncthreads(); if (blockIdx.x == 0 && threadIdx.x == 0) { const unsigned long long t0_ = __builtin_amdgcn_s_memrealtime(), w_ = *(volatile LAS unsigned long long*)(l3 + PTAB_OFF + 320);
            while (__builtin_amdgcn_s_memrealtime() - t0_ < w_) __builtin_amdgcn_s_sleep(8); } }
    if (PROBE_MASK != 0u) { __syncthreads(); TSTAMP();
        if (blockIdx.x == 0 && threadIdx.x == 0) { volatile LAS unsigned long long* ts_ = (volatile LAS unsigned long long*)(l3 + PTAB_OFF + 288); const unsigned long long t0_ = __builtin_amdgcn_s_memrealtime(), w_ = ts_[1];
            while (__builtin_amdgcn_s_memrealtime() - t0_ < w_) __builtin_amdgcn_s_sleep(8); } }
}

extern "C" void kernel_launch(void* const* d_in, const int* in_sizes, int n_in, void* d_out, int out_size, void* d_ws, size_t ws_size, hipStream_t stream) {
    static int grid_blocks = 0;
    if (grid_blocks == 0) {
        if (n_in != 25 || out_size != (int)OUT_TOTAL || ws_size < WS_END) { fprintf(stderr, "kernel_launch: unexpected shapes: n_in %d out %d ws %zu (need %zu)\n", n_in, out_size, ws_size, (size_t)WS_END); grid_blocks = -1; return; }
        int dev = 0, cus = 0, per_cu = 0;
        if (hipGetDevice(&dev) != hipSuccess || hipDeviceGetAttribute(&cus, hipDeviceAttributeMultiprocessorCount, dev) != hipSuccess) { grid_blocks = -1; return; }
        if (hipFuncSetAttribute((const void*)mega, hipFuncAttributeMaxDynamicSharedMemorySize, LDS_BYTES) != hipSuccess) { fprintf(stderr, "kernel_launch: hipFuncSetAttribute failed\n"); grid_blocks = -1; return; }
        if (hipOccupancyMaxActiveBlocksPerMultiprocessor(&per_cu, (const void*)mega, 512, LDS_BYTES) != hipSuccess || per_cu < 1) { fprintf(stderr, "kernel_launch: occupancy query says %d blocks per CU\n", per_cu); (void)hipGetLastError(); grid_blocks = -1; return; }
        grid_blocks = cus;
    }
    if (grid_blocks < 0) return;
    Params p{};
    for (int i = 0; i < 25; ++i) p.in[i] = (const float*)d_in[i];
    p.out = (float*)d_out; p.ws = (unsigned char*)d_ws;
    void* args[] = {&p};
    const hipError_t e = hipLaunchCooperativeKernel((void*)mega, dim3(grid_blocks), dim3(512), args, LDS_BYTES, stream);
    if (e != hipSuccess) fprintf(stderr, "kernel_launch: cooperative launch failed: %s (grid %d)\n", hipGetErrorString(e), grid_blocks);
}
```

```cpp
#include <hip/hip_runtime.h>
#include <hip/hip_cooperative_groups.h>
#include <cstdio>
#include <cstdint>
namespace cg = cooperative_groups;
#ifndef WGM_IN
#define WGM_IN 8
#endif
#ifndef WGM_OUT
#define WGM_OUT 4
#endif
#ifndef WGM_F1
#define WGM_F1 4
#endif
#ifndef WGM_F2
#define WGM_F2 4
#endif
#ifndef PREP_NT
#define PREP_NT 4
#endif
#ifndef PROBE_DUP
#define PROBE_DUP 0
#endif
#ifndef PROBE_SUB
#define PROBE_SUB 0
#endif
#ifndef PROBE_MASK
#define PROBE_MASK 0u
#endif
namespace pg8 {
#define PG8_LAS __attribute__((address_space(3)))
typedef unsigned short bf16_t;
typedef short bf16x8 __attribute__((ext_vector_type(8)));
typedef float f32x4 __attribute__((ext_vector_type(4)));
typedef unsigned u32x4 __attribute__((ext_vector_type(4)));
typedef unsigned u32x2 __attribute__((ext_vector_type(2)));
constexpr int BM = 256, BK = 64, HALF = 128, HTB = HALF * BK * 2  , STAGE_BYTES = 8 * HTB, NXCD = 8, WGM = 1;

__host__ __device__ __forceinline__ int lds_byte(int r, int c) { const int st = (r >> 4) * 2 + (c >> 5), rr = r & 15, cc = c & 31, ob = rr * 64 + cc * 2; return st * 1024 + (ob ^ (((ob >> 9) & 1) << 5)); }
__host__ __device__ __forceinline__ void stage_rc(int b, int& R, int& C) { const int st = b / 1024, sb = b % 1024, swz = sb ^ (((sb >> 9) & 1) << 5); R = (st >> 1) * 16 + swz / 64; C = (st & 1) * 32 + (swz % 64) / 2; }
__host__ __device__ __forceinline__ int perm32(int rho) { const int n = rho >> 4, i = rho & 15; return 8 * (i >> 2) + 4 * n + (i & 3); }

struct Unit { int pm, pn; };
struct Gemm { const bf16_t* A; const bf16_t* Bt; int M, N, K; };

struct StaticOrder {
    int nM, nN, nwg, G, c, wgm;
    __host__ __device__ void init(int M, int N, int G_, int c_, int wgm_ = WGM) { nM = M / BM; nN = N / BM; nwg = nM * nN; G = G_; c = c_; wgm = wgm_; }
    __host__ __device__ bool next(int i, Unit& u) const {
        const long L = (long)i * G + c; if (L >= nwg) return false;
        int wgid = (int)L; { const int q = nwg / NXCD, r = nwg % NXCD, xcd = wgid % NXCD, off = wgid / NXCD; wgid = (xcd < r ? xcd * (q + 1) : r * (q + 1) + (xcd - r) * q) + off; }
        const int nig = wgm * nN, gid = wgid / nig, fm = gid * wgm, gsz = (nM - fm) < wgm ? (nM - fm) : wgm;
        u.pm = fm + ((wgid % nig) % gsz); u.pn = (wgid % nig) / gsz; return true;
    }
    __device__ __forceinline__ void a_ready(const Unit&) const {}
    __device__ __forceinline__ void done(const Unit&) const {}
};

__device__ __forceinline__ unsigned cvt_pk_bf16(float lo, float hi) { unsigned r; asm volatile("v_cvt_pk_bf16_f32 %0, %1, %2" : "=v"(r) : "v"(lo), "v"(hi)); return r; }
struct EpiP {
    static constexpr bool PERM = true, AFTER_DRAIN = false;
    bf16_t* P; float* G; const float* RS; const float* bias;
    __device__ __forceinline__ void operator()(const f32x4 (&acc)[2][2][4][2], const Unit& u, int wr, int wc, int fr, int fq) const {
        const int row0 = u.pm * BM + wr * 64 + fr; const int cond = (u.pm < 16) ? 0 : 1 + ((u.pm - 16) >> 2);
        const int col0 = u.pn * BM + wc * 32 + 8 * fq;
        const float* bp = bias + (size_t)cond * 5376 + col0;
        if (u.pn < 20) {
#pragma unroll
            for (int ai = 0; ai < 2; ++ai)
#pragma unroll
                for (int m = 0; m < 4; ++m) { const int row = row0 + ai * HALF + m * 16; bf16_t* rowp = P + (size_t)row * 5120 + col0;
                    const float rs = RS ? rsqrtf(RS[row] * (1.f / 2048.f) + 1e-6f) : 1.f;
#pragma unroll
                    for (int bj = 0; bj < 2; ++bj) { f32x4 v0 = acc[ai][bj][m][0] * rs, v1 = acc[ai][bj][m][1] * rs;
                        if (RS) { v0 += *(const f32x4*)(bp + bj * HALF); v1 += *(const f32x4*)(bp + bj * HALF + 4); }
                        u32x4 w; w.x = cvt_pk_bf16(v0[0], v0[1]); w.y = cvt_pk_bf16(v0[2], v0[3]); w.z = cvt_pk_bf16(v1[0], v1[1]); w.w = cvt_pk_bf16(v1[2], v1[3]);
                        *(u32x4*)(rowp + bj * HALF) = w; } }
        } else if (wc < 2) {
            const int gc0 = wc * 32 + 8 * fq;
#pragma unroll
            for (int ai = 0; ai < 2; ++ai)
#pragma unroll
                for (int m = 0; m < 4; ++m) { const int row = row0 + ai * HALF + m * 16; float* rowp = G + (size_t)row * 64 + gc0;
                    const float rs = RS ? rsqrtf(RS[row] * (1.f / 2048.f) + 1e-6f) : 1.f;
                    f32x4 v0 = acc[ai][0][m][0] * rs, v1 = acc[ai][0][m][1] * rs;
                    if (RS) { v0 += *(const f32x4*)(bp); v1 += *(const f32x4*)(bp + 4); }
                    *(f32x4*)(rowp) = v0; *(f32x4*)(rowp + 4) = v1; }
        }
    }
};
struct EpiRes {
    static constexpr bool PERM = true, AFTER_DRAIN = false;
    const void* base0; const void* base1; void* out; const float* gate;
    bf16_t* Hn; const float* gnorm; const float* scale; float* RS;
    int base_bf16, out_bf16;
    __device__ __forceinline__ void operator()(const f32x4 (&acc)[2][2][4][2], const Unit& u, int wr, int wc, int fr, int fq) const {
        const int row0 = u.pm * BM + wr * 64 + fr; const int col0 = u.pn * BM + wc * 32 + 8 * fq;
        const int cond = (u.pm < 16) ? 0 : 1 + ((u.pm - 16) >> 2);
        const void* base = (u.pm < 16) ? base0 : base1;
        const float* gp = gate + (size_t)cond * 6 * 2048 + col0;
        f32x4 gv[2][2], gs[2][2];
#pragma unroll
        for (int bj = 0; bj < 2; ++bj)
#pragma unroll
            for (int n = 0; n < 2; ++n) { gv[bj][n] = *(const f32x4*)(gp + bj * HALF + n * 4);
                if (Hn) gs[bj][n] = *(const f32x4*)(gnorm + col0 + bj * HALF + n * 4) * (*(const f32x4*)(scale + (size_t)cond * 6 * 2048 + col0 + bj * HALF + n * 4) + 1.f); }
#pragma unroll
        for (int ai = 0; ai < 2; ++ai)
#pragma unroll
            for (int m = 0; m < 4; ++m) { const int row = row0 + ai * HALF + m * 16; const size_t off = (size_t)row * 2048 + col0; float ss = 0.f;
#pragma unroll
                for (int bj = 0; bj < 2; ++bj) { f32x4 b0, b1;
                    if (base_bf16) { const u32x4 w = *(const u32x4*)((const bf16_t*)base + off + bj * HALF);
                        b0 = (f32x4){__uint_as_float(w.x << 16), __uint_as_float(w.x & 0xffff0000u), __uint_as_float(w.y << 16), __uint_as_float(w.y & 0xffff0000u)};
                        b1 = (f32x4){__uint_as_float(w.z << 16), __uint_as_float(w.z & 0xffff0000u), __uint_as_float(w.w << 16), __uint_as_float(w.w & 0xffff0000u)}; }
                    else { b0 = *(const f32x4*)((const float*)base + off + bj * HALF); b1 = *(const f32x4*)((const float*)base + off + bj * HALF + 4); }
                    const f32x4 x0 = b0 + gv[bj][0] * acc[ai][bj][m][0], x1 = b1 + gv[bj][1] * acc[ai][bj][m][1];
                    if (out_bf16) { u32x4 w; w.x = cvt_pk_bf16(x0[0], x0[1]); w.y = cvt_pk_bf16(x0[2], x0[3]); w.z = cvt_pk_bf16(x1[0], x1[1]); w.w = cvt_pk_bf16(x1[2], x1[3]); *(u32x4*)((bf16_t*)out + off + bj * HALF) = w; }
                    else { __builtin_nontemporal_store(x0, (f32x4*)((float*)out + off + bj * HALF)); __builtin_nontemporal_store(x1, (f32x4*)((float*)out + off + bj * HALF + 4)); }
                    if (Hn) { ss += ((x0[0] * x0[0] + x0[1] * x0[1]) + (x0[2] * x0[2] + x0[3] * x0[3])) + ((x1[0] * x1[0] + x1[1] * x1[1]) + (x1[2] * x1[2] + x1[3] * x1[3]));
                        const f32x4 y0 = x0 * gs[bj][0], y1 = x1 * gs[bj][1];
                        u32x4 w; w.x = cvt_pk_bf16(y0[0], y0[1]); w.y = cvt_pk_bf16(y0[2], y0[3]); w.z = cvt_pk_bf16(y1[0], y1[1]); w.w = cvt_pk_bf16(y1[2], y1[3]);
                        *(u32x4*)(Hn + off + bj * HALF) = w; } }
                if (Hn) { ss += __shfl_xor(ss, 16); ss += __shfl_xor(ss, 32); if (fq == 0) atomicAdd(RS + row, ss); } }
    }
};
struct EpiSqRelu {
    static constexpr bool PERM = true, AFTER_DRAIN = false;
    bf16_t* O; int ldc; const float* RS; const float* bias;
    __device__ __forceinline__ void operator()(const f32x4 (&acc)[2][2][4][2], const Unit& u, int wr, int wc, int fr, int fq) const {
        const int row0 = u.pm * BM + wr * 64 + fr; const int col0 = u.pn * BM + wc * 32 + 8 * fq;
        const int cond = (u.pm < 16) ? 0 : 1 + ((u.pm - 16) >> 2);
        const float* bp = bias + (size_t)cond * ldc + col0;
        f32x4 bv[2][2];
#pragma unroll
        for (int bj = 0; bj < 2; ++bj)
#pragma unroll
            for (int n = 0; n < 2; ++n) bv[bj][n] = *(const f32x4*)(bp + bj * HALF + 4 * n);
#pragma unroll
        for (int ai = 0; ai < 2; ++ai)
#pragma unroll
            for (int m = 0; m < 4; ++m) { const int row = row0 + ai * HALF + m * 16; bf16_t* rowp = O + (size_t)row * ldc + col0;
                const float rs = rsqrtf(RS[row] * (1.f / 2048.f) + 1e-6f);
#pragma unroll
                for (int bj = 0; bj < 2; ++bj) { f32x4 v0 = acc[ai][bj][m][0] * rs + bv[bj][0], v1 = acc[ai][bj][m][1] * rs + bv[bj][1];
#pragma unroll
                    for (int e = 0; e < 4; ++e) { const float a = fmaxf(v0[e], 0.f), b = fmaxf(v1[e], 0.f); v0[e] = a * a; v1[e] = b * b; }
                    u32x4 w; w.x = cvt_pk_bf16(v0[0], v0[1]); w.y = cvt_pk_bf16(v0[2], v0[3]); w.z = cvt_pk_bf16(v1[0], v1[1]); w.w = cvt_pk_bf16(v1[2], v1[3]);
                    *(u32x4*)(rowp + bj * HALF) = w; } }
    }
};

template <class Epi, class Sched, bool ALIGN_EPI = false, bool SP2 = false>
__device__ __forceinline__ void gemm_phase(PG8_LAS unsigned char* lds, const Gemm g, const Sched& S, const Epi& E) {
    int tid = threadIdx.x; asm volatile("" : "+v"(tid)); const int wid = __builtin_amdgcn_readfirstlane(tid >> 6), lane = tid & 63, wr = wid >> 2, wc = wid & 3, fr = lane & 15, fq = lane >> 4;
    const int K = g.K, nt = K / BK;
    unsigned voffA[2], voffB[2];
#pragma unroll
    for (int i = 0; i < 2; ++i) { int R, C; stage_rc(tid * 16 + i * 8192, R, C); const int Rb = Epi::PERM ? ((R & ~31) + perm32(R & 31)) : R;
        voffA[i] = (unsigned)(R * K + C) * 2u; voffB[i] = (unsigned)(Rb * K + C) * 2u; }
    const size_t kstep = (size_t)(BK * 2);
    const size_t hstep = (size_t)HALF * K * 2;
    const size_t tstep = 2 * hstep;
    const unsigned ldsw = (unsigned)wid * 1024u;
    const int aoff = lds_byte(wr * 64 + fr, fq * 8), boff = lds_byte(wc * 32 + fr, fq * 8);
#define PG8_SA(b, h) (((b) * 2 + (h)) * HTB)
#define PG8_SB(b, h) ((4 + (b) * 2 + (h)) * HTB)
#define PG8_STAGE(bufoff, gbase, voff) do { _Pragma("unroll") for (int _i = 0; _i < 2; ++_i) \
        __builtin_amdgcn_global_load_lds((const unsigned*)((const char*)(gbase) + (voff)[_i]), (PG8_LAS unsigned*)(lds + (bufoff) + ldsw + _i * 8192), 16, 0, 0); } while (0)
#define PG8_LDA(dst, b, h) do { _Pragma("unroll") for (int m = 0; m < 4; ++m) _Pragma("unroll") for (int k = 0; k < 2; ++k) dst[m][k] = *(const PG8_LAS bf16x8*)(lds + PG8_SA(b, h) + aoff + m * 2048 + k * 1024); } while (0)
#define PG8_LDB(dst, b, h) do { _Pragma("unroll") for (int n = 0; n < 2; ++n) _Pragma("unroll") for (int k = 0; k < 2; ++k) dst[n][k] = *(const PG8_LAS bf16x8*)(lds + PG8_SB(b, h) + boff + n * 2048 + k * 1024); } while (0)
#define PG8_MMA(ai, bj, At, Bt) do { __builtin_amdgcn_s_setprio(1); _Pragma("unroll") for (int m = 0; m < 4; ++m) _Pragma("unroll") for (int n = 0; n < 2; ++n) _Pragma("unroll") for (int k = 0; k < 2; ++k) \
        acc[ai][bj][m][n] = __builtin_amdgcn_mfma_f32_16x16x32_bf16(Bt[n][k], At[m][k], acc[ai][bj][m][n], 0, 0, 0); __builtin_amdgcn_s_setprio(0); } while (0)
#define PG8_WAIT_V(n) asm volatile("s_waitcnt vmcnt(" #n ")" ::: "memory")
#define PG8_WAIT_L(n) asm volatile("s_waitcnt lgkmcnt(" #n ")" ::: "memory")
#define PG8_BAR __builtin_amdgcn_s_barrier()
#define PG8_SCHED __builtin_amdgcn_sched_barrier(0)
    Unit cur, nxt; int ui = 0;
    if (!S.next(0, cur)) return;
    f32x4 acc[2][2][4][2];
#pragma unroll
    for (int a = 0; a < 2; ++a)
#pragma unroll
        for (int b = 0; b < 2; ++b)
#pragma unroll
            for (int m = 0; m < 4; ++m)
#pragma unroll
                for (int n = 0; n < 2; ++n) acc[a][b][m][n] = (f32x4){0.f, 0.f, 0.f, 0.f};
    bf16x8 At[4][2], B0[2][2], B1[2][2];
    const char* cA = (const char*)g.A + (size_t)cur.pm * tstep; const char* cB = (const char*)g.Bt + (size_t)cur.pn * tstep;
    S.a_ready(cur);
    if constexpr (SP2) {
        PG8_STAGE(PG8_SB(0, 0), cB, voffB); PG8_STAGE(PG8_SB(0, 1), cB + hstep, voffB); PG8_STAGE(PG8_SA(0, 0), cA, voffA); PG8_STAGE(PG8_SA(0, 1), cA + hstep, voffA);
        if (wr == 1) PG8_BAR;
        PG8_WAIT_V(2); PG8_BAR;
        PG8_STAGE(PG8_SB(1, 0), cB + kstep, voffB); PG8_STAGE(PG8_SA(1, 0), cA + kstep, voffA); PG8_STAGE(PG8_SB(1, 1), cB + hstep + kstep, voffB);
        PG8_WAIT_V(6); PG8_BAR;
    } else {
        PG8_STAGE(PG8_SB(0, 0), cB, voffB); PG8_STAGE(PG8_SA(0, 0), cA, voffA); PG8_STAGE(PG8_SB(0, 1), cB + hstep, voffB); PG8_STAGE(PG8_SA(0, 1), cA + hstep, voffA);
        if (wr == 1) PG8_BAR;
        PG8_WAIT_V(4); PG8_BAR;
        PG8_STAGE(PG8_SB(1, 0), cB + kstep, voffB); PG8_STAGE(PG8_SA(1, 0), cA + kstep, voffA); PG8_STAGE(PG8_SB(1, 1), cB + hstep + kstep, voffB);
        PG8_WAIT_V(6); PG8_BAR;
    }
    for (;;) {
        const bool has_next = S.next(ui + 1, nxt);
        const char* nA = has_next ? (const char*)g.A + (size_t)nxt.pm * tstep : cA; const char* nB = has_next ? (const char*)g.Bt + (size_t)nxt.pn * tstep : cB;
        for (int t = 0; t < nt; t += 2) {
            const bool last = (t == nt - 2);
            const char* a1 = cA + (size_t)(t + 1) * kstep;
            const char* a2 = last ? nA : cA + (size_t)(t + 2) * kstep; const char* b2 = last ? nB : cB + (size_t)(t + 2) * kstep;
            const char* a3 = a2 + kstep; const char* b3 = b2 + kstep;
            if (last && has_next) S.a_ready(nxt);
            if constexpr (SP2) {
            PG8_LDB(B0, 0, 0); PG8_LDB(B1, 0, 1); PG8_SCHED; PG8_LDA(At, 0, 0); PG8_STAGE(PG8_SA(1, 1), a1 + hstep, voffA);
            PG8_WAIT_V(8); PG8_WAIT_L(0); PG8_BAR; PG8_MMA(0, 0, At, B0); PG8_MMA(0, 1, At, B1); PG8_BAR; PG8_SCHED;
            PG8_LDA(At, 0, 1); PG8_STAGE(PG8_SB(0, 0), b2, voffB); PG8_STAGE(PG8_SB(0, 1), b2 + hstep, voffB); PG8_STAGE(PG8_SA(0, 0), a2, voffA);
            PG8_WAIT_V(8); PG8_WAIT_L(0); PG8_BAR; PG8_MMA(1, 0, At, B0); PG8_MMA(1, 1, At, B1); PG8_BAR; PG8_SCHED;
            PG8_LDB(B0, 1, 0); PG8_LDB(B1, 1, 1); PG8_SCHED; PG8_LDA(At, 1, 0); PG8_STAGE(PG8_SA(0, 1), a2 + hstep, voffA);
            PG8_WAIT_V(8); PG8_WAIT_L(0); PG8_BAR; PG8_MMA(0, 0, At, B0); PG8_MMA(0, 1, At, B1); PG8_BAR; PG8_SCHED;
            PG8_LDA(At, 1, 1); PG8_STAGE(PG8_SB(1, 0), b3, voffB); PG8_STAGE(PG8_SB(1, 1), b3 + hstep, voffB); PG8_STAGE(PG8_SA(1, 0), a3, voffA);
            PG8_WAIT_V(8); PG8_WAIT_L(0); PG8_BAR; PG8_MMA(1, 0, At, B0); PG8_MMA(1, 1, At, B1); PG8_BAR; PG8_SCHED;
            } else {
            PG8_LDB(B0, 0, 0); PG8_SCHED; PG8_LDA(At, 0, 0); PG8_STAGE(PG8_SA(1, 1), a1 + hstep, voffA);
            PG8_WAIT_L(8); PG8_BAR; PG8_WAIT_L(0); PG8_MMA(0, 0, At, B0); PG8_BAR; PG8_SCHED;
            PG8_LDB(B1, 0, 1); PG8_STAGE(PG8_SB(0, 0), b2, voffB);
            PG8_BAR; PG8_WAIT_L(0); PG8_MMA(0, 1, At, B1); PG8_BAR;
            PG8_LDA(At, 0, 1); PG8_STAGE(PG8_SA(0, 0), a2, voffA);
            PG8_BAR; PG8_WAIT_L(0); PG8_MMA(1, 0, At, B0); PG8_BAR; PG8_SCHED;
            PG8_STAGE(PG8_SB(0, 1), b2 + hstep, voffB);
            PG8_WAIT_V(6); PG8_BAR; PG8_MMA(1, 1, At, B1); PG8_BAR;
            PG8_LDB(B0, 1, 0); PG8_SCHED; PG8_LDA(At, 1, 0); PG8_STAGE(PG8_SA(0, 1), a2 + hstep, voffA);
            PG8_WAIT_L(8); PG8_BAR; PG8_WAIT_L(0); PG8_MMA(0, 0, At, B0); PG8_BAR; PG8_SCHED;
            PG8_LDB(B1, 1, 1); PG8_STAGE(PG8_SB(1, 0), b3, voffB);
            PG8_BAR; PG8_WAIT_L(0); PG8_MMA(0, 1, At, B1); PG8_BAR;
            PG8_LDA(At, 1, 1); PG8_STAGE(PG8_SA(1, 0), a3, voffA);
            PG8_BAR; PG8_WAIT_L(0); PG8_MMA(1, 0, At, B0); PG8_BAR; PG8_SCHED;
            PG8_STAGE(PG8_SB(1, 1), b3 + hstep, voffB);
            PG8_WAIT_V(6); PG8_BAR; PG8_MMA(1, 1, At, B1); PG8_BAR;
            }
        }
        if constexpr (ALIGN_EPI) { if (wr == 0) PG8_BAR; }
        if constexpr (!Epi::AFTER_DRAIN) { E(acc, cur, wr, wc, fr, fq); S.done(cur); }
        if (!has_next) break;
#pragma unroll
        for (int a = 0; a < 2; ++a)
#pragma unroll
            for (int b = 0; b < 2; ++b)
#pragma unroll
                for (int m = 0; m < 4; ++m)
#pragma unroll
                    for (int n = 0; n < 2; ++n) acc[a][b][m][n] = (f32x4){0.f, 0.f, 0.f, 0.f};
        cur = nxt; cA = nA; cB = nB; ++ui;
        if constexpr (ALIGN_EPI) { if (wr == 1) PG8_BAR; }
    }
    PG8_WAIT_V(0);
    if constexpr (!ALIGN_EPI) { if (wr == 0) PG8_BAR; }
    PG8_BAR;
    if constexpr (Epi::AFTER_DRAIN) { E.fused(acc, cur, wr, wc, fr, fq, lds, wid, lane); S.done(cur); }
#undef PG8_SA
#undef PG8_SB
#undef PG8_STAGE
#undef PG8_LDA
#undef PG8_LDB
#undef PG8_MMA
#undef PG8_WAIT_V
#undef PG8_WAIT_L
#undef PG8_BAR
#undef PG8_SCHED
}
}
namespace att {
typedef unsigned short bf16;
constexpr int   D = 128, NW = 8, QBLK = 32, KVBLK = 64;
constexpr float SCALE = 0.088388347648318440f;
constexpr float THR = 8.f;
constexpr int SDEPTH = 2;
constexpr size_t SHM_V = KVBLK * D * 2, SHM_K = KVBLK * D * 2, SHM_ATTN = 2 * SHM_V + 2 * SHM_K + NW * 64 * 4;
__device__ __forceinline__ bf16 f2bf_s(float f) { unsigned u = __builtin_bit_cast(unsigned, f); return (bf16)((u + 0x7fffu + ((u >> 16) & 1u)) >> 16); }
using bf16x8 = __attribute__((ext_vector_type(8))) short;
using s16x4  = __attribute__((ext_vector_type(4))) short;
using f32x16 = __attribute__((ext_vector_type(16))) float;
using f32x8  = __attribute__((ext_vector_type(8))) float;
using u32x4  = __attribute__((ext_vector_type(4))) unsigned;
#define KSWZ(row, colB) ((row) * 256 + ((colB) ^ (((row) & 7) << 4)))
#define SBAR() __builtin_amdgcn_sched_barrier(0)
__device__ __forceinline__ int crow(int r, int hi) { return (r & 3) + 8 * (r >> 2) + 4 * hi; }
__device__ __forceinline__ unsigned cvtpk(float lo, float hi) {
  unsigned r; asm volatile("v_cvt_pk_bf16_f32 %0, %1, %2" : "=v"(r) : "v"(lo), "v"(hi)); return r;
}
__device__ __forceinline__ void partialSM(f32x16& p0, f32x16& p1, float& m_reg, float& mn, float& alpha) {
  constexpr float C = SCALE * 1.4426950408889634f;
  float pmax = p0[0]; for (int r = 1; r < 16; ++r) pmax = fmaxf(pmax, p0[r]); for (int r = 0; r < 16; ++r) pmax = fmaxf(pmax, p1[r]);
  { auto rr = __builtin_amdgcn_permlane32_swap(__float_as_uint(pmax), __float_as_uint(pmax), false, false);
    pmax = fmaxf(__uint_as_float(rr[0]), __uint_as_float(rr[1])); }
  if (__builtin_expect(__all(pmax - m_reg <= THR / SCALE), 1)) { mn = m_reg; alpha = 1.f; }
  else { mn = fmaxf(m_reg, pmax); alpha = __builtin_amdgcn_exp2f((m_reg - mn) * C); m_reg = mn; }
  float mnC = -mn * C;
  for (int r = 0; r < 16; ++r) p0[r] = fmaf(p0[r], C, mnC); for (int r = 0; r < 16; ++r) p1[r] = fmaf(p1[r], C, mnC);
  for (int r = 0; r < 16; ++r) p0[r] = __builtin_amdgcn_exp2f(p0[r]);
}
__device__ __forceinline__ void finishSM(f32x16& p0, f32x16& p1, float alpha, float& l_reg, bf16x8& pa0, bf16x8& pa1, bf16x8& pa2, bf16x8& pa3) {
  for (int r = 0; r < 16; ++r) p1[r] = __builtin_amdgcn_exp2f(p1[r]);
  float ps = 0; for (int r = 0; r < 16; ++r) ps += p0[r]; for (int r = 0; r < 16; ++r) ps += p1[r];
  { auto rr = __builtin_amdgcn_permlane32_swap(__float_as_uint(ps), __float_as_uint(ps), false, false);
    ps = __uint_as_float(rr[0]) + __uint_as_float(rr[1]); }
  l_reg = l_reg * alpha + ps;
#define PK4(P, BASE, OUT) do { unsigned a0 = cvtpk(P[BASE + 0], P[BASE + 1]), a1 = cvtpk(P[BASE + 2], P[BASE + 3]);   \
    unsigned b0 = cvtpk(P[BASE + 4], P[BASE + 5]), b1 = cvtpk(P[BASE + 6], P[BASE + 7]);                              \
    auto r0 = __builtin_amdgcn_permlane32_swap(a0, b0, false, false); auto r1 = __builtin_amdgcn_permlane32_swap(a1, b1, false, false); \
    u32x4 w = {r0[0], r1[0], r0[1], r1[1]}; OUT = *reinterpret_cast<bf16x8*>(&w); } while (0)
  PK4(p0, 0, pa0); PK4(p0, 8, pa1); PK4(p1, 0, pa2); PK4(p1, 8, pa3);
#undef PK4
}
__device__ __forceinline__ void qkt(f32x16& p0, f32x16& p1, const bf16* Ks, const bf16x8* qr, int r32, int hi) {
  p0 = f32x16{}; p1 = f32x16{};
  for (int d0 = 0; d0 < 8; ++d0) { int cb = (d0 * 16 + hi * 8) * 2;
    bf16x8 b0 = *reinterpret_cast<const bf16x8*>((const char*)Ks + KSWZ(r32, cb));
    bf16x8 b1 = *reinterpret_cast<const bf16x8*>((const char*)Ks + KSWZ(32 + r32, cb));
    p0 = __builtin_amdgcn_mfma_f32_32x32x16_bf16(b0, qr[d0], p0, 0, 0, 0);
    p1 = __builtin_amdgcn_mfma_f32_32x32x16_bf16(b1, qr[d0], p1, 0, 0, 0); }
}
__device__ __forceinline__ int v_st(int k, int c) { const int kk = (k & ~0xC) | ((k & 4) << 1) | ((k & 8) >> 1); return ((kk >> 3) * 4 + (c >> 5)) * 512 + ((kk & 7) * 32 + (c & 31)) * 2; }
__device__ __forceinline__ int v_rd_base(int lane) { return ((lane & 3) << 3) | (((lane >> 2) & 3) << 6) | (((lane >> 4) & 1) << 5) | (((lane >> 5) & 1) << 8); }
constexpr int v_rd_off(int d0, int ks, int half) { return d0 * 512 + ks * 4096 + half * 2048; }
template <int OFF> __device__ __forceinline__ s16x4 tr_read(int vb) {
  s16x4 r; asm volatile("ds_read_b64_tr_b16 %0, %1 offset:%2" : "=&v"(r) : "v"(vb), "i"(OFF) : "memory"); return r;
}
template <int D0> __device__ __forceinline__ void pv_one(f32x16& od, int vb, bf16x8 pa0, bf16x8 pa1, bf16x8 pa2, bf16x8 pa3) {
  const s16x4 l0 = tr_read<v_rd_off(D0, 0, 0)>(vb), h0 = tr_read<v_rd_off(D0, 0, 1)>(vb), l1 = tr_read<v_rd_off(D0, 1, 0)>(vb), h1 = tr_read<v_rd_off(D0, 1, 1)>(vb);
  const s16x4 l2 = tr_read<v_rd_off(D0, 2, 0)>(vb), h2 = tr_read<v_rd_off(D0, 2, 1)>(vb), l3 = tr_read<v_rd_off(D0, 3, 0)>(vb), h3 = tr_read<v_rd_off(D0, 3, 1)>(vb);
  asm volatile("s_waitcnt lgkmcnt(0)" ::: "memory"); SBAR();
#define PK(L, H) (bf16x8){L[0], L[1], L[2], L[3], H[0], H[1], H[2], H[3]}
  od = __builtin_amdgcn_mfma_f32_32x32x16_bf16(pa0, PK(l0, h0), od, 0, 0, 0);
  od = __builtin_amdgcn_mfma_f32_32x32x16_bf16(pa1, PK(l1, h1), od, 0, 0, 0);
  od = __builtin_amdgcn_mfma_f32_32x32x16_bf16(pa2, PK(l2, h2), od, 0, 0, 0);
  od = __builtin_amdgcn_mfma_f32_32x32x16_bf16(pa3, PK(l3, h3), od, 0, 0, 0);
#undef PK
}
__device__ __forceinline__ void pv_d0(f32x16* o, int vb, bf16x8 pa0, bf16x8 pa1, bf16x8 pa2, bf16x8 pa3) {
  pv_one<0>(o[0], vb, pa0, pa1, pa2, pa3); pv_one<1>(o[1], vb, pa0, pa1, pa2, pa3); pv_one<2>(o[2], vb, pa0, pa1, pa2, pa3); pv_one<3>(o[3], vb, pa0, pa1, pa2, pa3);
}

template <int LDQ, int LDK, int LDO>
__device__ __forceinline__ void attn_dense_body(const bf16* Qb, const bf16* Kh, const bf16* Vh,
                                                bf16* Ob, int seq, char* lds) {
  int tid = threadIdx.x; asm volatile("" : "+v"(tid)); const int wid = tid >> 6, lane = tid & 63, r32 = lane & 31, hi = lane >> 5;
  bf16* V_lds = (bf16*)lds; bf16* K_lds = (bf16*)(lds + 2 * SHM_V);
  float* ws = (float*)(lds + 2 * SHM_V + 2 * SHM_K) + wid * 64; float* li_l = ws; float* al_l = ws + 32;
  float m_reg = -1e30f, l_reg = 0; f32x16 o[4] = {}; bf16x8 qr[8];
  const bf16* Qw = Qb + (long)(wid * QBLK + r32) * LDQ + hi * 8;
#pragma unroll
  for (int d0 = 0; d0 < 8; ++d0) qr[d0] = *reinterpret_cast<const bf16x8*>(Qw + d0 * 16);
  const int sr = tid >> 4, sc = (tid & 15) * 8, vst0 = v_st(sr, sc), vst1 = v_st(32 + sr, sc);
  const int vb0 = (int)(uintptr_t)V_lds + v_rd_base(lane);
  struct { bf16x8 vs0, vs1, ks0, ks1; } sr_[SDEPTH];
#define SLOAD(i, k0) do { sr_[i].vs0 = (*reinterpret_cast<const bf16x8*>(&Vh[(long)((k0) + sr) * LDK + sc])); sr_[i].vs1 = (*reinterpret_cast<const bf16x8*>(&Vh[(long)((k0) + 32 + sr) * LDK + sc])); \
    sr_[i].ks0 = (*reinterpret_cast<const bf16x8*>(&Kh[(long)((k0) + sr) * LDK + sc])); sr_[i].ks1 = (*reinterpret_cast<const bf16x8*>(&Kh[(long)((k0) + 32 + sr) * LDK + sc])); } while (0)
#define SWRITE(b, i) do { *(bf16x8*)((char*)V_lds + (b) * SHM_V + vst0) = (sr_[i].vs0);          \
    *(bf16x8*)((char*)V_lds + (b) * SHM_V + vst1) = (sr_[i].vs1); int kc = sc * 2;               \
    *(bf16x8*)((char*)K_lds + (b) * SHM_K + KSWZ(sr, kc)) = (sr_[i].ks0);                       \
    *(bf16x8*)((char*)K_lds + (b) * SHM_K + KSWZ(32 + sr, kc)) = (sr_[i].ks1); } while (0)
#define SWAIT() do { if constexpr (SDEPTH == 2) asm volatile("s_waitcnt vmcnt(4)" ::: "memory"); else asm volatile("s_waitcnt vmcnt(0)" ::: "memory"); } while (0)
#define RESC(a) do { if (__any((a) < 1.f)) { if (hi == 0) al_l[r32] = (a); asm volatile("s_waitcnt lgkmcnt(0)" ::: "memory"); \
    for (int d = 0; d < 4; ++d) for (int r = 0; r < 16; ++r) o[d][r] *= al_l[crow(r, hi)]; } } while (0)
  f32x16 pA0, pA1, pB0, pB1; float mnA, mnB, alA, alB; bf16x8 pa0, pa1, pa2, pa3; const int NT = seq / KVBLK;
  constexpr int SE = 0, SO = SDEPTH - 1;
  SLOAD(SE, 0); asm volatile("s_waitcnt vmcnt(0)" ::: "memory"); SWRITE(0, SE); __syncthreads();
  qkt(pA0, pA1, K_lds, qr, r32, hi); partialSM(pA0, pA1, m_reg, mnA, alA);
  SLOAD(SO, KVBLK); if constexpr (SDEPTH == 2) { if (2 < NT) SLOAD(SE, 2 * KVBLK); }
  SWAIT(); SWRITE(1, SO); __syncthreads();
  for (int j = 1; j + 1 < NT; j += 2) {
    SBAR(); qkt(pB0, pB1, (bf16*)((char*)K_lds + SHM_K), qr, r32, hi);
    finishSM(pA0, pA1, alA, l_reg, pa0, pa1, pa2, pa3); SBAR();
    SLOAD(SO, (j + SDEPTH) * KVBLK); SBAR();
    pv_d0(o, vb0, pa0, pa1, pa2, pa3); partialSM(pB0, pB1, m_reg, mnB, alB);
    __syncthreads(); SWAIT(); SWRITE(0, SE);
    RESC(alB); __syncthreads();
    SBAR(); qkt(pA0, pA1, K_lds, qr, r32, hi);
    finishSM(pB0, pB1, alB, l_reg, pa0, pa1, pa2, pa3); SBAR();
    if (SDEPTH == 1 || j + 3 < NT) SLOAD(SE, (j + 1 + SDEPTH) * KVBLK); SBAR();
    pv_d0(o, vb0 + (int)SHM_V, pa0, pa1, pa2, pa3); partialSM(pA0, pA1, m_reg, mnA, alA);
    __syncthreads(); SWAIT(); SWRITE(1, SO);
    RESC(alA); __syncthreads();
  }
  SBAR(); qkt(pB0, pB1, (bf16*)((char*)K_lds + SHM_K), qr, r32, hi);
  finishSM(pA0, pA1, alA, l_reg, pa0, pa1, pa2, pa3); SBAR();
  pv_d0(o, vb0, pa0, pa1, pa2, pa3); partialSM(pB0, pB1, m_reg, mnB, alB);
  __syncthreads(); RESC(alB);
  finishSM(pB0, pB1, alB, l_reg, pa0, pa1, pa2, pa3); SBAR();
  pv_d0(o, vb0 + (int)SHM_V, pa0, pa1, pa2, pa3);
  if (hi == 0) li_l[r32] = l_reg; asm volatile("s_waitcnt lgkmcnt(0)" ::: "memory");
  float rli[16];
#pragma unroll
  for (int r = 0; r < 16; ++r) rli[r] = __builtin_amdgcn_rcpf(li_l[crow(r, hi)]);
  bf16* Ow = Ob + (long)(wid * QBLK) * LDO;
#pragma unroll
  for (int r = 0; r < 16; ++r) { int orow = crow(r, hi);
    for (int d0 = 0; d0 < 4; ++d0) Ow[(long)orow * LDO + d0 * 32 + r32] = f2bf_s(o[d0][r] * rli[r]); }
#undef SLOAD
#undef SWRITE
#undef SWAIT
#undef RESC
}
#undef KSWZ
#undef SBAR
}
typedef unsigned short bf16_t;
typedef float f32x4 __attribute__((ext_vector_type(4)));
typedef float f32x2 __attribute__((ext_vector_type(2)));
typedef unsigned u32x4 __attribute__((ext_vector_type(4)));
typedef unsigned u32x2 __attribute__((ext_vector_type(2)));
#define LAS __attribute__((address_space(3)))
constexpr int DM = 2048, NTOK = 8192, INC = 5168, PNW = 5376, PLD = 5120, FFD = 8192, NMOD = 12288;
constexpr size_t MiB = 1u << 20;
constexpr size_t WS_CTL = 0, WS_MODS = 1 * MiB, WS_WIN = 2 * MiB, WS_WOUT = 44 * MiB, WS_WFF1 = 60 * MiB, WS_WFF2 = 124 * MiB, WS_H = 188 * MiB, WS_XA = 220 * MiB, WS_XB = 284 * MiB,
    WS_P = 348 * MiB, WS_G = 428 * MiB, WS_QN = 430 * MiB, WS_KB = 446 * MiB, WS_VB = 451 * MiB, WS_LA = 456 * MiB, WS_DQKV = 472 * MiB, WS_GB = 496 * MiB, WS_OG = 497 * MiB, WS_OD = 529 * MiB,
    WS_MIX = 561 * MiB, WS_GQ = 593 * MiB, WS_GO = 601 * MiB, WS_GU = 617 * MiB, WS_GD = 633 * MiB, WS_END = 634 * MiB;
constexpr size_t WS_MC = 188 * MiB, WS_NC = 220 * MiB, WS_QE = 252 * MiB, WS_OL = 268 * MiB;
constexpr size_t WS_QUEUE = 32768;
constexpr size_t WS_RS = 65536;
constexpr size_t WS_BIAS = 1 * MiB + 524288;
constexpr size_t WS_H2 = 348 * MiB;
constexpr size_t ZERO_BYTES = 2 * MiB;
constexpr size_t OUT_Y = 0, OUT_CK = 16777216, OUT_CV = 18874368, OUT_SG = 20971520, OUT_SD = 23068672, OUT_TOTAL = 27262976;
constexpr int LDS_BYTES = 147456;
constexpr float EPS = 1e-6f;

struct Params { const float* in[25]; float* out; unsigned char* ws; };
constexpr int PTAB_OFF = 147456 - 512;
typedef __attribute__((address_space(3))) const unsigned* ptab_t;
__device__ __forceinline__ const void* ldp(ptab_t pt, int i) { unsigned a; asm volatile("v_mov_b32 %0, %1" : "=v"(a) : "s"((unsigned)(unsigned long long)pt + 8u * (unsigned)i));
    const ptab_t q = (ptab_t)(unsigned long long)a; const unsigned lo = __builtin_amdgcn_readfirstlane(q[0]), hi = __builtin_amdgcn_readfirstlane(q[1]); return (const void*)(__attribute__((address_space(1))) const unsigned char*)(((unsigned long long)hi << 32) | lo); }
#define PIN(i) ((const float*)ldp(pt, (i)))
#define POUT ((float*)ldp(pt, 25))
#define PWS ((unsigned char*)ldp(pt, 26))

__device__ __forceinline__ float bf2f(unsigned short v) { return __uint_as_float(((unsigned)v) << 16); }
__device__ __forceinline__ float bflo(unsigned w) { return __uint_as_float(w << 16); }
__device__ __forceinline__ float bfhi(unsigned w) { return __uint_as_float(w & 0xffff0000u); }
__device__ __forceinline__ unsigned short f2bf(float f) { unsigned u = __float_as_uint(f); return (unsigned short)((u + 0x7fffu + ((u >> 16) & 1u)) >> 16); }
typedef __bf16 bf16x2_hw __attribute__((ext_vector_type(2)));
__device__ __forceinline__ unsigned pk2(float lo, float hi) { const f32x2 v = {lo, hi}; return __builtin_bit_cast(unsigned, __builtin_convertvector(v, bf16x2_hw)); }
__device__ __forceinline__ float wave_sum(float v) {
#pragma unroll
    for (int o = 1; o < 64; o <<= 1) v += __shfl_xor(v, o);
    return v;
}
template <int N> __device__ __forceinline__ void wave_sum_n(float (&v)[N]) {
#pragma unroll
    for (int o = 1; o < 64; o <<= 1) {
        float t[N];
#pragma unroll
        for (int i = 0; i < N; ++i) t[i] = __shfl_xor(v[i], o);
#pragma unroll
        for (int i = 0; i < N; ++i) v[i] += t[i];
    }
}
__device__ __forceinline__ float silu_f(float x) { return x * __builtin_amdgcn_rcpf(1.f + __expf(-x)); }
__device__ __forceinline__ float softplus_f(float x) { return fmaxf(x, 0.f) + __logf(1.f + __expf(-fabsf(x))); }
__device__ __forceinline__ float logsigmoid_f(float x) { return fminf(x, 0.f) - __logf(1.f + __expf(-fabsf(x))); }
#define LDS_WAIT() asm volatile("s_waitcnt lgkmcnt(0)" ::: "memory")
#define LDS_BARRIER() do { asm volatile("s_waitcnt lgkmcnt(0)" ::: "memory"); __builtin_amdgcn_s_barrier(); asm volatile("" ::: "memory"); } while (0)
__device__ __forceinline__ int tid_opaque() { int t = threadIdx.x; asm volatile("" : "+v"(t)); return t; }

template <int MODE  >
__device__ __forceinline__ void transpose_item(const float* W, int ldw, int o0, int K, bf16_t* WT, int n0, int k0, LAS float* scr, int lane) {
    const int krow = lane >> 4, n4 = (lane & 15) * 4;
    if (MODE == 0) {
        f32x4 v[16];
#pragma unroll
        for (int i = 0; i < 16; ++i) v[i] = __builtin_nontemporal_load((const f32x4*)(W + (size_t)(k0 + 4 * i + krow) * ldw + o0 + n4));
#pragma unroll
        for (int i = 0; i < 16; ++i) { LAS float* s = scr + (4 * i + krow) * 65 + n4; s[0] = v[i].x; s[1] = v[i].y; s[2] = v[i].z; s[3] = v[i].w; }
    } else {
#pragma unroll 4
        for (int i = 0; i < 16; ++i) { LAS float* s = scr + (4 * i + krow) * 65 + n4;
#pragma unroll
            for (int e = 0; e < 4; ++e) { const int c = n4 + e; float x = 0.f;
                if (MODE == 1 && c < 48) x = W[(size_t)(k0 + 4 * i + krow) * ldw + (c < 32 ? 1536 + c : 5152 + (c - 32))];
                s[e] = x; } }
    }
    LDS_WAIT(); asm volatile("" ::: "memory");
    const int c8 = lane & 7;
#pragma unroll
    for (int j = 0; j < 8; ++j) { const int n = (lane >> 3) + 8 * j; const LAS float* s = scr + (8 * c8) * 65 + n;
        u32x4 o; o.x = pk2(s[0 * 65], s[1 * 65]); o.y = pk2(s[2 * 65], s[3 * 65]); o.z = pk2(s[4 * 65], s[5 * 65]); o.w = pk2(s[6 * 65], s[7 * 65]);
        *(u32x4*)(WT + (size_t)(n0 + n) * K + k0 + 8 * c8) = o; }
    LDS_WAIT(); asm volatile("" ::: "memory");
}
constexpr int TI_IN = 32 * 84, TI_OUT = 32 * 32, TI_F1 = 32 * 128, TI_F2 = 128 * 32, TI_L = TI_IN + TI_OUT + TI_F1 + TI_F2;
__device__ __forceinline__ void do_transposes(ptab_t pt, LAS unsigned char* lds, int first, int count, int worker, int n_workers) {
    const int tid = tid_opaque(), lane = tid & 63, wave = __builtin_amdgcn_readfirstlane(tid >> 6);
    unsigned char* ws = PWS;
    LAS float* scr = (LAS float*)(lds + wave * 16640);
    for (int it = first + worker; it < first + count; it += n_workers) {
        const int l = it / TI_L; int r = it - l * TI_L;
        const float* W; bf16_t* WT; int ldw, K, kb, nbk, o0, mode = 0;
        if (r < TI_IN) { kb = r / 84; nbk = r % 84; const int n0 = 64 * nbk; W = PIN(12) + (size_t)l * 2048 * INC; WT = (bf16_t*)(ws + WS_WIN) + (size_t)l * PNW * 2048; ldw = INC; K = 2048;
            o0 = n0 < 1536 ? n0 : n0 + 32; mode = n0 < 5120 ? 0 : (n0 == 5120 ? 1 : 2); }
        else if ((r -= TI_IN) < TI_OUT) { kb = r / 32; nbk = r % 32; W = PIN(22) + (size_t)l * 2048 * 2048; WT = (bf16_t*)(ws + WS_WOUT) + (size_t)l * 2048 * 2048; ldw = 2048; K = 2048; o0 = 64 * nbk; }
        else if ((r -= TI_OUT) < TI_F1) { kb = r / 128; nbk = r % 128; W = PIN(23) + (size_t)l * 2048 * 8192; WT = (bf16_t*)(ws + WS_WFF1) + (size_t)l * 8192 * 2048; ldw = 8192; K = 2048; o0 = 64 * nbk; }
        else { r -= TI_F1; kb = r / 32; nbk = r % 32; W = PIN(24) + (size_t)l * 8192 * 2048; WT = (bf16_t*)(ws + WS_WFF2) + (size_t)l * 2048 * 8192; ldw = 2048; K = 8192; o0 = 64 * nbk; }
        if (mode == 0) transpose_item<0>(W, ldw, o0, K, WT, 64 * nbk, 64 * kb, scr, lane);
        else if (mode == 1) transpose_item<1>(W, ldw, o0, K, WT, 64 * nbk, 64 * kb, scr, lane);
        else transpose_item<2>(W, ldw, o0, K, WT, 64 * nbk, 64 * kb, scr, lane);
    }
}
__device__ __forceinline__ void p0_prologue(ptab_t pt, LAS unsigned char* lds, int bid, int nb, bool do_mods) {
    const int tid = tid_opaque(), lane = tid & 63, wave = __builtin_amdgcn_readfirstlane(tid >> 6);
    unsigned char* ws = PWS;
    do_transposes(pt, lds, 0, TI_L, bid * 8 + wave, nb * 8);
    do_transposes(pt, lds, TI_L + TI_IN + TI_OUT + TI_F1, TI_F2 / 3, bid * 8 + wave, nb * 8);
    __syncthreads();
    if (do_mods) {
        LAS float* sc = (LAS float*)lds;
        LAS float* red = (LAS float*)(lds + 40960);
        float* mods = (float*)(ws + WS_MODS);
        for (int idx = tid; idx < 5 * 2048; idx += 512) { const int j = idx >> 11, k = idx & 2047; const float cv = (j == 0) ? PIN(7)[k] : PIN(6)[(j - 1) * 2048 + k]; sc[idx] = silu_f(cv); }
        __syncthreads();
        const bool act = lane < 48; const int half = act ? lane / 24 : 0, c4 = act ? (lane % 24) * 4 : 0;
        for (int it = bid; it < 256; it += nb) {
            const int l = it >> 7, nc = it & 127;
            const float* Wp = PIN(10) + ((size_t)l * 2048 + wave * 256 + half) * NMOD + nc * 96 + c4;
            f32x4 acc[5];
#pragma unroll
            for (int j = 0; j < 5; ++j) acc[j] = (f32x4){0.f, 0.f, 0.f, 0.f};
#pragma unroll 8
            for (int i = 0; i < 128; ++i) { const f32x4 w = __builtin_nontemporal_load((const f32x4*)(Wp + (size_t)(2 * i) * NMOD)); const int row = wave * 256 + 2 * i + half;
#pragma unroll
                for (int j = 0; j < 5; ++j) acc[j] += sc[j * 2048 + row] * w; }
            if (act) {
#pragma unroll
                for (int j = 0; j < 5; ++j) *(LAS f32x4*)(red + ((wave * 2 + half) * 5 + j) * 96 + c4) = acc[j]; }
            __syncthreads();
            if (tid < 480) { const int j = tid / 96, col = tid % 96; float s = PIN(11)[(size_t)l * NMOD + nc * 96 + col];
#pragma unroll
                for (int g = 0; g < 16; ++g) s += red[(g * 5 + j) * 96 + col];
                mods[((size_t)l * 5 + j) * NMOD + nc * 96 + col] = s; }
            __syncthreads();
        }
    }
}

__device__ __forceinline__ void norm_phase(const float* x0, const float* x1, const float* g, const float* mods_l, int shift_i, int scale_i, bf16_t* H, int bid, int nb) {
    const int tid = tid_opaque(), lane = tid & 63, wave = tid >> 6;
    constexpr int NR = 4; const int qrows = NTOK / NR;
    for (int r0 = bid * 8 + wave; r0 < qrows; r0 += nb * 8) {
        f32x4 v[NR][8]; float ss[NR];
#pragma unroll
        for (int u = 0; u < NR; ++u) { const int r = r0 + u * qrows; const float* xr = (r < 4096 ? x0 : x1) + (size_t)r * DM;
#pragma unroll
            for (int j = 0; j < 8; ++j) v[u][j] = __builtin_nontemporal_load((const f32x4*)(xr + 4 * (lane + 64 * j))); }
#pragma unroll
        for (int u = 0; u < NR; ++u) { ss[u] = 0.f;
#pragma unroll
            for (int j = 0; j < 8; ++j) ss[u] += (v[u][j].x * v[u][j].x + v[u][j].y * v[u][j].y) + (v[u][j].z * v[u][j].z + v[u][j].w * v[u][j].w); }
        wave_sum_n<NR>(ss);
#pragma unroll
        for (int u = 0; u < NR; ++u) { const int r = r0 + u * qrows; const float rstd = rsqrtf(ss[u] * (1.f / DM) + EPS);
            const int cond = r < 4096 ? 0 : 1 + ((r - 4096) >> 10);
            const float* sh = mods_l + ((size_t)cond * 6 + shift_i) * DM; const float* sc = mods_l + ((size_t)cond * 6 + scale_i) * DM;
#pragma unroll
            for (int j = 0; j < 8; ++j) { const int col = 4 * (lane + 64 * j); const f32x4 gg = *(const f32x4*)(g + col), s = *(const f32x4*)(sc + col), h = *(const f32x4*)(sh + col);
                const f32x4 o = v[u][j] * rstd * gg * (s + 1.f) + h; u32x2 w; w.x = pk2(o.x, o.y); w.y = pk2(o.z, o.w); *(u32x2*)(H + (size_t)r * DM + col) = w; } }
    }
}

__device__ __forceinline__ void bias_phase(const float* shift  , const bf16_t* WT, int N, float* out  , LAS unsigned char* lds, int bid, int nb) {
    const int tid = tid_opaque(), lane = tid & 63, wave = tid >> 6;
    LAS float* sh = (LAS float*)(lds + 65536);
    for (int idx = tid; idx < 5 * 2048; idx += 512) sh[idx] = shift[(size_t)(idx >> 11) * 6 * 2048 + (idx & 2047)];
    __syncthreads();
    const int NGW = nb * 8;
    for (int n0 = bid * 8 + wave; n0 < N; n0 += 2 * NGW) {
        u32x4 w[2][4]; float a[2][5];
#pragma unroll
        for (int u = 0; u < 2; ++u) { const int n = n0 + u * NGW < N ? n0 + u * NGW : n0; const bf16_t* row = WT + (size_t)n * 2048;
#pragma unroll
            for (int j = 0; j < 4; ++j) w[u][j] = *(const u32x4*)(row + (j * 64 + lane) * 8);
#pragma unroll
            for (int c = 0; c < 5; ++c) a[u][c] = 0.f; }
#pragma unroll
        for (int j = 0; j < 4; ++j) { const int k0 = (j * 64 + lane) * 8;
#pragma unroll
            for (int c = 0; c < 5; ++c) { const f32x4 s0 = *(const LAS f32x4*)(sh + c * 2048 + k0), s1 = *(const LAS f32x4*)(sh + c * 2048 + k0 + 4);
#pragma unroll
                for (int u = 0; u < 2; ++u) { const u32x4 ww = w[u][j];
                    a[u][c] += (bflo(ww.x) * s0.x + bfhi(ww.x) * s0.y) + (bflo(ww.y) * s0.z + bfhi(ww.y) * s0.w) + (bflo(ww.z) * s1.x + bfhi(ww.z) * s1.y) + (bflo(ww.w) * s1.z + bfhi(ww.w) * s1.w); } } }
        float f[10];
#pragma unroll
        for (int u = 0; u < 2; ++u)
#pragma unroll
            for (int c = 0; c < 5; ++c) f[u * 5 + c] = a[u][c];
        wave_sum_n<10>(f);
#pragma unroll
        for (int u = 0; u < 2; ++u) { const int n = n0 + u * NGW;
            if (n < N && lane < 5) out[(size_t)lane * N + n] = lane == 0 ? f[u * 5] : (lane == 1 ? f[u * 5 + 1] : (lane == 2 ? f[u * 5 + 2] : (lane == 3 ? f[u * 5 + 3] : f[u * 5 + 4]))); }
    }
    __syncthreads();
}

struct PrepPtrs { const bf16_t* P; const float* G; bf16_t* QN; bf16_t* KB; bf16_t* VB; float* LA; bf16_t* DQKV; float* GB; float* out_ck; float* out_cv; const float* cw; const float* alog; const float* dtb; };
template <int N> __device__ __forceinline__ void group16_sum_n(float (&v)[N]) {
#pragma unroll
    for (int o = 1; o < 16; o <<= 1) {
        float t[N];
#pragma unroll
        for (int i = 0; i < N; ++i) t[i] = __shfl_xor(v[i], o);
#pragma unroll
        for (int i = 0; i < N; ++i) v[i] += t[i];
    }
}
__device__ __forceinline__ void unpack8(const u32x4 w, float (&x)[8]) { x[0] = bflo(w.x); x[1] = bfhi(w.x); x[2] = bflo(w.y); x[3] = bfhi(w.y); x[4] = bflo(w.z); x[5] = bfhi(w.z); x[6] = bflo(w.w); x[7] = bfhi(w.w); }
__device__ __forceinline__ u32x4 pack8(const float (&x)[8]) { u32x4 w; w.x = pk2(x[0], x[1]); w.y = pk2(x[2], x[3]); w.z = pk2(x[4], x[5]); w.w = pk2(x[6], x[7]); return w; }
template <bool LAT, int NT>
__device__ __forceinline__ void prep_tok(const int (&r)[NT], int l, int lane, const PrepPtrs& pp, const LAS float* w2s, const float* qgp, const float* kgp) {
    const int g = lane >> 4, sub = lane & 15;
    int bq[NT], tq[NT]; const bf16_t* Pr[NT];
#pragma unroll
    for (int u = 0; u < NT; ++u) { const int rr = LAT ? r[u] - 4096 : r[u]; bq[u] = LAT ? rr >> 10 : rr >> 8; tq[u] = LAT ? rr & 1023 : rr & 255; Pr[u] = pp.P + (size_t)r[u] * PLD; }
    const int L = LAT ? 1024 : 256;
    {
        u32x4 xw[NT][3];
#pragma unroll
        for (int u = 0; u < NT; ++u)
#pragma unroll
            for (int j = 0; j < 3; ++j) xw[u][j] = *(const u32x4*)(Pr[u] + 1536 + j * 512 + lane * 8);
        const float sgn = (sub & 4) ? 1.f : -1.f;
        float cs[NT][8], sn[NT][8];
        if (LAT) {
#pragma unroll
            for (int e = 0; e < 8; ++e) { const float inv = exp2f(-(float)((sub & 3) * 8 + e) * (13.287712379549449f / 32.f));
#pragma unroll
                for (int u = 0; u < NT; ++u) { const float a = (float)(sub < 8 ? tq[u] >> 6 : tq[u] & 63) * inv; cs[u][e] = __cosf(a); sn[u][e] = __sinf(a); } } }
#pragma unroll
        for (int j = 0; j < 3; ++j) {
            float gn[8]; { const float* gp = (j < 2 ? qgp : kgp) + sub * 8; const f32x4 g0 = *(const f32x4*)gp, g1 = *(const f32x4*)(gp + 4);
#pragma unroll
                for (int e = 0; e < 4; ++e) { gn[e] = g0[e]; gn[4 + e] = g1[e]; } }
            float ss[NT];
#pragma unroll
            for (int u = 0; u < NT; ++u) { float x[8]; unpack8(xw[u][j], x); float s = 0.f;
#pragma unroll
                for (int e = 0; e < 8; ++e) s += x[e] * x[e];
                ss[u] = s; }
            group16_sum_n<NT>(ss);
#pragma unroll
            for (int u = 0; u < NT; ++u) { float x[8], y[8]; unpack8(xw[u][j], x); const float rstd = rsqrtf(ss[u] * (1.f / 128.f) + EPS);
                const size_t krow = LAT ? ((size_t)4096 + (size_t)bq[u] * 1280 + 256 + tq[u]) : (size_t)r[u];
#pragma unroll
                for (int e = 0; e < 8; ++e) y[e] = x[e] * rstd * gn[e];
                if (!LAT && j == 2) {
                    float* dst = (g < 2 ? pp.out_ck : pp.out_cv) + ((((size_t)bq[u] * 2 + l) * 256 + tq[u]) * 2 + (g & 1)) * 128 + sub * 8;
                    f32x4 o0, o1;
#pragma unroll
                    for (int e = 0; e < 4; ++e) { o0[e] = g < 2 ? y[e] : x[e]; o1[e] = g < 2 ? y[4 + e] : x[4 + e]; }
                    __builtin_nontemporal_store(o0, (f32x4*)dst); __builtin_nontemporal_store(o1, (f32x4*)(dst + 4)); }
                if (LAT) {
#pragma unroll
                    for (int e = 0; e < 8; ++e) { const float p = __shfl_xor(y[e], 4); y[e] = y[e] * cs[u][e] + sgn * p * sn[u][e]; } }
                if (j < 2) *(u32x4*)(pp.QN + (size_t)r[u] * 1024 + j * 512 + lane * 8) = pack8(y);
                else { bf16_t* dst = (g < 2 ? pp.KB : pp.VB) + krow * 256 + (g & 1) * 128 + sub * 8; const u32x4 yk = pack8(y); *(u32x4*)dst = g < 2 ? yk : xw[u][2]; } }
            asm volatile("" ::: "memory");
        }
    }
#pragma unroll
    for (int d = 0; d < 2; ++d) {
        float lr[NT][16];
#pragma unroll
        for (int u = 0; u < NT; ++u)
#pragma unroll
            for (int j = 0; j < 4; ++j) { const f32x4 t4 = *(const f32x4*)(pp.G + (size_t)r[u] * 64 + d * 16 + 4 * j); lr[u][4 * j] = t4.x; lr[u][4 * j + 1] = t4.y; lr[u][4 * j + 2] = t4.z; lr[u][4 * j + 3] = t4.w; }
#pragma unroll
        for (int jj = 0; jj < 4; ++jj) { const int n = lane + 64 * jj; float a[NT]; const float b0 = w2s[8192 + d * 256 + n];
#pragma unroll
            for (int u = 0; u < NT; ++u) a[u] = b0;
#pragma unroll
            for (int q = 0; q < 16; ++q) { const float w = w2s[(d * 16 + q) * 256 + n];
#pragma unroll
                for (int u = 0; u < NT; ++u) a[u] += lr[u][q] * w; }
#pragma unroll
            for (int u = 0; u < NT; ++u) pp.LA[(size_t)r[u] * 512 + d * 256 + n] = logsigmoid_f(a[u]) * (1.f / 16.f); }
    }
    {
        float ym[NT], yp[NT]; const bf16_t* Pm[NT]; const bf16_t* Pp[NT];
#pragma unroll
        for (int u = 0; u < NT; ++u) { ym[u] = tq[u] > 0 ? 1.f : 0.f; yp[u] = tq[u] < L - 1 ? 1.f : 0.f; Pm[u] = tq[u] > 0 ? Pr[u] - PLD : Pr[u]; Pp[u] = tq[u] < L - 1 ? Pr[u] + PLD : Pr[u]; }
#pragma unroll 1
        for (int j = 0; j < 3; ++j) { const int c = j * 512 + lane * 8;
            u32x4 xm[NT], xc[NT], xp[NT];
#pragma unroll
            for (int u = 0; u < NT; ++u) { xm[u] = *(const u32x4*)(Pm[u] + 3072 + c); xc[u] = *(const u32x4*)(Pr[u] + 3072 + c); xp[u] = *(const u32x4*)(Pp[u] + 3072 + c); }
            float w0[8], w1[8], w2[8];
#pragma unroll
            for (int q = 0; q < 2; ++q) { const f32x4 a0 = *(const f32x4*)(pp.cw + c + 4 * q), a1 = *(const f32x4*)(pp.cw + 1536 + c + 4 * q), a2 = *(const f32x4*)(pp.cw + 3072 + c + 4 * q);
#pragma unroll
                for (int e = 0; e < 4; ++e) { w0[4 * q + e] = a0[e]; w1[4 * q + e] = a1[e]; w2[4 * q + e] = a2[e]; } }
            float y[NT][8], ss[NT];
#pragma unroll
            for (int u = 0; u < NT; ++u) { float am[8], ac[8], ap[8]; unpack8(xm[u], am); unpack8(xc[u], ac); unpack8(xp[u], ap); float s = 0.f;
#pragma unroll
                for (int e = 0; e < 8; ++e) { const float v = silu_f(w0[e] * am[e] * ym[u] + w1[e] * ac[e] + w2[e] * ap[e] * yp[u]); y[u][e] = v; s += v * v; }
                ss[u] = s; }
            if (j < 2) { group16_sum_n<NT>(ss);
#pragma unroll
                for (int u = 0; u < NT; ++u) { const float sc = rsqrtf(ss[u] + EPS) * (j == 0 ? 0.08838834764831845f : 1.f);
#pragma unroll
                    for (int e = 0; e < 8; ++e) y[u][e] *= sc; } }
#pragma unroll
            for (int u = 0; u < NT; ++u) *(u32x4*)(pp.DQKV + (size_t)r[u] * 1536 + c) = pack8(y[u]);
        }
    }
    if (lane < 8) {
#pragma unroll
        for (int u = 0; u < NT; ++u) { const float a = pp.G[(size_t)r[u] * 64 + 32 + lane], bb = pp.G[(size_t)r[u] * 64 + 40 + lane];
            pp.GB[(size_t)r[u] * 16 + lane] = -__expf(pp.alog[l * 8 + lane]) * softplus_f(a + pp.dtb[l * 8 + lane]); pp.GB[(size_t)r[u] * 16 + 8 + lane] = 1.f / (1.f + __expf(-bb)); } }
}
__device__ __forceinline__ void prep_phase(ptab_t pt, int l, LAS unsigned char* lds, int bid, int nb) {
    const int tid = tid_opaque(), lane = tid & 63, wave = tid >> 6;
    unsigned char* ws = PWS;
    PrepPtrs pp; pp.P = (const bf16_t*)(ws + WS_P); pp.G = (const float*)(ws + WS_G); pp.QN = (bf16_t*)(ws + WS_QN); pp.KB = (bf16_t*)(ws + WS_KB); pp.VB = (bf16_t*)(ws + WS_VB);
    pp.LA = (float*)(ws + WS_LA); pp.DQKV = (bf16_t*)(ws + WS_DQKV); pp.GB = (float*)(ws + WS_GB); pp.out_ck = POUT + OUT_CK; pp.out_cv = POUT + OUT_CV;
    pp.cw = PIN(18) + (size_t)l * 3 * 1536; pp.alog = PIN(19); pp.dtb = PIN(20);
    LAS float* w2s = (LAS float*)lds;
    for (int i = tid; i < 8192; i += 512) w2s[i] = PIN(13)[(size_t)l * 8192 + i];
    for (int i = tid; i < 512; i += 512) w2s[8192 + i] = PIN(14)[(size_t)l * 512 + i];
    __syncthreads();
    const float* qgp = PIN(16) + l * 128; const float* kgp = PIN(17) + l * 128;
    constexpr int NT = PREP_NT, RQ = 4096 / NT;
    const int gw = bid * 8 + wave, NGW = nb * 8, HW = NGW >> 1;
    if (gw < HW) {
#pragma unroll 1
        for (int r = gw; r < RQ; r += HW) { int rc[NT];
#pragma unroll
            for (int u = 0; u < NT; ++u) rc[u] = r + u * RQ;
            prep_tok<false, NT>(rc, l, lane, pp, w2s, qgp, kgp); } }
    else {
#pragma unroll 1
        for (int r = gw - HW; r < RQ; r += HW) { int rl[NT];
#pragma unroll
            for (int u = 0; u < NT; ++u) rl[u] = 4096 + r + u * RQ;
            prep_tok<true, NT>(rl, l, lane, pp, w2s, qgp, kgp); } }
    for (int i = bid * 512 + tid; i < 65536; i += nb * 512) { const int b = i >> 14, rem = i & 16383, pq = rem >> 6, c4 = rem & 63;
        const size_t srcx = (((size_t)b * 2 + l) * 256 + pq) * 256 + c4 * 4, dst = ((size_t)4096 + (size_t)b * 1280 + pq) * 256 + c4 * 4;
        const f32x4 k4 = *(const f32x4*)(PIN(2) + srcx), v4 = *(const f32x4*)(PIN(3) + srcx);
        u32x2 kw, vw; kw.x = pk2(k4.x, k4.y); kw.y = pk2(k4.z, k4.w); vw.x = pk2(v4.x, v4.y); vw.y = pk2(v4.z, v4.w);
        *(u32x2*)(pp.KB + dst) = kw; *(u32x2*)(pp.VB + dst) = vw; }
}

__device__ __forceinline__ void gla_naive_item(ptab_t pt, int l, bool lat, int b, int h, int d, LAS float* red) {
    const int tid = tid_opaque(), vq = tid & 127, kg = tid >> 7;
    unsigned char* ws = PWS;
    const bf16_t* P = (const bf16_t*)(ws + WS_P); const float* LA = (const float*)(ws + WS_LA); float* OG = (float*)(ws + WS_OG);
    const int L = lat ? 1024 : 256, rowbase = lat ? 4096 + b * 1024 : b * 256;
    float S[16];
    const size_t sidx = ((((size_t)b * 2 + l) * 2 + d) * 4 + h) * 8192 + (size_t)(kg * 16) * 128 + vq;
#pragma unroll
    for (int j = 0; j < 16; ++j) S[j] = lat ? PIN(4)[sidx + j * 128] : 0.f;
    f32x4 la[4], nla[4]; u32x4 kq[4], nkq[4]; unsigned short vv, nvv;
#define GLA_LOAD(LAv, KQv, Vv, step) do { const int t_ = d ? L - 1 - (step) : (step); const size_t r_ = (size_t)(rowbase + t_); \
        const float* lp_ = LA + r_ * 512 + d * 256 + h * 64 + kg * 16; const bf16_t* pr_ = P + r_ * PLD; \
        _Pragma("unroll") for (int j_ = 0; j_ < 4; ++j_) LAv[j_] = *(const f32x4*)(lp_ + 4 * j_); \
        KQv[0] = *(const u32x4*)(pr_ + 256 + h * 64 + kg * 16); KQv[1] = *(const u32x4*)(pr_ + 256 + h * 64 + kg * 16 + 8); \
        KQv[2] = *(const u32x4*)(pr_ + h * 64 + kg * 16); KQv[3] = *(const u32x4*)(pr_ + h * 64 + kg * 16 + 8); Vv = pr_[512 + h * 128 + vq]; } while (0)
    GLA_LOAD(la, kq, vv, 0);
    for (int step = 0; step < L; ++step) {
        const int sn = step + 1 < L ? step + 1 : step;
        GLA_LOAD(nla, nkq, nvv, sn);
        const float v = bf2f(vv); float part = 0.f;
#pragma unroll
        for (int j = 0; j < 16; ++j) { const unsigned kw = kq[j >> 3][(j >> 1) & 3], qw = kq[2 + (j >> 3)][(j >> 1) & 3];
            const float kk = (j & 1) ? bfhi(kw) : bflo(kw), qq = (j & 1) ? bfhi(qw) : bflo(qw);
            S[j] = __expf(la[j >> 2][j & 3]) * S[j] + kk * v; part += S[j] * qq; }
        red[((step & 1) * 4 + kg) * 128 + vq] = part * 0.125f;
        __syncthreads();
        if (kg == 0) { const LAS float* rp = red + (step & 1) * 512 + vq; const int t = d ? L - 1 - step : step;
            OG[((size_t)d * NTOK + rowbase + t) * 512 + h * 128 + vq] = (rp[0] + rp[128]) + (rp[256] + rp[384]); }
#pragma unroll
        for (int j = 0; j < 4; ++j) { la[j] = nla[j]; kq[j] = nkq[j]; } vv = nvv;
    }
#undef GLA_LOAD
    if (!lat) {
#pragma unroll
        for (int j = 0; j < 16; ++j) POUT[OUT_SG + sidx + j * 128] = S[j]; }
    __syncthreads();
}
__device__ __forceinline__ void dn_naive_item(ptab_t pt, int l, bool lat, int b, int h, int d, LAS float* red) {
    const int tid = tid_opaque(), vq = tid & 127, kg = tid >> 7;
    unsigned char* ws = PWS;
    const bf16_t* DQKV = (const bf16_t*)(ws + WS_DQKV); const float* GB = (const float*)(ws + WS_GB); float* OD = (float*)(ws + WS_OD);
    const int L = lat ? 1024 : 256, rowbase = lat ? 4096 + b * 1024 : b * 256;
    LAS float* redR = red; LAS float* redO = red + 1024;
    float S[32];
    const size_t sidx = ((((size_t)b * 2 + l) * 2 + d) * 4 + h) * 16384 + (size_t)(kg * 32) * 128 + vq;
#pragma unroll
    for (int j = 0; j < 32; ++j) S[j] = lat ? PIN(5)[sidx + j * 128] : 0.f;
    u32x4 kq[8], nkq[8]; unsigned short vv, nvv; float gg, ngg, be, nbe;
#define DN_LOAD(KQv, Vv, Gv, Bv, step) do { const int t_ = d ? L - 1 - (step) : (step); const size_t r_ = (size_t)(rowbase + t_); const bf16_t* pr_ = DQKV + r_ * 1536; \
        _Pragma("unroll") for (int j_ = 0; j_ < 4; ++j_) { KQv[j_] = *(const u32x4*)(pr_ + 512 + h * 128 + kg * 32 + 8 * j_); KQv[4 + j_] = *(const u32x4*)(pr_ + h * 128 + kg * 32 + 8 * j_); } \
        Vv = pr_[1024 + h * 128 + vq]; Gv = GB[r_ * 16 + d * 4 + h]; Bv = GB[r_ * 16 + 8 + d * 4 + h]; } while (0)
    DN_LOAD(kq, vv, gg, be, 0);
    for (int step = 0; step < L; ++step) {
        const int sn = step + 1 < L ? step + 1 : step;
        DN_LOAD(nkq, nvv, ngg, nbe, sn);
        float kf[32], rp = 0.f;
#pragma unroll
        for (int j = 0; j < 32; ++j) { const unsigned kw = kq[j >> 3][(j >> 1) & 3]; kf[j] = (j & 1) ? bfhi(kw) : bflo(kw); rp += kf[j] * S[j]; }
        redR[((step & 1) * 4 + kg) * 128 + vq] = rp;
        __syncthreads();
        if (step > 0 && kg == 0) { const LAS float* op = redO + ((step - 1) & 1) * 512 + vq; const int t = d ? L - step : step - 1;
            OD[((size_t)d * NTOK + rowbase + t) * 512 + h * 128 + vq] = (op[0] + op[128]) + (op[256] + op[384]); }
        const LAS float* rr = redR + (step & 1) * 512 + vq;
        const float rs = (rr[0] + rr[128]) + (rr[256] + rr[384]);
        const float eg = __expf(gg), w = be * (bf2f(vv) - eg * rs);
        float op = 0.f;
#pragma unroll
        for (int j = 0; j < 32; ++j) { const unsigned qw = kq[4 + (j >> 3)][(j >> 1) & 3]; const float qq = (j & 1) ? bfhi(qw) : bflo(qw);
            S[j] = eg * S[j] + kf[j] * w; op += qq * S[j]; }
        redO[((step & 1) * 4 + kg) * 128 + vq] = op;
#pragma unroll
        for (int j = 0; j < 8; ++j) kq[j] = nkq[j];
        vv = nvv; gg = ngg; be = nbe;
    }
#undef DN_LOAD
    __syncthreads();
    if (kg == 0) { const LAS float* op = redO + ((L - 1) & 1) * 512 + vq; const int t = d ? 0 : L - 1;
        OD[((size_t)d * NTOK + rowbase + t) * 512 + h * 128 + vq] = (op[0] + op[128]) + (op[256] + op[384]); }
    if (!lat) {
#pragma unroll
        for (int j = 0; j < 32; ++j) POUT[OUT_SD + sidx + j * 128] = S[j]; }
    __syncthreads();
}

typedef short bf16x8 __attribute__((ext_vector_type(8)));
typedef float f32x16 __attribute__((ext_vector_type(16)));
__device__ __forceinline__ int crow(int r, int hi) { return (r & 3) + 8 * (r >> 2) + 4 * hi; }
template <int K>
__device__ __forceinline__ f32x16 mm_tile(const LAS bf16_t* A, int lda, const LAS bf16_t* Bt, int ldb, int tm, int tn, int lane, f32x16 acc) {
    const int r32 = lane & 31, hi = lane >> 5;
    const LAS bf16_t* ap = A + (tm * 32 + r32) * lda + hi * 8; const LAS bf16_t* bp = Bt + (tn * 32 + r32) * ldb + hi * 8;
#pragma unroll
    for (int k0 = 0; k0 < K; k0 += 16) { const bf16x8 a = *(const LAS bf16x8*)(ap + k0), b = *(const LAS bf16x8*)(bp + k0); acc = __builtin_amdgcn_mfma_f32_32x32x16_bf16(a, b, acc, 0, 0, 0); }
    return acc;
}
template <int K>
__device__ __forceinline__ f32x16 mm_tile_ga(const bf16_t* A, int lda, const LAS bf16_t* Bt, int ldb, int tm, int tn, int lane, f32x16 acc) {
    const int r32 = lane & 31, hi = lane >> 5;
    const bf16_t* ap = A + (size_t)(tm * 32 + r32) * lda + hi * 8; const LAS bf16_t* bp = Bt + (tn * 32 + r32) * ldb + hi * 8;
    bf16x8 a[K / 16];
#pragma unroll
    for (int k = 0; k < K / 16; ++k) a[k] = *(const bf16x8*)(ap + 16 * k);
#pragma unroll
    for (int k = 0; k < K / 16; ++k) { const bf16x8 b = *(const LAS bf16x8*)(bp + 16 * k); acc = __builtin_amdgcn_mfma_f32_32x32x16_bf16(a[k], b, acc, 0, 0, 0); }
    return acc;
}
__device__ __forceinline__ void acc_store_pk(unsigned* dst, const f32x16& acc, int lane) {
#pragma unroll
    for (int r2 = 0; r2 < 8; ++r2) dst[r2 * 64 + lane] = pk2(acc[2 * r2], acc[2 * r2 + 1]);
}
__device__ __forceinline__ void acc_load_pk(const unsigned* src, unsigned (&w)[8], int lane) {
#pragma unroll
    for (int r2 = 0; r2 < 8; ++r2) w[r2] = src[r2 * 64 + lane];
}
__device__ __forceinline__ void acc_to_ST(LAS bf16_t* ST, int ld, int row0, int col0, const f32x16& s, int lane) {
    const int r32 = lane & 31, hi = lane >> 5;
#pragma unroll
    for (int g = 0; g < 4; ++g) { u32x2 w; w.x = pk2(s[4 * g], s[4 * g + 1]); w.y = pk2(s[4 * g + 2], s[4 * g + 3]);
        *(LAS u32x2*)(ST + (col0 + r32) * ld + row0 + 8 * g + 4 * hi) = w; }
}
__device__ __forceinline__ void store_o_tile_pk(unsigned* dst, const f32x16& o, long long row0, int st, int col0  , int lane) {
    const int odd = lane & 1; long long wb = row0 * 256 + ((col0 + (lane & 31)) >> 1);
    asm volatile("" : "+v"(wb));
#pragma unroll
    for (int r2 = 0; r2 < 8; ++r2) { const float send = odd ? o[2 * r2] : o[2 * r2 + 1]; const float recv = __shfl_xor(send, 1);
        const unsigned w = odd ? pk2(recv, o[2 * r2 + 1]) : pk2(o[2 * r2], recv);
        const int r = 2 * r2 + odd; dst[wb + (long long)st * 256 * ((r & 3) + 8 * (r >> 2))] = w; }
}
constexpr int N_CH_UNITS = 1024;
struct UnitPre { u32x4 r[6]; float f[2]; };
__device__ __forceinline__ void unit_geom(int unit, int& d, int& h, bool& lat, int& c, int& L, int& rowbase) {
    d = unit & 1; h = (unit >> 1) & 3; const int slot = unit >> 3; lat = slot >= 64; const int b = lat ? (slot - 64) >> 4 : slot >> 2; c = lat ? (slot - 64) & 15 : slot & 3;
    L = lat ? 1024 : 256; rowbase = lat ? 4096 + b * 1024 : b * 256;
}
__device__ __forceinline__ void gla_unit_load(ptab_t pt, int unit, UnitPre& p) {
    const int tid = tid_opaque(); unsigned char* ws = PWS; const bf16_t* P = (const bf16_t*)(ws + WS_P); const float* LA = (const float*)(ws + WS_LA);
    int d, h, c, L, rowbase; bool lat; unit_geom(unit, d, h, lat, c, L, rowbase);
#pragma unroll
    for (int q = 0; q < 2; ++q) { const int idx = tid + 512 * q, i = idx >> 4, c4 = idx & 15; const int s = c * 64 + i, t = d ? L - 1 - s : s;
        p.r[q] = *(const u32x4*)(LA + (size_t)(rowbase + t) * 512 + d * 256 + h * 64 + c4 * 4); }
    { const int i = tid >> 3, k0 = (tid & 7) * 8, v0 = (tid & 7) * 16; const int s = c * 64 + i, t = d ? L - 1 - s : s; const bf16_t* Pr = P + (size_t)(rowbase + t) * PLD;
      p.r[2] = *(const u32x4*)(Pr + h * 64 + k0); p.r[3] = *(const u32x4*)(Pr + 256 + h * 64 + k0); p.r[4] = *(const u32x4*)(Pr + 512 + h * 128 + v0); p.r[5] = *(const u32x4*)(Pr + 512 + h * 128 + v0 + 8); }
    p.f[0] = 0.f; p.f[1] = 0.f;
}
__device__ __forceinline__ void dn_unit_load(ptab_t pt, int unit, UnitPre& p) {
    const int tid = tid_opaque(); unsigned char* ws = PWS; const bf16_t* DQKV = (const bf16_t*)(ws + WS_DQKV); const float* GB = (const float*)(ws + WS_GB);
    int d, h, c, L, rowbase; bool lat; unit_geom(unit, d, h, lat, c, L, rowbase);
    { const int i = tid >> 3, c16 = (tid & 7) * 16; const int s = c * 64 + i, t = d ? L - 1 - s : s; const bf16_t* pr = DQKV + (size_t)(rowbase + t) * 1536 + h * 128 + c16;
      p.r[0] = *(const u32x4*)(pr); p.r[1] = *(const u32x4*)(pr + 8); p.r[2] = *(const u32x4*)(pr + 512); p.r[3] = *(const u32x4*)(pr + 520); p.r[4] = *(const u32x4*)(pr + 1024); p.r[5] = *(const u32x4*)(pr + 1032); }
    { const int i = tid & 63; const int s = c * 64 + i, t = d ? L - 1 - s : s; const float* gp = GB + (size_t)(rowbase + t) * 16 + d * 4 + h; p.f[0] = gp[0]; p.f[1] = gp[8]; }
}
__device__ __forceinline__ void gla_chunk_unit(ptab_t pt, int unit, LAS unsigned char* lds, const UnitPre& pre) {
    const int tid = tid_opaque(), lane = tid & 63, wave = tid >> 6;
    unsigned char* ws = PWS;
    const bf16_t* P = (const bf16_t*)(ws + WS_P); const float* LA = (const float*)(ws + WS_LA);
    bf16_t* GQ = (bf16_t*)(ws + WS_GQ) + (size_t)unit * 4096; unsigned* GO = (unsigned*)(ws + WS_GO) + (size_t)unit * 4096; unsigned* GU = (unsigned*)(ws + WS_GU) + (size_t)unit * 4096; float* GD = (float*)(ws + WS_GD) + (size_t)unit * 64;
    const int d = unit & 1, h = (unit >> 1) & 3, slot = unit >> 3;
    const bool lat = slot >= 64; const int b = lat ? (slot - 64) >> 4 : slot >> 2, c = lat ? (slot - 64) & 15 : slot & 3;
    const int L = lat ? 1024 : 256, rowbase = lat ? 4096 + b * 1024 : b * 256;
    LAS float* Bs = (LAS float*)lds;
    LAS bf16_t* Qt = (LAS bf16_t*)(lds + 16640);
    LAS bf16_t* Kt = Qt + 64 * 72;
    LAS bf16_t* KhT = Kt + 64 * 72;
    LAS bf16_t* VT = KhT + 64 * 72;
    LAS bf16_t* Am = VT + 128 * 72;
#pragma unroll
    for (int q = 0; q < 2; ++q) { const int idx = tid + 512 * q, i = idx >> 4, c4 = idx & 15; const u32x4 v = pre.r[q];
        Bs[i * 65 + c4 * 4] = __uint_as_float(v.x); Bs[i * 65 + c4 * 4 + 1] = __uint_as_float(v.y); Bs[i * 65 + c4 * 4 + 2] = __uint_as_float(v.z); Bs[i * 65 + c4 * 4 + 3] = __uint_as_float(v.w); }
    LDS_BARRIER();
    {
        const int k = tid & 63, s = tid >> 6; LAS float* tot = (LAS float*)(lds + 16640);
        float v[8]; float a = 0.f;
#pragma unroll
        for (int i = 0; i < 8; ++i) { a += Bs[(s * 8 + i) * 65 + k]; v[i] = a; }
        tot[s * 64 + k] = a;
        LDS_BARRIER();
        float off = 0.f;
#pragma unroll
        for (int q = 0; q < 7; ++q) off += (q < s) ? tot[q * 64 + k] : 0.f;
#pragma unroll
        for (int i = 0; i < 8; ++i) Bs[(s * 8 + i) * 65 + k] = v[i] + off;
    }
    LDS_BARRIER();
    { const int i = tid >> 3, k0 = (tid & 7) * 8;
      const u32x4 qw = pre.r[2], kw = pre.r[3];
#pragma unroll
      for (int e = 0; e < 8; ++e) { const float bb = Bs[i * 65 + k0 + e], bl = Bs[63 * 65 + k0 + e];
          const float qv = (e & 1) ? bfhi(qw[e >> 1]) : bflo(qw[e >> 1]), kv = (e & 1) ? bfhi(kw[e >> 1]) : bflo(kw[e >> 1]);
          Qt[i * 72 + k0 + e] = f2bf(qv * 0.125f * __expf(bb)); Kt[i * 72 + k0 + e] = f2bf(kv * __expf(-bb)); KhT[(k0 + e) * 72 + i] = f2bf(kv * __expf(bl - bb)); }
      const int v0 = (tid & 7) * 16;
      const u32x4 va = pre.r[4], vb = pre.r[5];
#pragma unroll
      for (int e = 0; e < 8; ++e) { VT[(v0 + e) * 72 + i] = (bf16_t)((e & 1) ? (va[e >> 1] >> 16) : (va[e >> 1] & 0xffffu)); VT[(v0 + 8 + e) * 72 + i] = (bf16_t)((e & 1) ? (vb[e >> 1] >> 16) : (vb[e >> 1] & 0xffffu)); }
      if (tid < 64) GD[tid] = __expf(Bs[63 * 65 + tid]); }
    LDS_BARRIER();
    { f32x16 acc = {}; acc = mm_tile<64>(KhT, 72, VT, 72, wave >> 2, wave & 3, lane, acc); acc_store_pk(GU + wave * 512, acc, lane); }
    if (wave < 4) { f32x16 acc = {}; const int tm = wave >> 1, tn = wave & 1; acc = mm_tile<64>(Qt, 72, Kt, 72, tm, tn, lane, acc);
        const int r32 = lane & 31, hi = lane >> 5;
#pragma unroll
        for (int r = 0; r < 16; ++r) { const int i = tm * 32 + crow(r, hi), j = tn * 32 + r32; Am[i * 72 + j] = f2bf(j <= i ? acc[r] : 0.f); } }
    { const int i = tid >> 3, k0 = (tid & 7) * 8; *(u32x4*)(GQ + i * 64 + k0) = *(const LAS u32x4*)(Qt + i * 72 + k0); }
    LDS_BARRIER();
    { f32x16 acc = {}; acc = mm_tile<64>(Am, 72, VT, 72, wave >> 2, wave & 3, lane, acc); acc_store_pk(GO + wave * 512, acc, lane); }
    LDS_BARRIER();
}
__device__ __forceinline__ void gla_scan_item(ptab_t pt, int l, bool lat, int b, int h, int d, LAS unsigned char* lds) {
    const int tid = tid_opaque(), lane = tid & 63, wave = tid >> 6, r32 = lane & 31, hi = lane >> 5;
    unsigned char* ws = PWS;
    float* OG = (float*)(ws + WS_OG);
    const int L = lat ? 1024 : 256, rowbase = lat ? 4096 + b * 1024 : b * 256, nch = L >> 6, slot0 = lat ? 64 + b * 16 : b * 4;
    const int tm = wave >> 2, tn = wave & 3;
    LAS bf16_t* ST = (LAS bf16_t*)lds;
    f32x16 S;
    const size_t sbase = ((((size_t)b * 2 + l) * 2 + d) * 4 + h) * 8192;
#pragma unroll
    for (int r = 0; r < 16; ++r) S[r] = lat ? PIN(4)[sbase + (size_t)(tm * 32 + crow(r, hi)) * 128 + tn * 32 + r32] : 0.f;
    unsigned ow[8], uw[8], now[8], nuw[8]; float dec[16], ndec[16]; bf16x8 qa[4], nqa[4];
#define GLA_SLOAD(OW, UW, DEC, QA, cc) do { const int unit_ = ((slot0 + (cc)) * 4 + h) * 2 + d; \
        acc_load_pk((const unsigned*)(ws + WS_GO) + (size_t)unit_ * 4096 + wave * 512, OW, lane); acc_load_pk((const unsigned*)(ws + WS_GU) + (size_t)unit_ * 4096 + wave * 512, UW, lane); \
        const float* gd_ = (const float*)(ws + WS_GD) + (size_t)unit_ * 64; _Pragma("unroll") for (int r_ = 0; r_ < 16; ++r_) DEC[r_] = gd_[tm * 32 + crow(r_, hi)]; \
        const bf16_t* gq_ = (const bf16_t*)(ws + WS_GQ) + (size_t)unit_ * 4096 + (size_t)(tm * 32 + r32) * 64 + hi * 8; _Pragma("unroll") for (int k_ = 0; k_ < 4; ++k_) QA[k_] = *(const bf16x8*)(gq_ + 16 * k_); } while (0)
    GLA_SLOAD(ow, uw, dec, qa, 0);
    GLA_SLOAD(now, nuw, ndec, nqa, 1);
#define GLA_STEP(c, OW, UW, DEC, QA) do { \
        acc_to_ST(ST, 72, tm * 32, tn * 32, S, lane); \
        LDS_BARRIER(); \
        f32x16 o; \
        _Pragma("unroll") for (int r2 = 0; r2 < 8; ++r2) { o[2 * r2] = bflo(OW[r2]); o[2 * r2 + 1] = bfhi(OW[r2]); } \
        { const LAS bf16_t* bp = ST + (tn * 32 + r32) * 72 + hi * 8; \
          _Pragma("unroll") for (int k = 0; k < 4; ++k) { const bf16x8 bb = *(const LAS bf16x8*)(bp + 16 * k); o = __builtin_amdgcn_mfma_f32_32x32x16_bf16(QA[k], bb, o, 0, 0, 0); } } \
        { const int s0_ = (c) * 64 + tm * 32 + 4 * hi; store_o_tile_pk((unsigned*)OG, o, (long long)((size_t)d * NTOK + rowbase + (d ? L - 1 - s0_ : s0_)), d ? -1 : 1, h * 128 + tn * 32, lane); } \
        _Pragma("unroll") for (int r2 = 0; r2 < 8; ++r2) { S[2 * r2] = DEC[2 * r2] * S[2 * r2] + bflo(UW[r2]); S[2 * r2 + 1] = DEC[2 * r2 + 1] * S[2 * r2 + 1] + bfhi(UW[r2]); } \
        { const int cn_ = (c) + 2 < nch ? (c) + 2 : nch - 1; GLA_SLOAD(OW, UW, DEC, QA, cn_); } \
        LDS_BARRIER(); } while (0)
    for (int c = 0; c < nch; c += 2) {
        GLA_STEP(c, ow, uw, dec, qa);
        GLA_STEP(c + 1, now, nuw, ndec, nqa);
    }
#undef GLA_STEP
#undef GLA_SLOAD
    if (!lat) {
#pragma unroll
        for (int r = 0; r < 16; ++r) POUT[OUT_SG + sbase + (size_t)(tm * 32 + crow(r, hi)) * 128 + tn * 32 + r32] = S[r]; }
}
template <int BLK>
__device__ __forceinline__ void solve_diag(float (&x)[64], const LAS float* Af) {
    f32x4 an[4];
    an[0] = *(const LAS f32x4*)(Af + (16 * BLK + 1) * 68 + 16 * BLK);
#pragma unroll
    for (int ii = 1; ii < 16; ++ii) { const int i = 16 * BLK + ii; f32x4 ac[4];
#pragma unroll
        for (int j4 = 0; j4 < (ii + 3) / 4; ++j4) ac[j4] = an[j4];
        if (ii + 1 < 16) {
#pragma unroll
            for (int j4 = 0; j4 < (ii + 4) / 4; ++j4) an[j4] = *(const LAS f32x4*)(Af + (i + 1) * 68 + 16 * BLK + 4 * j4); }
        float s0 = 0.f, s1 = 0.f, s2 = 0.f, s3 = 0.f;
#pragma unroll
        for (int j4 = 0; j4 < (ii + 3) / 4; ++j4) { s0 += ac[j4].x * x[16 * BLK + 4 * j4]; s1 += ac[j4].y * x[16 * BLK + 4 * j4 + 1]; s2 += ac[j4].z * x[16 * BLK + 4 * j4 + 2]; s3 += ac[j4].w * x[16 * BLK + 4 * j4 + 3]; }
        x[i] -= (s0 + s1) + (s2 + s3); asm("" : "+v"(x[i])); }
}
template <int BLK>
__device__ __forceinline__ void solve_offdiag(const LAS bf16_t* Ab, const LAS bf16_t* UT, const LAS bf16_t* WT, LAS float* Rb, int wave, int lane) {
    f32x16 acc = {};
    acc = mm_tile<16 * BLK>(Ab, 72, wave < 4 ? UT : WT, 72, BLK >> 1, wave & 3, lane, acc);
    const int r32 = lane & 31, hi = lane >> 5;
#pragma unroll
    for (int r = 0; r < 16; ++r) { const int rr = crow(r, hi) - (BLK & 1) * 16; if (rr >= 0 && rr < 16) Rb[rr * 260 + wave * 32 + r32] = acc[r]; }
}
template <int BLK>
__device__ __forceinline__ void solve_step(float (&x)[64], const LAS float* Af, const LAS bf16_t* Ab, LAS bf16_t* UT, LAS bf16_t* WT, LAS float* Rb, int tid, int wave, int lane) {
    if (BLK > 0) { solve_offdiag<(BLK > 0 ? BLK : 1)>(Ab, UT, WT, Rb, wave, lane); LDS_BARRIER(); }
    if (tid < 256) {
        if (BLK > 0) {
#pragma unroll
            for (int ii = 0; ii < 16; ++ii) { x[16 * BLK + ii] -= Rb[ii * 260 + tid]; asm("" : "+v"(x[16 * BLK + ii])); } }
        solve_diag<BLK>(x, Af);
        LAS bf16_t* dst = (tid < 128 ? UT + tid * 72 : WT + (tid - 128) * 72) + 16 * BLK;
        u32x4 w0, w1; w0.x = pk2(x[16 * BLK], x[16 * BLK + 1]); w0.y = pk2(x[16 * BLK + 2], x[16 * BLK + 3]); w0.z = pk2(x[16 * BLK + 4], x[16 * BLK + 5]); w0.w = pk2(x[16 * BLK + 6], x[16 * BLK + 7]);
        w1.x = pk2(x[16 * BLK + 8], x[16 * BLK + 9]); w1.y = pk2(x[16 * BLK + 10], x[16 * BLK + 11]); w1.z = pk2(x[16 * BLK + 12], x[16 * BLK + 13]); w1.w = pk2(x[16 * BLK + 14], x[16 * BLK + 15]);
        *(LAS u32x4*)(dst) = w0; *(LAS u32x4*)(dst + 8) = w1; }
    if (BLK < 3) LDS_BARRIER();
}
#define SUBA_BEGIN() unsigned long long tsa_ = 0; if (PROBE_SUB >= 10 && PROBE_SUB <= 14 && blockIdx.x == 0) { LDS_BARRIER(); tsa_ = __builtin_amdgcn_s_memrealtime(); }
#define SUBA_END(k) do { if (PROBE_SUB == (k) && blockIdx.x == 0) { LDS_BARRIER(); if (threadIdx.x == 0) *(volatile LAS unsigned long long*)(lds + PTAB_OFF + 320) += __builtin_amdgcn_s_memrealtime() - tsa_; } } while (0)
#define SUBA_MARK() do { if (PROBE_SUB >= 10 && PROBE_SUB <= 14 && blockIdx.x == 0) { LDS_BARRIER(); tsa_ = __builtin_amdgcn_s_memrealtime(); } } while (0)
__device__ __forceinline__ void dn_chunk_unit(ptab_t pt, int unit, LAS unsigned char* lds, const UnitPre& pre) {
    SUBA_BEGIN(); unsigned long long tsa0_ = tsa_;
    const int tid = tid_opaque(), lane = tid & 63, wave = tid >> 6, r32 = lane & 31, hi = lane >> 5;
    unsigned char* ws = PWS;
    const bf16_t* DQKV = (const bf16_t*)(ws + WS_DQKV); const float* GB = (const float*)(ws + WS_GB);
    bf16_t* MC = (bf16_t*)(ws + WS_MC) + (size_t)unit * 16384; unsigned* NC = (unsigned*)(ws + WS_NC) + (size_t)unit * 8192;
    bf16_t* QE = (bf16_t*)(ws + WS_QE) + (size_t)unit * 8192; unsigned* OL = (unsigned*)(ws + WS_OL) + (size_t)unit * 4096;
    const int d = unit & 1, h = (unit >> 1) & 3, slot = unit >> 3;
    const bool lat = slot >= 64; const int b = lat ? (slot - 64) >> 4 : slot >> 2, c = lat ? (slot - 64) & 15 : slot & 3;
    const int L = lat ? 1024 : 256, rowbase = lat ? 4096 + b * 1024 : b * 256;
    LAS bf16_t* Qs = (LAS bf16_t*)lds;
    LAS bf16_t* Ks = Qs + 64 * 136;
    LAS bf16_t* Vs = Ks + 64 * 136;
    LAS float* Af = (LAS float*)(lds + 52224);
    LAS bf16_t* Att = (LAS bf16_t*)(lds + 69632);
    LAS bf16_t* KhT = (LAS bf16_t*)(lds + 78848);
    LAS bf16_t* WT = (LAS bf16_t*)(lds + 97280);
    LAS bf16_t* UT = (LAS bf16_t*)(lds + 115712);
    LAS float* Gs = (LAS float*)(lds + 134144);
    LAS float* Bt = Gs + 64;
    LAS bf16_t* Ab = (LAS bf16_t*)(lds + 134656);
    LAS float* Rb = (LAS float*)(lds + 34816);
    { const int i = tid >> 3, c16 = (tid & 7) * 16;
      const u32x4 q0 = pre.r[0], q1 = pre.r[1], k0 = pre.r[2], k1 = pre.r[3], v0 = pre.r[4], v1 = pre.r[5];
      *(LAS u32x4*)(Qs + i * 136 + c16) = q0; *(LAS u32x4*)(Qs + i * 136 + c16 + 8) = q1; *(LAS u32x4*)(Ks + i * 136 + c16) = k0; *(LAS u32x4*)(Ks + i * 136 + c16 + 8) = k1;
      *(LAS u32x4*)(Vs + i * 136 + c16) = v0; *(LAS u32x4*)(Vs + i * 136 + c16 + 8) = v1; }
    if (tid < 64) { float x = pre.f[0]; const float be = pre.f[1];
#pragma unroll
        for (int o = 1; o < 64; o <<= 1) { const float n = __shfl_up(x, o); if (lane >= o) x += n; }
        Gs[tid] = x; Bt[tid] = be; }
    LDS_BARRIER();
    { const int w4 = wave & 3, tm = w4 >> 1, tn = w4 & 1; f32x16 acc = {};
      acc = mm_tile<128>(wave < 4 ? Ks : Qs, 136, Ks, 136, tm, tn, lane, acc);
      const int j = tn * 32 + r32; const float Gj = Gs[j];
#pragma unroll
      for (int r = 0; r < 16; ++r) { const int i = tm * 32 + crow(r, hi); const float e = __expf(Gs[i] - Gj);
          if (wave < 4) { const float av = (j < i) ? Bt[i] * acc[r] * e : 0.f; Af[i * 68 + j] = av; Ab[i * 72 + j] = f2bf(av); } else Att[i * 72 + j] = f2bf((j <= i) ? acc[r] * e : 0.f); } }
    LDS_BARRIER();
    SUBA_END(11); SUBA_MARK();
    {
        float x[64];
        if (tid < 128) {
#pragma unroll
            for (int j = 0; j < 64; ++j) x[j] = bf2f(Vs[j * 136 + tid]) * Bt[j];
        } else if (tid < 256) {
#pragma unroll
            for (int j = 0; j < 64; ++j) x[j] = bf2f(Ks[j * 136 + tid - 128]) * Bt[j] * __expf(Gs[j]);
        } else {
#pragma unroll
            for (int j = 0; j < 64; ++j) x[j] = 0.f;
            const int t2 = tid - 256, i = t2 >> 2, a0 = (t2 & 3) * 32; const float f = __expf(Gs[63] - Gs[i]);
#pragma unroll 8
            for (int e = 0; e < 32; ++e) KhT[(a0 + e) * 72 + i] = f2bf(bf2f(Ks[i * 136 + a0 + e]) * f);
        }
#pragma unroll
        for (int j = 0; j < 64; ++j) asm("" : "+v"(x[j]));
        LDS_BARRIER();
        solve_step<0>(x, Af, Ab, UT, WT, Rb, tid, wave, lane);
        solve_step<1>(x, Af, Ab, UT, WT, Rb, tid, wave, lane);
        solve_step<2>(x, Af, Ab, UT, WT, Rb, tid, wave, lane);
        solve_step<3>(x, Af, Ab, UT, WT, Rb, tid, wave, lane);
    }
    LDS_BARRIER();
    SUBA_END(12); SUBA_MARK();
    { const int tn = wave & 3, tmo = wave >> 2; const float eGl = __expf(Gs[63]);
      { f32x16 acc = {}; acc = mm_tile<64>(Att, 72, UT, 72, tmo, tn, lane, acc); acc_store_pk(OL + wave * 512, acc, lane); }
      { f32x16 acc = {}; acc = mm_tile<64>(Att, 72, WT, 72, tmo, tn, lane, acc);
#pragma unroll
        for (int r = 0; r < 16; ++r) { const int i = tmo * 32 + crow(r, hi), a = tn * 32 + r32; QE[i * 128 + a] = f2bf(bf2f(Qs[i * 136 + a]) * __expf(Gs[i]) - acc[r]); } }
#pragma unroll
      for (int q = 0; q < 2; ++q) { const int tm = tmo + 2 * q;
        { f32x16 acc = {}; acc = mm_tile<64>(KhT, 72, UT, 72, tm, tn, lane, acc); acc_store_pk(NC + (tm * 4 + tn) * 512, acc, lane); }
        { f32x16 acc = {}; acc = mm_tile<64>(KhT, 72, WT, 72, tm, tn, lane, acc);
#pragma unroll
          for (int r = 0; r < 16; ++r) { const int a = tm * 32 + crow(r, hi), a2 = tn * 32 + r32; MC[a * 128 + a2] = f2bf((a == a2 ? eGl : 0.f) - acc[r]); } } } }
    LDS_BARRIER();
    SUBA_END(13); tsa_ = tsa0_; SUBA_END(10);
    if (PROBE_SUB == 14 && blockIdx.x == 0 && threadIdx.x == 0) *(volatile LAS unsigned long long*)(lds + PTAB_OFF + 320) += 1000;
}
__device__ __forceinline__ void dn_scan_item(ptab_t pt, int l, bool lat, int b, int h, int d, int vh, LAS unsigned char* lds) {
    const int tid = tid_opaque(), lane = tid & 63, wave = tid >> 6, r32 = lane & 31, hi = lane >> 5;
    unsigned char* ws = PWS;
    float* OD = (float*)(ws + WS_OD);
    const int L = lat ? 1024 : 256, rowbase = lat ? 4096 + b * 1024 : b * 256, nch = L >> 6, slot0 = lat ? 64 + b * 16 : b * 4;
    const int tm = wave & 3, tnl = wave >> 2, tn = vh * 2 + tnl;
    const bool ow_ = wave < 4; const int tmo = wave & 1, tnlo = (wave >> 1) & 1, tno = vh * 2 + tnlo;
    LAS bf16_t* ST = (LAS bf16_t*)lds;
    LAS bf16_t* AMb = (LAS bf16_t*)(lds + 34816);
    f32x16 S;
    const size_t sbase = ((((size_t)b * 2 + l) * 2 + d) * 4 + h) * 16384;
#pragma unroll
    for (int r = 0; r < 16; ++r) S[r] = lat ? PIN(5)[sbase + (size_t)(tm * 32 + crow(r, hi)) * 128 + tn * 32 + r32] : 0.f;
    u32x4 stg[6], stg2[6]; unsigned ow[8], n0[8], now[8], nn0[8];
#define DN_GLOAD(STG, cc) do { const int unit_ = ((slot0 + (cc)) * 4 + h) * 2 + d; const bf16_t* mc_ = (const bf16_t*)(ws + WS_MC) + (size_t)unit_ * 16384; const bf16_t* qe_ = (const bf16_t*)(ws + WS_QE) + (size_t)unit_ * 8192; \
        _Pragma("unroll") for (int j_ = 0; j_ < 4; ++j_) STG[j_] = *(const u32x4*)(mc_ + (size_t)(tid + 512 * j_) * 8); \
        _Pragma("unroll") for (int j_ = 0; j_ < 2; ++j_) STG[4 + j_] = *(const u32x4*)(qe_ + (size_t)(tid + 512 * j_) * 8); } while (0)
#define DN_TLOAD(OW, N0, cc) do { const int unit_ = ((slot0 + (cc)) * 4 + h) * 2 + d; \
        acc_load_pk((const unsigned*)(ws + WS_OL) + (size_t)unit_ * 4096 + (tmo * 4 + tno) * 512, OW, lane); acc_load_pk((const unsigned*)(ws + WS_NC) + (size_t)unit_ * 8192 + (tm * 4 + tn) * 512, N0, lane); } while (0)
#define DN_SWRITE(buf) do { LAS bf16_t* am_ = AMb + (buf) * 26112; LAS bf16_t* aq_ = am_ + 128 * 136; \
        _Pragma("unroll") for (int j_ = 0; j_ < 4; ++j_) { const int q_ = tid + 512 * j_; *(LAS u32x4*)(am_ + (q_ >> 4) * 136 + (q_ & 15) * 8) = stg[j_]; } \
        _Pragma("unroll") for (int j_ = 0; j_ < 2; ++j_) { const int q_ = tid + 512 * j_; *(LAS u32x4*)(aq_ + (q_ >> 4) * 136 + (q_ & 15) * 8) = stg[4 + j_]; } } while (0)
    DN_GLOAD(stg, 0); DN_SWRITE(0);
    DN_TLOAD(ow, n0, 0); DN_TLOAD(now, nn0, 1);
    DN_GLOAD(stg2, 1); DN_GLOAD(stg, (nch > 2 ? 2 : 1));
#define DN_STEP(c, OW, N0, STGN, STGNAME_IS_STG2) do { \
        acc_to_ST(ST, 136, tm * 32, tnl * 32, S, lane); \
        LDS_BARRIER(); \
        const LAS bf16_t* am = AMb + ((c) & 1) * 26112; const LAS bf16_t* aq = am + 128 * 136; \
        _Pragma("unroll") for (int r2 = 0; r2 < 8; ++r2) { S[2 * r2] = bflo(N0[r2]); S[2 * r2 + 1] = bfhi(N0[r2]); } \
        f32x16 o; \
        if (ow_) { _Pragma("unroll") for (int r2 = 0; r2 < 8; ++r2) { o[2 * r2] = bflo(OW[r2]); o[2 * r2 + 1] = bfhi(OW[r2]); } } \
        { const int cn_ = (c) + 2 < nch ? (c) + 2 : nch - 1; DN_TLOAD(OW, N0, cn_); }     \
        if (ow_) { o = mm_tile<128>(aq, 136, ST, 136, tmo, tnlo, lane, o); \
            const int s0_ = (c) * 64 + tmo * 32 + 4 * hi; store_o_tile_pk((unsigned*)OD, o, (long long)((size_t)d * NTOK + rowbase + (d ? L - 1 - s0_ : s0_)), d ? -1 : 1, h * 128 + tno * 32, lane); } \
        S = mm_tile<128>(am, 136, ST, 136, tm, tnl, lane, S); \
        { LAS bf16_t* am_ = AMb + (((c) + 1) & 1) * 26112; LAS bf16_t* aq_ = am_ + 128 * 136;     \
          _Pragma("unroll") for (int j_ = 0; j_ < 4; ++j_) { const int q_ = tid + 512 * j_; *(LAS u32x4*)(am_ + (q_ >> 4) * 136 + (q_ & 15) * 8) = STGN[j_]; } \
          _Pragma("unroll") for (int j_ = 0; j_ < 2; ++j_) { const int q_ = tid + 512 * j_; *(LAS u32x4*)(aq_ + (q_ >> 4) * 136 + (q_ & 15) * 8) = STGN[4 + j_]; } } \
        { const int cn_ = (c) + 3 < nch ? (c) + 3 : nch - 1; DN_GLOAD(STGN, cn_); }     \
        LDS_BARRIER(); } while (0)
    for (int c = 0; c < nch; c += 2) {
        DN_STEP(c, ow, n0, stg2, 1);
        DN_STEP(c + 1, now, nn0, stg, 0);
    }
#undef DN_STEP
#undef DN_GLOAD
#undef DN_TLOAD
#undef DN_SWRITE
    if (!lat) {
#pragma unroll
        for (int r = 0; r < 16; ++r) POUT[OUT_SD + sbase + (size_t)(tm * 32 + crow(r, hi)) * 128 + tn * 32 + r32] = S[r]; }
}
__device__ __forceinline__ void mixer1_phase(ptab_t pt, int l, unsigned char* lds_generic, int bid, int nb, int rep) {
    LAS unsigned char* l3 = (LAS unsigned char*)lds_generic;
    LAS int* qslot = (LAS int*)(l3 + PTAB_OFF + 272);
    unsigned* qctr = (unsigned*)(PWS + WS_QUEUE) + (l * 4 + rep) * 64;
    constexpr int N_ITEMS = 2048;
    int it = bid, itn = bid + nb;
    UnitPre pc, pn;
    if (it < N_ITEMS) { if (it < 1024) dn_unit_load(pt, it, pc); else gla_unit_load(pt, it - 1024, pc); }
    while (it < N_ITEMS) {
        int nxt2 = 0;
        if (threadIdx.x == 0) nxt2 = 2 * nb + (int)atomicAdd(qctr, 1u);
        if (itn < N_ITEMS) { if (itn < 1024) dn_unit_load(pt, itn, pn); else gla_unit_load(pt, itn - 1024, pn); }
        if (it < 1024) { for (int q_ = 0; q_ < (PROBE_DUP == 8 ? 2 : 1); ++q_) dn_chunk_unit(pt, it, l3, pc); }
        else { for (int q_ = 0; q_ < (PROBE_DUP == 9 ? 2 : 1); ++q_) gla_chunk_unit(pt, it - 1024, l3, pc); }
        LDS_BARRIER();
        if (threadIdx.x == 0) *qslot = nxt2;
        LDS_BARRIER();
        it = itn; itn = *qslot;
#pragma unroll
        for (int q = 0; q < 6; ++q) pc.r[q] = pn.r[q];
        pc.f[0] = pn.f[0]; pc.f[1] = pn.f[1];
    }
}
__device__ __forceinline__ void mixer2_phase(ptab_t pt, int l, unsigned char* lds_generic, int bid, int nb, int rep) {
    LAS unsigned char* l3 = (LAS unsigned char*)lds_generic;
    LAS int* qslot = (LAS int*)(l3 + PTAB_OFF + 272);
    unsigned* qctr = (unsigned*)(PWS + WS_QUEUE) + (l * 4 + 2 + rep) * 64;
    const int n_tr = (l == 0 && rep == 0) ? (TI_OUT + TI_F1) / 8 : 0;
    const int N_ITEMS = 736 + n_tr;
    int it = bid;
    while (it < N_ITEMS) {
        int nxt = 0;
        if (threadIdx.x == 0) nxt = nb + (int)atomicAdd(qctr, 1u);
        if (it < 128 || (it >= 224 && it < 352)) {
            unsigned char* ws = PWS;
            const bf16_t* QN = (const bf16_t*)(ws + WS_QN); const bf16_t* KB = (const bf16_t*)(ws + WS_KB); const bf16_t* VB = (const bf16_t*)(ws + WS_VB); bf16_t* MIX = (bf16_t*)(ws + WS_MIX);
            const bool lat = it < 128; const int i = lat ? it : it - 224;
            const int b = lat ? i >> 5 : i >> 3, h = lat ? (i >> 2) & 7 : i & 7, qb = lat ? i & 3 : 0;
            const size_t row0 = lat ? 4096 + (size_t)b * 1024 + qb * 256 : (size_t)b * 256;
            const size_t krow0 = lat ? (size_t)4096 + (size_t)b * 1280 : (size_t)b * 256;
            att::attn_dense_body<1024, 256, 2048>(QN + row0 * 1024 + h * 128, KB + krow0 * 256 + (h >> 2) * 128, VB + krow0 * 256 + (h >> 2) * 128, MIX + row0 * 2048 + 512 + h * 128, lat ? 1280 : 256, (char*)lds_generic);
        } else if (it < 192 || (it >= 352 && it < 608)) { const bool lat = it < 192; const int j = lat ? it - 128 : it - 352; const int vh = j & 1, q = j >> 1;
            dn_scan_item(pt, l, lat, q >> 3, (q >> 1) & 3, q & 1, vh, l3);
        } else if (it < 736) { const bool lat = it < 224; const int q = lat ? it - 192 : it - 608;
            gla_scan_item(pt, l, lat, q >> 3, (q >> 1) & 3, q & 1, l3);
        } else { const int wv = __builtin_amdgcn_readfirstlane((int)threadIdx.x >> 6);
            do_transposes(pt, l3, TI_L + TI_IN + (it - 736) * 8, 8, wv, 8);
        }
        LDS_BARRIER();
        if (threadIdx.x == 0) *qslot = nxt;
        LDS_BARRIER();
        it = *qslot;
    }
}

__device__ __forceinline__ void postmix_phase(ptab_t pt, int l, int bid, int nb) {
    const int tid = tid_opaque(), lane = tid & 63, wave = tid >> 6, sub = lane & 15;
    unsigned char* ws = PWS;
    const bf16_t* P = (const bf16_t*)(ws + WS_P); const unsigned* OG = (const unsigned*)(ws + WS_OG); const unsigned* OD = (const unsigned*)(ws + WS_OD); bf16_t* MIX = (bf16_t*)(ws + WS_MIX);
    const float* ggp = PIN(15) + l * 128 + sub * 8; const float* dgp = PIN(21) + l * 128 + sub * 8;
    constexpr int NT = 4;
#pragma unroll 1
    for (int r0 = bid * 8 + wave; r0 < NTOK / NT; r0 += nb * 8) {
#pragma unroll
        for (int part = 0; part < 2; ++part) {
            const unsigned* O = part ? OD : OG; const int gc = part ? 4608 : 1024, mc = part ? 1536 : 0;
            u32x4 p[NT], q[NT], z[NT];
#pragma unroll
            for (int u = 0; u < NT; ++u) { const size_t r = (size_t)(r0 + u * (NTOK / NT));
                p[u] = __builtin_nontemporal_load((const u32x4*)(O + r * 256 + lane * 4)); q[u] = __builtin_nontemporal_load((const u32x4*)(O + ((size_t)NTOK + r) * 256 + lane * 4)); z[u] = *(const u32x4*)(P + r * PLD + gc + lane * 8); }
            float a[NT][8], ss[NT];
#pragma unroll
            for (int u = 0; u < NT; ++u) { float x[8], y[8]; unpack8(p[u], x); unpack8(q[u], y); float s = 0.f;
#pragma unroll
                for (int e = 0; e < 8; ++e) { a[u][e] = x[e] + y[e]; s += a[u][e] * a[u][e]; }
                ss[u] = s; }
            group16_sum_n<NT>(ss);
            float gn[8]; { const float* gp = part ? dgp : ggp; const f32x4 g0 = *(const f32x4*)gp, g1 = *(const f32x4*)(gp + 4);
#pragma unroll
                for (int e = 0; e < 4; ++e) { gn[e] = g0[e]; gn[4 + e] = g1[e]; } }
#pragma unroll
            for (int u = 0; u < NT; ++u) { const size_t r = (size_t)(r0 + u * (NTOK / NT)); const float rstd = rsqrtf(ss[u] * (1.f / 128.f) + EPS); float zz[8], o[8]; unpack8(z[u], zz);
#pragma unroll
                for (int e = 0; e < 8; ++e) o[e] = a[u][e] * rstd * gn[e] * silu_f(zz[e]);
                *(u32x4*)(MIX + r * 2048 + mc + lane * 8) = pack8(o); }
        }
    }
}

#define RLX_AGENT __ATOMIC_RELAXED, __HIP_MEMORY_SCOPE_AGENT
#define XB_TMO      128
#define XB_XCNT(j)  (256  + 64 * (j))
#define XB_XSUB(j)  (1280 + 64 * (j))
#define XB_XGEN(j)  (2304 + 64 * (j))
#define XB_TOP      3328
#define XB_TOPGEN   3392
#define XCD_BAR_WORDS 3456
#define XB_SPIN_CAP (1u << 18)

__device__ __forceinline__ unsigned xb_ld(unsigned* p)              { return __hip_atomic_load(p, __ATOMIC_RELAXED, __HIP_MEMORY_SCOPE_AGENT); }
__device__ __forceinline__ unsigned xb_add(unsigned* p, unsigned v) { return __hip_atomic_fetch_add(p, v, __ATOMIC_RELAXED, __HIP_MEMORY_SCOPE_AGENT); }
__device__ __forceinline__ unsigned xb_xcc_id() { return (unsigned)__builtin_amdgcn_s_getreg((3 << 11) | 20) & 0xFu; }
#define XB_SPIN(cond, bar) do { unsigned _sp = 0; while (cond) { __builtin_amdgcn_s_sleep(1); \
    if ((++_sp & 255u) == 0u) { if (xb_ld(&(bar)[XB_TMO])) break; if (_sp > XB_SPIN_CAP) { atomicAdd(&(bar)[XB_TMO], 1u); break; } } } } while (0)

struct XcdBarrier {
    unsigned* bar; unsigned x;
    volatile LAS unsigned* st;
};

__device__ __forceinline__ XcdBarrier xcd_barrier_post(unsigned* bar, volatile LAS unsigned* st) {
    XcdBarrier b; b.bar = bar; b.x = xb_xcc_id(); b.st = st;
    if (threadIdx.x == 0) (void)xb_add(&bar[XB_XCNT(b.x)], 1u);
    return b;
}
__device__ __forceinline__ void xcd_barrier_complete(unsigned* bar, unsigned x, unsigned& nloc, unsigned& nx) {
    const unsigned G = gridDim.x * gridDim.y * gridDim.z;
    unsigned sum, cnt, mine, sp = 0u;
    for (;;) {
        sum = 0u; cnt = 0u; mine = 0u;
#pragma unroll
        for (unsigned j = 0; j < 16; ++j) { const unsigned c = xb_ld(&bar[XB_XCNT(j)]); sum += c; cnt += (c > 0u) ? 1u : 0u; mine = (j == x) ? c : mine; }
        if (sum == G) break;
        __builtin_amdgcn_s_sleep(1);
        if ((++sp & 255u) == 0u) { if (xb_ld(&bar[XB_TMO])) break; if (sp > XB_SPIN_CAP) { atomicAdd(&bar[XB_TMO], 1u); break; } }
    }
    nloc = mine > 0u ? mine : 1u; nx = cnt > 0u ? cnt : 1u;
}

__device__ __forceinline__ void xcd_barrier(const XcdBarrier& b) {
    asm volatile("s_waitcnt vmcnt(0)" ::: "memory");
    __syncthreads();
    if (threadIdx.x == 0) {
        unsigned* bar = b.bar;
        __builtin_amdgcn_s_waitcnt(0);
        unsigned nloc = b.st[0], nx = b.st[1];
        if (nloc == 0u) { xcd_barrier_complete(bar, b.x, nloc, nx); b.st[0] = nloc; b.st[1] = nx; }
        const unsigned old = xb_add(&bar[XB_XSUB(b.x)], 1u);
        const unsigned gen = old / nloc;
        if (old + 1u == (gen + 1u) * nloc) {
            __builtin_amdgcn_fence(__ATOMIC_RELEASE, "agent");
            asm volatile("s_waitcnt vmcnt(0)" ::: "memory");
            const unsigned og = xb_add(&bar[XB_TOP], 1u);
            const unsigned tg = og / nx;
            if (og + 1u == (tg + 1u) * nx) xb_add(&bar[XB_TOPGEN], 1u);
            else XB_SPIN(xb_ld(&bar[XB_TOPGEN]) == tg, bar);
            __builtin_amdgcn_fence(__ATOMIC_ACQUIRE, "agent");
            xb_add(&bar[XB_XGEN(b.x)], 1u);
            asm volatile("s_waitcnt vmcnt(0)" ::: "memory");
        } else {
            XB_SPIN(xb_ld(&bar[XB_XGEN(b.x)]) == gen, bar);
            __builtin_amdgcn_fence(__ATOMIC_ACQUIRE, "agent");
            asm volatile("s_waitcnt vmcnt(0)" ::: "memory");
        }
    }
    __syncthreads();
}

__global__ void __launch_bounds__(512, 2) mega(Params p) {
    extern __shared__ __attribute__((aligned(16))) unsigned char lds[];
    cg::grid_group grid = cg::this_grid();
    const int bid = blockIdx.x, nb = gridDim.x;
    LAS unsigned char* l3 = (LAS unsigned char*)lds;
    ptab_t pt = (ptab_t)(l3 + PTAB_OFF);
    if (threadIdx.x < 27) { const int i = threadIdx.x; const void* v = i < 25 ? (const void*)p.in[i] : (i == 25 ? (const void*)p.out : (const void*)p.ws);
        ((LAS unsigned long long*)(l3 + PTAB_OFF))[i] = (unsigned long long)v; }
    if (threadIdx.x < 2) ((LAS unsigned*)(l3 + PTAB_OFF + 256))[threadIdx.x] = 0u;
    if (PROBE_SUB != 0 && threadIdx.x == 0) *(volatile LAS unsigned long long*)(l3 + PTAB_OFF + 320) = 0;
    __syncthreads();
    { unsigned* ctl = (unsigned*)PWS; for (int i = bid * 512 + (int)threadIdx.x; i < 40960; i += nb * 512) ctl[i] = 0u; }
#define TSTAMP() do { if (PROBE_MASK != 0u && blockIdx.x == 0 && threadIdx.x == 0) { volatile LAS unsigned long long* ts_ = (volatile LAS unsigned long long*)(l3 + PTAB_OFF + 288); \
        const unsigned long long now_ = __builtin_amdgcn_s_memrealtime(); const unsigned s_ = (unsigned)ts_[2]; if ((PROBE_MASK >> s_) & 1u) ts_[1] += now_ - ts_[0]; ts_[0] = now_; ts_[2] = s_ + 1; } } while (0)
#define GSYNC() do { xcd_barrier(xbar); TSTAMP(); } while (0)
    if (PROBE_MASK != 0u && blockIdx.x == 0 && threadIdx.x == 0) { volatile LAS unsigned long long* ts_ = (volatile LAS unsigned long long*)(l3 + PTAB_OFF + 288); ts_[0] = __builtin_amdgcn_s_memrealtime(); ts_[1] = 0; ts_[2] = 0; }
    p0_prologue(pt, l3, bid, nb, true);
    asm volatile("s_waitcnt vmcnt(0)" ::: "memory"); __syncthreads();
    grid.sync();
    XcdBarrier xbar = xcd_barrier_post((unsigned*)PWS + 1024, (volatile LAS unsigned*)(l3 + PTAB_OFF + 256));
    TSTAMP();
    if (PROBE_DUP == 3) { p0_prologue(pt, l3, bid, nb, false); }
    if (PROBE_DUP == 5) { for (int i = 0; i < 20; ++i) GSYNC(); }
#define REP(code) for (int rep_ = 0; rep_ < ((PROBE_DUP == (code)) ? 2 : 1); ++rep_)
#pragma unroll 1
    for (int l = 0; l < 2; ++l) {
        if (l == 0) { REP(4) { unsigned char* ws = PWS; const float* mods_l = (const float*)(ws + WS_MODS);
          norm_phase(PIN(0), PIN(1) - (size_t)4096 * DM, PIN(8), mods_l, 0, 1, (bf16_t*)(ws + WS_H), bid, nb);
          if (rep_ == 0) bias_phase(mods_l + 3 * DM, (const bf16_t*)(ws + WS_WFF1), FFD, (float*)(ws + WS_BIAS), l3, bid, nb);
          GSYNC(); } }
        REP(2) { unsigned char* ws = PWS; pg8::Gemm g{(const bf16_t*)(ws + WS_H), (const bf16_t*)(ws + WS_WIN) + (size_t)l * PNW * 2048, NTOK, PNW, 2048}; pg8::StaticOrder S; S.init(NTOK, PNW, nb, bid, WGM_IN);
          pg8::EpiP E{(bf16_t*)(ws + WS_P), (float*)(ws + WS_G), l == 0 ? (const float*)nullptr : (const float*)(ws + WS_RS) + 8192, (const float*)(ws + WS_BIAS) + 5 * 8192};
          pg8::gemm_phase<pg8::EpiP, pg8::StaticOrder, true, true>(l3, g, S, E);
          if (rep_ == 0 && bid + 2 * nb >= 672) { const int nidle = nb - (672 - 2 * nb); const int wv = __builtin_amdgcn_readfirstlane((int)threadIdx.x >> 6);
              __syncthreads();
              if (l == 0) do_transposes(pt, l3, TI_L, TI_IN, (bid - (672 - 2 * nb)) * 8 + wv, nidle * 8);
              else do_transposes(pt, l3, TI_L + TI_IN + TI_OUT + TI_F1 + TI_F2 / 3, TI_F2 - TI_F2 / 3, (bid - (672 - 2 * nb)) * 8 + wv, nidle * 8); }
          GSYNC(); }
        REP(4) { prep_phase(pt, l, l3, bid, nb);
          if (l == 0 && rep_ == 0) { unsigned char* ws = PWS; __syncthreads();
              bias_phase((const float*)(ws + WS_MODS) + (size_t)5 * NMOD, (const bf16_t*)(ws + WS_WIN) + (size_t)PNW * 2048, PNW, (float*)(ws + WS_BIAS) + 5 * 8192, l3, bid, nb); }
          GSYNC(); }
        REP(6) { mixer1_phase(pt, l, lds, bid, nb, rep_);
          GSYNC(); }
        REP(7) { mixer2_phase(pt, l, lds, bid, nb, rep_);
          GSYNC(); }
        REP(4) { postmix_phase(pt, l, bid, nb);
          if (l == 0 && rep_ == 0) { unsigned char* ws = PWS;
              bias_phase((const float*)(ws + WS_MODS) + (size_t)5 * NMOD + 3 * DM, (const bf16_t*)(ws + WS_WFF1) + (size_t)FFD * 2048, FFD, (float*)(ws + WS_BIAS) + 10 * 8192, l3, bid, nb); }
          GSYNC(); }
        REP(2) { unsigned char* ws = PWS; const float* mods_l = (const float*)(ws + WS_MODS) + (size_t)l * 5 * NMOD;
          const void* xin0 = l == 0 ? (const void*)PIN(0) : (const void*)(ws + WS_XB); const void* xin1 = l == 0 ? (const void*)(PIN(1) - (size_t)4096 * DM) : (const void*)(ws + WS_XB);
          pg8::Gemm g{(const bf16_t*)(ws + WS_MIX), (const bf16_t*)(ws + WS_WOUT) + (size_t)l * 2048 * 2048, NTOK, 2048, 2048}; pg8::StaticOrder S; S.init(NTOK, 2048, nb, bid, WGM_OUT);
          pg8::EpiRes E{xin0, xin1, (void*)(ws + WS_XA), mods_l + 2 * DM, rep_ == 0 ? (bf16_t*)(ws + WS_H) : (bf16_t*)nullptr, PIN(9) + l * DM, mods_l + 4 * DM, (float*)(ws + WS_RS) + (l == 0 ? 0 : 2 * 8192), l == 0 ? 0 : 1, 1};
          pg8::gemm_phase<pg8::EpiRes, pg8::StaticOrder, true, true>(l3, g, S, E);
          GSYNC(); }
        REP(2) { unsigned char* ws = PWS; pg8::Gemm g{(const bf16_t*)(ws + WS_H), (const bf16_t*)(ws + WS_WFF1) + (size_t)l * 8192 * 2048, NTOK, FFD, 2048}; pg8::StaticOrder S; S.init(NTOK, FFD, nb, bid, WGM_F1);
          pg8::EpiSqRelu E{(bf16_t*)(ws + WS_H2), FFD, (const float*)(ws + WS_RS) + (l == 0 ? 0 : 2 * 8192), (const float*)(ws + WS_BIAS) + (l == 0 ? 0 : 10 * 8192)};
          pg8::gemm_phase<pg8::EpiSqRelu, pg8::StaticOrder, true, true>(l3, g, S, E);
          GSYNC(); }
        REP(2) { unsigned char* ws = PWS; const float* mods_l = (const float*)(ws + WS_MODS) + (size_t)l * 5 * NMOD; const float* XA = (const float*)(ws + WS_XA);
          pg8::Gemm g{(const bf16_t*)(ws + WS_H2), (const bf16_t*)(ws + WS_WFF2) + (size_t)l * 2048 * 8192, NTOK, 2048, FFD}; pg8::StaticOrder S; S.init(NTOK, 2048, nb, bid, WGM_F2);
          pg8::EpiRes E{(const void*)XA, (const void*)XA, l == 0 ? (void*)(ws + WS_XB) : (void*)(POUT + OUT_Y), mods_l + 5 * DM, (l == 0 && rep_ == 0) ? (bf16_t*)(ws + WS_H) : (bf16_t*)nullptr, PIN(8) + DM, mods_l + 5 * NMOD + 1 * DM, (float*)(ws + WS_RS) + 8192, 1, l == 0 ? 1 : 0};
          pg8::gemm_phase<pg8::EpiRes, pg8::StaticOrder, true, true>(l3, g, S, E);
          if (l == 0 || rep_ + 1 < ((PROBE_DUP == 2) ? 2 : 1)) GSYNC(); }
    }
    if (PROBE_SUB != 0) { __syncthreads(); if (blockIdx.x == 0 && threadIdx.x == 0) { const unsigned long long t0_ = __builtin_amdgcn_s_memrealtime(), w_ = *(volatile LAS unsigned long long*)(l3 + PTAB_OFF + 320);
            while (__builtin_amdgcn_s_memrealtime() - t0_ < w_) __builtin_amdgcn_s_sleep(8); } }
    if (PROBE_MASK != 0u) { __syncthreads(); TSTAMP();
        if (blockIdx.x == 0 && threadIdx.x == 0) { volatile LAS unsigned long long* ts_ = (volatile LAS unsigned long long*)(l3 + PTAB_OFF + 288); const unsigned long long t0_ = __builtin_amdgcn_s_memrealtime(), w_ = ts_[1];
            while (__builtin_amdgcn_s_memrealtime() - t0_ < w_) __builtin_amdgcn_s_sleep(8); } }
}

extern "C" void kernel_launch(void* const* d_in, const int* in_sizes, int n_in, void* d_out, int out_size, void* d_ws, size_t ws_size, hipStream_t stream) {
    static int grid_blocks = 0;
    if (grid_blocks == 0) {
        if (n_in != 25 || out_size != (int)OUT_TOTAL || ws_size < WS_END) { fprintf(stderr, "kernel_launch: unexpected shapes: n_in %d out %d ws %zu (need %zu)\n", n_in, out_size, ws_size, (size_t)WS_END); grid_blocks = -1; return; }
        int dev = 0, cus = 0, per_cu = 0;
        if (hipGetDevice(&dev) != hipSuccess || hipDeviceGetAttribute(&cus, hipDeviceAttributeMultiprocessorCount, dev) != hipSuccess) { grid_blocks = -1; return; }
        if (hipFuncSetAttribute((const void*)mega, hipFuncAttributeMaxDynamicSharedMemorySize, LDS_BYTES) != hipSuccess) { fprintf(stderr, "kernel_launch: hipFuncSetAttribute failed\n"); grid_blocks = -1; return; }
        if (hipOccupancyMaxActiveBlocksPerMultiprocessor(&per_cu, (const void*)mega, 512, LDS_BYTES) != hipSuccess || per_cu < 1) { fprintf(stderr, "kernel_launch: occupancy query says %d blocks per CU\n", per_cu); (void)hipGetLastError(); grid_blocks = -1; return; }
        grid_blocks = cus;
    }
    if (grid_blocks < 0) return;
    Params p{};
    for (int i = 0; i < 25; ++i) p.in[i] = (const float*)d_in[i];
    p.out = (float*)d_out; p.ws = (unsigned char*)d_ws;
    void* args[] = {&p};
    const hipError_t e = hipLaunchCooperativeKernel((void*)mega, dim3(grid_blocks), dim3(512), args, LDS_BYTES, stream);
    if (e != hipSuccess) fprintf(stderr, "kernel_launch: cooperative launch failed: %s (grid %d)\n", hipGetErrorString(e), grid_blocks);
}
```

```cpp
#include <hip/hip_runtime.h>
#include <hip/hip_cooperative_groups.h>
#include <cstdio>
#include <cstdint>
namespace cg = cooperative_groups;
#ifndef WGM_IN
#define WGM_IN 4
#endif
#ifndef WGM_OUT
#define WGM_OUT 4
#endif
#ifndef WGM_F1
#define WGM_F1 4
#endif
#ifndef WGM_F2
#define WGM_F2 4
#endif
#ifndef RSS
#define RSS 8
#endif
#ifndef PREP_NT
#define PREP_NT 4
#endif
#ifndef PROBE_DUP
#define PROBE_DUP 0
#endif
#ifndef PROBE_SUB
#define PROBE_SUB 0
#endif
#ifndef PROBE_MASK
#define PROBE_MASK 0u
#endif
namespace pg8 {
#define PG8_LAS __attribute__((address_space(3)))
typedef unsigned short bf16_t;
typedef short bf16x8 __attribute__((ext_vector_type(8)));
typedef float f32x4 __attribute__((ext_vector_type(4)));
typedef unsigned u32x4 __attribute__((ext_vector_type(4)));
typedef unsigned u32x2 __attribute__((ext_vector_type(2)));
constexpr int BM = 256, BK = 64, HALF = 128, HTB = HALF * BK * 2  , STAGE_BYTES = 8 * HTB, NXCD = 8, WGM = 1;

__host__ __device__ __forceinline__ int lds_byte(int r, int c) { const int st = (r >> 4) * 2 + (c >> 5), rr = r & 15, cc = c & 31, ob = rr * 64 + cc * 2; return st * 1024 + (ob ^ (((ob >> 9) & 1) << 5)); }
__host__ __device__ __forceinline__ void stage_rc(int b, int& R, int& C) { const int st = b / 1024, sb = b % 1024, swz = sb ^ (((sb >> 9) & 1) << 5); R = (st >> 1) * 16 + swz / 64; C = (st & 1) * 32 + (swz % 64) / 2; }
__host__ __device__ __forceinline__ int perm32(int rho) { const int n = rho >> 4, i = rho & 15; return 8 * (i >> 2) + 4 * n + (i & 3); }

struct Unit { int pm, pn; };
struct Gemm { const bf16_t* A; const bf16_t* Bt; int M, N, K; };

struct StaticOrder {
    int nM, nN, nwg, G, c, wgm;
    __host__ __device__ void init(int M, int N, int G_, int c_, int wgm_ = WGM) { nM = M / BM; nN = N / BM; nwg = nM * nN; G = G_; c = c_; wgm = wgm_; }
    __host__ __device__ bool next(int i, Unit& u) const {
        const long L = (long)i * G + c; if (L >= nwg) return false;
        int wgid = (int)L; { const int q = nwg / NXCD, r = nwg % NXCD, xcd = wgid % NXCD, off = wgid / NXCD; wgid = (xcd < r ? xcd * (q + 1) : r * (q + 1) + (xcd - r) * q) + off; }
        const int nig = wgm * nN, gid = wgid / nig, fm = gid * wgm, gsz = (nM - fm) < wgm ? (nM - fm) : wgm;
        u.pm = fm + ((wgid % nig) % gsz); u.pn = (wgid % nig) / gsz; return true;
    }
    __device__ __forceinline__ void a_ready(const Unit&) const {}
    __device__ __forceinline__ void done(const Unit&) const {}
};

__device__ __forceinline__ unsigned cvt_pk_bf16(float lo, float hi) { unsigned r; asm volatile("v_cvt_pk_bf16_f32 %0, %1, %2" : "=v"(r) : "v"(lo), "v"(hi)); return r; }
struct EpiP {
    static constexpr bool PERM = true, AFTER_DRAIN = false;
    bf16_t* P; float* G; const float* RS; const float* bias;
    __device__ __forceinline__ void operator()(const f32x4 (&acc)[2][2][4][2], const Unit& u, int wr, int wc, int fr, int fq) const {
        const int row0 = u.pm * BM + wr * 64 + fr; const int cond = (u.pm < 16) ? 0 : 1 + ((u.pm - 16) >> 2);
        const int col0 = u.pn * BM + wc * 32 + 8 * fq;
        const float* bp = bias + (size_t)cond * 5376 + col0;
        if (u.pn < 20) {
#pragma unroll
            for (int ai = 0; ai < 2; ++ai)
#pragma unroll
                for (int m = 0; m < 4; ++m) { const int row = row0 + ai * HALF + m * 16; bf16_t* rowp = P + (size_t)row * 5120 + col0;
                    const float rs = RS ? rsqrtf(RS[(size_t)row * RSS] * (1.f / 2048.f) + 1e-6f) : 1.f;
#pragma unroll
                    for (int bj = 0; bj < 2; ++bj) { f32x4 v0 = acc[ai][bj][m][0] * rs, v1 = acc[ai][bj][m][1] * rs;
                        if (RS) { v0 += *(const f32x4*)(bp + bj * HALF); v1 += *(const f32x4*)(bp + bj * HALF + 4); }
                        u32x4 w; w.x = cvt_pk_bf16(v0[0], v0[1]); w.y = cvt_pk_bf16(v0[2], v0[3]); w.z = cvt_pk_bf16(v1[0], v1[1]); w.w = cvt_pk_bf16(v1[2], v1[3]);
                        *(u32x4*)(rowp + bj * HALF) = w; } }
        } else if (wc < 2) {
            const int gc0 = wc * 32 + 8 * fq;
#pragma unroll
            for (int ai = 0; ai < 2; ++ai)
#pragma unroll
                for (int m = 0; m < 4; ++m) { const int row = row0 + ai * HALF + m * 16; float* rowp = G + (size_t)row * 64 + gc0;
                    const float rs = RS ? rsqrtf(RS[(size_t)row * RSS] * (1.f / 2048.f) + 1e-6f) : 1.f;
                    f32x4 v0 = acc[ai][0][m][0] * rs, v1 = acc[ai][0][m][1] * rs;
                    if (RS) { v0 += *(const f32x4*)(bp); v1 += *(const f32x4*)(bp + 4); }
                    *(f32x4*)(rowp) = v0; *(f32x4*)(rowp + 4) = v1; }
        }
    }
};
struct EpiRes {
    static constexpr bool PERM = true, AFTER_DRAIN = false;
    const void* base0; const void* base1; void* out; const float* gate;
    bf16_t* Hn; const float* gnorm; const float* scale; float* RS;
    int base_bf16, out_bf16;
    template <bool BB  , bool OB  , bool HN  >
    __device__ __forceinline__ void body(const f32x4 (&acc)[2][2][4][2], const void* base, const f32x4 (&gv)[2][2], const f32x4 (&gs)[2][2], int row0, int col0, int fq) const {
        constexpr int NB = BB ? 4 : 2, NBATCH = 16 / NB;
        u32x4 bw[2][NB]; f32x4 bf[2][NB][2];
#define EPI_OFF(s_) ((size_t)(row0 + ((s_) >> 3) * HALF + (((s_) >> 1) & 3) * 16) * 2048 + col0 + ((s_) & 1) * HALF)
#define EPI_LOAD(b_, slot_) do { _Pragma("unroll") for (int q_ = 0; q_ < NB; ++q_) { const size_t o_ = EPI_OFF((b_) * NB + q_); \
            if (BB) bw[slot_][q_] = *(const u32x4*)((const bf16_t*)base + o_); else { bf[slot_][q_][0] = *(const f32x4*)((const float*)base + o_); bf[slot_][q_][1] = *(const f32x4*)((const float*)base + o_ + 4); } } } while (0)
        constexpr bool LOOK = false;
        if (LOOK) EPI_LOAD(0, 0);
        float ss = 0.f;
#pragma unroll
        for (int b = 0; b < NBATCH; ++b) {
            if (LOOK) { if (b + 1 < NBATCH) { if ((b + 1) & 1) EPI_LOAD(b + 1, 1); else EPI_LOAD(b + 1, 0); } }
            else { if (b & 1) EPI_LOAD(b, 1); else EPI_LOAD(b, 0); }
#pragma unroll
            for (int q = 0; q < NB; ++q) { const int sidx = b * NB + q, ai = sidx >> 3, m = (sidx >> 1) & 3, bj = sidx & 1; const size_t off = EPI_OFF(sidx);
                f32x4 b0, b1;
                if (BB) { const u32x4 w = bw[b & 1][q];
                    b0 = (f32x4){__uint_as_float(w.x << 16), __uint_as_float(w.x & 0xffff0000u), __uint_as_float(w.y << 16), __uint_as_float(w.y & 0xffff0000u)};
                    b1 = (f32x4){__uint_as_float(w.z << 16), __uint_as_float(w.z & 0xffff0000u), __uint_as_float(w.w << 16), __uint_as_float(w.w & 0xffff0000u)}; }
                else { b0 = bf[b & 1][q][0]; b1 = bf[b & 1][q][1]; }
                const f32x4 x0 = b0 + gv[bj][0] * acc[ai][bj][m][0], x1 = b1 + gv[bj][1] * acc[ai][bj][m][1];
                if (OB) { u32x4 w; w.x = cvt_pk_bf16(x0[0], x0[1]); w.y = cvt_pk_bf16(x0[2], x0[3]); w.z = cvt_pk_bf16(x1[0], x1[1]); w.w = cvt_pk_bf16(x1[2], x1[3]); *(u32x4*)((bf16_t*)out + off) = w; }
                else { __builtin_nontemporal_store(x0, (f32x4*)((float*)out + off)); __builtin_nontemporal_store(x1, (f32x4*)((float*)out + off + 4)); }
                if (HN) { ss += ((x0[0] * x0[0] + x0[1] * x0[1]) + (x0[2] * x0[2] + x0[3] * x0[3])) + ((x1[0] * x1[0] + x1[1] * x1[1]) + (x1[2] * x1[2] + x1[3] * x1[3]));
                    const f32x4 y0 = x0 * gs[bj][0], y1 = x1 * gs[bj][1];
                    u32x4 w; w.x = cvt_pk_bf16(y0[0], y0[1]); w.y = cvt_pk_bf16(y0[2], y0[3]); w.z = cvt_pk_bf16(y1[0], y1[1]); w.w = cvt_pk_bf16(y1[2], y1[3]);
                    *(u32x4*)(Hn + off) = w;
                    if (bj == 1) { const int row = row0 + ai * HALF + m * 16; ss += __shfl_xor(ss, 16); ss += __shfl_xor(ss, 32); if (fq == 0) atomicAdd(RS + (size_t)row * RSS, ss); ss = 0.f; } } }
            asm volatile("" ::: "memory");
        }
#undef EPI_OFF
#undef EPI_LOAD
    }
    __device__ __forceinline__ void operator()(const f32x4 (&acc)[2][2][4][2], const Unit& u, int wr, int wc, int fr, int fq) const {
        const int row0 = u.pm * BM + wr * 64 + fr; const int col0 = u.pn * BM + wc * 32 + 8 * fq;
        const int cond = (u.pm < 16) ? 0 : 1 + ((u.pm - 16) >> 2);
        const void* base = (u.pm < 16) ? base0 : base1;
        const float* gp = gate + (size_t)cond * 6 * 2048 + col0;
        f32x4 gv[2][2], gs[2][2];
#pragma unroll
        for (int bj = 0; bj < 2; ++bj)
#pragma unroll
            for (int n = 0; n < 2; ++n) { gv[bj][n] = *(const f32x4*)(gp + bj * HALF + n * 4);
                gs[bj][n] = Hn ? *(const f32x4*)(gnorm + col0 + bj * HALF + n * 4) * (*(const f32x4*)(scale + (size_t)cond * 6 * 2048 + col0 + bj * HALF + n * 4) + 1.f) : (f32x4){0.f, 0.f, 0.f, 0.f}; }
        if (!base_bf16) body<false, true, true>(acc, base, gv, gs, row0, col0, fq);
        else if (Hn) body<true, true, true>(acc, base, gv, gs, row0, col0, fq);
        else body<true, false, false>(acc, base, gv, gs, row0, col0, fq);
    }
};
struct EpiSqRelu {
    static constexpr bool PERM = true, AFTER_DRAIN = false;
    bf16_t* O; int ldc; const float* RS; const float* bias;
    __device__ __forceinline__ void operator()(const f32x4 (&acc)[2][2][4][2], const Unit& u, int wr, int wc, int fr, int fq) const {
        const int row0 = u.pm * BM + wr * 64 + fr; const int col0 = u.pn * BM + wc * 32 + 8 * fq;
        const int cond = (u.pm < 16) ? 0 : 1 + ((u.pm - 16) >> 2);
        const float* bp = bias + (size_t)cond * ldc + col0;
        f32x4 bv[2][2];
#pragma unroll
        for (int bj = 0; bj < 2; ++bj)
#pragma unroll
            for (int n = 0; n < 2; ++n) bv[bj][n] = *(const f32x4*)(bp + bj * HALF + 4 * n);
#pragma unroll
        for (int ai = 0; ai < 2; ++ai)
#pragma unroll
            for (int m = 0; m < 4; ++m) { const int row = row0 + ai * HALF + m * 16; bf16_t* rowp = O + (size_t)row * ldc + col0;
                const float rs = rsqrtf(RS[(size_t)row * RSS] * (1.f / 2048.f) + 1e-6f);
#pragma unroll
                for (int bj = 0; bj < 2; ++bj) { f32x4 v0 = acc[ai][bj][m][0] * rs + bv[bj][0], v1 = acc[ai][bj][m][1] * rs + bv[bj][1];
#pragma unroll
                    for (int e = 0; e < 4; ++e) { const float a = fmaxf(v0[e], 0.f), b = fmaxf(v1[e], 0.f); v0[e] = a * a; v1[e] = b * b; }
                    u32x4 w; w.x = cvt_pk_bf16(v0[0], v0[1]); w.y = cvt_pk_bf16(v0[2], v0[3]); w.z = cvt_pk_bf16(v1[0], v1[1]); w.w = cvt_pk_bf16(v1[2], v1[3]);
                    *(u32x4*)(rowp + bj * HALF) = w; } }
    }
};

template <class Epi, class Sched, bool ALIGN_EPI = false, bool SP2 = false>
__device__ __forceinline__ void gemm_phase(PG8_LAS unsigned char* lds, const Gemm g, const Sched& S, const Epi& E) {
    int tid = threadIdx.x; asm volatile("" : "+v"(tid)); const int wid = __builtin_amdgcn_readfirstlane(tid >> 6), lane = tid & 63, wr = wid >> 2, wc = wid & 3, fr = lane & 15, fq = lane >> 4;
    const int K = g.K, nt = K / BK;
    unsigned voffA[2], voffB[2];
#pragma unroll
    for (int i = 0; i < 2; ++i) { int R, C; stage_rc(tid * 16 + i * 8192, R, C); const int Rb = Epi::PERM ? ((R & ~31) + perm32(R & 31)) : R;
        voffA[i] = (unsigned)(R * K + C) * 2u; voffB[i] = (unsigned)(Rb * K + C) * 2u; }
    const size_t kstep = (size_t)(BK * 2);
    const size_t hstep = (size_t)HALF * K * 2;
    const size_t tstep = 2 * hstep;
    const unsigned ldsw = (unsigned)wid * 1024u;
    const int aoff = lds_byte(wr * 64 + fr, fq * 8), boff = lds_byte(wc * 32 + fr, fq * 8);
#define PG8_SA(b, h) (((b) * 2 + (h)) * HTB)
#define PG8_SB(b, h) ((4 + (b) * 2 + (h)) * HTB)
#define PG8_STAGE(bufoff, gbase, voff) do { _Pragma("unroll") for (int _i = 0; _i < 2; ++_i) \
        __builtin_amdgcn_global_load_lds((const unsigned*)((const char*)(gbase) + (voff)[_i]), (PG8_LAS unsigned*)(lds + (bufoff) + ldsw + _i * 8192), 16, 0, 0); } while (0)
#define PG8_LDA(dst, b, h) do { _Pragma("unroll") for (int m = 0; m < 4; ++m) _Pragma("unroll") for (int k = 0; k < 2; ++k) dst[m][k] = *(const PG8_LAS bf16x8*)(lds + PG8_SA(b, h) + aoff + m * 2048 + k * 1024); } while (0)
#define PG8_LDB(dst, b, h) do { _Pragma("unroll") for (int n = 0; n < 2; ++n) _Pragma("unroll") for (int k = 0; k < 2; ++k) dst[n][k] = *(const PG8_LAS bf16x8*)(lds + PG8_SB(b, h) + boff + n * 2048 + k * 1024); } while (0)
#define PG8_MMA(ai, bj, At, Bt) do { __builtin_amdgcn_s_setprio(1); _Pragma("unroll") for (int m = 0; m < 4; ++m) _Pragma("unroll") for (int n = 0; n < 2; ++n) _Pragma("unroll") for (int k = 0; k < 2; ++k) \
        acc[ai][bj][m][n] = __builtin_amdgcn_mfma_f32_16x16x32_bf16(Bt[n][k], At[m][k], acc[ai][bj][m][n], 0, 0, 0); __builtin_amdgcn_s_setprio(0); } while (0)
#define PG8_WAIT_V(n) asm volatile("s_waitcnt vmcnt(" #n ")" ::: "memory")
#define PG8_WAIT_L(n) asm volatile("s_waitcnt lgkmcnt(" #n ")" ::: "memory")
#define PG8_BAR __builtin_amdgcn_s_barrier()
#define PG8_SCHED __builtin_amdgcn_sched_barrier(0)
    Unit cur, nxt; int ui = 0;
    if (!S.next(0, cur)) return;
    f32x4 acc[2][2][4][2];
#pragma unroll
    for (int a = 0; a < 2; ++a)
#pragma unroll
        for (int b = 0; b < 2; ++b)
#pragma unroll
            for (int m = 0; m < 4; ++m)
#pragma unroll
                for (int n = 0; n < 2; ++n) acc[a][b][m][n] = (f32x4){0.f, 0.f, 0.f, 0.f};
    bf16x8 At[4][2], B0[2][2], B1[2][2];
    const char* cA = (const char*)g.A + (size_t)cur.pm * tstep; const char* cB = (const char*)g.Bt + (size_t)cur.pn * tstep;
    S.a_ready(cur);
    if constexpr (SP2) {
        PG8_STAGE(PG8_SB(0, 0), cB, voffB); PG8_STAGE(PG8_SB(0, 1), cB + hstep, voffB); PG8_STAGE(PG8_SA(0, 0), cA, voffA); PG8_STAGE(PG8_SA(0, 1), cA + hstep, voffA);
        if (wr == 1) PG8_BAR;
        PG8_WAIT_V(2); PG8_BAR;
        PG8_STAGE(PG8_SB(1, 0), cB + kstep, voffB); PG8_STAGE(PG8_SA(1, 0), cA + kstep, voffA); PG8_STAGE(PG8_SB(1, 1), cB + hstep + kstep, voffB);
        PG8_WAIT_V(6); PG8_BAR;
    } else {
        PG8_STAGE(PG8_SB(0, 0), cB, voffB); PG8_STAGE(PG8_SA(0, 0), cA, voffA); PG8_STAGE(PG8_SB(0, 1), cB + hstep, voffB); PG8_STAGE(PG8_SA(0, 1), cA + hstep, voffA);
        if (wr == 1) PG8_BAR;
        PG8_WAIT_V(4); PG8_BAR;
        PG8_STAGE(PG8_SB(1, 0), cB + kstep, voffB); PG8_STAGE(PG8_SA(1, 0), cA + kstep, voffA); PG8_STAGE(PG8_SB(1, 1), cB + hstep + kstep, voffB);
        PG8_WAIT_V(6); PG8_BAR;
    }
    for (;;) {
        const bool has_next = S.next(ui + 1, nxt);
        const char* nA = has_next ? (const char*)g.A + (size_t)nxt.pm * tstep : cA; const char* nB = has_next ? (const char*)g.Bt + (size_t)nxt.pn * tstep : cB;
        for (int t = 0; t < nt; t += 2) {
            const bool last = (t == nt - 2);
            const char* a1 = cA + (size_t)(t + 1) * kstep;
            const char* a2 = last ? nA : cA + (size_t)(t + 2) * kstep; const char* b2 = last ? nB : cB + (size_t)(t + 2) * kstep;
            const char* a3 = a2 + kstep; const char* b3 = b2 + kstep;
            if (last && has_next) S.a_ready(nxt);
            if constexpr (SP2) {
            PG8_LDB(B0, 0, 0); PG8_LDB(B1, 0, 1); PG8_SCHED; PG8_LDA(At, 0, 0); PG8_STAGE(PG8_SA(1, 1), a1 + hstep, voffA);
            PG8_WAIT_V(8); PG8_WAIT_L(0); PG8_BAR; PG8_MMA(0, 0, At, B0); PG8_MMA(0, 1, At, B1); PG8_BAR; PG8_SCHED;
            PG8_LDA(At, 0, 1); PG8_STAGE(PG8_SB(0, 0), b2, voffB); PG8_STAGE(PG8_SB(0, 1), b2 + hstep, voffB); PG8_STAGE(PG8_SA(0, 0), a2, voffA);
            PG8_WAIT_V(8); PG8_WAIT_L(0); PG8_BAR; PG8_MMA(1, 0, At, B0); PG8_MMA(1, 1, At, B1); PG8_BAR; PG8_SCHED;
            PG8_LDB(B0, 1, 0); PG8_LDB(B1, 1, 1); PG8_SCHED; PG8_LDA(At, 1, 0); PG8_STAGE(PG8_SA(0, 1), a2 + hstep, voffA);
            PG8_WAIT_V(8); PG8_WAIT_L(0); PG8_BAR; PG8_MMA(0, 0, At, B0); PG8_MMA(0, 1, At, B1); PG8_BAR; PG8_SCHED;
            PG8_LDA(At, 1, 1); PG8_STAGE(PG8_SB(1, 0), b3, voffB); PG8_STAGE(PG8_SB(1, 1), b3 + hstep, voffB); PG8_STAGE(PG8_SA(1, 0), a3, voffA);
            PG8_WAIT_V(8); PG8_WAIT_L(0); PG8_BAR; PG8_MMA(1, 0, At, B0); PG8_MMA(1, 1, At, B1); PG8_BAR; PG8_SCHED;
            } else {
            PG8_LDB(B0, 0, 0); PG8_SCHED; PG8_LDA(At, 0, 0); PG8_STAGE(PG8_SA(1, 1), a1 + hstep, voffA);
            PG8_WAIT_L(8); PG8_BAR; PG8_WAIT_L(0); PG8_MMA(0, 0, At, B0); PG8_BAR; PG8_SCHED;
            PG8_LDB(B1, 0, 1); PG8_STAGE(PG8_SB(0, 0), b2, voffB);
            PG8_BAR; PG8_WAIT_L(0); PG8_MMA(0, 1, At, B1); PG8_BAR;
            PG8_LDA(At, 0, 1); PG8_STAGE(PG8_SA(0, 0), a2, voffA);
            PG8_BAR; PG8_WAIT_L(0); PG8_MMA(1, 0, At, B0); PG8_BAR; PG8_SCHED;
            PG8_STAGE(PG8_SB(0, 1), b2 + hstep, voffB);
            PG8_WAIT_V(6); PG8_BAR; PG8_MMA(1, 1, At, B1); PG8_BAR;
            PG8_LDB(B0, 1, 0); PG8_SCHED; PG8_LDA(At, 1, 0); PG8_STAGE(PG8_SA(0, 1), a2 + hstep, voffA);
            PG8_WAIT_L(8); PG8_BAR; PG8_WAIT_L(0); PG8_MMA(0, 0, At, B0); PG8_BAR; PG8_SCHED;
            PG8_LDB(B1, 1, 1); PG8_STAGE(PG8_SB(1, 0), b3, voffB);
            PG8_BAR; PG8_WAIT_L(0); PG8_MMA(0, 1, At, B1); PG8_BAR;
            PG8_LDA(At, 1, 1); PG8_STAGE(PG8_SA(1, 0), a3, voffA);
            PG8_BAR; PG8_WAIT_L(0); PG8_MMA(1, 0, At, B0); PG8_BAR; PG8_SCHED;
            PG8_STAGE(PG8_SB(1, 1), b3 + hstep, voffB);
            PG8_WAIT_V(6); PG8_BAR; PG8_MMA(1, 1, At, B1); PG8_BAR;
            }
        }
        if constexpr (ALIGN_EPI) { if (wr == 0) PG8_BAR; }
        if constexpr (!Epi::AFTER_DRAIN) { E(acc, cur, wr, wc, fr, fq); S.done(cur); }
        if (!has_next) break;
#pragma unroll
        for (int a = 0; a < 2; ++a)
#pragma unroll
            for (int b = 0; b < 2; ++b)
#pragma unroll
                for (int m = 0; m < 4; ++m)
#pragma unroll
                    for (int n = 0; n < 2; ++n) acc[a][b][m][n] = (f32x4){0.f, 0.f, 0.f, 0.f};
        cur = nxt; cA = nA; cB = nB; ++ui;
        if constexpr (ALIGN_EPI) { if (wr == 1) PG8_BAR; }
    }
    PG8_WAIT_V(0);
    if constexpr (!ALIGN_EPI) { if (wr == 0) PG8_BAR; }
    PG8_BAR;
    if constexpr (Epi::AFTER_DRAIN) { E.fused(acc, cur, wr, wc, fr, fq, lds, wid, lane); S.done(cur); }
#undef PG8_SA
#undef PG8_SB
#undef PG8_STAGE
#undef PG8_LDA
#undef PG8_LDB
#undef PG8_MMA
#undef PG8_WAIT_V
#undef PG8_WAIT_L
#undef PG8_BAR
#undef PG8_SCHED
}
}
namespace att {
typedef unsigned short bf16;
constexpr int   D = 128, NW = 8, QBLK = 32, KVBLK = 64;
constexpr float SCALE = 0.088388347648318440f;
constexpr float THR = 8.f;
constexpr int SDEPTH = 2;
constexpr size_t SHM_V = KVBLK * D * 2, SHM_K = KVBLK * D * 2, SHM_ATTN = 2 * SHM_V + 2 * SHM_K + NW * 64 * 4;
__device__ __forceinline__ bf16 f2bf_s(float f) { unsigned u = __builtin_bit_cast(unsigned, f); return (bf16)((u + 0x7fffu + ((u >> 16) & 1u)) >> 16); }
using bf16x8 = __attribute__((ext_vector_type(8))) short;
using s16x4  = __attribute__((ext_vector_type(4))) short;
using f32x16 = __attribute__((ext_vector_type(16))) float;
using f32x8  = __attribute__((ext_vector_type(8))) float;
using u32x4  = __attribute__((ext_vector_type(4))) unsigned;
#define KSWZ(row, colB) ((row) * 256 + ((colB) ^ (((row) & 7) << 4)))
#define SBAR() __builtin_amdgcn_sched_barrier(0)
__device__ __forceinline__ int crow(int r, int hi) { return (r & 3) + 8 * (r >> 2) + 4 * hi; }
__device__ __forceinline__ unsigned cvtpk(float lo, float hi) {
  unsigned r; asm volatile("v_cvt_pk_bf16_f32 %0, %1, %2" : "=v"(r) : "v"(lo), "v"(hi)); return r;
}
__device__ __forceinline__ void partialSM(f32x16& p0, f32x16& p1, float& m_reg, float& mn, float& alpha) {
  constexpr float C = SCALE * 1.4426950408889634f;
  float pmax = p0[0]; for (int r = 1; r < 16; ++r) pmax = fmaxf(pmax, p0[r]); for (int r = 0; r < 16; ++r) pmax = fmaxf(pmax, p1[r]);
  { auto rr = __builtin_amdgcn_permlane32_swap(__float_as_uint(pmax), __float_as_uint(pmax), false, false);
    pmax = fmaxf(__uint_as_float(rr[0]), __uint_as_float(rr[1])); }
  if (__builtin_expect(__all(pmax - m_reg <= THR / SCALE), 1)) { mn = m_reg; alpha = 1.f; }
  else { mn = fmaxf(m_reg, pmax); alpha = __builtin_amdgcn_exp2f((m_reg - mn) * C); m_reg = mn; }
  float mnC = -mn * C;
  for (int r = 0; r < 16; ++r) p0[r] = fmaf(p0[r], C, mnC); for (int r = 0; r < 16; ++r) p1[r] = fmaf(p1[r], C, mnC);
  for (int r = 0; r < 16; ++r) p0[r] = __builtin_amdgcn_exp2f(p0[r]);
}
__device__ __forceinline__ void finishSM(f32x16& p0, f32x16& p1, float alpha, float& l_reg, bf16x8& pa0, bf16x8& pa1, bf16x8& pa2, bf16x8& pa3) {
  for (int r = 0; r < 16; ++r) p1[r] = __builtin_amdgcn_exp2f(p1[r]);
  float ps = 0; for (int r = 0; r < 16; ++r) ps += p0[r]; for (int r = 0; r < 16; ++r) ps += p1[r];
  { auto rr = __builtin_amdgcn_permlane32_swap(__float_as_uint(ps), __float_as_uint(ps), false, false);
    ps = __uint_as_float(rr[0]) + __uint_as_float(rr[1]); }
  l_reg = l_reg * alpha + ps;
#define PK4(P, BASE, OUT) do { unsigned a0 = cvtpk(P[BASE + 0], P[BASE + 1]), a1 = cvtpk(P[BASE + 2], P[BASE + 3]);   \
    unsigned b0 = cvtpk(P[BASE + 4], P[BASE + 5]), b1 = cvtpk(P[BASE + 6], P[BASE + 7]);                              \
    auto r0 = __builtin_amdgcn_permlane32_swap(a0, b0, false, false); auto r1 = __builtin_amdgcn_permlane32_swap(a1, b1, false, false); \
    u32x4 w = {r0[0], r1[0], r0[1], r1[1]}; OUT = *reinterpret_cast<bf16x8*>(&w); } while (0)
  PK4(p0, 0, pa0); PK4(p0, 8, pa1); PK4(p1, 0, pa2); PK4(p1, 8, pa3);
#undef PK4
}
__device__ __forceinline__ void qkt(f32x16& p0, f32x16& p1, const bf16* Ks, const bf16x8* qr, int r32, int hi) {
  p0 = f32x16{}; p1 = f32x16{};
  for (int d0 = 0; d0 < 8; ++d0) { int cb = (d0 * 16 + hi * 8) * 2;
    bf16x8 b0 = *reinterpret_cast<const bf16x8*>((const char*)Ks + KSWZ(r32, cb));
    bf16x8 b1 = *reinterpret_cast<const bf16x8*>((const char*)Ks + KSWZ(32 + r32, cb));
    p0 = __builtin_amdgcn_mfma_f32_32x32x16_bf16(b0, qr[d0], p0, 0, 0, 0);
    p1 = __builtin_amdgcn_mfma_f32_32x32x16_bf16(b1, qr[d0], p1, 0, 0, 0); }
}
__device__ __forceinline__ int v_st(int k, int c) { const int kk = (k & ~0xC) | ((k & 4) << 1) | ((k & 8) >> 1); return ((kk >> 3) * 4 + (c >> 5)) * 512 + ((kk & 7) * 32 + (c & 31)) * 2; }
__device__ __forceinline__ int v_rd_base(int lane) { return ((lane & 3) << 3) | (((lane >> 2) & 3) << 6) | (((lane >> 4) & 1) << 5) | (((lane >> 5) & 1) << 8); }
constexpr int v_rd_off(int d0, int ks, int half) { return d0 * 512 + ks * 4096 + half * 2048; }
template <int OFF> __device__ __forceinline__ s16x4 tr_read(int vb) {
  s16x4 r; asm volatile("ds_read_b64_tr_b16 %0, %1 offset:%2" : "=&v"(r) : "v"(vb), "i"(OFF) : "memory"); return r;
}
template <int D0> __device__ __forceinline__ void pv_one(f32x16& od, int vb, bf16x8 pa0, bf16x8 pa1, bf16x8 pa2, bf16x8 pa3) {
  const s16x4 l0 = tr_read<v_rd_off(D0, 0, 0)>(vb), h0 = tr_read<v_rd_off(D0, 0, 1)>(vb), l1 = tr_read<v_rd_off(D0, 1, 0)>(vb), h1 = tr_read<v_rd_off(D0, 1, 1)>(vb);
  const s16x4 l2 = tr_read<v_rd_off(D0, 2, 0)>(vb), h2 = tr_read<v_rd_off(D0, 2, 1)>(vb), l3 = tr_read<v_rd_off(D0, 3, 0)>(vb), h3 = tr_read<v_rd_off(D0, 3, 1)>(vb);
  asm volatile("s_waitcnt lgkmcnt(0)" ::: "memory"); SBAR();
#define PK(L, H) (bf16x8){L[0], L[1], L[2], L[3], H[0], H[1], H[2], H[3]}
  od = __builtin_amdgcn_mfma_f32_32x32x16_bf16(pa0, PK(l0, h0), od, 0, 0, 0);
  od = __builtin_amdgcn_mfma_f32_32x32x16_bf16(pa1, PK(l1, h1), od, 0, 0, 0);
  od = __builtin_amdgcn_mfma_f32_32x32x16_bf16(pa2, PK(l2, h2), od, 0, 0, 0);
  od = __builtin_amdgcn_mfma_f32_32x32x16_bf16(pa3, PK(l3, h3), od, 0, 0, 0);
#undef PK
}
__device__ __forceinline__ void pv_d0(f32x16* o, int vb, bf16x8 pa0, bf16x8 pa1, bf16x8 pa2, bf16x8 pa3) {
  pv_one<0>(o[0], vb, pa0, pa1, pa2, pa3); pv_one<1>(o[1], vb, pa0, pa1, pa2, pa3); pv_one<2>(o[2], vb, pa0, pa1, pa2, pa3); pv_one<3>(o[3], vb, pa0, pa1, pa2, pa3);
}

template <int LDQ, int LDK, int LDO>
__device__ __forceinline__ void attn_dense_body(const bf16* Qb, const bf16* Kh, const bf16* Vh,
                                                bf16* Ob, int seq, char* lds) {
  int tid = threadIdx.x; asm volatile("" : "+v"(tid)); const int wid = tid >> 6, lane = tid & 63, r32 = lane & 31, hi = lane >> 5;
  bf16* V_lds = (bf16*)lds; bf16* K_lds = (bf16*)(lds + 2 * SHM_V);
  float* ws = (float*)(lds + 2 * SHM_V + 2 * SHM_K) + wid * 64; float* li_l = ws; float* al_l = ws + 32;
  float m_reg = -1e30f, l_reg = 0; f32x16 o[4] = {}; bf16x8 qr[8];
  const bf16* Qw = Qb + (long)(wid * QBLK + r32) * LDQ + hi * 8;
#pragma unroll
  for (int d0 = 0; d0 < 8; ++d0) qr[d0] = *reinterpret_cast<const bf16x8*>(Qw + d0 * 16);
  const int sr = tid >> 4, sc = (tid & 15) * 8, vst0 = v_st(sr, sc), vst1 = v_st(32 + sr, sc);
  const int vb0 = (int)(uintptr_t)V_lds + v_rd_base(lane);
  struct { bf16x8 vs0, vs1, ks0, ks1; } sr_[SDEPTH];
#define SLOAD(i, k0) do { sr_[i].vs0 = (*reinterpret_cast<const bf16x8*>(&Vh[(long)((k0) + sr) * LDK + sc])); sr_[i].vs1 = (*reinterpret_cast<const bf16x8*>(&Vh[(long)((k0) + 32 + sr) * LDK + sc])); \
    sr_[i].ks0 = (*reinterpret_cast<const bf16x8*>(&Kh[(long)((k0) + sr) * LDK + sc])); sr_[i].ks1 = (*reinterpret_cast<const bf16x8*>(&Kh[(long)((k0) + 32 + sr) * LDK + sc])); } while (0)
#define SWRITE(b, i) do { *(bf16x8*)((char*)V_lds + (b) * SHM_V + vst0) = (sr_[i].vs0);          \
    *(bf16x8*)((char*)V_lds + (b) * SHM_V + vst1) = (sr_[i].vs1); int kc = sc * 2;               \
    *(bf16x8*)((char*)K_lds + (b) * SHM_K + KSWZ(sr, kc)) = (sr_[i].ks0);                       \
    *(bf16x8*)((char*)K_lds + (b) * SHM_K + KSWZ(32 + sr, kc)) = (sr_[i].ks1); } while (0)
#define SWAIT() do { if constexpr (SDEPTH == 2) asm volatile("s_waitcnt vmcnt(4)" ::: "memory"); else asm volatile("s_waitcnt vmcnt(0)" ::: "memory"); } while (0)
#define RESC(a) do { if (__any((a) < 1.f)) { if (hi == 0) al_l[r32] = (a); asm volatile("s_waitcnt lgkmcnt(0)" ::: "memory"); \
    for (int d = 0; d < 4; ++d) for (int r = 0; r < 16; ++r) o[d][r] *= al_l[crow(r, hi)]; } } while (0)
  f32x16 pA0, pA1, pB0, pB1; float mnA, mnB, alA, alB; bf16x8 pa0, pa1, pa2, pa3; const int NT = seq / KVBLK;
  constexpr int SE = 0, SO = SDEPTH - 1;
  if constexpr (SDEPTH == 2) {
    SLOAD(SE, 0); SLOAD(SO, KVBLK); asm volatile("s_waitcnt vmcnt(4)" ::: "memory"); SWRITE(0, SE); if (2 < NT) SLOAD(SE, 2 * KVBLK); __syncthreads();
    qkt(pA0, pA1, K_lds, qr, r32, hi); partialSM(pA0, pA1, m_reg, mnA, alA);
    if (2 < NT) SWAIT(); else asm volatile("s_waitcnt vmcnt(0)" ::: "memory");
    SWRITE(1, SO); __syncthreads();
  } else {
    SLOAD(SE, 0); asm volatile("s_waitcnt vmcnt(0)" ::: "memory"); SWRITE(0, SE); __syncthreads();
    qkt(pA0, pA1, K_lds, qr, r32, hi); partialSM(pA0, pA1, m_reg, mnA, alA);
    SLOAD(SO, KVBLK);
    SWAIT(); SWRITE(1, SO); __syncthreads();
  }
  for (int j = 1; j + 1 < NT; j += 2) {
    SBAR(); qkt(pB0, pB1, (bf16*)((char*)K_lds + SHM_K), qr, r32, hi);
    finishSM(pA0, pA1, alA, l_reg, pa0, pa1, pa2, pa3); SBAR();
    SLOAD(SO, (j + SDEPTH) * KVBLK); SBAR();
    pv_d0(o, vb0, pa0, pa1, pa2, pa3); partialSM(pB0, pB1, m_reg, mnB, alB);
    __syncthreads(); SWAIT(); SWRITE(0, SE);
    RESC(alB); __syncthreads();
    SBAR(); qkt(pA0, pA1, K_lds, qr, r32, hi);
    finishSM(pB0, pB1, alB, l_reg, pa0, pa1, pa2, pa3); SBAR();
    if (SDEPTH == 1 || j + 3 < NT) SLOAD(SE, (j + 1 + SDEPTH) * KVBLK); SBAR();
    pv_d0(o, vb0 + (int)SHM_V, pa0, pa1, pa2, pa3); partialSM(pA0, pA1, m_reg, mnA, alA);
    __syncthreads(); SWAIT(); SWRITE(1, SO);
    RESC(alA); __syncthreads();
  }
  SBAR(); qkt(pB0, pB1, (bf16*)((char*)K_lds + SHM_K), qr, r32, hi);
  finishSM(pA0, pA1, alA, l_reg, pa0, pa1, pa2, pa3); SBAR();
  pv_d0(o, vb0, pa0, pa1, pa2, pa3); partialSM(pB0, pB1, m_reg, mnB, alB);
  __syncthreads(); RESC(alB);
  finishSM(pB0, pB1, alB, l_reg, pa0, pa1, pa2, pa3); SBAR();
  pv_d0(o, vb0 + (int)SHM_V, pa0, pa1, pa2, pa3);
  if (hi == 0) li_l[r32] = l_reg; asm volatile("s_waitcnt lgkmcnt(0)" ::: "memory");
  float rli[16];
#pragma unroll
  for (int r = 0; r < 16; ++r) rli[r] = __builtin_amdgcn_rcpf(li_l[crow(r, hi)]);
  bf16* Ow = Ob + (long)(wid * QBLK) * LDO;
#pragma unroll
  for (int r = 0; r < 16; ++r) { int orow = crow(r, hi);
    for (int d0 = 0; d0 < 4; ++d0) Ow[(long)orow * LDO + d0 * 32 + r32] = f2bf_s(o[d0][r] * rli[r]); }
#undef SLOAD
#undef SWRITE
#undef SWAIT
#undef RESC
}
#undef KSWZ
#undef SBAR
}
typedef unsigned short bf16_t;
typedef float f32x4 __attribute__((ext_vector_type(4)));
typedef float f32x2 __attribute__((ext_vector_type(2)));
typedef unsigned u32x4 __attribute__((ext_vector_type(4)));
typedef unsigned u32x2 __attribute__((ext_vector_type(2)));
#define LAS __attribute__((address_space(3)))
constexpr int DM = 2048, NTOK = 8192, INC = 5168, PNW = 5376, PLD = 5120, FFD = 8192, NMOD = 12288;
constexpr size_t MiB = 1u << 20;
constexpr size_t WS_CTL = 0, WS_MODS = 1 * MiB, WS_WIN = 2 * MiB, WS_WOUT = 44 * MiB, WS_WFF1 = 60 * MiB, WS_WFF2 = 124 * MiB, WS_H = 188 * MiB, WS_XA = 220 * MiB, WS_XB = 284 * MiB,
    WS_P = 348 * MiB, WS_G = 428 * MiB, WS_QN = 430 * MiB, WS_KB = 446 * MiB, WS_VB = 451 * MiB, WS_LA = 456 * MiB, WS_DQKV = 472 * MiB, WS_GB = 496 * MiB, WS_OG = 497 * MiB, WS_OD = 529 * MiB,
    WS_MIX = 561 * MiB, WS_GQ = 593 * MiB, WS_GO = 601 * MiB, WS_GU = 617 * MiB, WS_GD = 633 * MiB, WS_END = 634 * MiB;
constexpr size_t WS_MC = 188 * MiB, WS_NC = 220 * MiB, WS_QE = 252 * MiB, WS_OL = 268 * MiB;
constexpr size_t WS_QUEUE = 32768;
constexpr size_t WS_RS = 262144;
constexpr size_t WS_BIAS = 1 * MiB + 524288;
constexpr size_t WS_H2 = 348 * MiB;
constexpr size_t ZERO_BYTES = 2 * MiB;
constexpr size_t OUT_Y = 0, OUT_CK = 16777216, OUT_CV = 18874368, OUT_SG = 20971520, OUT_SD = 23068672, OUT_TOTAL = 27262976;
constexpr int LDS_BYTES = 147456;
constexpr float EPS = 1e-6f;

struct Params { const float* in[25]; float* out; unsigned char* ws; };
constexpr int PTAB_OFF = 147456 - 512;
typedef __attribute__((address_space(3))) const unsigned* ptab_t;
__device__ __forceinline__ const void* ldp(ptab_t pt, int i) { unsigned a; asm volatile("v_mov_b32 %0, %1" : "=v"(a) : "s"((unsigned)(unsigned long long)pt + 8u * (unsigned)i));
    const ptab_t q = (ptab_t)(unsigned long long)a; const unsigned lo = __builtin_amdgcn_readfirstlane(q[0]), hi = __builtin_amdgcn_readfirstlane(q[1]); return (const void*)(__attribute__((address_space(1))) const unsigned char*)(((unsigned long long)hi << 32) | lo); }
#define PIN(i) ((const float*)ldp(pt, (i)))
#define POUT ((float*)ldp(pt, 25))
#define PWS ((unsigned char*)ldp(pt, 26))

__device__ __forceinline__ float bf2f(unsigned short v) { return __uint_as_float(((unsigned)v) << 16); }
__device__ __forceinline__ float bflo(unsigned w) { return __uint_as_float(w << 16); }
__device__ __forceinline__ float bfhi(unsigned w) { return __uint_as_float(w & 0xffff0000u); }
typedef __bf16 bf16x2_hw __attribute__((ext_vector_type(2)));
__device__ __forceinline__ unsigned pk2(float lo, float hi) { const f32x2 v = {lo, hi}; return __builtin_bit_cast(unsigned, __builtin_convertvector(v, bf16x2_hw)); }
__device__ __forceinline__ unsigned short f2bf(float f) { return (unsigned short)pk2(f, 0.f); }
template <int CTRL> __device__ __forceinline__ float dpp_mov(float v) { return __builtin_bit_cast(float, __builtin_amdgcn_update_dpp(0, __builtin_bit_cast(int, v), CTRL, 0xF, 0xF, true)); }
__device__ __forceinline__ float row16_sum(float v) { v += dpp_mov<0xB1>(v); v += dpp_mov<0x4E>(v); v += dpp_mov<0x124>(v); v += dpp_mov<0x128>(v); return v; }
__device__ __forceinline__ float xrow_sum(float v) {
    { auto r = __builtin_amdgcn_permlane16_swap(__float_as_uint(v), __float_as_uint(v), false, false); v = __uint_as_float(r[0]) + __uint_as_float(r[1]); }
    { auto r = __builtin_amdgcn_permlane32_swap(__float_as_uint(v), __float_as_uint(v), false, false); v = __uint_as_float(r[0]) + __uint_as_float(r[1]); }
    return v;
}
__device__ __forceinline__ float wave_sum(float v) { return xrow_sum(row16_sum(v)); }
template <int N> __device__ __forceinline__ void wave_sum_n(float (&v)[N]) {
#pragma unroll
    for (int i = 0; i < N; ++i) v[i] = row16_sum(v[i]);
#pragma unroll
    for (int i = 0; i < N; ++i) v[i] = xrow_sum(v[i]);
}
__device__ __forceinline__ float silu_f(float x) { return x * __builtin_amdgcn_rcpf(1.f + __expf(-x)); }
__device__ __forceinline__ float softplus_f(float x) { return fmaxf(x, 0.f) + __logf(1.f + __expf(-fabsf(x))); }
__device__ __forceinline__ float logsigmoid_f(float x) { return fminf(x, 0.f) - __logf(1.f + __expf(-fabsf(x))); }
#define LDS_WAIT() asm volatile("s_waitcnt lgkmcnt(0)" ::: "memory")
#define LDS_BARRIER() do { asm volatile("s_waitcnt lgkmcnt(0)" ::: "memory"); __builtin_amdgcn_s_barrier(); asm volatile("" ::: "memory"); } while (0)
__device__ __forceinline__ int tid_opaque() { int t = threadIdx.x; asm volatile("" : "+v"(t)); return t; }

struct TItem { const float* src; bf16_t* dst; int ldw, o0, K, mode; };
constexpr int TI_IN = 32 * 84, TI_OUT = 32 * 32, TI_F1 = 32 * 128, TI_F2 = 128 * 32, TI_L = TI_IN + TI_OUT + TI_F1 + TI_F2;
__device__ __forceinline__ TItem titem_decode(ptab_t pt, int it) {
    unsigned char* ws = PWS; TItem t; t.mode = 0;
    const int l = it / TI_L; int r = it - l * TI_L; const float* W; bf16_t* WT; int kb, nbk;
    if (r < TI_IN) { kb = r / 84; nbk = r % 84; const int n0 = 64 * nbk; W = PIN(12) + (size_t)l * 2048 * INC; WT = (bf16_t*)(ws + WS_WIN) + (size_t)l * PNW * 2048; t.ldw = INC; t.K = 2048;
        t.o0 = n0 < 1536 ? n0 : n0 + 32; t.mode = n0 < 5120 ? 0 : (n0 == 5120 ? 1 : 2); }
    else if ((r -= TI_IN) < TI_OUT) { kb = r / 32; nbk = r % 32; W = PIN(22) + (size_t)l * 2048 * 2048; WT = (bf16_t*)(ws + WS_WOUT) + (size_t)l * 2048 * 2048; t.ldw = 2048; t.K = 2048; t.o0 = 64 * nbk; }
    else if ((r -= TI_OUT) < TI_F1) { kb = r / 128; nbk = r % 128; W = PIN(23) + (size_t)l * 2048 * 8192; WT = (bf16_t*)(ws + WS_WFF1) + (size_t)l * 8192 * 2048; t.ldw = 8192; t.K = 2048; t.o0 = 64 * nbk; }
    else { r -= TI_F1; kb = r / 32; nbk = r % 32; W = PIN(24) + (size_t)l * 8192 * 2048; WT = (bf16_t*)(ws + WS_WFF2) + (size_t)l * 2048 * 8192; t.ldw = 2048; t.K = 8192; t.o0 = 64 * nbk; }
    t.src = W + (size_t)(64 * kb) * t.ldw; t.dst = WT + (size_t)(64 * nbk) * t.K + 64 * kb;
    return t;
}
__device__ __forceinline__ void titem_load(const TItem& t, f32x4 (&v)[16], int lane) {
    const int krow = lane >> 4, n4 = (lane & 15) * 4;
    if (t.mode == 0) {
#pragma unroll
        for (int i = 0; i < 16; ++i) v[i] = __builtin_nontemporal_load((const f32x4*)(t.src + (size_t)(4 * i + krow) * t.ldw + t.o0 + n4)); }
}
__device__ __forceinline__ void titem_store(const TItem& t, const f32x4 (&v)[16], LAS float* scr, int lane) {
    const int krow = lane >> 4, n4 = (lane & 15) * 4;
    if (t.mode == 0) {
#pragma unroll
        for (int i = 0; i < 16; ++i) { LAS float* s = scr + (4 * i + krow) * 65 + n4; s[0] = v[i].x; s[1] = v[i].y; s[2] = v[i].z; s[3] = v[i].w; }
    } else {
#pragma unroll 4
        for (int i = 0; i < 16; ++i) { LAS float* s = scr + (4 * i + krow) * 65 + n4;
#pragma unroll
            for (int e = 0; e < 4; ++e) { const int c = n4 + e; float x = 0.f;
                if (t.mode == 1 && c < 48) x = t.src[(size_t)(4 * i + krow) * t.ldw + (c < 32 ? 1536 + c : 5152 + (c - 32))];
                s[e] = x; } }
    }
    LDS_WAIT(); asm volatile("" ::: "memory");
    const int c8 = lane & 7;
#pragma unroll
    for (int j = 0; j < 8; ++j) { const int n = (lane >> 3) + 8 * j; const LAS float* s = scr + (8 * c8) * 65 + n;
        u32x4 o; o.x = pk2(s[0 * 65], s[1 * 65]); o.y = pk2(s[2 * 65], s[3 * 65]); o.z = pk2(s[4 * 65], s[5 * 65]); o.w = pk2(s[6 * 65], s[7 * 65]);
        *(u32x4*)(t.dst + (size_t)n * t.K + 8 * c8) = o; }
    LDS_WAIT(); asm volatile("" ::: "memory");
}
__device__ __forceinline__ void do_transposes(ptab_t pt, LAS unsigned char* lds, int first, int count, int worker, int n_workers) {
    const int tid = tid_opaque(), lane = tid & 63, wave = __builtin_amdgcn_readfirstlane(tid >> 6);
    LAS float* scr = (LAS float*)(lds + wave * 16640);
    const int end = first + count; int it = first + worker;
    if (it >= end) return;
    f32x4 va[16], vb[16];
    TItem A = titem_decode(pt, it), B = A; titem_load(A, va, lane);
    for (;;) {
        int itn = it + n_workers; bool has = itn < end;
        if (has) { B = titem_decode(pt, itn); titem_load(B, vb, lane); }
        titem_store(A, va, scr, lane);
        if (!has) break;
        it = itn; itn = it + n_workers; has = itn < end;
        if (has) { A = titem_decode(pt, itn); titem_load(A, va, lane); }
        titem_store(B, vb, scr, lane);
        if (!has) break;
        it = itn;
    }
}
__device__ __forceinline__ void p0_prologue(ptab_t pt, LAS unsigned char* lds, int bid, int nb, bool do_mods) {
    const int tid = tid_opaque(), lane = tid & 63, wave = __builtin_amdgcn_readfirstlane(tid >> 6);
    unsigned char* ws = PWS;
    do_transposes(pt, lds, 0, TI_L, bid * 8 + wave, nb * 8);
    do_transposes(pt, lds, TI_L + TI_IN + TI_OUT + TI_F1, TI_F2 / 4, bid * 8 + wave, nb * 8);
    __syncthreads();
    if (do_mods) {
        LAS float* sc = (LAS float*)lds;
        LAS float* red = (LAS float*)(lds + 40960);
        float* mods = (float*)(ws + WS_MODS);
        for (int idx = tid; idx < 5 * 2048; idx += 512) { const int j = idx >> 11, k = idx & 2047; const float cv = (j == 0) ? PIN(7)[k] : PIN(6)[(j - 1) * 2048 + k]; sc[idx] = silu_f(cv); }
        __syncthreads();
        const bool act = lane < 48; const int half = act ? lane / 24 : 0, c4 = act ? (lane % 24) * 4 : 0;
        for (int it = bid; it < 256; it += nb) {
            const int l = it >> 7, nc = it & 127;
            const float* Wp = PIN(10) + ((size_t)l * 2048 + wave * 256 + half) * NMOD + nc * 96 + c4;
            f32x4 acc[5];
#pragma unroll
            for (int j = 0; j < 5; ++j) acc[j] = (f32x4){0.f, 0.f, 0.f, 0.f};
#pragma unroll 12
            for (int i = 0; i < 128; ++i) { const f32x4 w = __builtin_nontemporal_load((const f32x4*)(Wp + (size_t)(2 * i) * NMOD)); const int row = wave * 256 + 2 * i + half;
#pragma unroll
                for (int j = 0; j < 5; ++j) acc[j] += sc[j * 2048 + row] * w; }
            if (act) {
#pragma unroll
                for (int j = 0; j < 5; ++j) *(LAS f32x4*)(red + ((wave * 2 + half) * 5 + j) * 96 + c4) = acc[j]; }
            __syncthreads();
            if (tid < 480) { const int j = tid / 96, col = tid % 96; float s = PIN(11)[(size_t)l * NMOD + nc * 96 + col];
#pragma unroll
                for (int g = 0; g < 16; ++g) s += red[(g * 5 + j) * 96 + col];
                mods[((size_t)l * 5 + j) * NMOD + nc * 96 + col] = s; }
            __syncthreads();
        }
    }
}

__device__ __forceinline__ void norm_phase(const float* x0, const float* x1, const float* g, const float* mods_l, int shift_i, int scale_i, bf16_t* H, int bid, int nb) {
    const int tid = tid_opaque(), lane = tid & 63, wave = tid >> 6;
    constexpr int NR = 4; const int qrows = NTOK / NR;
    for (int r0 = bid * 8 + wave; r0 < qrows; r0 += nb * 8) {
        f32x4 v[NR][8]; float ss[NR];
#pragma unroll
        for (int u = 0; u < NR; ++u) { const int r = r0 + u * qrows; const float* xr = (r < 4096 ? x0 : x1) + (size_t)r * DM;
#pragma unroll
            for (int j = 0; j < 8; ++j) v[u][j] = __builtin_nontemporal_load((const f32x4*)(xr + 4 * (lane + 64 * j))); }
#pragma unroll
        for (int u = 0; u < NR; ++u) { ss[u] = 0.f;
#pragma unroll
            for (int j = 0; j < 8; ++j) ss[u] += (v[u][j].x * v[u][j].x + v[u][j].y * v[u][j].y) + (v[u][j].z * v[u][j].z + v[u][j].w * v[u][j].w); }
        wave_sum_n<NR>(ss);
#pragma unroll
        for (int u = 0; u < NR; ++u) { const int r = r0 + u * qrows; const float rstd = rsqrtf(ss[u] * (1.f / DM) + EPS);
            const int cond = r < 4096 ? 0 : 1 + ((r - 4096) >> 10);
            const float* sh = mods_l + ((size_t)cond * 6 + shift_i) * DM; const float* sc = mods_l + ((size_t)cond * 6 + scale_i) * DM;
#pragma unroll
            for (int j = 0; j < 8; ++j) { const int col = 4 * (lane + 64 * j); const f32x4 gg = *(const f32x4*)(g + col), s = *(const f32x4*)(sc + col), h = *(const f32x4*)(sh + col);
                const f32x4 o = v[u][j] * rstd * gg * (s + 1.f) + h; u32x2 w; w.x = pk2(o.x, o.y); w.y = pk2(o.z, o.w); *(u32x2*)(H + (size_t)r * DM + col) = w; } }
    }
}

__device__ __forceinline__ void bias_phase(const float* shift  , const bf16_t* WT, int N, float* out  , LAS unsigned char* lds, int bid, int nb) {
    const int tid = tid_opaque(), lane = tid & 63, wave = tid >> 6;
    LAS float* sh = (LAS float*)(lds + 65536);
    for (int idx = tid; idx < 5 * 2048; idx += 512) sh[idx] = shift[(size_t)(idx >> 11) * 6 * 2048 + (idx & 2047)];
    __syncthreads();
    const int NGW = nb * 8; constexpr int NC_ = 3;
    for (int n0 = bid * 8 + wave; n0 < N; n0 += NC_ * NGW) {
        u32x4 w[NC_][4]; float a[NC_][5];
#pragma unroll
        for (int u = 0; u < NC_; ++u) { const int n = n0 + u * NGW < N ? n0 + u * NGW : n0; const bf16_t* row = WT + (size_t)n * 2048;
#pragma unroll
            for (int j = 0; j < 4; ++j) w[u][j] = *(const u32x4*)(row + (j * 64 + lane) * 8);
#pragma unroll
            for (int c = 0; c < 5; ++c) a[u][c] = 0.f; }
#pragma unroll
        for (int j = 0; j < 4; ++j) { const int k0 = (j * 64 + lane) * 8;
#pragma unroll
            for (int c = 0; c < 5; ++c) { const f32x4 s0 = *(const LAS f32x4*)(sh + c * 2048 + k0), s1 = *(const LAS f32x4*)(sh + c * 2048 + k0 + 4);
#pragma unroll
                for (int u = 0; u < NC_; ++u) { const u32x4 ww = w[u][j];
                    a[u][c] += (bflo(ww.x) * s0.x + bfhi(ww.x) * s0.y) + (bflo(ww.y) * s0.z + bfhi(ww.y) * s0.w) + (bflo(ww.z) * s1.x + bfhi(ww.z) * s1.y) + (bflo(ww.w) * s1.z + bfhi(ww.w) * s1.w); } } }
        float f[5 * NC_];
#pragma unroll
        for (int u = 0; u < NC_; ++u)
#pragma unroll
            for (int c = 0; c < 5; ++c) f[u * 5 + c] = a[u][c];
        wave_sum_n<5 * NC_>(f);
#pragma unroll
        for (int u = 0; u < NC_; ++u) { const int n = n0 + u * NGW;
            if (n < N && lane < 5) out[(size_t)lane * N + n] = lane == 0 ? f[u * 5] : (lane == 1 ? f[u * 5 + 1] : (lane == 2 ? f[u * 5 + 2] : (lane == 3 ? f[u * 5 + 3] : f[u * 5 + 4]))); }
    }
    __syncthreads();
}

struct PrepPtrs { const bf16_t* P; const float* G; bf16_t* QN; bf16_t* KB; bf16_t* VB; float* LA; bf16_t* DQKV; float* GB; float* out_ck; float* out_cv; const float* cw; const float* alog; const float* dtb; };
template <int N> __device__ __forceinline__ void group16_sum_n(float (&v)[N]) {
#pragma unroll
    for (int i = 0; i < N; ++i) v[i] = row16_sum(v[i]);
}
__device__ __forceinline__ void unpack8(const u32x4 w, float (&x)[8]) { x[0] = bflo(w.x); x[1] = bfhi(w.x); x[2] = bflo(w.y); x[3] = bfhi(w.y); x[4] = bflo(w.z); x[5] = bfhi(w.z); x[6] = bflo(w.w); x[7] = bfhi(w.w); }
__device__ __forceinline__ u32x4 pack8(const float (&x)[8]) { u32x4 w; w.x = pk2(x[0], x[1]); w.y = pk2(x[2], x[3]); w.z = pk2(x[4], x[5]); w.w = pk2(x[6], x[7]); return w; }
template <bool LAT, int NT>
__device__ __forceinline__ void prep_tok(const int (&r)[NT], int l, int lane, const PrepPtrs& pp, const LAS float* w2s, const float* qgp, const float* kgp) {
    const int g = lane >> 4, sub = lane & 15;
    int bq[NT], tq[NT]; const bf16_t* Pr[NT];
#pragma unroll
    for (int u = 0; u < NT; ++u) { const int rr = LAT ? r[u] - 4096 : r[u]; bq[u] = LAT ? rr >> 10 : rr >> 8; tq[u] = LAT ? rr & 1023 : rr & 255; Pr[u] = pp.P + (size_t)r[u] * PLD; }
    const int L = LAT ? 1024 : 256;
    float lrv[NT][2], gav[NT], gbv[NT];
    const float ymf = tq[0] > 0 ? 1.f : 0.f, ypl = tq[NT - 1] < L - 1 ? 1.f : 0.f;
    const bf16_t* Pm0 = tq[0] > 0 ? Pr[0] - PLD : Pr[0]; const bf16_t* PpL = tq[NT - 1] < L - 1 ? Pr[NT - 1] + PLD : Pr[NT - 1];
    u32x4 xa[NT + 2], xb2[NT + 2];
    auto conv_load = [&](int j, u32x4 (&x)[NT + 2]) { const int c = j * 512 + lane * 8;
#pragma unroll
        for (int u = 0; u < NT; ++u) x[u + 1] = *(const u32x4*)(Pr[u] + 3072 + c);
        x[0] = *(const u32x4*)(Pm0 + 3072 + c); x[NT + 1] = *(const u32x4*)(PpL + 3072 + c); };
    {
        u32x4 xw[NT][3];
#pragma unroll
        for (int u = 0; u < NT; ++u)
#pragma unroll
            for (int j = 0; j < 3; ++j) xw[u][j] = __builtin_nontemporal_load((const u32x4*)(Pr[u] + 1536 + j * 512 + lane * 8));
#pragma unroll
        for (int u = 0; u < NT; ++u) { lrv[u][0] = pp.G[(size_t)r[u] * 64 + sub]; lrv[u][1] = pp.G[(size_t)r[u] * 64 + 16 + sub]; gav[u] = pp.G[(size_t)r[u] * 64 + 32 + (lane & 7)]; gbv[u] = pp.G[(size_t)r[u] * 64 + 40 + (lane & 7)]; }
        const float sgn = (sub & 4) ? 1.f : -1.f;
        float cs[NT][8], sn[NT][8];
        if (LAT) {
#pragma unroll
            for (int e = 0; e < 8; ++e) { const float inv = exp2f(-(float)((sub & 3) * 8 + e) * (13.287712379549449f / 32.f));
#pragma unroll
                for (int u = 0; u < NT; ++u) { const float a = (float)(sub < 8 ? tq[u] >> 6 : tq[u] & 63) * inv; cs[u][e] = __cosf(a); sn[u][e] = __sinf(a); } } }
#pragma unroll
        for (int j = 0; j < 3; ++j) {
            float gn[8]; { const float* gp = (j < 2 ? qgp : kgp) + sub * 8; const f32x4 g0 = *(const f32x4*)gp, g1 = *(const f32x4*)(gp + 4);
#pragma unroll
                for (int e = 0; e < 4; ++e) { gn[e] = g0[e]; gn[4 + e] = g1[e]; } }
            float ss[NT];
#pragma unroll
            for (int u = 0; u < NT; ++u) { float x[8]; unpack8(xw[u][j], x); float s = 0.f;
#pragma unroll
                for (int e = 0; e < 8; ++e) s += x[e] * x[e];
                ss[u] = s; }
            group16_sum_n<NT>(ss);
#pragma unroll
            for (int u = 0; u < NT; ++u) { float x[8], y[8]; unpack8(xw[u][j], x); const float rstd = rsqrtf(ss[u] * (1.f / 128.f) + EPS);
                const size_t krow = LAT ? ((size_t)4096 + (size_t)bq[u] * 1280 + 256 + tq[u]) : (size_t)r[u];
#pragma unroll
                for (int e = 0; e < 8; ++e) y[e] = x[e] * rstd * gn[e];
                if (!LAT && j == 2) {
                    float* dst = (g < 2 ? pp.out_ck : pp.out_cv) + ((((size_t)bq[u] * 2 + l) * 256 + tq[u]) * 2 + (g & 1)) * 128 + sub * 8;
                    f32x4 o0, o1;
#pragma unroll
                    for (int e = 0; e < 4; ++e) { o0[e] = g < 2 ? y[e] : x[e]; o1[e] = g < 2 ? y[4 + e] : x[4 + e]; }
                    __builtin_nontemporal_store(o0, (f32x4*)dst); __builtin_nontemporal_store(o1, (f32x4*)(dst + 4)); }
                if (LAT) {
#pragma unroll
                    for (int e = 0; e < 8; ++e) { const float p = __shfl_xor(y[e], 4); y[e] = y[e] * cs[u][e] + sgn * p * sn[u][e]; } }
                if (j < 2) *(u32x4*)(pp.QN + (size_t)r[u] * 1024 + j * 512 + lane * 8) = pack8(y);
                else { bf16_t* dst = (g < 2 ? pp.KB : pp.VB) + krow * 256 + (g & 1) * 128 + sub * 8; const u32x4 yk = pack8(y); *(u32x4*)dst = g < 2 ? yk : xw[u][2]; } }
            asm volatile("" ::: "memory");
        }
    }
    conv_load(0, xa);
#pragma unroll
    for (int d = 0; d < 2; ++d) {
        f32x4 a[NT]; const f32x4 b0 = *(const LAS f32x4*)(w2s + 8192 + d * 256 + lane * 4);
#pragma unroll
        for (int u = 0; u < NT; ++u) a[u] = b0;
#pragma unroll
        for (int q = 0; q < 16; ++q) { const f32x4 w = *(const LAS f32x4*)(w2s + (d * 16 + q) * 256 + lane * 4);
#pragma unroll
            for (int u = 0; u < NT; ++u) a[u] += __builtin_bit_cast(float, __builtin_amdgcn_readlane(__builtin_bit_cast(int, lrv[u][d]), q)) * w; }
#pragma unroll
        for (int u = 0; u < NT; ++u) { f32x4 o;
#pragma unroll
            for (int e = 0; e < 4; ++e) o[e] = logsigmoid_f(a[u][e]) * (1.f / 16.f);
            *(f32x4*)(pp.LA + (size_t)r[u] * 512 + d * 256 + lane * 4) = o; }
    }
    {
        auto conv_group = [&](int j, const u32x4 (&x)[NT + 2]) { const int c = j * 512 + lane * 8;
            float w0[8], w1[8], w2[8];
#pragma unroll
            for (int q = 0; q < 2; ++q) { const f32x4 a0 = *(const f32x4*)(pp.cw + c + 4 * q), a1 = *(const f32x4*)(pp.cw + 1536 + c + 4 * q), a2 = *(const f32x4*)(pp.cw + 3072 + c + 4 * q);
#pragma unroll
                for (int e = 0; e < 4; ++e) { w0[4 * q + e] = a0[e]; w1[4 * q + e] = a1[e]; w2[4 * q + e] = a2[e]; } }
            float y[NT][8], ss[NT];
#pragma unroll
            for (int u = 0; u < NT; ++u) { float am[8], ac[8], ap[8]; unpack8(x[u], am); unpack8(x[u + 1], ac); unpack8(x[u + 2], ap); float s = 0.f;
                const float ym = u == 0 ? ymf : 1.f, yp = u == NT - 1 ? ypl : 1.f;
#pragma unroll
                for (int e = 0; e < 8; ++e) { const float v = silu_f(w0[e] * am[e] * ym + w1[e] * ac[e] + w2[e] * ap[e] * yp); y[u][e] = v; s += v * v; }
                ss[u] = s; }
            if (j < 2) { group16_sum_n<NT>(ss);
#pragma unroll
                for (int u = 0; u < NT; ++u) { const float sc = rsqrtf(ss[u] + EPS) * (j == 0 ? 0.08838834764831845f : 1.f);
#pragma unroll
                    for (int e = 0; e < 8; ++e) y[u][e] *= sc; } }
#pragma unroll
            for (int u = 0; u < NT; ++u) *(u32x4*)(pp.DQKV + (size_t)r[u] * 1536 + c) = pack8(y[u]); };
        conv_load(1, xb2); conv_group(0, xa); asm volatile("" ::: "memory");
        conv_load(2, xa);  conv_group(1, xb2); asm volatile("" ::: "memory");
        conv_group(2, xa);
    }
    if (lane < 8) {
#pragma unroll
        for (int u = 0; u < NT; ++u) { const float a = gav[u], bb = gbv[u];
            pp.GB[(size_t)r[u] * 16 + lane] = -__expf(pp.alog[l * 8 + lane]) * softplus_f(a + pp.dtb[l * 8 + lane]); pp.GB[(size_t)r[u] * 16 + 8 + lane] = 1.f / (1.f + __expf(-bb)); } }
}
__device__ __forceinline__ void prep_phase(ptab_t pt, int l, LAS unsigned char* lds, int bid, int nb) {
    const int tid = tid_opaque(), lane = tid & 63, wave = tid >> 6;
    unsigned char* ws = PWS;
    PrepPtrs pp; pp.P = (const bf16_t*)(ws + WS_P); pp.G = (const float*)(ws + WS_G); pp.QN = (bf16_t*)(ws + WS_QN); pp.KB = (bf16_t*)(ws + WS_KB); pp.VB = (bf16_t*)(ws + WS_VB);
    pp.LA = (float*)(ws + WS_LA); pp.DQKV = (bf16_t*)(ws + WS_DQKV); pp.GB = (float*)(ws + WS_GB); pp.out_ck = POUT + OUT_CK; pp.out_cv = POUT + OUT_CV;
    pp.cw = PIN(18) + (size_t)l * 3 * 1536; pp.alog = PIN(19); pp.dtb = PIN(20);
    LAS float* w2s = (LAS float*)lds;
    for (int i = tid; i < 8192; i += 512) w2s[i] = PIN(13)[(size_t)l * 8192 + i];
    for (int i = tid; i < 512; i += 512) w2s[8192 + i] = PIN(14)[(size_t)l * 512 + i];
    for (int i = bid * 512 + tid; i < 65536; i += nb * 512) { const int b = i >> 14, rem = i & 16383, pq = rem >> 6, c4 = rem & 63;
        const size_t srcx = (((size_t)b * 2 + l) * 256 + pq) * 256 + c4 * 4, dst = ((size_t)4096 + (size_t)b * 1280 + pq) * 256 + c4 * 4;
        const f32x4 k4 = __builtin_nontemporal_load((const f32x4*)(PIN(2) + srcx)), v4 = __builtin_nontemporal_load((const f32x4*)(PIN(3) + srcx));
        u32x2 kw, vw; kw.x = pk2(k4.x, k4.y); kw.y = pk2(k4.z, k4.w); vw.x = pk2(v4.x, v4.y); vw.y = pk2(v4.z, v4.w);
        *(u32x2*)(pp.KB + dst) = kw; *(u32x2*)(pp.VB + dst) = vw; }
    __syncthreads();
    const float* qgp = PIN(16) + l * 128; const float* kgp = PIN(17) + l * 128;
    constexpr int NT = PREP_NT, RQ = 4096 / NT;
    const int gw = bid * 8 + wave, NGW = nb * 8, HW = NGW >> 1;
    if (gw < HW) {
#pragma unroll 1
        for (int r = gw; r < RQ; r += HW) { int rc[NT];
#pragma unroll
            for (int u = 0; u < NT; ++u) rc[u] = NT * r + u;
            prep_tok<false, NT>(rc, l, lane, pp, w2s, qgp, kgp); } }
    else {
#pragma unroll 1
        for (int r = gw - HW; r < RQ; r += HW) { int rl[NT];
#pragma unroll
            for (int u = 0; u < NT; ++u) rl[u] = 4096 + NT * r + u;
            prep_tok<true, NT>(rl, l, lane, pp, w2s, qgp, kgp); } }
}

__device__ __forceinline__ void gla_naive_item(ptab_t pt, int l, bool lat, int b, int h, int d, LAS float* red) {
    const int tid = tid_opaque(), vq = tid & 127, kg = tid >> 7;
    unsigned char* ws = PWS;
    const bf16_t* P = (const bf16_t*)(ws + WS_P); const float* LA = (const float*)(ws + WS_LA); float* OG = (float*)(ws + WS_OG);
    const int L = lat ? 1024 : 256, rowbase = lat ? 4096 + b * 1024 : b * 256;
    float S[16];
    const size_t sidx = ((((size_t)b * 2 + l) * 2 + d) * 4 + h) * 8192 + (size_t)(kg * 16) * 128 + vq;
#pragma unroll
    for (int j = 0; j < 16; ++j) S[j] = lat ? PIN(4)[sidx + j * 128] : 0.f;
    f32x4 la[4], nla[4]; u32x4 kq[4], nkq[4]; unsigned short vv, nvv;
#define GLA_LOAD(LAv, KQv, Vv, step) do { const int t_ = d ? L - 1 - (step) : (step); const size_t r_ = (size_t)(rowbase + t_); \
        const float* lp_ = LA + r_ * 512 + d * 256 + h * 64 + kg * 16; const bf16_t* pr_ = P + r_ * PLD; \
        _Pragma("unroll") for (int j_ = 0; j_ < 4; ++j_) LAv[j_] = *(const f32x4*)(lp_ + 4 * j_); \
        KQv[0] = *(const u32x4*)(pr_ + 256 + h * 64 + kg * 16); KQv[1] = *(const u32x4*)(pr_ + 256 + h * 64 + kg * 16 + 8); \
        KQv[2] = *(const u32x4*)(pr_ + h * 64 + kg * 16); KQv[3] = *(const u32x4*)(pr_ + h * 64 + kg * 16 + 8); Vv = pr_[512 + h * 128 + vq]; } while (0)
    GLA_LOAD(la, kq, vv, 0);
    for (int step = 0; step < L; ++step) {
        const int sn = step + 1 < L ? step + 1 : step;
        GLA_LOAD(nla, nkq, nvv, sn);
        const float v = bf2f(vv); float part = 0.f;
#pragma unroll
        for (int j = 0; j < 16; ++j) { const unsigned kw = kq[j >> 3][(j >> 1) & 3], qw = kq[2 + (j >> 3)][(j >> 1) & 3];
            const float kk = (j & 1) ? bfhi(kw) : bflo(kw), qq = (j & 1) ? bfhi(qw) : bflo(qw);
            S[j] = __expf(la[j >> 2][j & 3]) * S[j] + kk * v; part += S[j] * qq; }
        red[((step & 1) * 4 + kg) * 128 + vq] = part * 0.125f;
        __syncthreads();
        if (kg == 0) { const LAS float* rp = red + (step & 1) * 512 + vq; const int t = d ? L - 1 - step : step;
            OG[((size_t)d * NTOK + rowbase + t) * 512 + h * 128 + vq] = (rp[0] + rp[128]) + (rp[256] + rp[384]); }
#pragma unroll
        for (int j = 0; j < 4; ++j) { la[j] = nla[j]; kq[j] = nkq[j]; } vv = nvv;
    }
#undef GLA_LOAD
    if (!lat) {
#pragma unroll
        for (int j = 0; j < 16; ++j) POUT[OUT_SG + sidx + j * 128] = S[j]; }
    __syncthreads();
}
__device__ __forceinline__ void dn_naive_item(ptab_t pt, int l, bool lat, int b, int h, int d, LAS float* red) {
    const int tid = tid_opaque(), vq = tid & 127, kg = tid >> 7;
    unsigned char* ws = PWS;
    const bf16_t* DQKV = (const bf16_t*)(ws + WS_DQKV); const float* GB = (const float*)(ws + WS_GB); float* OD = (float*)(ws + WS_OD);
    const int L = lat ? 1024 : 256, rowbase = lat ? 4096 + b * 1024 : b * 256;
    LAS float* redR = red; LAS float* redO = red + 1024;
    float S[32];
    const size_t sidx = ((((size_t)b * 2 + l) * 2 + d) * 4 + h) * 16384 + (size_t)(kg * 32) * 128 + vq;
#pragma unroll
    for (int j = 0; j < 32; ++j) S[j] = lat ? PIN(5)[sidx + j * 128] : 0.f;
    u32x4 kq[8], nkq[8]; unsigned short vv, nvv; float gg, ngg, be, nbe;
#define DN_LOAD(KQv, Vv, Gv, Bv, step) do { const int t_ = d ? L - 1 - (step) : (step); const size_t r_ = (size_t)(rowbase + t_); const bf16_t* pr_ = DQKV + r_ * 1536; \
        _Pragma("unroll") for (int j_ = 0; j_ < 4; ++j_) { KQv[j_] = *(const u32x4*)(pr_ + 512 + h * 128 + kg * 32 + 8 * j_); KQv[4 + j_] = *(const u32x4*)(pr_ + h * 128 + kg * 32 + 8 * j_); } \
        Vv = pr_[1024 + h * 128 + vq]; Gv = GB[r_ * 16 + d * 4 + h]; Bv = GB[r_ * 16 + 8 + d * 4 + h]; } while (0)
    DN_LOAD(kq, vv, gg, be, 0);
    for (int step = 0; step < L; ++step) {
        const int sn = step + 1 < L ? step + 1 : step;
        DN_LOAD(nkq, nvv, ngg, nbe, sn);
        float kf[32], rp = 0.f;
#pragma unroll
        for (int j = 0; j < 32; ++j) { const unsigned kw = kq[j >> 3][(j >> 1) & 3]; kf[j] = (j & 1) ? bfhi(kw) : bflo(kw); rp += kf[j] * S[j]; }
        redR[((step & 1) * 4 + kg) * 128 + vq] = rp;
        __syncthreads();
        if (step > 0 && kg == 0) { const LAS float* op = redO + ((step - 1) & 1) * 512 + vq; const int t = d ? L - step : step - 1;
            OD[((size_t)d * NTOK + rowbase + t) * 512 + h * 128 + vq] = (op[0] + op[128]) + (op[256] + op[384]); }
        const LAS float* rr = redR + (step & 1) * 512 + vq;
        const float rs = (rr[0] + rr[128]) + (rr[256] + rr[384]);
        const float eg = __expf(gg), w = be * (bf2f(vv) - eg * rs);
        float op = 0.f;
#pragma unroll
        for (int j = 0; j < 32; ++j) { const unsigned qw = kq[4 + (j >> 3)][(j >> 1) & 3]; const float qq = (j & 1) ? bfhi(qw) : bflo(qw);
            S[j] = eg * S[j] + kf[j] * w; op += qq * S[j]; }
        redO[((step & 1) * 4 + kg) * 128 + vq] = op;
#pragma unroll
        for (int j = 0; j < 8; ++j) kq[j] = nkq[j];
        vv = nvv; gg = ngg; be = nbe;
    }
#undef DN_LOAD
    __syncthreads();
    if (kg == 0) { const LAS float* op = redO + ((L - 1) & 1) * 512 + vq; const int t = d ? 0 : L - 1;
        OD[((size_t)d * NTOK + rowbase + t) * 512 + h * 128 + vq] = (op[0] + op[128]) + (op[256] + op[384]); }
    if (!lat) {
#pragma unroll
        for (int j = 0; j < 32; ++j) POUT[OUT_SD + sidx + j * 128] = S[j]; }
    __syncthreads();
}

typedef short bf16x8 __attribute__((ext_vector_type(8)));
typedef float f32x16 __attribute__((ext_vector_type(16)));
__device__ __forceinline__ int crow(int r, int hi) { return (r & 3) + 8 * (r >> 2) + 4 * hi; }
template <int K>
__device__ __forceinline__ f32x16 mm_tile(const LAS bf16_t* A, int lda, const LAS bf16_t* Bt, int ldb, int tm, int tn, int lane, f32x16 acc) {
    const int r32 = lane & 31, hi = lane >> 5;
    const LAS bf16_t* ap = A + (tm * 32 + r32) * lda + hi * 8; const LAS bf16_t* bp = Bt + (tn * 32 + r32) * ldb + hi * 8;
#pragma unroll
    for (int k0 = 0; k0 < K; k0 += 16) { const bf16x8 a = *(const LAS bf16x8*)(ap + k0), b = *(const LAS bf16x8*)(bp + k0); acc = __builtin_amdgcn_mfma_f32_32x32x16_bf16(a, b, acc, 0, 0, 0); }
    return acc;
}
template <int K>
__device__ __forceinline__ f32x16 mm_tile_ga(const bf16_t* A, int lda, const LAS bf16_t* Bt, int ldb, int tm, int tn, int lane, f32x16 acc) {
    const int r32 = lane & 31, hi = lane >> 5;
    const bf16_t* ap = A + (size_t)(tm * 32 + r32) * lda + hi * 8; const LAS bf16_t* bp = Bt + (tn * 32 + r32) * ldb + hi * 8;
    bf16x8 a[K / 16];
#pragma unroll
    for (int k = 0; k < K / 16; ++k) a[k] = *(const bf16x8*)(ap + 16 * k);
#pragma unroll
    for (int k = 0; k < K / 16; ++k) { const bf16x8 b = *(const LAS bf16x8*)(bp + 16 * k); acc = __builtin_amdgcn_mfma_f32_32x32x16_bf16(a[k], b, acc, 0, 0, 0); }
    return acc;
}
__device__ __forceinline__ void acc_store_pk(unsigned* dst, const f32x16& acc, int lane) {
#pragma unroll
    for (int r2 = 0; r2 < 8; ++r2) dst[r2 * 64 + lane] = pk2(acc[2 * r2], acc[2 * r2 + 1]);
}
__device__ __forceinline__ void acc_load_pk(const unsigned* src, unsigned (&w)[8], int lane) {
#pragma unroll
    for (int r2 = 0; r2 < 8; ++r2) w[r2] = src[r2 * 64 + lane];
}
__device__ __forceinline__ void acc_to_ST(LAS bf16_t* ST, int ld, int row0, int col0, const f32x16& s, int lane) {
    const int r32 = lane & 31, hi = lane >> 5;
#pragma unroll
    for (int g = 0; g < 4; ++g) { u32x2 w; w.x = pk2(s[4 * g], s[4 * g + 1]); w.y = pk2(s[4 * g + 2], s[4 * g + 3]);
        *(LAS u32x2*)(ST + (col0 + r32) * ld + row0 + 8 * g + 4 * hi) = w; }
}
__device__ __forceinline__ void store_o_tile_pk(unsigned* dst, const f32x16& o, long long row0, int st, int col0  , int lane) {
    const int odd = lane & 1; long long wb = row0 * 256 + ((col0 + (lane & 31)) >> 1);
    asm volatile("" : "+v"(wb));
#pragma unroll
    for (int r2 = 0; r2 < 8; ++r2) { float a = o[2 * r2], b = o[2 * r2 + 1]; asm("" : "+v"(a), "+v"(b));
        const float send = odd ? a : b;
        const float recv = __builtin_bit_cast(float, __builtin_amdgcn_update_dpp(0, __builtin_bit_cast(int, send), 0xB1  , 0xF, 0xF, false));
        const unsigned w = pk2(odd ? recv : a, odd ? b : recv);
        const int r = 2 * r2 + odd; dst[wb + (long long)st * 256 * ((r & 3) + 8 * (r >> 2))] = w; }
}
constexpr int N_CH_UNITS = 1024;
struct UnitPre { u32x4 r[6]; float f[2]; };
__device__ __forceinline__ void unit_geom(int unit, int& d, int& h, bool& lat, int& c, int& L, int& rowbase) {
    d = unit & 1; h = (unit >> 1) & 3; const int slot = unit >> 3; lat = slot >= 64; const int b = lat ? (slot - 64) >> 4 : slot >> 2; c = lat ? (slot - 64) & 15 : slot & 3;
    L = lat ? 1024 : 256; rowbase = lat ? 4096 + b * 1024 : b * 256;
}
__device__ __forceinline__ void gla_unit_load(ptab_t pt, int unit, UnitPre& p) {
    const int tid = tid_opaque(); unsigned char* ws = PWS; const bf16_t* P = (const bf16_t*)(ws + WS_P); const float* LA = (const float*)(ws + WS_LA);
    int d, h, c, L, rowbase; bool lat; unit_geom(unit, d, h, lat, c, L, rowbase);
#pragma unroll
    for (int q = 0; q < 2; ++q) { const int idx = tid + 512 * q, i = idx >> 4, c4 = idx & 15; const int s = c * 64 + i, t = d ? L - 1 - s : s;
        p.r[q] = *(const u32x4*)(LA + (size_t)(rowbase + t) * 512 + d * 256 + h * 64 + c4 * 4); }
    { const int i = tid >> 3, k0 = (tid & 7) * 8, v0 = (tid & 7) * 16; const int s = c * 64 + i, t = d ? L - 1 - s : s; const bf16_t* Pr = P + (size_t)(rowbase + t) * PLD;
      p.r[2] = *(const u32x4*)(Pr + h * 64 + k0); p.r[3] = *(const u32x4*)(Pr + 256 + h * 64 + k0); p.r[4] = *(const u32x4*)(Pr + 512 + h * 128 + v0); p.r[5] = *(const u32x4*)(Pr + 512 + h * 128 + v0 + 8); }
    p.f[0] = 0.f; p.f[1] = 0.f;
}
__device__ __forceinline__ void dn_unit_load(ptab_t pt, int unit, UnitPre& p) {
    const int tid = tid_opaque(); unsigned char* ws = PWS; const bf16_t* DQKV = (const bf16_t*)(ws + WS_DQKV); const float* GB = (const float*)(ws + WS_GB);
    int d, h, c, L, rowbase; bool lat; unit_geom(unit, d, h, lat, c, L, rowbase);
    { const int i = tid >> 3, c16 = (tid & 7) * 16; const int s = c * 64 + i, t = d ? L - 1 - s : s; const bf16_t* pr = DQKV + (size_t)(rowbase + t) * 1536 + h * 128 + c16;
      p.r[0] = *(const u32x4*)(pr); p.r[1] = *(const u32x4*)(pr + 8); p.r[2] = *(const u32x4*)(pr + 512); p.r[3] = *(const u32x4*)(pr + 520); p.r[4] = *(const u32x4*)(pr + 1024); p.r[5] = *(const u32x4*)(pr + 1032); }
    { const int i = tid & 63; const int s = c * 64 + i, t = d ? L - 1 - s : s; const float* gp = GB + (size_t)(rowbase + t) * 16 + d * 4 + h; p.f[0] = gp[0]; p.f[1] = gp[8]; }
}
__device__ __forceinline__ void gla_chunk_unit(ptab_t pt, int unit, LAS unsigned char* lds, const UnitPre& pre) {
    const int tid = tid_opaque(), lane = tid & 63, wave = tid >> 6;
    unsigned char* ws = PWS;
    const bf16_t* P = (const bf16_t*)(ws + WS_P); const float* LA = (const float*)(ws + WS_LA);
    bf16_t* GQ = (bf16_t*)(ws + WS_GQ) + (size_t)unit * 4096; unsigned* GO = (unsigned*)(ws + WS_GO) + (size_t)unit * 4096; unsigned* GU = (unsigned*)(ws + WS_GU) + (size_t)unit * 4096; float* GD = (float*)(ws + WS_GD) + (size_t)unit * 64;
    const int d = unit & 1, h = (unit >> 1) & 3, slot = unit >> 3;
    const bool lat = slot >= 64; const int b = lat ? (slot - 64) >> 4 : slot >> 2, c = lat ? (slot - 64) & 15 : slot & 3;
    const int L = lat ? 1024 : 256, rowbase = lat ? 4096 + b * 1024 : b * 256;
    LAS float* Bs = (LAS float*)lds;
    LAS bf16_t* Qt = (LAS bf16_t*)(lds + 16640);
    LAS bf16_t* Kt = Qt + 64 * 72;
    LAS bf16_t* KhT = Kt + 64 * 72;
    LAS bf16_t* VT = KhT + 64 * 72;
    LAS bf16_t* Am = VT + 128 * 72;
#pragma unroll
    for (int q = 0; q < 2; ++q) { const int idx = tid + 512 * q, i = idx >> 4, c4 = idx & 15; const u32x4 v = pre.r[q];
        Bs[i * 65 + c4 * 4] = __uint_as_float(v.x); Bs[i * 65 + c4 * 4 + 1] = __uint_as_float(v.y); Bs[i * 65 + c4 * 4 + 2] = __uint_as_float(v.z); Bs[i * 65 + c4 * 4 + 3] = __uint_as_float(v.w); }
    LDS_BARRIER();
    {
        float v[8];
#pragma unroll
        for (int q = 0; q < 8; ++q) v[q] = Bs[lane * 65 + wave * 8 + q];
#pragma unroll
        for (int q = 0; q < 8; ++q) { float x = v[q];
            x += dpp_mov<0x111>(x); x += dpp_mov<0x112>(x); x += dpp_mov<0x114>(x); x += dpp_mov<0x118>(x);
            x += __builtin_bit_cast(float, __builtin_amdgcn_update_dpp(0, __builtin_bit_cast(int, x), 0x142, 0xA, 0xF, false));
            x += __builtin_bit_cast(float, __builtin_amdgcn_update_dpp(0, __builtin_bit_cast(int, x), 0x143, 0xC, 0xF, false));
            v[q] = x; }
#pragma unroll
        for (int q = 0; q < 8; ++q) Bs[lane * 65 + wave * 8 + q] = v[q];
    }
    LDS_BARRIER();
    { const int i = tid >> 3, k0 = (tid & 7) * 8;
      const u32x4 qw = pre.r[2], kw = pre.r[3];
      float qo[8], ko[8];
#pragma unroll
      for (int e = 0; e < 8; ++e) { const float bb = Bs[i * 65 + k0 + e], bl = Bs[63 * 65 + k0 + e];
          const float qv = (e & 1) ? bfhi(qw[e >> 1]) : bflo(qw[e >> 1]), kv = (e & 1) ? bfhi(kw[e >> 1]) : bflo(kw[e >> 1]);
          qo[e] = qv * 0.125f * __expf(bb); ko[e] = kv * __expf(-bb); KhT[(k0 + e) * 72 + i] = f2bf(kv * __expf(bl - bb)); }
      *(LAS u32x4*)(Qt + i * 72 + k0) = pack8(qo); *(LAS u32x4*)(Kt + i * 72 + k0) = pack8(ko);
      const int v0 = (tid & 7) * 16;
      const u32x4 va = pre.r[4], vb = pre.r[5];
#pragma unroll
      for (int e = 0; e < 8; ++e) { VT[(v0 + e) * 72 + i] = (bf16_t)((e & 1) ? (va[e >> 1] >> 16) : (va[e >> 1] & 0xffffu)); VT[(v0 + 8 + e) * 72 + i] = (bf16_t)((e & 1) ? (vb[e >> 1] >> 16) : (vb[e >> 1] & 0xffffu)); }
      if (tid < 64) GD[tid] = __expf(Bs[63 * 65 + tid]); }
    LDS_BARRIER();
    { f32x16 acc = {}; acc = mm_tile<64>(KhT, 72, VT, 72, wave >> 2, wave & 3, lane, acc); acc_store_pk(GU + wave * 512, acc, lane); }
    if (wave < 4) { f32x16 acc = {}; const int tm = wave >> 1, tn = wave & 1; acc = mm_tile<64>(Qt, 72, Kt, 72, tm, tn, lane, acc);
        const int r32 = lane & 31, hi = lane >> 5;
#pragma unroll
        for (int r = 0; r < 16; ++r) { const int i = tm * 32 + crow(r, hi), j = tn * 32 + r32; Am[i * 72 + j] = f2bf(j <= i ? acc[r] : 0.f); } }
    { const int i = tid >> 3, k0 = (tid & 7) * 8; *(u32x4*)(GQ + i * 64 + k0) = *(const LAS u32x4*)(Qt + i * 72 + k0); }
    LDS_BARRIER();
    { f32x16 acc = {}; acc = mm_tile<64>(Am, 72, VT, 72, wave >> 2, wave & 3, lane, acc); acc_store_pk(GO + wave * 512, acc, lane); }
    LDS_BARRIER();
}
__device__ __forceinline__ void gla_scan_item(ptab_t pt, int l, bool lat, int b, int h, int d, LAS unsigned char* lds) {
    const int tid = tid_opaque(), lane = tid & 63, wave = tid >> 6, r32 = lane & 31, hi = lane >> 5;
    unsigned char* ws = PWS;
    float* OG = (float*)(ws + WS_OG);
    const int L = lat ? 1024 : 256, rowbase = lat ? 4096 + b * 1024 : b * 256, nch = L >> 6, slot0 = lat ? 64 + b * 16 : b * 4;
    const int tm = wave >> 2, tn = wave & 3;
    LAS bf16_t* ST = (LAS bf16_t*)lds;
    f32x16 S;
    const size_t sbase = ((((size_t)b * 2 + l) * 2 + d) * 4 + h) * 8192;
#pragma unroll
    for (int r = 0; r < 16; ++r) S[r] = lat ? __builtin_nontemporal_load(PIN(4) + sbase + (size_t)(tm * 32 + crow(r, hi)) * 128 + tn * 32 + r32) : 0.f;
    unsigned ow[8], uw[8], now[8], nuw[8]; float dec[16], ndec[16]; bf16x8 qa[4], nqa[4];
#define GLA_SLOAD(OW, UW, DEC, QA, cc) do { const int unit_ = ((slot0 + (cc)) * 4 + h) * 2 + d; \
        acc_load_pk((const unsigned*)(ws + WS_GO) + (size_t)unit_ * 4096 + wave * 512, OW, lane); acc_load_pk((const unsigned*)(ws + WS_GU) + (size_t)unit_ * 4096 + wave * 512, UW, lane); \
        const float* gd_ = (const float*)(ws + WS_GD) + (size_t)unit_ * 64; _Pragma("unroll") for (int r_ = 0; r_ < 16; ++r_) DEC[r_] = gd_[tm * 32 + crow(r_, hi)]; \
        const bf16_t* gq_ = (const bf16_t*)(ws + WS_GQ) + (size_t)unit_ * 4096 + (size_t)(tm * 32 + r32) * 64 + hi * 8; _Pragma("unroll") for (int k_ = 0; k_ < 4; ++k_) QA[k_] = *(const bf16x8*)(gq_ + 16 * k_); } while (0)
    GLA_SLOAD(ow, uw, dec, qa, 0);
    GLA_SLOAD(now, nuw, ndec, nqa, 1);
#define GLA_STEP(c, OW, UW, DEC, QA) do { \
        acc_to_ST(ST, 72, tm * 32, tn * 32, S, lane); \
        LDS_BARRIER(); \
        f32x16 o; \
        _Pragma("unroll") for (int r2 = 0; r2 < 8; ++r2) { o[2 * r2] = bflo(OW[r2]); o[2 * r2 + 1] = bfhi(OW[r2]); } \
        { const LAS bf16_t* bp = ST + (tn * 32 + r32) * 72 + hi * 8; \
          _Pragma("unroll") for (int k = 0; k < 4; ++k) { const bf16x8 bb = *(const LAS bf16x8*)(bp + 16 * k); o = __builtin_amdgcn_mfma_f32_32x32x16_bf16(QA[k], bb, o, 0, 0, 0); } } \
        { const int s0_ = (c) * 64 + tm * 32 + 4 * hi; store_o_tile_pk((unsigned*)OG, o, (long long)((size_t)d * NTOK + rowbase + (d ? L - 1 - s0_ : s0_)), d ? -1 : 1, h * 128 + tn * 32, lane); } \
        _Pragma("unroll") for (int r2 = 0; r2 < 8; ++r2) { S[2 * r2] = DEC[2 * r2] * S[2 * r2] + bflo(UW[r2]); S[2 * r2 + 1] = DEC[2 * r2 + 1] * S[2 * r2 + 1] + bfhi(UW[r2]); } \
        { const int cn_ = (c) + 2 < nch ? (c) + 2 : nch - 1; GLA_SLOAD(OW, UW, DEC, QA, cn_); } \
        LDS_BARRIER(); } while (0)
    for (int c = 0; c < nch; c += 2) {
        GLA_STEP(c, ow, uw, dec, qa);
        GLA_STEP(c + 1, now, nuw, ndec, nqa);
    }
#undef GLA_STEP
#undef GLA_SLOAD
    if (!lat) {
#pragma unroll
        for (int r = 0; r < 16; ++r) POUT[OUT_SG + sbase + (size_t)(tm * 32 + crow(r, hi)) * 128 + tn * 32 + r32] = S[r]; }
}
template <int BLK>
__device__ __forceinline__ void solve_diag(float (&x)[64], const LAS float* Af) {
    float xb[16];
#pragma unroll
    for (int m = 0; m < 16; ++m) xb[m] = x[16 * BLK + m];
    const LAS float* base = Af + (16 * BLK) * 68 + 16 * BLK;
    f32x4 a0[15], a1[11], a2[7], a3[3];
#pragma unroll
    for (int r = 1; r < 16; ++r) a0[r - 1] = *(const LAS f32x4*)(base + r * 68);
#pragma unroll
    for (int r = 5; r < 16; ++r) a1[r - 5] = *(const LAS f32x4*)(base + r * 68 + 4);
#pragma unroll
    for (int k = 0; k < 4; ++k) { asm("" : "+v"(xb[k]));
#pragma unroll
        for (int i = k + 1; i < 16; ++i) xb[i] = __builtin_fmaf(-a0[i - 1][k], xb[k], xb[i]); }
#pragma unroll
    for (int r = 9; r < 16; ++r) a2[r - 9] = *(const LAS f32x4*)(base + r * 68 + 8);
#pragma unroll
    for (int k = 4; k < 8; ++k) { asm("" : "+v"(xb[k]));
#pragma unroll
        for (int i = k + 1; i < 16; ++i) xb[i] = __builtin_fmaf(-a1[i - 5][k - 4], xb[k], xb[i]); }
#pragma unroll
    for (int r = 13; r < 16; ++r) a3[r - 13] = *(const LAS f32x4*)(base + r * 68 + 12);
#pragma unroll
    for (int k = 8; k < 12; ++k) { asm("" : "+v"(xb[k]));
#pragma unroll
        for (int i = k + 1; i < 16; ++i) xb[i] = __builtin_fmaf(-a2[i - 9][k - 8], xb[k], xb[i]); }
#pragma unroll
    for (int k = 12; k < 15; ++k) { asm("" : "+v"(xb[k]));
#pragma unroll
        for (int i = k + 1; i < 16; ++i) xb[i] = __builtin_fmaf(-a3[i - 13][k - 12], xb[k], xb[i]); }
#pragma unroll
    for (int m = 0; m < 16; ++m) { asm("" : "+v"(xb[m])); x[16 * BLK + m] = xb[m]; }
}
template <int BLK>
__device__ __forceinline__ void solve_offdiag(const LAS bf16_t* Ab, const LAS bf16_t* UT, const LAS bf16_t* WT, LAS float* Rb, int wave, int lane) {
    f32x16 acc = {};
    acc = mm_tile<16 * BLK>(Ab, 72, wave < 4 ? UT : WT, 72, BLK >> 1, wave & 3, lane, acc);
    const int r32 = lane & 31, hi = lane >> 5;
#pragma unroll
    for (int r = 0; r < 16; ++r) { const int rr = crow(r, hi) - (BLK & 1) * 16; if (rr >= 0 && rr < 16) Rb[rr * 260 + wave * 32 + r32] = acc[r]; }
}
template <int BLK>
__device__ __forceinline__ void solve_step(float (&x)[64], const LAS float* Af, const LAS bf16_t* Ab, LAS bf16_t* UT, LAS bf16_t* WT, LAS float* Rb, int tid, int wave, int lane) {
    if (BLK > 0) { solve_offdiag<(BLK > 0 ? BLK : 1)>(Ab, UT, WT, Rb, wave, lane); LDS_BARRIER(); }
    if (tid < 256) {
        if (BLK > 0) {
#pragma unroll
            for (int ii = 0; ii < 16; ++ii) { x[16 * BLK + ii] -= Rb[ii * 260 + tid]; asm("" : "+v"(x[16 * BLK + ii])); } }
        solve_diag<BLK>(x, Af);
        LAS bf16_t* dst = (tid < 128 ? UT + tid * 72 : WT + (tid - 128) * 72) + 16 * BLK;
        u32x4 w0, w1; w0.x = pk2(x[16 * BLK], x[16 * BLK + 1]); w0.y = pk2(x[16 * BLK + 2], x[16 * BLK + 3]); w0.z = pk2(x[16 * BLK + 4], x[16 * BLK + 5]); w0.w = pk2(x[16 * BLK + 6], x[16 * BLK + 7]);
        w1.x = pk2(x[16 * BLK + 8], x[16 * BLK + 9]); w1.y = pk2(x[16 * BLK + 10], x[16 * BLK + 11]); w1.z = pk2(x[16 * BLK + 12], x[16 * BLK + 13]); w1.w = pk2(x[16 * BLK + 14], x[16 * BLK + 15]);
        *(LAS u32x4*)(dst) = w0; *(LAS u32x4*)(dst + 8) = w1; }
    if (BLK < 3) LDS_BARRIER();
}
#define SUBA_BEGIN() unsigned long long tsa_ = 0; if (PROBE_SUB >= 10 && PROBE_SUB <= 14 && blockIdx.x == 0) { LDS_BARRIER(); tsa_ = __builtin_amdgcn_s_memrealtime(); }
#define SUBA_END(k) do { if (PROBE_SUB == (k) && blockIdx.x == 0) { LDS_BARRIER(); if (threadIdx.x == 0) *(volatile LAS unsigned long long*)(lds + PTAB_OFF + 320) += __builtin_amdgcn_s_memrealtime() - tsa_; } } while (0)
#define SUBA_MARK() do { if (PROBE_SUB >= 10 && PROBE_SUB <= 14 && blockIdx.x == 0) { LDS_BARRIER(); tsa_ = __builtin_amdgcn_s_memrealtime(); } } while (0)
__device__ __forceinline__ void dn_chunk_unit(ptab_t pt, int unit, LAS unsigned char* lds, const UnitPre& pre) {
    SUBA_BEGIN(); unsigned long long tsa0_ = tsa_;
    const int tid = tid_opaque(), lane = tid & 63, wave = tid >> 6, r32 = lane & 31, hi = lane >> 5;
    unsigned char* ws = PWS;
    const bf16_t* DQKV = (const bf16_t*)(ws + WS_DQKV); const float* GB = (const float*)(ws + WS_GB);
    bf16_t* MC = (bf16_t*)(ws + WS_MC) + (size_t)unit * 16384; unsigned* NC = (unsigned*)(ws + WS_NC) + (size_t)unit * 8192;
    bf16_t* QE = (bf16_t*)(ws + WS_QE) + (size_t)unit * 8192; unsigned* OL = (unsigned*)(ws + WS_OL) + (size_t)unit * 4096;
    const int d = unit & 1, h = (unit >> 1) & 3, slot = unit >> 3;
    const bool lat = slot >= 64; const int b = lat ? (slot - 64) >> 4 : slot >> 2, c = lat ? (slot - 64) & 15 : slot & 3;
    const int L = lat ? 1024 : 256, rowbase = lat ? 4096 + b * 1024 : b * 256;
    LAS bf16_t* Qs = (LAS bf16_t*)lds;
    LAS bf16_t* Ks = Qs + 64 * 136;
    LAS bf16_t* Vs = Ks + 64 * 136;
    LAS float* Af = (LAS float*)(lds + 52224);
    LAS bf16_t* Att = (LAS bf16_t*)(lds + 69632);
    LAS bf16_t* KhT = (LAS bf16_t*)(lds + 78848);
    LAS bf16_t* WT = (LAS bf16_t*)(lds + 97280);
    LAS bf16_t* UT = (LAS bf16_t*)(lds + 115712);
    LAS float* Gs = (LAS float*)(lds + 134144);
    LAS float* Bt = Gs + 64;
    LAS bf16_t* Ab = (LAS bf16_t*)(lds + 134656);
    LAS float* BG = (LAS float*)(lds + 143872);
    LAS float* EG = BG + 64;
    LAS float* Rb = (LAS float*)(lds + 34816);
    { const int i = tid >> 3, c16 = (tid & 7) * 16;
      const u32x4 q0 = pre.r[0], q1 = pre.r[1], k0 = pre.r[2], k1 = pre.r[3], v0 = pre.r[4], v1 = pre.r[5];
      *(LAS u32x4*)(Qs + i * 136 + c16) = q0; *(LAS u32x4*)(Qs + i * 136 + c16 + 8) = q1; *(LAS u32x4*)(Ks + i * 136 + c16) = k0; *(LAS u32x4*)(Ks + i * 136 + c16 + 8) = k1;
      *(LAS u32x4*)(Vs + i * 136 + c16) = v0; *(LAS u32x4*)(Vs + i * 136 + c16 + 8) = v1; }
    if (tid < 64) { float x = pre.f[0]; const float be = pre.f[1];
        { x += dpp_mov<0x111>(x); x += dpp_mov<0x112>(x); x += dpp_mov<0x114>(x); x += dpp_mov<0x118>(x);
          x += __builtin_bit_cast(float, __builtin_amdgcn_update_dpp(0, __builtin_bit_cast(int, x), 0x142, 0xA, 0xF, false));
          x += __builtin_bit_cast(float, __builtin_amdgcn_update_dpp(0, __builtin_bit_cast(int, x), 0x143, 0xC, 0xF, false)); }
        Gs[tid] = x; Bt[tid] = be; { const float eg_ = __expf(x); EG[tid] = eg_; BG[tid] = be * eg_; } }
    LDS_BARRIER();
    { const int w4 = wave & 3, tm = w4 >> 1, tn = w4 & 1; f32x16 acc = {};
      acc = mm_tile<128>(wave < 4 ? Ks : Qs, 136, Ks, 136, tm, tn, lane, acc);
      const int j = tn * 32 + r32; const float Gj = Gs[j];
#pragma unroll
      for (int r = 0; r < 16; ++r) { const int i = tm * 32 + crow(r, hi); const float e = __expf(Gs[i] - Gj);
          if (wave < 4) { const float av = (j < i) ? Bt[i] * acc[r] * e : 0.f; Af[i * 68 + j] = av; Ab[i * 72 + j] = f2bf(av); } else Att[i * 72 + j] = f2bf((j <= i) ? acc[r] * e : 0.f); } }
    LDS_BARRIER();
    SUBA_END(11); SUBA_MARK();
    {
        float x[64];
        if (tid < 128) {
#pragma unroll
            for (int j = 0; j < 64; ++j) x[j] = bf2f(Vs[j * 136 + tid]) * Bt[j];
        } else if (tid < 256) {
#pragma unroll
            for (int j = 0; j < 64; ++j) x[j] = bf2f(Ks[j * 136 + tid - 128]) * BG[j];
        } else {
#pragma unroll
            for (int j = 0; j < 64; ++j) x[j] = 0.f;
            const int t2 = tid - 256, i = t2 >> 2, a0 = (t2 & 3) * 32; const float f = __expf(Gs[63] - Gs[i]);
#pragma unroll
            for (int q = 0; q < 4; ++q) { float kv[8]; unpack8(*(const LAS u32x4*)(Ks + i * 136 + a0 + 8 * q), kv);
#pragma unroll
                for (int e = 0; e < 8; ++e) KhT[(a0 + 8 * q + e) * 72 + i] = f2bf(kv[e] * f); }
        }
#pragma unroll
        for (int j = 0; j < 64; ++j) asm("" : "+v"(x[j]));
        LDS_BARRIER();
        solve_step<0>(x, Af, Ab, UT, WT, Rb, tid, wave, lane);
        solve_step<1>(x, Af, Ab, UT, WT, Rb, tid, wave, lane);
        solve_step<2>(x, Af, Ab, UT, WT, Rb, tid, wave, lane);
        solve_step<3>(x, Af, Ab, UT, WT, Rb, tid, wave, lane);
    }
    LDS_BARRIER();
    SUBA_END(12); SUBA_MARK();
    { const int tn = wave & 3, tmo = wave >> 2; const float eGl = EG[63];
      bf16x8 bu[4], bw[4];
      { const LAS bf16_t* pu = UT + (tn * 32 + r32) * 72 + hi * 8; const LAS bf16_t* pw = WT + (tn * 32 + r32) * 72 + hi * 8;
#pragma unroll
        for (int k = 0; k < 4; ++k) { bu[k] = *(const LAS bf16x8*)(pu + 16 * k); bw[k] = *(const LAS bf16x8*)(pw + 16 * k); } }
      { bf16x8 aa[4]; const LAS bf16_t* pa = Att + (tmo * 32 + r32) * 72 + hi * 8;
#pragma unroll
        for (int k = 0; k < 4; ++k) aa[k] = *(const LAS bf16x8*)(pa + 16 * k);
        f32x16 au = {}, aw = {};
#pragma unroll
        for (int k = 0; k < 4; ++k) { au = __builtin_amdgcn_mfma_f32_32x32x16_bf16(aa[k], bu[k], au, 0, 0, 0); aw = __builtin_amdgcn_mfma_f32_32x32x16_bf16(aa[k], bw[k], aw, 0, 0, 0); }
        acc_store_pk(OL + wave * 512, au, lane);
#pragma unroll
        for (int r = 0; r < 16; ++r) { const int i = tmo * 32 + crow(r, hi), a = tn * 32 + r32; QE[i * 128 + a] = f2bf(bf2f(Qs[i * 136 + a]) * EG[i] - aw[r]); } }
#pragma unroll
      for (int q = 0; q < 2; ++q) { const int tm = tmo + 2 * q;
        bf16x8 aa[4]; const LAS bf16_t* pa = KhT + (tm * 32 + r32) * 72 + hi * 8;
#pragma unroll
        for (int k = 0; k < 4; ++k) aa[k] = *(const LAS bf16x8*)(pa + 16 * k);
        f32x16 au = {}, aw = {};
#pragma unroll
        for (int k = 0; k < 4; ++k) { au = __builtin_amdgcn_mfma_f32_32x32x16_bf16(aa[k], bu[k], au, 0, 0, 0); aw = __builtin_amdgcn_mfma_f32_32x32x16_bf16(aa[k], bw[k], aw, 0, 0, 0); }
        acc_store_pk(NC + (tm * 4 + tn) * 512, au, lane);
#pragma unroll
        for (int r = 0; r < 16; ++r) { const int a = tm * 32 + crow(r, hi), a2 = tn * 32 + r32; MC[a * 128 + a2] = f2bf((a == a2 ? eGl : 0.f) - aw[r]); } } }
    LDS_BARRIER();
    SUBA_END(13); tsa_ = tsa0_; SUBA_END(10);
    if (PROBE_SUB == 14 && blockIdx.x == 0 && threadIdx.x == 0) *(volatile LAS unsigned long long*)(lds + PTAB_OFF + 320) += 1000;
}
__device__ __forceinline__ void dn_scan_item(ptab_t pt, int l, bool lat, int b, int h, int d, int vh, LAS unsigned char* lds) {
    const int tid = tid_opaque(), lane = tid & 63, wave = tid >> 6, r32 = lane & 31, hi = lane >> 5;
    unsigned char* ws = PWS;
    float* OD = (float*)(ws + WS_OD);
    const int L = lat ? 1024 : 256, rowbase = lat ? 4096 + b * 1024 : b * 256, nch = L >> 6, slot0 = lat ? 64 + b * 16 : b * 4;
    const int tm = wave & 3, tnl = wave >> 2, tn = vh * 2 + tnl;
    const bool ow_ = wave < 4; const int tmo = wave & 1, tnlo = (wave >> 1) & 1, tno = vh * 2 + tnlo;
    LAS bf16_t* ST = (LAS bf16_t*)lds;
    LAS bf16_t* AMb = (LAS bf16_t*)(lds + 34816);
    f32x16 S;
    const size_t sbase = ((((size_t)b * 2 + l) * 2 + d) * 4 + h) * 16384;
#pragma unroll
    for (int r = 0; r < 16; ++r) S[r] = lat ? __builtin_nontemporal_load(PIN(5) + sbase + (size_t)(tm * 32 + crow(r, hi)) * 128 + tn * 32 + r32) : 0.f;
    u32x4 stg[6], stg2[6]; unsigned ow[8], n0[8], now[8], nn0[8];
#define DN_GLOAD(STG, cc) do { const int unit_ = ((slot0 + (cc)) * 4 + h) * 2 + d; const bf16_t* mc_ = (const bf16_t*)(ws + WS_MC) + (size_t)unit_ * 16384; const bf16_t* qe_ = (const bf16_t*)(ws + WS_QE) + (size_t)unit_ * 8192; \
        _Pragma("unroll") for (int j_ = 0; j_ < 4; ++j_) STG[j_] = *(const u32x4*)(mc_ + (size_t)(tid + 512 * j_) * 8); \
        _Pragma("unroll") for (int j_ = 0; j_ < 2; ++j_) STG[4 + j_] = *(const u32x4*)(qe_ + (size_t)(tid + 512 * j_) * 8); } while (0)
#define DN_TLOAD(OW, N0, cc) do { const int unit_ = ((slot0 + (cc)) * 4 + h) * 2 + d; \
        acc_load_pk((const unsigned*)(ws + WS_OL) + (size_t)unit_ * 4096 + (tmo * 4 + tno) * 512, OW, lane); acc_load_pk((const unsigned*)(ws + WS_NC) + (size_t)unit_ * 8192 + (tm * 4 + tn) * 512, N0, lane); } while (0)
#define DN_SWRITE(buf) do { LAS bf16_t* am_ = AMb + (buf) * 26112; LAS bf16_t* aq_ = am_ + 128 * 136; \
        _Pragma("unroll") for (int j_ = 0; j_ < 4; ++j_) { const int q_ = tid + 512 * j_; *(LAS u32x4*)(am_ + (q_ >> 4) * 136 + (q_ & 15) * 8) = stg[j_]; } \
        _Pragma("unroll") for (int j_ = 0; j_ < 2; ++j_) { const int q_ = tid + 512 * j_; *(LAS u32x4*)(aq_ + (q_ >> 4) * 136 + (q_ & 15) * 8) = stg[4 + j_]; } } while (0)
    DN_GLOAD(stg, 0);
    DN_TLOAD(ow, n0, 0); DN_TLOAD(now, nn0, 1);
    DN_GLOAD(stg2, 1);
    DN_SWRITE(0);
    DN_GLOAD(stg, (nch > 2 ? 2 : 1));
#define DN_STEP(c, OW, N0, STGN, STGNAME_IS_STG2) do { \
        acc_to_ST(ST, 136, tm * 32, tnl * 32, S, lane); \
        LDS_BARRIER(); \
        const LAS bf16_t* am = AMb + ((c) & 1) * 26112; const LAS bf16_t* aq = am + 128 * 136; \
        _Pragma("unroll") for (int r2 = 0; r2 < 8; ++r2) { S[2 * r2] = bflo(N0[r2]); S[2 * r2 + 1] = bfhi(N0[r2]); } \
        f32x16 o; \
        if (ow_) { _Pragma("unroll") for (int r2 = 0; r2 < 8; ++r2) { o[2 * r2] = bflo(OW[r2]); o[2 * r2 + 1] = bfhi(OW[r2]); } } \
        { const int cn_ = (c) + 2 < nch ? (c) + 2 : nch - 1; DN_TLOAD(OW, N0, cn_); }     \
        if (ow_) { o = mm_tile<128>(aq, 136, ST, 136, tmo, tnlo, lane, o); \
            const int s0_ = (c) * 64 + tmo * 32 + 4 * hi; store_o_tile_pk((unsigned*)OD, o, (long long)((size_t)d * NTOK + rowbase + (d ? L - 1 - s0_ : s0_)), d ? -1 : 1, h * 128 + tno * 32, lane); } \
        S = mm_tile<128>(am, 136, ST, 136, tm, tnl, lane, S); \
        { LAS bf16_t* am_ = AMb + (((c) + 1) & 1) * 26112; LAS bf16_t* aq_ = am_ + 128 * 136;     \
          _Pragma("unroll") for (int j_ = 0; j_ < 4; ++j_) { const int q_ = tid + 512 * j_; *(LAS u32x4*)(am_ + (q_ >> 4) * 136 + (q_ & 15) * 8) = STGN[j_]; } \
          _Pragma("unroll") for (int j_ = 0; j_ < 2; ++j_) { const int q_ = tid + 512 * j_; *(LAS u32x4*)(aq_ + (q_ >> 4) * 136 + (q_ & 15) * 8) = STGN[4 + j_]; } } \
        { const int cn_ = (c) + 3 < nch ? (c) + 3 : nch - 1; DN_GLOAD(STGN, cn_); }     \
        LDS_BARRIER(); } while (0)
    for (int c = 0; c < nch; c += 2) {
        DN_STEP(c, ow, n0, stg2, 1);
        DN_STEP(c + 1, now, nn0, stg, 0);
    }
#undef DN_STEP
#undef DN_GLOAD
#undef DN_TLOAD
#undef DN_SWRITE
    if (!lat) {
#pragma unroll
        for (int r = 0; r < 16; ++r) POUT[OUT_SD + sbase + (size_t)(tm * 32 + crow(r, hi)) * 128 + tn * 32 + r32] = S[r]; }
}
__device__ __forceinline__ void mixer1_phase(ptab_t pt, int l, unsigned char* lds_generic, int bid, int nb, int rep) {
    LAS unsigned char* l3 = (LAS unsigned char*)lds_generic;
    LAS int* qslot = (LAS int*)(l3 + PTAB_OFF + 272);
    unsigned* qctr = (unsigned*)(PWS + WS_QUEUE) + (l * 4 + rep) * 64;
    constexpr int N_ITEMS = 2048;
    int it = bid, itn = bid + nb;
    UnitPre pc, pn;
    if (it < N_ITEMS) { if (it < 1024) dn_unit_load(pt, it, pc); else gla_unit_load(pt, it - 1024, pc); }
    while (it < N_ITEMS) {
        int nxt2 = 0;
        if (threadIdx.x == 0) nxt2 = 2 * nb + (int)atomicAdd(qctr, 1u);
        if (itn < N_ITEMS) { if (itn < 1024) dn_unit_load(pt, itn, pn); else gla_unit_load(pt, itn - 1024, pn); }
        if (it < 1024) { for (int q_ = 0; q_ < (PROBE_DUP == 8 ? 2 : 1); ++q_) dn_chunk_unit(pt, it, l3, pc); }
        else { for (int q_ = 0; q_ < (PROBE_DUP == 9 ? 2 : 1); ++q_) gla_chunk_unit(pt, it - 1024, l3, pc); }
        LDS_BARRIER();
        if (threadIdx.x == 0) *qslot = nxt2;
        LDS_BARRIER();
        it = itn; itn = *qslot;
#pragma unroll
        for (int q = 0; q < 6; ++q) pc.r[q] = pn.r[q];
        pc.f[0] = pn.f[0]; pc.f[1] = pn.f[1];
    }
}
__device__ __forceinline__ void mixer2_phase(ptab_t pt, int l, unsigned char* lds_generic, int bid, int nb, int rep) {
    LAS unsigned char* l3 = (LAS unsigned char*)lds_generic;
    LAS int* qslot = (LAS int*)(l3 + PTAB_OFF + 272);
    unsigned* qctr = (unsigned*)(PWS + WS_QUEUE) + (l * 4 + 2 + rep) * 64;
    const int n_tr = (l == 0 && rep == 0) ? (TI_OUT + TI_F1) / 8 : 0;
    const int N_ITEMS = 736 + n_tr;
    int it = bid;
    while (it < N_ITEMS) {
        int nxt = 0;
        if (threadIdx.x == 0) nxt = nb + (int)atomicAdd(qctr, 1u);
        if (it < 128 || (it >= 224 && it < 352)) {
            unsigned char* ws = PWS;
            const bf16_t* QN = (const bf16_t*)(ws + WS_QN); const bf16_t* KB = (const bf16_t*)(ws + WS_KB); const bf16_t* VB = (const bf16_t*)(ws + WS_VB); bf16_t* MIX = (bf16_t*)(ws + WS_MIX);
            const bool lat = it < 128; const int i = lat ? it : it - 224;
            const int b = lat ? i >> 5 : i >> 3, h = lat ? (i >> 2) & 7 : i & 7, qb = lat ? i & 3 : 0;
            const size_t row0 = lat ? 4096 + (size_t)b * 1024 + qb * 256 : (size_t)b * 256;
            const size_t krow0 = lat ? (size_t)4096 + (size_t)b * 1280 : (size_t)b * 256;
            att::attn_dense_body<1024, 256, 2048>(QN + row0 * 1024 + h * 128, KB + krow0 * 256 + (h >> 2) * 128, VB + krow0 * 256 + (h >> 2) * 128, MIX + row0 * 2048 + 512 + h * 128, lat ? 1280 : 256, (char*)lds_generic);
        } else if (it < 192 || (it >= 352 && it < 608)) { const bool lat = it < 192; const int j = lat ? it - 128 : it - 352; const int vh = j & 1, q = j >> 1;
            dn_scan_item(pt, l, lat, q >> 3, (q >> 1) & 3, q & 1, vh, l3);
        } else if (it < 736) { const bool lat = it < 224; const int q = lat ? it - 192 : it - 608;
            gla_scan_item(pt, l, lat, q >> 3, (q >> 1) & 3, q & 1, l3);
        } else { const int wv = __builtin_amdgcn_readfirstlane((int)threadIdx.x >> 6);
            do_transposes(pt, l3, TI_L + TI_IN + (it - 736) * 8, 8, wv, 8);
        }
        LDS_BARRIER();
        if (threadIdx.x == 0) *qslot = nxt;
        LDS_BARRIER();
        it = *qslot;
    }
}

__device__ __forceinline__ void postmix_phase(ptab_t pt, int l, int bid, int nb) {
    const int tid = tid_opaque(), lane = tid & 63, wave = tid >> 6, sub = lane & 15;
    unsigned char* ws = PWS;
    const bf16_t* P = (const bf16_t*)(ws + WS_P); const unsigned* OG = (const unsigned*)(ws + WS_OG); const unsigned* OD = (const unsigned*)(ws + WS_OD); bf16_t* MIX = (bf16_t*)(ws + WS_MIX);
    const float* ggp = PIN(15) + l * 128 + sub * 8; const float* dgp = PIN(21) + l * 128 + sub * 8;
    constexpr int NT = 4;
#pragma unroll 1
    for (int r0 = bid * 8 + wave; r0 < NTOK / NT; r0 += nb * 8) {
#pragma unroll
        for (int part = 0; part < 2; ++part) {
            const unsigned* O = part ? OD : OG; const int gc = part ? 4608 : 1024, mc = part ? 1536 : 0;
            u32x4 p[NT], q[NT], z[NT];
#pragma unroll
            for (int u = 0; u < NT; ++u) { const size_t r = (size_t)(r0 + u * (NTOK / NT));
                p[u] = __builtin_nontemporal_load((const u32x4*)(O + r * 256 + lane * 4)); q[u] = __builtin_nontemporal_load((const u32x4*)(O + ((size_t)NTOK + r) * 256 + lane * 4)); z[u] = __builtin_nontemporal_load((const u32x4*)(P + r * PLD + gc + lane * 8)); }
            float a[NT][8], ss[NT];
#pragma unroll
            for (int u = 0; u < NT; ++u) { float x[8], y[8]; unpack8(p[u], x); unpack8(q[u], y); float s = 0.f;
#pragma unroll
                for (int e = 0; e < 8; ++e) { a[u][e] = x[e] + y[e]; s += a[u][e] * a[u][e]; }
                ss[u] = s; }
            group16_sum_n<NT>(ss);
            float gn[8]; { const float* gp = part ? dgp : ggp; const f32x4 g0 = *(const f32x4*)gp, g1 = *(const f32x4*)(gp + 4);
#pragma unroll
                for (int e = 0; e < 4; ++e) { gn[e] = g0[e]; gn[4 + e] = g1[e]; } }
#pragma unroll
            for (int u = 0; u < NT; ++u) { const size_t r = (size_t)(r0 + u * (NTOK / NT)); const float rstd = rsqrtf(ss[u] * (1.f / 128.f) + EPS); float zz[8], o[8]; unpack8(z[u], zz);
#pragma unroll
                for (int e = 0; e < 8; ++e) o[e] = a[u][e] * rstd * gn[e] * silu_f(zz[e]);
                *(u32x4*)(MIX + r * 2048 + mc + lane * 8) = pack8(o); }
        }
    }
}

#define RLX_AGENT __ATOMIC_RELAXED, __HIP_MEMORY_SCOPE_AGENT
#define XB_TMO      128
#define XB_XCNT(j)  (256  + 64 * (j))
#define XB_XSUB(j)  (1280 + 64 * (j))
#define XB_XGEN(j)  (2304 + 64 * (j))
#define XB_TOP      3328
#define XB_TOPGEN   3392
#define XCD_BAR_WORDS 3456
#define XB_SPIN_CAP (1u << 18)

__device__ __forceinline__ unsigned xb_ld(unsigned* p)              { return __hip_atomic_load(p, __ATOMIC_RELAXED, __HIP_MEMORY_SCOPE_AGENT); }
__device__ __forceinline__ unsigned xb_add(unsigned* p, unsigned v) { return __hip_atomic_fetch_add(p, v, __ATOMIC_RELAXED, __HIP_MEMORY_SCOPE_AGENT); }
__device__ __forceinline__ unsigned xb_xcc_id() { return (unsigned)__builtin_amdgcn_s_getreg((3 << 11) | 20) & 0xFu; }
#define XB_SPIN(cond, bar) do { unsigned _sp = 0; while (cond) { __builtin_amdgcn_s_sleep(1); \
    if ((++_sp & 255u) == 0u) { if (xb_ld(&(bar)[XB_TMO])) break; if (_sp > XB_SPIN_CAP) { atomicAdd(&(bar)[XB_TMO], 1u); break; } } } } while (0)

struct XcdBarrier {
    unsigned* bar; unsigned x;
    volatile LAS unsigned* st;
};

__device__ __forceinline__ XcdBarrier xcd_barrier_post(unsigned* bar, volatile LAS unsigned* st) {
    XcdBarrier b; b.bar = bar; b.x = xb_xcc_id(); b.st = st;
    if (threadIdx.x == 0) (void)xb_add(&bar[XB_XCNT(b.x)], 1u);
    return b;
}
__device__ __forceinline__ void xcd_barrier_complete(unsigned* bar, unsigned x, unsigned& nloc, unsigned& nx) {
    const unsigned G = gridDim.x * gridDim.y * gridDim.z;
    unsigned sum, cnt, mine, sp = 0u;
    for (;;) {
        sum = 0u; cnt = 0u; mine = 0u;
#pragma unroll
        for (unsigned j = 0; j < 16; ++j) { const unsigned c = xb_ld(&bar[XB_XCNT(j)]); sum += c; cnt += (c > 0u) ? 1u : 0u; mine = (j == x) ? c : mine; }
        if (sum == G) break;
        __builtin_amdgcn_s_sleep(1);
        if ((++sp & 255u) == 0u) { if (xb_ld(&bar[XB_TMO])) break; if (sp > XB_SPIN_CAP) { atomicAdd(&bar[XB_TMO], 1u); break; } }
    }
    nloc = mine > 0u ? mine : 1u; nx = cnt > 0u ? cnt : 1u;
}

__device__ __forceinline__ void xcd_barrier(const XcdBarrier& b) {
    asm volatile("s_waitcnt vmcnt(0)" ::: "memory");
    __syncthreads();
    if (threadIdx.x == 0) {
        unsigned* bar = b.bar;
        __builtin_amdgcn_s_waitcnt(0);
        unsigned nloc = b.st[0], nx = b.st[1];
        if (nloc == 0u) { xcd_barrier_complete(bar, b.x, nloc, nx); b.st[0] = nloc; b.st[1] = nx; }
        const unsigned old = xb_add(&bar[XB_XSUB(b.x)], 1u);
        const unsigned gen = old / nloc;
        if (old + 1u == (gen + 1u) * nloc) {
            __builtin_amdgcn_fence(__ATOMIC_RELEASE, "agent");
            asm volatile("s_waitcnt vmcnt(0)" ::: "memory");
            const unsigned og = xb_add(&bar[XB_TOP], 1u);
            const unsigned tg = og / nx;
            if (og + 1u == (tg + 1u) * nx) xb_add(&bar[XB_TOPGEN], 1u);
            else XB_SPIN(xb_ld(&bar[XB_TOPGEN]) == tg, bar);
            __builtin_amdgcn_fence(__ATOMIC_ACQUIRE, "agent");
            xb_add(&bar[XB_XGEN(b.x)], 1u);
            asm volatile("s_waitcnt vmcnt(0)" ::: "memory");
        } else {
            XB_SPIN(xb_ld(&bar[XB_XGEN(b.x)]) == gen, bar);
            __builtin_amdgcn_fence(__ATOMIC_ACQUIRE, "agent");
            asm volatile("s_waitcnt vmcnt(0)" ::: "memory");
        }
    }
    __syncthreads();
}

__global__ void __launch_bounds__(512, 2) mega(Params p) {
    extern __shared__ __attribute__((aligned(16))) unsigned char lds[];
    cg::grid_group grid = cg::this_grid();
    const int bid = blockIdx.x, nb = gridDim.x;
    LAS unsigned char* l3 = (LAS unsigned char*)lds;
    ptab_t pt = (ptab_t)(l3 + PTAB_OFF);
    if (threadIdx.x < 27) { const int i = threadIdx.x; const void* v = i < 25 ? (const void*)p.in[i] : (i == 25 ? (const void*)p.out : (const void*)p.ws);
        ((LAS unsigned long long*)(l3 + PTAB_OFF))[i] = (unsigned long long)v; }
    if (threadIdx.x < 2) ((LAS unsigned*)(l3 + PTAB_OFF + 256))[threadIdx.x] = 0u;
    if (PROBE_SUB != 0 && threadIdx.x == 0) *(volatile LAS unsigned long long*)(l3 + PTAB_OFF + 320) = 0;
    __syncthreads();
    { unsigned* ctl = (unsigned*)PWS; for (int i = bid * 512 + (int)threadIdx.x; i < 262144; i += nb * 512) ctl[i] = 0u; }
#define TSTAMP() do { if (PROBE_MASK != 0u && blockIdx.x == 0 && threadIdx.x == 0) { volatile LAS unsigned long long* ts_ = (volatile LAS unsigned long long*)(l3 + PTAB_OFF + 288); \
        const unsigned long long now_ = __builtin_amdgcn_s_memrealtime(); const unsigned s_ = (unsigned)ts_[2]; if ((PROBE_MASK >> s_) & 1u) ts_[1] += now_ - ts_[0]; ts_[0] = now_; ts_[2] = s_ + 1; } } while (0)
#define GSYNC() do { xcd_barrier(xbar); TSTAMP(); } while (0)
    if (PROBE_MASK != 0u && blockIdx.x == 0 && threadIdx.x == 0) { volatile LAS unsigned long long* ts_ = (volatile LAS unsigned long long*)(l3 + PTAB_OFF + 288); ts_[0] = __builtin_amdgcn_s_memrealtime(); ts_[1] = 0; ts_[2] = 0; }
    p0_prologue(pt, l3, bid, nb, true);
    asm volatile("s_waitcnt vmcnt(0)" ::: "memory"); __syncthreads();
    grid.sync();
    XcdBarrier xbar = xcd_barrier_post((unsigned*)PWS + 1024, (volatile LAS unsigned*)(l3 + PTAB_OFF + 256));
    TSTAMP();
    if (PROBE_DUP == 3) { p0_prologue(pt, l3, bid, nb, false); }
    if (PROBE_DUP == 5) { for (int i = 0; i < 20; ++i) GSYNC(); }
#define REP(code) for (int rep_ = 0; rep_ < ((PROBE_DUP == (code)) ? 2 : 1); ++rep_)
#pragma unroll 1
    for (int l = 0; l < 2; ++l) {
        if (l == 0) { REP(4) { unsigned char* ws = PWS; const float* mods_l = (const float*)(ws + WS_MODS);
          norm_phase(PIN(0), PIN(1) - (size_t)4096 * DM, PIN(8), mods_l, 0, 1, (bf16_t*)(ws + WS_H), bid, nb);
          GSYNC(); } }
        REP(2) { unsigned char* ws = PWS; pg8::Gemm g{(const bf16_t*)(ws + WS_H), (const bf16_t*)(ws + WS_WIN) + (size_t)l * PNW * 2048, NTOK, PNW, 2048}; pg8::StaticOrder S; S.init(NTOK, PNW, nb, bid, WGM_IN);
          pg8::EpiP E{(bf16_t*)(ws + WS_P), (float*)(ws + WS_G), l == 0 ? (const float*)nullptr : (const float*)(ws + WS_RS) + 8192 * RSS, (const float*)(ws + WS_BIAS) + 5 * 8192};
          pg8::gemm_phase<pg8::EpiP, pg8::StaticOrder, true, true>(l3, g, S, E);
          if (rep_ == 0 && bid + 2 * nb >= 672) { const int nidle = nb - (672 - 2 * nb); const int wv = __builtin_amdgcn_readfirstlane((int)threadIdx.x >> 6);
              __syncthreads();
              if (l == 0) do_transposes(pt, l3, TI_L, TI_IN, (bid - (672 - 2 * nb)) * 8 + wv, nidle * 8);
              else do_transposes(pt, l3, TI_L + TI_IN + TI_OUT + TI_F1 + TI_F2 / 4, TI_F2 - TI_F2 / 4, (bid - (672 - 2 * nb)) * 8 + wv, nidle * 8);
              __syncthreads();
              bias_phase((const float*)(ws + WS_MODS) + (size_t)l * 5 * NMOD + 3 * DM, (const bf16_t*)(ws + WS_WFF1) + (size_t)l * FFD * 2048, FFD, (float*)(ws + WS_BIAS) + (l == 0 ? 0 : 10 * 8192), l3, bid - (672 - 2 * nb), nidle); }
          GSYNC(); }
        REP(4) { prep_phase(pt, l, l3, bid, nb);
          if (l == 0 && rep_ == 0) { unsigned char* ws = PWS; __syncthreads();
              bias_phase((const float*)(ws + WS_MODS) + (size_t)5 * NMOD, (const bf16_t*)(ws + WS_WIN) + (size_t)PNW * 2048, PNW, (float*)(ws + WS_BIAS) + 5 * 8192, l3, bid, nb); }
          GSYNC(); }
        REP(6) { mixer1_phase(pt, l, lds, bid, nb, rep_);
          GSYNC(); }
        REP(7) { mixer2_phase(pt, l, lds, bid, nb, rep_);
          GSYNC(); }
        REP(4) { postmix_phase(pt, l, bid, nb);
          GSYNC(); }
        REP(2) { unsigned char* ws = PWS; const float* mods_l = (const float*)(ws + WS_MODS) + (size_t)l * 5 * NMOD;
          const void* xin0 = l == 0 ? (const void*)PIN(0) : (const void*)(ws + WS_XB); const void* xin1 = l == 0 ? (const void*)(PIN(1) - (size_t)4096 * DM) : (const void*)(ws + WS_XB);
          pg8::Gemm g{(const bf16_t*)(ws + WS_MIX), (const bf16_t*)(ws + WS_WOUT) + (size_t)l * 2048 * 2048, NTOK, 2048, 2048}; pg8::StaticOrder S; S.init(NTOK, 2048, nb, bid, WGM_OUT);
          pg8::EpiRes E{xin0, xin1, (void*)(ws + WS_XA), mods_l + 2 * DM, rep_ == 0 ? (bf16_t*)(ws + WS_H) : (bf16_t*)nullptr, PIN(9) + l * DM, mods_l + 4 * DM, (float*)(ws + WS_RS) + (l == 0 ? 0 : 2 * 8192 * RSS), l == 0 ? 0 : 1, 1};
          pg8::gemm_phase<pg8::EpiRes, pg8::StaticOrder, true, true>(l3, g, S, E);
          GSYNC(); }
        REP(2) { unsigned char* ws = PWS; pg8::Gemm g{(const bf16_t*)(ws + WS_H), (const bf16_t*)(ws + WS_WFF1) + (size_t)l * 8192 * 2048, NTOK, FFD, 2048}; pg8::StaticOrder S; S.init(NTOK, FFD, nb, bid, WGM_F1);
          pg8::EpiSqRelu E{(bf16_t*)(ws + WS_H2), FFD, (const float*)(ws + WS_RS) + (l == 0 ? 0 : 2 * 8192 * RSS), (const float*)(ws + WS_BIAS) + (l == 0 ? 0 : 10 * 8192)};
          pg8::gemm_phase<pg8::EpiSqRelu, pg8::StaticOrder, true, true>(l3, g, S, E);
          GSYNC(); }
        REP(2) { unsigned char* ws = PWS; const float* mods_l = (const float*)(ws + WS_MODS) + (size_t)l * 5 * NMOD; const float* XA = (const float*)(ws + WS_XA);
          pg8::Gemm g{(const bf16_t*)(ws + WS_H2), (const bf16_t*)(ws + WS_WFF2) + (size_t)l * 2048 * 8192, NTOK, 2048, FFD}; pg8::StaticOrder S; S.init(NTOK, 2048, nb, bid, WGM_F2);
          pg8::EpiRes E{(const void*)XA, (const void*)XA, l == 0 ? (void*)(ws + WS_XB) : (void*)(POUT + OUT_Y), mods_l + 5 * DM, (l == 0 && rep_ == 0) ? (bf16_t*)(ws + WS_H) : (bf16_t*)nullptr, PIN(8) + DM, mods_l + 5 * NMOD + 1 * DM, (float*)(ws + WS_RS) + 8192 * RSS, 1, l == 0 ? 1 : 0};
          pg8::gemm_phase<pg8::EpiRes, pg8::StaticOrder, true, true>(l3, g, S, E);
          if (l == 0 || rep_ + 1 < ((PROBE_DUP == 2) ? 2 : 1)) GSYNC(); }
    }
    if (PROBE_SUB != 0) { __syncthreads(); if (blockIdx.x == 0 && threadIdx.x == 0) { const unsigned long long t0_ = __builtin_amdgcn_s_memrealtime(), w_ = *(volatile LAS unsigned long long*)(l3 + PTAB_OFF + 320);
            while (__builtin_amdgcn_s_memrealtime() - t0_ < w_) __builtin_amdgcn_s_sleep(8); } }
    if (PROBE_MASK != 0u) { __syncthreads(); TSTAMP();
        if (blockIdx.x == 0 && threadIdx.x == 0) { volatile LAS unsigned long long* ts_ = (volatile LAS unsigned long long*)(l3 + PTAB_OFF + 288); const unsigned long long t0_ = __builtin_amdgcn_s_memrealtime(), w_ = ts_[1];
            while (__builtin_amdgcn_s_memrealtime() - t0_ < w_) __builtin_amdgcn_s_sleep(8); } }
}

extern "C" void kernel_launch(void* const* d_in, const int* in_sizes, int n_in, void* d_out, int out_size, void* d_ws, size_t ws_size, hipStream_t stream) {
    static int grid_blocks = 0;
    if (grid_blocks == 0) {
        if (n_in != 25 || out_size != (int)OUT_TOTAL || ws_size < WS_END) { fprintf(stderr, "kernel_launch: unexpected shapes: n_in %d out %d ws %zu (need %zu)\n", n_in, out_size, ws_size, (size_t)WS_END); grid_blocks = -1; return; }
        int dev = 0, cus = 0, per_cu = 0;
        if (hipGetDevice(&dev) != hipSuccess || hipDeviceGetAttribute(&cus, hipDeviceAttributeMultiprocessorCount, dev) != hipSuccess) { grid_blocks = -1; return; }
        if (hipFuncSetAttribute((const void*)mega, hipFuncAttributeMaxDynamicSharedMemorySize, LDS_BYTES) != hipSuccess) { fprintf(stderr, "kernel_launch: hipFuncSetAttribute failed\n"); grid_blocks = -1; return; }
        if (hipOccupancyMaxActiveBlocksPerMultiprocessor(&per_cu, (const void*)mega, 512, LDS_BYTES) != hipSuccess || per_cu < 1) { fprintf(stderr, "kernel_launch: occupancy query says %d blocks per CU\n", per_cu); (void)hipGetLastError(); grid_blocks = -1; return; }
        grid_blocks = cus;
    }
    if (grid_blocks < 0) return;
    Params p{};
    for (int i = 0; i < 25; ++i) p.in[i] = (const float*)d_in[i];
    p.out = (float*)d_out; p.ws = (unsigned char*)d_ws;
    void* args[] = {&p};
    const hipError_t e = hipLaunchCooperativeKernel((void*)mega, dim3(grid_blocks), dim3(512), args, LDS_BYTES, stream);
    if (e != hipSuccess) fprintf(stderr, "kernel_launch: cooperative launch failed: %s (grid %d)\n", hipGetErrorString(e), grid_blocks);
}
```
